# Optimizing an MI355X kernel written in HIP

```python
import math
import jax, jax.numpy as jnp
from jax import lax
import numpy as np

D_MODEL = 1024
BATCH = 16
SEQ = 2048
DEPTH = 1

DN_HEADS = 4
DN_DK = 128
DN_DV = 128
CONV_K = 4
CHUNK = 64
DSA_HEADS = 8
DSA_DH = 64
Q_RANK = 256
KV_RANK = 128
IDX_HEADS = 8
IDX_DIM = 64
TOPK_MAX = 256
Q_BLOCK = 128
NUM_BUCKETS = 32
MAX_DISTANCE = 128
MEM_LEN = 256
X_HEADS = 4
X_DH = D_MODEL // X_HEADS
D_FF = -(-8 * D_MODEL // (3 * 256)) * 256
EPS = 1e-6
DN_QK_W = DN_HEADS * DN_DK
DN_V_W = DN_HEADS * DN_DV
PROJ_SIZES = (DN_QK_W, DN_QK_W, DN_V_W, DN_V_W, DN_HEADS, DN_HEADS, Q_RANK, KV_RANK, IDX_DIM, IDX_HEADS)
PROJ_OUT = sum(PROJ_SIZES)
MIX_WIDTH = DN_V_W + DSA_HEADS * DSA_DH

kernel_name = 'hybrid_gdn_dsa_block'


def rmsnorm(x, g):
    xf = x.astype(jnp.float32)
    y = xf * lax.rsqrt(jnp.mean(xf * xf, axis=-1, keepdims=True) + EPS)
    return (y * g.astype(jnp.float32)).astype(x.dtype)


def layernorm(x, g, b):
    xf = x.astype(jnp.float32)
    mu = jnp.mean(xf, axis=-1, keepdims=True)
    xc = xf - mu
    y = xc * lax.rsqrt(jnp.mean(xc * xc, axis=-1, keepdims=True) + EPS)
    return (y * g.astype(jnp.float32) + b.astype(jnp.float32)).astype(x.dtype)


def l2norm(x):
    xf = x.astype(jnp.float32)
    return (xf * lax.rsqrt(jnp.sum(xf * xf, axis=-1, keepdims=True) + EPS)).astype(x.dtype)


def causal_depthwise_conv(x, w):
    width = w.shape[0]
    return lax.conv_general_dilated(
        x, w[:, None, :].astype(x.dtype), window_strides=(1,), padding=[(width - 1, 0)],
        dimension_numbers=('NWC', 'WIO', 'NWC'), feature_group_count=x.shape[-1])


def relative_bucket(dist):
    max_exact = NUM_BUCKETS // 2
    d = jnp.maximum(dist, 0)
    log_ratio = jnp.log(jnp.maximum(d, max_exact).astype(jnp.float32) / max_exact) / math.log(MAX_DISTANCE / max_exact)
    large = max_exact + (log_ratio * (NUM_BUCKETS - max_exact)).astype(jnp.int32)
    return jnp.where(d < max_exact, d, jnp.minimum(large, NUM_BUCKETS - 1))


def gated_delta_rule_chunked(q, k, v, beta, g):
    b, s, nh, dk = q.shape
    dv = v.shape[-1]
    nc = s // CHUNK
    f32 = jnp.float32

    def chunks(t):
        return jnp.moveaxis(t.astype(f32).reshape(b, nc, CHUNK, nh, *t.shape[3:]), 3, 1)

    q, k, v, beta, g = chunks(q), chunks(k), chunks(v), chunks(beta), chunks(g)
    g_cum = jnp.cumsum(g, axis=-1)
    pos = jnp.arange(CHUNK)
    incl = pos[:, None] >= pos[None, :]
    strict = pos[:, None] > pos[None, :]
    decay = jnp.exp(jnp.where(incl, g_cum[..., :, None] - g_cum[..., None, :], -jnp.inf))
    kk = jnp.einsum('bhncd,bhnmd->bhncm', k, k)
    a_mat = jnp.where(strict, beta[..., :, None] * kk * decay, 0.0) + jnp.eye(CHUNK, dtype=f32)
    rhs = jnp.concatenate([v * beta[..., None], k * (beta * jnp.exp(g_cum))[..., None]], axis=-1)
    sol = lax.linalg.triangular_solve(a_mat, rhs, left_side=True, lower=True, unit_diagonal=True)
    u, w = sol[..., :dv], sol[..., dv:]
    qk = jnp.where(incl, jnp.einsum('bhncd,bhnmd->bhncm', q, k) * decay, 0.0)
    q_dec = q * jnp.exp(g_cum)[..., None]
    k_dec = k * jnp.exp(g_cum[..., -1:] - g_cum)[..., None]
    last = jnp.exp(g_cum[..., -1])

    def step(state, xs):
        u_c, w_c, qk_c, qd_c, kd_c, last_c = xs
        v_new = u_c - jnp.einsum('bhcd,bhde->bhce', w_c, state)
        o_c = jnp.einsum('bhcd,bhde->bhce', qd_c, state) + jnp.einsum('bhcm,bhme->bhce', qk_c, v_new)
        state = state * last_c[..., None, None] + jnp.einsum('bhcd,bhce->bhde', kd_c, v_new)
        return state, o_c

    xs = tuple(jnp.moveaxis(t, 2, 0) for t in (u, w, qk, q_dec, k_dec, last))
    _, o = lax.scan(step, jnp.zeros((b, nh, dk, dv), f32), xs)
    return jnp.transpose(o, (1, 0, 3, 2, 4)).reshape(b, s, nh, dv)


def dsa_sparse_attention(q_abs, c_kv, q_idx, w_idx, k_idx, rel_bias):
    b, s = c_kv.shape[:2]
    k_sel = min(TOPK_MAX, s // 4)
    nb = s // Q_BLOCK
    key_pos = jnp.arange(s)

    def blocks(t):
        return jnp.moveaxis(t.reshape(b, nb, Q_BLOCK, *t.shape[2:]), 1, 0)

    def one_block(args):
        qi, wi, qa, tq = args
        rel = jax.nn.relu(jnp.einsum('bqhd,bsd->bqhs', qi, k_idx))
        score = jnp.einsum('bqh,bqhs->bqs', wi, rel).astype(jnp.float32)
        score = jnp.where(key_pos[None, None, :] <= tq[None, :, None], score, -jnp.inf)
        _, idx = lax.top_k(score, k_sel)
        c_sel = jax.vmap(lambda c, i: c[i])(c_kv, idx)
        dist = tq[None, :, None] - idx
        bias = jnp.moveaxis(rel_bias[relative_bucket(dist)], -1, 2)
        logits = jnp.einsum('bqhc,bqkc->bqhk', qa, c_sel).astype(jnp.float32) * (DSA_DH ** -0.5)
        logits = jnp.where((dist >= 0)[:, :, None, :], logits + bias.astype(jnp.float32), -1e30)
        p = jax.nn.softmax(logits, axis=-1).astype(c_sel.dtype)
        return jnp.einsum('bqhk,bqkc->bqhc', p, c_sel)

    t_blocks = jnp.arange(s).reshape(nb, Q_BLOCK)
    o = lax.map(one_block, (blocks(q_idx), blocks(w_idx), blocks(q_abs), t_blocks))
    return jnp.moveaxis(o, 0, 1).reshape(b, s, *q_abs.shape[2:])


def setup_inputs(seed: int = 0) -> dict:
    key = jax.random.key(seed)
    ks = jax.random.split(key, 32)
    L = DEPTH
    f32 = jnp.float32

    def nrm(k, shape, fan_in):
        return jax.random.normal(k, shape, f32) * (fan_in ** -0.5)

    def gain(k, shape):
        return 1.0 + 0.02 * jax.random.normal(k, shape, f32)

    dt = jnp.exp(jax.random.uniform(ks[5], (L, DN_HEADS), f32, math.log(1e-3), math.log(1e-1)))
    return {
        'x': jax.random.normal(ks[0], (BATCH, SEQ, D_MODEL), f32),
        'mem': jax.random.normal(ks[1], (BATCH, MEM_LEN, D_MODEL), f32),
        'g_mix': gain(ks[2], (L, D_MODEL)),
        'w_in': nrm(ks[3], (L, D_MODEL, PROJ_OUT), D_MODEL),
        'conv_w': nrm(ks[4], (L, CONV_K, 2 * DN_QK_W + DN_V_W), CONV_K),
        'a_log': jnp.log(jax.random.uniform(ks[6], (L, DN_HEADS), f32, 1.0, 16.0)),
        'dt_bias': dt + jnp.log(-jnp.expm1(-dt)),
        'dn_norm_g': gain(ks[7], (L, DN_DV)),
        'q_norm_g': gain(ks[8], (L, Q_RANK)),
        'kv_norm_g': gain(ks[9], (L, KV_RANK)),
        'w_uq': nrm(ks[10], (L, Q_RANK, DSA_HEADS * DSA_DH), Q_RANK),
        'w_uk': nrm(ks[11], (L, DSA_HEADS, DSA_DH, KV_RANK), DSA_DH),
        'w_uv': nrm(ks[12], (L, DSA_HEADS, KV_RANK, DSA_DH), KV_RANK),
        'w_qidx': nrm(ks[13], (L, Q_RANK, IDX_HEADS * IDX_DIM), Q_RANK),
        'kidx_ln_g': gain(ks[14], (L, IDX_DIM)),
        'kidx_ln_b': 0.02 * jax.random.normal(ks[15], (L, IDX_DIM), f32),
        'rel_bias': 0.5 * jax.random.normal(ks[16], (NUM_BUCKETS, DSA_HEADS), f32),
        'w_out': nrm(ks[17], (L, MIX_WIDTH, D_MODEL), MIX_WIDTH),
        'g_xattn': gain(ks[18], (L, D_MODEL)),
        'g_mem': gain(ks[19], (L, D_MODEL)),
        'w_xq': nrm(ks[20], (L, D_MODEL, D_MODEL), D_MODEL),
        'w_xkv': nrm(ks[21], (L, D_MODEL, 2 * D_MODEL), D_MODEL),
        'w_xo': nrm(ks[22], (L, D_MODEL, D_MODEL), D_MODEL),
        'g_ffn': gain(ks[23], (L, D_MODEL)),
        'w_gate': nrm(ks[24], (L, D_MODEL, D_FF), D_MODEL),
        'w_up': nrm(ks[25], (L, D_MODEL, D_FF), D_MODEL),
        'w_down': nrm(ks[26], (L, D_FF, D_MODEL), D_FF),
        'g_final': gain(ks[27], (D_MODEL,)),
    }


def reference(x, mem, g_mix, w_in, conv_w, a_log, dt_bias, dn_norm_g, q_norm_g, kv_norm_g, w_uq, w_uk, w_uv,
              w_qidx, kidx_ln_g, kidx_ln_b, rel_bias, w_out, g_xattn, g_mem, w_xq, w_xkv, w_xo, g_ffn,
              w_gate, w_up, w_down, g_final):
    b, s, _ = x.shape
    m_len = mem.shape[1]
    f32 = jnp.float32
    offs = np.cumsum(PROJ_SIZES)[:-1].tolist()
    for l in range(DEPTH):
        h = rmsnorm(x, g_mix[l])
        proj = h @ w_in[l]
        dq, dk, dv, dz, db, da, cq, ckv, kix, wix = jnp.split(proj, offs, axis=-1)

        qkv = jax.nn.silu(causal_depthwise_conv(jnp.concatenate([dq, dk, dv], axis=-1), conv_w[l]))
        dq, dk, dv = jnp.split(qkv, [DN_QK_W, 2 * DN_QK_W], axis=-1)
        q = l2norm(dq.reshape(b, s, DN_HEADS, DN_DK)) * (DN_DK ** -0.5)
        k = l2norm(dk.reshape(b, s, DN_HEADS, DN_DK))
        v = dv.reshape(b, s, DN_HEADS, DN_DV)
        beta = jax.nn.sigmoid(db.astype(f32))
        g = -jnp.exp(a_log[l].astype(f32)) * jax.nn.softplus(da.astype(f32) + dt_bias[l].astype(f32))
        o_dn = gated_delta_rule_chunked(q, k, v, beta, g).astype(x.dtype)
        o_dn = rmsnorm(o_dn, dn_norm_g[l]) * jax.nn.silu(dz).reshape(b, s, DN_HEADS, DN_DV)
        o_dn = o_dn.reshape(b, s, DN_V_W)

        cq = rmsnorm(cq, q_norm_g[l])
        q_d = (cq @ w_uq[l]).reshape(b, s, DSA_HEADS, DSA_DH)
        q_abs = jnp.einsum('bshd,hdc->bshc', q_d, w_uk[l])
        c_kv = rmsnorm(ckv, kv_norm_g[l])
        q_idx = (cq @ w_qidx[l]).reshape(b, s, IDX_HEADS, IDX_DIM)
        k_idx = layernorm(kix, kidx_ln_g[l], kidx_ln_b[l])
        w_idx = wix * (IDX_HEADS ** -0.5 * IDX_DIM ** -0.5)
        o_lat = dsa_sparse_attention(q_abs, c_kv, q_idx, w_idx, k_idx, rel_bias)
        o_dsa = jnp.einsum('bshc,hcd->bshd', o_lat, w_uv[l]).reshape(b, s, DSA_HEADS * DSA_DH)

        x = x + jnp.concatenate([o_dn, o_dsa], axis=-1) @ w_out[l]

        hx = rmsnorm(x, g_xattn[l])
        mn = rmsnorm(mem, g_mem[l])
        qx = (hx @ w_xq[l]).reshape(b, s, X_HEADS, X_DH)
        kvx = (mn @ w_xkv[l]).reshape(b, m_len, 2, X_HEADS, X_DH)
        logits = jnp.einsum('bshd,bmhd->bhsm', qx, kvx[:, :, 0]).astype(f32) * (X_DH ** -0.5)
        p = jax.nn.softmax(logits, axis=-1).astype(x.dtype)
        ox = jnp.einsum('bhsm,bmhd->bshd', p, kvx[:, :, 1]).reshape(b, s, D_MODEL)
        x = x + ox @ w_xo[l]

        hf = rmsnorm(x, g_ffn[l])
        x = x + (jax.nn.silu(hf @ w_gate[l]) * (hf @ w_up[l])) @ w_down[l]
    return rmsnorm(x, g_final)
```

```cpp
#include <hip/hip_runtime.h>
#include <cstdio>
#include <cstdint>

typedef unsigned short bf16_t;
__device__ __forceinline__ float bf2f(bf16_t h) { return __uint_as_float(((unsigned)h) << 16); }
__device__ __forceinline__ bf16_t f2bf(float f) { unsigned u = __float_as_uint(f); return (bf16_t)((u + 0x7fffu + ((u >> 16) & 1u)) >> 16); }

constexpr int D = 1024, BATCH = 16, SEQ = 2048, M = BATCH * SEQ;
constexpr int PROJ_REF = 2512, PROJ = 2560;
constexpr int MEM_LEN = 256, MM = BATCH * MEM_LEN;
constexpr int DFF = 2816;
constexpr float EPS = 1e-6f;
constexpr float LOG2E = 1.4426950408889634f;
constexpr int C_DQ = 0, C_DK = 512, C_DV = 1024, C_DZ = 1536, C_CQ = 2048, C_CKV = 2304, C_KIX = 2432, C_WIX = 2496, C_DB = 2504, C_DA = 2508;
constexpr int MIXK = 1536;

constexpr size_t MiB = 1u << 20;
constexpr size_t WS_WIN = 0, WS_WKV = 5 * MiB, WS_WDSA = 9 * MiB, WS_WOUT = 10 * MiB, WS_WXQ = 13 * MiB, WS_WXO = 15 * MiB, WS_WGU = 17 * MiB, WS_WDN = 28 * MiB;
constexpr size_t WS_CTL = 34 * MiB, CTL_ZERO_BYTES = 256 * 1024;
constexpr size_t WS_ST = 35 * MiB;
constexpr size_t ST_RSTDX = 0, ST_CQSS = 128 * 1024  , ST_LPART = 640 * 1024  , ST_WIDX = 2688 * 1024  , ST_BETA = 3712 * 1024  , ST_G = 4224 * 1024  , ST_BIAS = 4736 * 1024;
constexpr size_t WS_MNB = 40 * MiB, WS_KX = 48 * MiB, WS_VT = 56 * MiB, WS_CKV = 64 * MiB, WS_KIDX = 72 * MiB;
constexpr size_t WS_SSQ = 76 * MiB;
constexpr size_t WS_PROJ = 80 * MiB;
constexpr size_t WS_XB = 240 * MiB;
constexpr size_t WS_QABS = 240 * MiB;
constexpr size_t WS_MIX = 336 * MiB;
constexpr size_t WS_X1B = 240 * MiB, WS_QX = 304 * MiB, WS_P = 368 * MiB, WS_OX = 432 * MiB, WS_X2B = 304 * MiB, WS_ACT = 80 * MiB;
constexpr size_t WS_NEED = 512 * MiB;

#define DPP_ADD(v, CTRL) ((v) + __int_as_float(__builtin_amdgcn_update_dpp(0, __float_as_int(v), (CTRL), 0xF, 0xF, true)))
__device__ __forceinline__ float wave_sum(float v) {
    v = DPP_ADD(v, 0xB1);
    v = DPP_ADD(v, 0x4E);
    v = DPP_ADD(v, 0x141);
    v = DPP_ADD(v, 0x140);
    const int b = __float_as_int(v);
    const float s0 = __int_as_float(__builtin_amdgcn_readlane(b, 0)), s1 = __int_as_float(__builtin_amdgcn_readlane(b, 16)), s2 = __int_as_float(__builtin_amdgcn_readlane(b, 32)), s3 = __int_as_float(__builtin_amdgcn_readlane(b, 48));
    return (s0 + s1) + (s2 + s3);
}
namespace pg8 {
#define PG8_LAS __attribute__((address_space(3)))
typedef short bf16x8 __attribute__((ext_vector_type(8)));
typedef float f32x4 __attribute__((ext_vector_type(4)));
typedef unsigned u32x4 __attribute__((ext_vector_type(4)));
typedef unsigned u32x2 __attribute__((ext_vector_type(2)));
constexpr int BM = 256, BK = 64, HALF = 128, HTB = HALF * BK * 2  , STAGE_BYTES = 8 * HTB, NXCD = 8, WGM = 8;

__host__ __device__ __forceinline__ int lds_byte(int r, int c) { const int st = (r >> 4) * 2 + (c >> 5), rr = r & 15, cc = c & 31, ob = rr * 64 + cc * 2; return st * 1024 + (ob ^ (((ob >> 9) & 1) << 5)); }
__host__ __device__ __forceinline__ void stage_rc(int b, int& R, int& C) { const int st = b / 1024, sb = b % 1024, swz = sb ^ (((sb >> 9) & 1) << 5); R = (st >> 1) * 16 + swz / 64; C = (st & 1) * 32 + (swz % 64) / 2; }
__host__ __device__ __forceinline__ int perm32(int rho) { const int n = rho >> 4, i = rho & 15; return 8 * (i >> 2) + 4 * n + (i & 3); }

struct Unit { int pm, pn; long ao, bo; };
struct Gemm { const bf16_t* A; const bf16_t* Bt; int lda, ldb, K; };

struct StaticOrder {
    int nM, nN, nwg, G, c;
    __host__ __device__ __forceinline__ void init(int M_, int N_, int G_, int c_) { nM = M_ / BM; nN = N_ / BM; nwg = nM * nN; G = G_; c = c_; }
    __host__ __device__ __forceinline__ bool next(int i, Unit& u) const {
        const long L = (long)i * G + c; if (L >= nwg) return false;
        int wgid = (int)L; { const int q = nwg / NXCD, r = nwg % NXCD, xcd = wgid % NXCD, off = wgid / NXCD; wgid = (xcd < r ? xcd * (q + 1) : r * (q + 1) + (xcd - r) * q) + off; }
        const int nig = WGM * nN, gid = wgid / nig, fm = gid * WGM, gsz = (nM - fm) < WGM ? (nM - fm) : WGM;
        u.pm = fm + ((wgid % nig) % gsz); u.pn = (wgid % nig) / gsz; u.ao = 0; u.bo = 0; return true;
    }
};
struct OneUnit { Unit u; __host__ __device__ __forceinline__ bool next(int i, Unit& o) const { if (i) return false; o = u; return true; } };
struct TwoUnits { Unit u0, u1; int n; __host__ __device__ __forceinline__ bool next(int i, Unit& o) const { if (i >= n) return false; o = i ? u1 : u0; return true; } };

typedef float cvf32x2_t __attribute__((ext_vector_type(2))); typedef __bf16 cvbf16x2_t __attribute__((ext_vector_type(2)));
__device__ __forceinline__ unsigned cvt_pk_bf16(float lo, float hi) { cvf32x2_t v = {lo, hi}; return __builtin_bit_cast(unsigned, __builtin_convertvector(v, cvbf16x2_t)); }
__device__ __forceinline__ u32x4 pack8(const f32x4& a, const f32x4& b) { u32x4 w; w.x = cvt_pk_bf16(a[0], a[1]); w.y = cvt_pk_bf16(a[2], a[3]); w.z = cvt_pk_bf16(b[0], b[1]); w.w = cvt_pk_bf16(b[2], b[3]); return w; }
__device__ __forceinline__ float dot4(const f32x4& a) { return (a[0] * a[0] + a[1] * a[1]) + (a[2] * a[2] + a[3] * a[3]); }
__device__ __forceinline__ float sum4(const f32x4& a) { return (a[0] + a[1]) + (a[2] + a[3]); }
__device__ __forceinline__ float lo_bf(unsigned w) { return __uint_as_float(w << 16); }
__device__ __forceinline__ float hi_bf(unsigned w) { return __uint_as_float(w & 0xffff0000u); }

typedef f32x4 Acc[2][2][4][2];
#define PG8_EPI_ROWS(...) _Pragma("unroll") for (int ai = 0; ai < 2; ++ai) _Pragma("unroll") for (int m = 0; m < 4; ++m) { const int rl = ai * HALF + wr * 64 + m * 16 + fr; __VA_ARGS__ }

struct EpiProj { static constexpr bool PERM = true;
    bf16_t* O; int ldc; const float* rs; float* cqss; int ssq_pn;
    __device__ __forceinline__ void operator()(const Acc& acc, const Unit& u, int wr, int wc, int fr, int fq) const {
        const int col0 = u.pn * BM + wc * 32 + 8 * fq; const bool doss = (u.pn == ssq_pn);
        PG8_EPI_ROWS( const int row = u.pm * BM + rl; const float r = rs ? rs[row] : 1.f; float ss = 0.f; bf16_t* rowp = O + (size_t)row * ldc + col0;
            _Pragma("unroll") for (int bj = 0; bj < 2; ++bj) { const f32x4 v0 = acc[ai][bj][m][0] * r, v1 = acc[ai][bj][m][1] * r; *(u32x4*)(rowp + bj * HALF) = pack8(v0, v1); ss += dot4(v0) + dot4(v1); }
            if (doss) { ss += __shfl_xor(ss, 16); ss += __shfl_xor(ss, 32); if (fq == 0) cqss[(size_t)row * 4 + wc] = ss; } )
    }
};
template <int NP> struct EpiNormScale { static constexpr bool PERM = true;
    bf16_t* O; int ldc; const float* part; float inv_dim;
    __device__ __forceinline__ void operator()(const Acc& acc, const Unit& u, int wr, int wc, int fr, int fq) const {
        const int col0 = u.pn * BM + wc * 32 + 8 * fq;
        PG8_EPI_ROWS( const int row = u.pm * BM + rl; float s = 0.f;
            _Pragma("unroll") for (int q = 0; q < NP / 4; ++q) s += sum4(*(const f32x4*)(part + (size_t)row * NP + 4 * q));
            const float r = rsqrtf(s * inv_dim + EPS); bf16_t* rowp = O + (size_t)row * ldc + col0;
            _Pragma("unroll") for (int bj = 0; bj < 2; ++bj) *(u32x4*)(rowp + bj * HALF) = pack8(acc[ai][bj][m][0] * r, acc[ai][bj][m][1] * r); )
    }
};
template <bool SRC16> struct EpiResid { static constexpr bool PERM = true;
    const float* src; const bf16_t* src16; bf16_t* xb; float* ssq; const float* rinv;
    __device__ __forceinline__ void operator()(const Acc& acc, const Unit& u, int wr, int wc, int fr, int fq) const {
        const int col0 = u.pn * BM + wc * 32 + 8 * fq;
        PG8_EPI_ROWS( const size_t row = (size_t)u.pm * BM + rl; float ss = 0.f; const size_t off = row * 1024 + col0; const float rsc = (SRC16 && rinv) ? 1.f / rinv[row] : 1.f;
            _Pragma("unroll") for (int bj = 0; bj < 2; ++bj) { f32x4 s0, s1;
                if (SRC16) { const u32x4 w = *(const u32x4*)(src16 + off + bj * HALF); s0 = (f32x4){lo_bf(w.x), hi_bf(w.x), lo_bf(w.y), hi_bf(w.y)} * rsc; s1 = (f32x4){lo_bf(w.z), hi_bf(w.z), lo_bf(w.w), hi_bf(w.w)} * rsc; }
                else { s0 = *(const f32x4*)(src + off + bj * HALF); s1 = *(const f32x4*)(src + off + bj * HALF + 4); }
                const f32x4 v0 = s0 + acc[ai][bj][m][0], v1 = s1 + acc[ai][bj][m][1];
                *(u32x4*)(xb + off + bj * HALF) = pack8(v0, v1); ss += dot4(v0) + dot4(v1); }
            ss += __shfl_xor(ss, 16); ss += __shfl_xor(ss, 32); if (fq == 0) ssq[row * 16 + u.pn * 4 + wc] = ss; )
    }
};
struct EpiResidF32 { static constexpr bool PERM = true;
    const bf16_t* src16; float* dst; float* ssq;
    __device__ __forceinline__ void operator()(const Acc& acc, const Unit& u, int wr, int wc, int fr, int fq) const {
        const int col0 = u.pn * BM + wc * 32 + 8 * fq;
        PG8_EPI_ROWS( const size_t row = (size_t)u.pm * BM + rl; float ss = 0.f; const size_t off = row * 1024 + col0;
            _Pragma("unroll") for (int bj = 0; bj < 2; ++bj) { const u32x4 w = *(const u32x4*)(src16 + off + bj * HALF);
                const f32x4 v0 = (f32x4){lo_bf(w.x), hi_bf(w.x), lo_bf(w.y), hi_bf(w.y)} + acc[ai][bj][m][0], v1 = (f32x4){lo_bf(w.z), hi_bf(w.z), lo_bf(w.w), hi_bf(w.w)} + acc[ai][bj][m][1];
                *(f32x4*)(dst + off + bj * HALF) = v0; *(f32x4*)(dst + off + bj * HALF + 4) = v1; ss += dot4(v0) + dot4(v1); }
            ss += __shfl_xor(ss, 16); ss += __shfl_xor(ss, 32); if (fq == 0) ssq[row * 16 + u.pn * 4 + wc] = ss; )
    }
};
struct EpiFinal { static constexpr bool PERM = true;
    const bf16_t* src16; float* dst; float* part; unsigned* cnt; const float* gain;
    __device__ __forceinline__ void operator()(Acc& acc, const Unit& u, int wr, int wc, int fr, int fq) const {
        const int col0 = u.pn * BM + wc * 32 + 8 * fq;
        PG8_EPI_ROWS( const size_t row = (size_t)u.pm * BM + rl; float ss = 0.f; const size_t off = row * 1024 + col0;
            _Pragma("unroll") for (int bj = 0; bj < 2; ++bj) { const u32x4 w = *(const u32x4*)(src16 + off + bj * HALF); const f32x4 s0 = {lo_bf(w.x), hi_bf(w.x), lo_bf(w.y), hi_bf(w.y)}, s1 = {lo_bf(w.z), hi_bf(w.z), lo_bf(w.w), hi_bf(w.w)};
                acc[ai][bj][m][0] += s0; acc[ai][bj][m][1] += s1; ss += dot4(acc[ai][bj][m][0]) + dot4(acc[ai][bj][m][1]); }
            ss += __shfl_xor(ss, 16); ss += __shfl_xor(ss, 32);
            if (fq == 0) __hip_atomic_store(part + row * 16 + u.pn * 4 + wc, ss, __ATOMIC_RELAXED, __HIP_MEMORY_SCOPE_AGENT); )
        asm volatile("s_waitcnt vmcnt(0)" ::: "memory");
        unsigned* c = cnt + 64 * u.pm;
        if ((threadIdx.x & 63) == 0) __hip_atomic_fetch_add(c, 1u, __ATOMIC_RELAXED, __HIP_MEMORY_SCOPE_AGENT);
        for (unsigned spins = 0; spins < (1u << 22); ++spins) { if ((unsigned)__builtin_amdgcn_readfirstlane(__hip_atomic_load(c, __ATOMIC_RELAXED, __HIP_MEMORY_SCOPE_AGENT)) >= 32u) break; __builtin_amdgcn_s_sleep(4); }
        __builtin_amdgcn_fence(__ATOMIC_ACQUIRE, "agent");
        f32x4 gv[2][2];
        _Pragma("unroll") for (int bj = 0; bj < 2; ++bj) { gv[bj][0] = *(const f32x4*)(gain + col0 + bj * HALF); gv[bj][1] = *(const f32x4*)(gain + col0 + bj * HALF + 4); }
        PG8_EPI_ROWS( const size_t row = (size_t)u.pm * BM + rl; float s = 0.f;
            _Pragma("unroll") for (int q = 0; q < 4; ++q) s += sum4(*(const f32x4*)(part + row * 16 + 4 * q));
            const float r = rsqrtf(s * (1.f / 1024.f) + EPS); const size_t off = row * 1024 + col0;
            _Pragma("unroll") for (int bj = 0; bj < 2; ++bj) { *(f32x4*)(dst + off + bj * HALF) = acc[ai][bj][m][0] * gv[bj][0] * r; *(f32x4*)(dst + off + bj * HALF + 4) = acc[ai][bj][m][1] * gv[bj][1] * r; } )
    }
};
struct EpiExpP { static constexpr bool PERM = true;
    bf16_t* Pb; float* lpart;
    __device__ __forceinline__ void operator()(const Acc& acc, const Unit& u, int wr, int wc, int fr, int fq) const {
        const int h = (int)(u.ao >> 9), rowbase = u.pm * BM, col0 = wc * 32 + 8 * fq; bf16_t* O = Pb + (size_t)rowbase * 1024 + h * 256;
        PG8_EPI_ROWS( float ss = 0.f; bf16_t* rowp = O + (size_t)rl * 1024 + col0;
            _Pragma("unroll") for (int bj = 0; bj < 2; ++bj) { f32x4 v0 = acc[ai][bj][m][0], v1 = acc[ai][bj][m][1];
                _Pragma("unroll") for (int e = 0; e < 4; ++e) { v0[e] = __builtin_amdgcn_exp2f(v0[e]); v1[e] = __builtin_amdgcn_exp2f(v1[e]); }
                const u32x4 w = pack8(v0, v1); *(u32x4*)(rowp + bj * HALF) = w;
                ss += (lo_bf(w.x) + hi_bf(w.x)) + (lo_bf(w.y) + hi_bf(w.y)) + (lo_bf(w.z) + hi_bf(w.z)) + (lo_bf(w.w) + hi_bf(w.w)); }
            ss += __shfl_xor(ss, 16); ss += __shfl_xor(ss, 32); if (fq == 0) lpart[(size_t)(rowbase + rl) * 16 + h * 4 + wc] = ss; )
    }
};
struct EpiPV { static constexpr bool PERM = true;
    bf16_t* Ob; const float* lpart;
    __device__ __forceinline__ void operator()(const Acc& acc, const Unit& u, int wr, int wc, int fr, int fq) const {
        const int h = u.pn, rowbase = u.pm * BM, col0 = wc * 32 + 8 * fq; bf16_t* O = Ob + (size_t)rowbase * 1024 + h * 256;
        PG8_EPI_ROWS( const float r = 1.f / sum4(*(const f32x4*)(lpart + (size_t)(rowbase + rl) * 16 + h * 4)); bf16_t* rowp = O + (size_t)rl * 1024 + col0;
            _Pragma("unroll") for (int bj = 0; bj < 2; ++bj) *(u32x4*)(rowp + bj * HALF) = pack8(acc[ai][bj][m][0] * r, acc[ai][bj][m][1] * r); )
    }
};
struct EpiSwiglu { static constexpr bool PERM = true;
    bf16_t* act; const float* part;
    __device__ __forceinline__ void operator()(const Acc& acc, const Unit& u, int wr, int wc, int fr, int fq) const {
        const int col0 = u.pn * BM + wc * 32 + 8 * fq;
        PG8_EPI_ROWS( const size_t row = (size_t)u.pm * BM + rl; float s = 0.f;
            _Pragma("unroll") for (int q = 0; q < 4; ++q) s += sum4(*(const f32x4*)(part + row * 16 + 4 * q));
            const float r = rsqrtf(s * (1.f / 1024.f) + EPS); bf16_t* rowp = act + row * DFF + (col0 >> 1);
            _Pragma("unroll") for (int bj = 0; bj < 2; ++bj) { const f32x4 a = acc[ai][bj][m][0] * r, b = acc[ai][bj][m][1] * r;
                const float o0 = a[0] * __builtin_amdgcn_rcpf(1.f + __builtin_amdgcn_exp2f(-LOG2E * a[0])) * a[1], o1 = a[2] * __builtin_amdgcn_rcpf(1.f + __builtin_amdgcn_exp2f(-LOG2E * a[2])) * a[3];
                const float o2 = b[0] * __builtin_amdgcn_rcpf(1.f + __builtin_amdgcn_exp2f(-LOG2E * b[0])) * b[1], o3 = b[2] * __builtin_amdgcn_rcpf(1.f + __builtin_amdgcn_exp2f(-LOG2E * b[2])) * b[3];
                u32x2 w; w.x = cvt_pk_bf16(o0, o1); w.y = cvt_pk_bf16(o2, o3); *(u32x2*)(rowp + bj * (HALF / 2)) = w; } )
    }
};

template <class Epi, class Sched, bool ALIGN_EPI>
__device__ __forceinline__ void gemm_phase(PG8_LAS unsigned char* lds, const Gemm g, const Sched& S, const Epi& E) {
    int tid = threadIdx.x; asm volatile("" : "+v"(tid));
    const int wid = __builtin_amdgcn_readfirstlane(tid >> 6), lane = tid & 63, wr = wid >> 2, wc = wid & 3, fr = lane & 15, fq = lane >> 4;
    int Kop = g.K; asm volatile("" : "+s"(Kop));
    const int nt = Kop / BK;
    unsigned voffA[2], voffB[2];
#pragma unroll
    for (int i = 0; i < 2; ++i) { int R, C; stage_rc(tid * 16 + i * 8192, R, C); const int Rb = Epi::PERM ? ((R & ~31) + perm32(R & 31)) : R;
        voffA[i] = (unsigned)(R * g.lda + C) * 2u; voffB[i] = (unsigned)(Rb * g.ldb + C) * 2u; }
    const size_t kstep = (size_t)(BK * 2);
    const size_t hstepA = (size_t)HALF * g.lda * 2, hstepB = (size_t)HALF * g.ldb * 2;
    const size_t tstepA = 2 * hstepA, tstepB = 2 * hstepB;
    const unsigned ldsw = (unsigned)wid * 1024u;
    const int aoff = lds_byte(wr * 64 + fr, fq * 8), boff = lds_byte(wc * 32 + fr, fq * 8);
#define PG8_SA(b, h) (((b) * 2 + (h)) * HTB)
#define PG8_SB(b, h) ((4 + (b) * 2 + (h)) * HTB)
#define PG8_STAGE(bufoff, gbase, voff) do { _Pragma("unroll") for (int _i = 0; _i < 2; ++_i) \
        __builtin_amdgcn_global_load_lds((const unsigned*)((const char*)(gbase) + (voff)[_i]), (PG8_LAS unsigned*)(lds + (bufoff) + ldsw + _i * 8192), 16, 0, 0); } while (0)
#define PG8_LDA(dst, b, h) do { _Pragma("unroll") for (int m = 0; m < 4; ++m) _Pragma("unroll") for (int k = 0; k < 2; ++k) dst[m][k] = *(const PG8_LAS bf16x8*)(lds + PG8_SA(b, h) + aoff + m * 2048 + k * 1024); } while (0)
#define PG8_LDB(dst, b, h) do { _Pragma("unroll") for (int n = 0; n < 2; ++n) _Pragma("unroll") for (int k = 0; k < 2; ++k) dst[n][k] = *(const PG8_LAS bf16x8*)(lds + PG8_SB(b, h) + boff + n * 2048 + k * 1024); } while (0)
#define PG8_MMA(ai, bj, At, Bt) do { __builtin_amdgcn_s_setprio(1); _Pragma("unroll") for (int m = 0; m < 4; ++m) _Pragma("unroll") for (int n = 0; n < 2; ++n) _Pragma("unroll") for (int k = 0; k < 2; ++k) \
        acc[ai][bj][m][n] = __builtin_amdgcn_mfma_f32_16x16x32_bf16(Bt[n][k], At[m][k], acc[ai][bj][m][n], 0, 0, 0); __builtin_amdgcn_s_setprio(0); } while (0)
#define PG8_WAIT_V(n) asm volatile("s_waitcnt vmcnt(" #n ")" ::: "memory")
#define PG8_WAIT_L(n) asm volatile("s_waitcnt lgkmcnt(" #n ")" ::: "memory")
#define PG8_BAR __builtin_amdgcn_s_barrier()
#define PG8_SCHED __builtin_amdgcn_sched_barrier(0)
    Unit cur, nxt; int ui = 0;
    if (!S.next(0, cur)) return;
    Acc acc;
#pragma unroll
    for (int a = 0; a < 2; ++a)
#pragma unroll
        for (int b = 0; b < 2; ++b)
#pragma unroll
            for (int m = 0; m < 4; ++m)
#pragma unroll
                for (int n = 0; n < 2; ++n) acc[a][b][m][n] = (f32x4){0.f, 0.f, 0.f, 0.f};
    bf16x8 At[4][2], B0[2][2], B1[2][2];
    const char* cA = (const char*)g.A + (size_t)cur.pm * tstepA + cur.ao; const char* cB = (const char*)g.Bt + (size_t)cur.pn * tstepB + cur.bo;
    PG8_STAGE(PG8_SB(0, 0), cB, voffB); PG8_STAGE(PG8_SB(0, 1), cB + hstepB, voffB); PG8_STAGE(PG8_SA(0, 0), cA, voffA); PG8_STAGE(PG8_SA(0, 1), cA + hstepA, voffA);
    if (wr == 1) PG8_BAR;
    PG8_WAIT_V(2); PG8_BAR;
    PG8_STAGE(PG8_SB(1, 0), cB + kstep, voffB); PG8_STAGE(PG8_SA(1, 0), cA + kstep, voffA); PG8_STAGE(PG8_SB(1, 1), cB + hstepB + kstep, voffB);
    PG8_WAIT_V(6); PG8_BAR;
    for (;;) {
        const bool has_next = S.next(ui + 1, nxt);
        const char* nA = has_next ? (const char*)g.A + (size_t)nxt.pm * tstepA + nxt.ao : cA; const char* nB = has_next ? (const char*)g.Bt + (size_t)nxt.pn * tstepB + nxt.bo : cB;
        for (int t = 0; t < nt; t += 2) {
            const bool last = (t == nt - 2);
            const char* a1 = cA + (size_t)(t + 1) * kstep;
            const char* a2 = last ? nA : cA + (size_t)(t + 2) * kstep; const char* b2 = last ? nB : cB + (size_t)(t + 2) * kstep;
            const char* a3 = a2 + kstep; const char* b3 = b2 + kstep;
            PG8_LDB(B0, 0, 0); PG8_LDB(B1, 0, 1); PG8_SCHED; PG8_LDA(At, 0, 0); PG8_STAGE(PG8_SA(1, 1), a1 + hstepA, voffA);
            PG8_WAIT_V(8); PG8_WAIT_L(0); PG8_BAR; PG8_MMA(0, 0, At, B0); PG8_MMA(0, 1, At, B1); PG8_BAR; PG8_SCHED;
            PG8_LDA(At, 0, 1); PG8_STAGE(PG8_SB(0, 0), b2, voffB); PG8_STAGE(PG8_SB(0, 1), b2 + hstepB, voffB); PG8_STAGE(PG8_SA(0, 0), a2, voffA);
            PG8_WAIT_V(8); PG8_WAIT_L(0); PG8_BAR; PG8_MMA(1, 0, At, B0); PG8_MMA(1, 1, At, B1); PG8_BAR; PG8_SCHED;
            PG8_LDB(B0, 1, 0); PG8_LDB(B1, 1, 1); PG8_SCHED; PG8_LDA(At, 1, 0); PG8_STAGE(PG8_SA(0, 1), a2 + hstepA, voffA);
            PG8_WAIT_V(8); PG8_WAIT_L(0); PG8_BAR; PG8_MMA(0, 0, At, B0); PG8_MMA(0, 1, At, B1); PG8_BAR; PG8_SCHED;
            PG8_LDA(At, 1, 1); PG8_STAGE(PG8_SB(1, 0), b3, voffB); PG8_STAGE(PG8_SB(1, 1), b3 + hstepB, voffB); PG8_STAGE(PG8_SA(1, 0), a3, voffA);
            PG8_WAIT_V(8); PG8_WAIT_L(0); PG8_BAR; PG8_MMA(1, 0, At, B0); PG8_MMA(1, 1, At, B1); PG8_BAR; PG8_SCHED;
        }
        if constexpr (ALIGN_EPI) { if (wr == 0) PG8_BAR; }
        E(acc, cur, wr, wc, fr, fq);
        if (!has_next) break;
#pragma unroll
        for (int a = 0; a < 2; ++a)
#pragma unroll
            for (int b = 0; b < 2; ++b)
#pragma unroll
                for (int m = 0; m < 4; ++m)
#pragma unroll
                    for (int n = 0; n < 2; ++n) acc[a][b][m][n] = (f32x4){0.f, 0.f, 0.f, 0.f};
        cur = nxt; cA = nA; cB = nB; ++ui;
        if constexpr (ALIGN_EPI) { if (wr == 1) PG8_BAR; }
    }
    PG8_WAIT_V(0);
    if constexpr (!ALIGN_EPI) { if (wr == 0) PG8_BAR; }
    PG8_BAR;
#undef PG8_SA
#undef PG8_SB
#undef PG8_STAGE
#undef PG8_LDA
#undef PG8_LDB
#undef PG8_MMA
#undef PG8_WAIT_V
#undef PG8_WAIT_L
#undef PG8_BAR
#undef PG8_SCHED
}
}
constexpr int NWAVES = 8;
constexpr int RING_BYTES = 131072;
constexpr int LDSCTL_OFF = RING_BYTES, MISC_OFF = LDSCTL_OFF + 320;
constexpr int LDS_BYTES = 147456;
#define GAS __attribute__((address_space(1)))
#define LAS __attribute__((address_space(3)))
typedef unsigned v4u __attribute__((ext_vector_type(4)));
typedef float f32x4 __attribute__((ext_vector_type(4)));
typedef GAS unsigned gu32;
#define RLX_AGENT __ATOMIC_RELAXED, __HIP_MEMORY_SCOPE_AGENT
#define LDS_WAIT() asm volatile("s_waitcnt lgkmcnt(0)" ::: "memory")
#define VM_WAIT() asm volatile("s_waitcnt vmcnt(0)" ::: "memory")
__device__ __forceinline__ unsigned pk2(float lo, float hi) { return (unsigned)f2bf(lo) | ((unsigned)f2bf(hi) << 16); }

#define XB_TMO      128
#define XB_XCNT(j)  (256  + 64 * (j))
#define XB_XSUB(j)  (1280 + 64 * (j))
#define XB_XGEN(j)  (2304 + 64 * (j))
#define XB_TOP      3328
#define XB_TOPGEN   3392
#define XCD_BAR_WORDS 3456
#define XB_SPIN_CAP (1u << 18)
__device__ __forceinline__ unsigned xb_ld(unsigned* p)              { return __hip_atomic_load(p, __ATOMIC_RELAXED, __HIP_MEMORY_SCOPE_AGENT); }
__device__ __forceinline__ unsigned xb_add(unsigned* p, unsigned v) { return __hip_atomic_fetch_add(p, v, __ATOMIC_RELAXED, __HIP_MEMORY_SCOPE_AGENT); }
__device__ __forceinline__ unsigned xb_xcc_id() { return (unsigned)__builtin_amdgcn_s_getreg((3 << 11) | 20) & 0xFu; }
#define XB_SPIN(cond, bar) do { unsigned _sp = 0; while (cond) { __builtin_amdgcn_s_sleep(1); \
    if ((++_sp & 255u) == 0u) { if (xb_ld(&(bar)[XB_TMO])) break; if (_sp > XB_SPIN_CAP) { atomicAdd(&(bar)[XB_TMO], 1u); break; } } } } while (0)
struct XcdBarrier { unsigned* bar; unsigned x; volatile LAS unsigned* st; };
__device__ __forceinline__ XcdBarrier xcd_barrier_post(unsigned* bar, volatile LAS unsigned* st) {
    XcdBarrier b; b.bar = bar; b.x = xb_xcc_id(); b.st = st;
    if (threadIdx.x == 0) (void)xb_add(&bar[XB_XCNT(b.x)], 1u);
    return b;
}
__device__ __forceinline__ void xcd_barrier_complete(unsigned* bar, unsigned x, unsigned& nloc, unsigned& nx) {
    const unsigned G = gridDim.x * gridDim.y * gridDim.z;
    unsigned sum, cnt, mine, sp = 0u;
    for (;;) {
        sum = 0u; cnt = 0u; mine = 0u;
#pragma unroll
        for (unsigned j = 0; j < 16; ++j) { const unsigned c = xb_ld(&bar[XB_XCNT(j)]); sum += c; cnt += (c > 0u) ? 1u : 0u; mine = (j == x) ? c : mine; }
        if (sum == G) break;
        __builtin_amdgcn_s_sleep(1);
        if ((++sp & 255u) == 0u) { if (xb_ld(&bar[XB_TMO])) break; if (sp > XB_SPIN_CAP) { atomicAdd(&bar[XB_TMO], 1u); break; } }
    }
    nloc = mine > 0u ? mine : 1u; nx = cnt > 0u ? cnt : 1u;
}
__device__ __forceinline__ void xcd_barrier(const XcdBarrier& b) {
    asm volatile("s_waitcnt vmcnt(0)" ::: "memory");
    __syncthreads();
    if (threadIdx.x == 0) {
        unsigned* bar = b.bar;
        __builtin_amdgcn_s_waitcnt(0);
        unsigned nloc = b.st[0], nx = b.st[1];
        if (nloc == 0u) { xcd_barrier_complete(bar, b.x, nloc, nx); b.st[0] = nloc; b.st[1] = nx; }
        const unsigned old = xb_add(&bar[XB_XSUB(b.x)], 1u);
        const unsigned gen = old / nloc;
        if (old + 1u == (gen + 1u) * nloc) {
            __builtin_amdgcn_fence(__ATOMIC_RELEASE, "agent");
            asm volatile("s_waitcnt vmcnt(0)" ::: "memory");
            const unsigned og = xb_add(&bar[XB_TOP], 1u);
            const unsigned tg = og / nx;
            if (og + 1u == (tg + 1u) * nx) xb_add(&bar[XB_TOPGEN], 1u);
            else XB_SPIN(xb_ld(&bar[XB_TOPGEN]) == tg, bar);
            __builtin_amdgcn_fence(__ATOMIC_ACQUIRE, "agent");
            xb_add(&bar[XB_XGEN(b.x)], 1u);
            asm volatile("s_waitcnt vmcnt(0)" ::: "memory");
        } else {
            XB_SPIN(xb_ld(&bar[XB_XGEN(b.x)]) == gen, bar);
            __builtin_amdgcn_fence(__ATOMIC_ACQUIRE, "agent");
            asm volatile("s_waitcnt vmcnt(0)" ::: "memory");
        }
    }
    __syncthreads();
}

struct SrcWin { const float* w; const float* g;
    __device__ __forceinline__ float at(int k, int n) const {
        int src;
        if (n < 2048) src = n; else if (n < C_CKV) src = 2056 + (n - C_CQ); else if (n < C_KIX) src = 2312 + (n - C_CKV); else if (n < C_WIX) src = 2440 + (n - C_KIX);
        else if (n < C_DB) src = 2504 + (n - C_WIX); else if (n < C_DA) src = 2048 + (n - C_DB); else if (n < 2512) src = 2052 + (n - C_DA); else src = -1;
        return src >= 0 ? w[(size_t)k * PROJ_REF + src] * g[k] : 0.f; } };
struct SrcPlain { const float* w; int ld; const float* g; float cs;
    __device__ __forceinline__ float at(int k, int n) const { return w[(size_t)k * ld + n] * (g ? g[k] : 1.f) * cs; } };
struct SrcQidx { const float* w; const float* g;
    __device__ __forceinline__ float at(int k, int n) const { const int s = n >> 7, head = (n >> 4) & 7, r = n & 15; return w[(size_t)k * 512 + head * 64 + 16 * s + r] * g[k]; } };
struct SrcGU { const float* wg; const float* wu; const float* g;
    __device__ __forceinline__ float at(int k, int n) const { const size_t i = (size_t)k * DFF + (n >> 1); const float a = wg[i], b = wu[i]; return ((n & 1) ? b : a) * g[k]; } };
template <class Src> __device__ __forceinline__ void tr_item(const Src& S, int Nsz, bf16_t* WT, int ldo, int koff, LAS float* scr, int item, int lane) {
    const int nblk = Nsz / 32, kb = item / nblk, nb = item % nblk, k0 = 64 * kb, n0 = 32 * nb;
    float t[32];
#pragma unroll
    for (int i = 0; i < 32; ++i) t[i] = S.at(k0 + 2 * i + (lane >> 5), n0 + (lane & 31));
#pragma unroll
    for (int i = 0; i < 32; ++i) scr[(2 * i + (lane >> 5)) * 33 + (lane & 31)] = t[i];
    LDS_WAIT(); asm volatile("" ::: "memory");
    const int c = lane & 7;
#pragma unroll
    for (int j = 0; j < 4; ++j) { const int n = (lane >> 3) + 8 * j; const LAS float* s = scr + (8 * c) * 33 + n;
        v4u o; o.x = pk2(s[0 * 33], s[1 * 33]); o.y = pk2(s[2 * 33], s[3 * 33]); o.z = pk2(s[4 * 33], s[5 * 33]); o.w = pk2(s[6 * 33], s[7 * 33]);
        *(GAS v4u*)(WT + (size_t)(n0 + n) * ldo + koff + k0 + 8 * c) = o; }
    LDS_WAIT(); asm volatile("" ::: "memory");
}
__device__ __forceinline__ void heavy_item(const float* Ap, int lda, const float* Bp, int ldb, const float* cs, float cmul, int k0, int n0, int n0out, bf16_t* WT, int ldo, int koff, LAS float* scr, int lane) {
    LAS float* At = scr; LAS float* tt = scr + 2048;
#pragma unroll
    for (int i = 0; i < 8; ++i) { const int e = (i * 64 + lane) * 4, r = e >> 6, d = e & 63; *(LAS f32x4*)(At + e) = *(const GAS f32x4*)(Ap + (size_t)(k0 + r) * lda + d); }
    float bc[64];
#pragma unroll
    for (int d = 0; d < 64; ++d) bc[d] = Bp[(size_t)d * ldb + n0 + (lane & 31)];
    LDS_WAIT(); asm volatile("" ::: "memory");
#pragma unroll 2
    for (int i = 0; i < 16; ++i) { const int kk = 2 * i + (lane >> 5); const LAS f32x4* ar = (const LAS f32x4*)(At + kk * 64); float s0 = 0.f, s1 = 0.f;
#pragma unroll
        for (int q = 0; q < 16; q += 2) { const f32x4 a = ar[q], b2 = ar[q + 1]; s0 += a.x * bc[4 * q] + a.y * bc[4 * q + 1] + a.z * bc[4 * q + 2] + a.w * bc[4 * q + 3]; s1 += b2.x * bc[4 * q + 4] + b2.y * bc[4 * q + 5] + b2.z * bc[4 * q + 6] + b2.w * bc[4 * q + 7]; }
        tt[kk * 33 + (lane & 31)] = (s0 + s1) * (cs ? cs[k0 + kk] : 1.f) * cmul; }
    LDS_WAIT(); asm volatile("" ::: "memory");
    const int c = lane & 3;
#pragma unroll
    for (int j = 0; j < 2; ++j) { const int n = (lane >> 2) + 16 * j; const LAS float* s = tt + (8 * c) * 33 + n;
        v4u o; o.x = pk2(s[0 * 33], s[1 * 33]); o.y = pk2(s[2 * 33], s[3 * 33]); o.z = pk2(s[4 * 33], s[5 * 33]); o.w = pk2(s[6 * 33], s[7 * 33]);
        *(GAS v4u*)(WT + (size_t)(n0out + n) * ldo + koff + k0 + 8 * c) = o; }
    LDS_WAIT(); asm volatile("" ::: "memory");
}
template <int NR> __device__ __forceinline__ void row_prep(const float* xrow, const float* gain, bf16_t* orow, float* rstd_out, int lane) {
    f32x4 v[NR][4]; float s[NR];
#pragma unroll
    for (int r = 0; r < NR; ++r)
#pragma unroll
        for (int j = 0; j < 4; ++j) v[r][j] = *((const GAS f32x4*)(xrow + (size_t)r * 1024) + lane + 64 * j);
#pragma unroll
    for (int r = 0; r < NR; ++r) { float a = 0.f;
#pragma unroll
        for (int j = 0; j < 4; ++j) a += (v[r][j].x * v[r][j].x + v[r][j].y * v[r][j].y) + (v[r][j].z * v[r][j].z + v[r][j].w * v[r][j].w);
        s[r] = a; }
#pragma unroll
    for (int r = 0; r < NR; ++r) { const float rstd = rsqrtf(wave_sum(s[r]) * (1.f / 1024.f) + EPS);
        if (rstd_out && lane == 0) rstd_out[r] = rstd;
        GAS unsigned long long* o8 = (GAS unsigned long long*)(orow + (size_t)r * 1024) + lane;
#pragma unroll
        for (int j = 0; j < 4; ++j) { f32x4 a = v[r][j];
            if (gain) { const f32x4 gg = *((const GAS f32x4*)gain + lane + 64 * j); a = a * gg * rstd; } else a = a * rstd;
            o8[64 * j] = (unsigned long long)pk2(a.x, a.y) | ((unsigned long long)pk2(a.z, a.w) << 32); } }
}
namespace dsa {
typedef short bf16x8 __attribute__((ext_vector_type(8)));
typedef short s16x4 __attribute__((ext_vector_type(4)));
typedef float f32x16 __attribute__((ext_vector_type(16)));
typedef float f32x4 __attribute__((ext_vector_type(4)));
typedef unsigned u32x4 __attribute__((ext_vector_type(4)));
typedef unsigned short u16x4 __attribute__((ext_vector_type(4)));
constexpr int HIST_OFF = 145152;
constexpr int SC_OFF = 0, LIST_OFF = 132096, BIAS_OFF = 140288, W_OFF = 144416, NSEL_OFF = 144928, BMAX_OFF = 144992, CMAX_OFF = 145024;
__device__ __forceinline__ int xsw(int rr) { return rr < 8 ? 2 * rr : 2 * ((rr + 4) & 7) + 1; }
typedef float cvf32x2_t __attribute__((ext_vector_type(2))); typedef __bf16 cvbf16x2_t __attribute__((ext_vector_type(2)));
__device__ __forceinline__ unsigned cvtpk(float lo, float hi) { cvf32x2_t v = {lo, hi}; return __builtin_bit_cast(unsigned, __builtin_convertvector(v, cvbf16x2_t)); }
__device__ __forceinline__ int mbcnt64(unsigned long long m) { return (int)__builtin_amdgcn_mbcnt_hi((unsigned)(m >> 32), __builtin_amdgcn_mbcnt_lo((unsigned)m, 0u)); }

__device__ __forceinline__ void phase_init(LAS unsigned char* lds, const float* biastab, const float* kvg, int tid) {
    LAS float* bt = (LAS float*)(lds + BIAS_OFF);
    for (int i = tid; i < 129 * 8; i += 512) bt[i] = biastab[i];
    if (tid < 64) { float m = fmaxf(fabsf(kvg[tid]), fabsf(kvg[tid + 64]));
#pragma unroll
        for (int o = 1; o < 64; o <<= 1) m = fmaxf(m, __shfl_xor(m, o));
        if (tid == 0) *(LAS float*)(lds + CMAX_OFF) = m * 11.313708499f * 1.01f; }
    __syncthreads();
    if (tid < 8) { float m = -1e30f; for (int d = 0; d < 129; ++d) m = fmaxf(m, bt[d * 8 + tid]); ((LAS float*)(lds + BMAX_OFF))[tid] = m; }
    __syncthreads();
}

__device__ __forceinline__ void scores(LAS unsigned char* lds, int b, int q0, const bf16_t* qabs, const bf16_t* kidx, int wave, int lane) {
    const int hi = lane >> 5, c32 = lane & 31;
    const int a_ = c32 >> 3, hp = (c32 >> 2) & 1, r3 = c32 & 3;
    const int head = 4 * (a_ & 1) + r3, qt = 2 * hp + (a_ >> 1);
    bf16x8 A[4][4];
#pragma unroll
    for (int rt = 0; rt < 4; ++rt)
#pragma unroll
        for (int s = 0; s < 4; ++s) A[rt][s] = *(const bf16x8*)(qabs + (size_t)(b * 2048 + q0 + 4 * rt + qt) * 1536 + 1024 + s * 128 + head * 16 + 8 * hi);
    const int nkt = (q0 + 16 + 31) >> 5;
    LAS float* SC = (LAS float*)(lds + SC_OFF); const LAS float* Wl = (const LAS float*)(lds + W_OFF);
    bf16x8 Bn[4];
    { const bf16_t* kr = kidx + (size_t)(b * 2048 + (wave < nkt ? wave : 0) * 32 + c32) * 64 + 8 * hi;
#pragma unroll
      for (int s = 0; s < 4; ++s) Bn[s] = *(const bf16x8*)(kr + 16 * s); }
    __syncthreads();
    for (int kt = wave; kt < nkt; kt += 8) {
        bf16x8 B[4];
#pragma unroll
        for (int s = 0; s < 4; ++s) B[s] = Bn[s];
        if (kt + 8 < nkt) { const bf16_t* kr = kidx + (size_t)(b * 2048 + (kt + 8) * 32 + c32) * 64 + 8 * hi;
#pragma unroll
            for (int s = 0; s < 4; ++s) Bn[s] = *(const bf16x8*)(kr + 16 * s); }
        const int key = kt * 32 + c32;
        f32x16 acc[4];
#pragma unroll
        for (int rt = 0; rt < 4; ++rt) acc[rt] = (f32x16){0.f, 0.f, 0.f, 0.f, 0.f, 0.f, 0.f, 0.f, 0.f, 0.f, 0.f, 0.f, 0.f, 0.f, 0.f, 0.f};
#pragma unroll
        for (int s = 0; s < 4; ++s)
#pragma unroll
            for (int rt = 0; rt < 4; ++rt) acc[rt] = __builtin_amdgcn_mfma_f32_32x32x16_bf16(A[rt][s], B[s], acc[rt], 0, 0, 0);
        f32x4 wv[4][4];
#pragma unroll
        for (int rt = 0; rt < 4; ++rt) { const LAS f32x4* wp = (const LAS f32x4*)(Wl + (4 * rt + 2 * hi) * 8);
#pragma unroll
            for (int q = 0; q < 4; ++q) wv[rt][q] = wp[q]; }
#pragma unroll
        for (int rt = 0; rt < 4; ++rt) {
            const f32x4 w0 = wv[rt][0], w1 = wv[rt][1], w2 = wv[rt][2], w3 = wv[rt][3]; const f32x16 a = acc[rt];
            float s0 = w0.x * fmaxf(a[0], 0.f); s0 += w0.y * fmaxf(a[1], 0.f); s0 += w0.z * fmaxf(a[2], 0.f); s0 += w0.w * fmaxf(a[3], 0.f);
            s0 += w1.x * fmaxf(a[4], 0.f); s0 += w1.y * fmaxf(a[5], 0.f); s0 += w1.z * fmaxf(a[6], 0.f); s0 += w1.w * fmaxf(a[7], 0.f);
            float s1 = w2.x * fmaxf(a[8], 0.f); s1 += w2.y * fmaxf(a[9], 0.f); s1 += w2.z * fmaxf(a[10], 0.f); s1 += w2.w * fmaxf(a[11], 0.f);
            s1 += w3.x * fmaxf(a[12], 0.f); s1 += w3.y * fmaxf(a[13], 0.f); s1 += w3.z * fmaxf(a[14], 0.f); s1 += w3.w * fmaxf(a[15], 0.f);
            const int ql = 4 * rt + 2 * hi, t0 = q0 + ql;
            SC[ql * 2048 + key] = key <= t0 ? s0 : -INFINITY; SC[(ql + 1) * 2048 + key] = key <= t0 + 1 ? s1 : -INFINITY;
        }
    }
}
__device__ __forceinline__ void topk(LAS unsigned char* lds, int q0, int qq, int lane) {
    const int t = q0 + qq, n = t + 1;
    LAS unsigned short* list = (LAS unsigned short*)(lds + LIST_OFF) + qq * 256; LAS int* nsel = (LAS int*)(lds + NSEL_OFF);
    if (n <= 256) { for (int i = lane; i < 256; i += 64) list[i] = (unsigned short)(i < n ? i : t); if (lane == 0) nsel[qq] = n; return; }
    const int nk = ((q0 + 16 + 31) >> 5) * 32;
    const LAS float* SC = (const LAS float*)(lds + SC_OFF) + qq * 2048;
    unsigned u[32];
#pragma unroll
    for (int j = 0; j < 32; ++j) { const int key = lane + 64 * j; unsigned v = 0u; if (key < nk) { const unsigned bts = __float_as_uint(SC[key]); v = (bts & 0x80000000u) ? ~bts : (bts | 0x80000000u); } u[j] = v; }
    unsigned tau = 0u;
    for (int bit = 31; bit >= 0; --bit) {
        const unsigned cand = tau | (1u << bit); int cnt = 0;
#pragma unroll
        for (int j = 0; j < 32; ++j) cnt += __popcll(__ballot(u[j] >= cand));
        if (cnt >= 256) tau = cand;
        if (cnt == 256) break;
    }
    int cgt = 0;
#pragma unroll
    for (int j = 0; j < 32; ++j) cgt += __popcll(__ballot(u[j] > tau));
    const int r = 256 - cgt; int base = 0, eqb = 0;
#pragma unroll
    for (int j = 0; j < 32; ++j) {
        const bool gt = u[j] > tau, eq = u[j] == tau; const unsigned long long em = __ballot(eq);
        const bool sel = gt || (eq && (eqb + mbcnt64(em)) < r); const unsigned long long sm = __ballot(sel);
        if (sel) list[base + mbcnt64(sm)] = (unsigned short)(lane + 64 * j);
        base += __popcll(sm); eqb += __popcll(em);
    }
    if (lane == 0) nsel[qq] = 256;
}
__device__ __forceinline__ int wave_scan_incl(int x) {
    x += __builtin_amdgcn_update_dpp(0, x, 0x111, 0xF, 0xF, true);
    x += __builtin_amdgcn_update_dpp(0, x, 0x112, 0xF, 0xF, true);
    x += __builtin_amdgcn_update_dpp(0, x, 0x114, 0xF, 0xF, true);
    x += __builtin_amdgcn_update_dpp(0, x, 0x118, 0xF, 0xF, true);
    x += __builtin_amdgcn_update_dpp(0, x, 0x142, 0xA, 0xF, false);
    x += __builtin_amdgcn_update_dpp(0, x, 0x143, 0xC, 0xF, false);
    return x;
}
__device__ __forceinline__ void topk2(LAS unsigned char* lds, int q0, int qq, int wave, int lane, unsigned* dbg_flag_g = nullptr) {
    const int t = q0 + qq, n = t + 1;
    LAS unsigned short* list = (LAS unsigned short*)(lds + LIST_OFF) + qq * 256; LAS int* nsel = (LAS int*)(lds + NSEL_OFF);
    if (n <= 256) { for (int i = lane; i < 256; i += 64) list[i] = (unsigned short)(i < n ? i : t); if (lane == 0) nsel[qq] = n; return; }
    const int nk = ((q0 + 16 + 31) >> 5) * 32;
    const LAS float* SC = (const LAS float*)(lds + SC_OFF) + qq * 2048;
    LAS int* hist = (LAS int*)(lds + HIST_OFF) + wave * 64;
    float v[32]; float lo = INFINITY, hi = -INFINITY;
#pragma unroll
    for (int j = 0; j < 8; ++j) { f32x4 x = {-INFINITY, -INFINITY, -INFINITY, -INFINITY}; if (256 * j + 4 * lane < nk) x = *(const LAS f32x4*)(SC + 256 * j + 4 * lane);
#pragma unroll
        for (int e = 0; e < 4; ++e) { v[4 * j + e] = x[e]; hi = fmaxf(hi, x[e]); lo = fminf(lo, x[e] == -INFINITY ? INFINITY : x[e]); } }
#pragma unroll
    for (int o = 1; o < 64; o <<= 1) { hi = fmaxf(hi, __shfl_xor(hi, o)); lo = fminf(lo, __shfl_xor(lo, o)); }
    bool ok = hi > lo;
    float sc = 0.f, off = 0.f; int B = 0, B2 = 0, need2 = 0, ncand = 0;
    if (ok) {
        sc = 63.99f / (hi - lo); off = -lo * sc;
        hist[lane] = 0;
#pragma unroll
        for (int j = 0; j < 8; ++j) if (256 * j < nk) {
#pragma unroll
            for (int e = 0; e < 4; ++e) { const int i = 4 * j + e; int bb = (int)__builtin_fmaf(v[i], sc, off); bb = bb < 0 ? 0 : (bb > 63 ? 63 : bb); (void)__hip_atomic_fetch_add((LAS unsigned*)&hist[bb], 1u, __ATOMIC_RELAXED, __HIP_MEMORY_SCOPE_WORKGROUP); } }
        int c = hist[lane]; int incl = wave_scan_incl(c); int tot = __builtin_amdgcn_readlane(incl, 63); int suf = tot - incl + c;
        unsigned long long m = __ballot(suf >= 256); B = 63 - __builtin_clzll(m);
        const int above = (B < 63) ? __builtin_amdgcn_readlane(suf, (B + 1) & 63) : 0; const int need1 = 256 - above;
        ok = (B > 0);
        if (ok) {
            const float fB = (float)B;
            hist[lane] = 0;
#pragma unroll
            for (int j = 0; j < 8; ++j) if (256 * j < nk) {
#pragma unroll
              for (int e = 0; e < 4; ++e) { const int i = 4 * j + e; const float f = __builtin_fmaf(v[i], sc, off); int bb = (int)f; bb = bb > 63 ? 63 : bb; if (bb == B) { int b2 = (int)((f - fB) * 64.f); b2 = b2 < 0 ? 0 : (b2 > 63 ? 63 : b2); (void)__hip_atomic_fetch_add((LAS unsigned*)&hist[b2], 1u, __ATOMIC_RELAXED, __HIP_MEMORY_SCOPE_WORKGROUP); } } }
            c = hist[lane]; incl = wave_scan_incl(c); tot = __builtin_amdgcn_readlane(incl, 63); suf = tot - incl + c;
            m = __ballot(suf >= need1); B2 = 63 - __builtin_clzll(m);
            const int above2 = (B2 < 63) ? __builtin_amdgcn_readlane(suf, (B2 + 1) & 63) : 0; need2 = need1 - above2; ncand = __builtin_amdgcn_readlane(c, B2);
            ok = (ncand <= 64) && (B < 63 || B2 < 63);
        }
    }
#ifdef DSA_FALLBACK_COUNT
    if (!ok && lane == 0) atomicAdd(dbg_flag_g + 64, 1u);
#endif
    if (!ok) { topk(lds, q0, qq, lane); return; }
    const float thrLo = (float)B + (float)B2 * (1.f / 64.f), thrHi = (float)B + (float)(B2 + 1) * (1.f / 64.f);
    LAS float* cv = (LAS float*)list; LAS unsigned short* ck = list + 128;
    int base = 0;
#pragma unroll
    for (int j = 0; j < 8; ++j) if (256 * j < nk) {
#pragma unroll
      for (int e = 0; e < 4; ++e) { const int i = 4 * j + e; const float f = __builtin_fmaf(v[i], sc, off); const bool isc = (f >= thrLo) && (f < thrHi); const unsigned long long cm = __ballot(isc);
        if (cm) { if (isc) { const int pos = base + mbcnt64(cm); cv[pos] = v[i]; ck[pos] = (unsigned short)(256 * j + 4 * lane + e); } base += __popcll(cm); } } }
    const float myv = lane < ncand ? cv[lane] : -INFINITY; const int myk = lane < ncand ? (int)ck[lane] : 0x7fffffff; int rank = 0;
    for (int k = 0; k < ncand; ++k) { const float vk = __int_as_float(__builtin_amdgcn_readlane(__float_as_int(myv), k)); const int kk = __builtin_amdgcn_readlane(myk, k); rank += (vk > myv || (vk == myv && kk < myk)) ? 1 : 0; }
    const unsigned long long lm = __ballot(lane < ncand && rank == need2 - 1); const int ll = (int)__builtin_ctzll(lm);
    const float tauv = __int_as_float(__builtin_amdgcn_readlane(__float_as_int(myv), ll)); const int tauk = __builtin_amdgcn_readlane(myk, ll);
    base = 0;
#pragma unroll
    for (int j = 0; j < 8; ++j) if (256 * j < nk) {
#pragma unroll
      for (int e = 0; e < 4; ++e) { const int i = 4 * j + e; const int key = 256 * j + 4 * lane + e; const bool sel = (v[i] > tauv) || (v[i] == tauv && key <= tauk); const unsigned long long sm = __ballot(sel);
        if (sel) list[base + mbcnt64(sm)] = (unsigned short)key; base += __popcll(sm); } }
    if (lane == 0) nsel[qq] = 256;
}
__device__ __forceinline__ void attend2(LAS unsigned char* lds, int b, int q0, int wave, int lane, const bf16_t* qabs, const bf16_t* ckv, bf16_t* mix) {
    const int r16 = lane & 15, g = lane >> 4;
    LAS unsigned char* buf0 = lds + wave * 16384; LAS unsigned char* buf1 = buf0 + 8192;
    const LAS unsigned short* listw = (const LAS unsigned short*)(lds + LIST_OFF) + (2 * wave) * 256;
    const LAS float* biasT = (const LAS float*)(lds + BIAS_OFF);
    const int n0 = ((const LAS int*)(lds + NSEL_OFF))[2 * wave], n1 = ((const LAS int*)(lds + NSEL_OFF))[2 * wave + 1];
    const int ns0 = (n0 + 31) >> 5, total = ns0 + ((n1 + 31) >> 5);
    const float cmax = *(const LAS float*)(lds + CMAX_OFF), bmax = ((const LAS float*)(lds + BMAX_OFF))[r16 & 7];
    const int xr = xsw(r16);
    const int q4 = r16 >> 2, p4 = r16 & 3; const int rra = 4 * g + q4, rrb = 16 + 4 * g + q4; const int xa = xsw(rra & 15), xb = xsw(rrb & 15);
    int t = 0, n = 0; size_t row = 0; const LAS unsigned short* list = listw; bf16x8 QB[4]; float Mh = 0.f, lsum = 0.f; f32x4 O[8];
    u32x4 X[8], Y[8];
#define DSA_LOAD(ST, kk) do { if ((kk) < total) { const int sel_ = (kk) >= ns0 ? 1 : 0; const LAS unsigned short* lp_ = listw + sel_ * 256 + ((kk) - (sel_ ? ns0 : 0)) * 32; \
        _Pragma("unroll") for (int i_ = 0; i_ < 8; ++i_) { const int rr_ = 4 * i_ + g; const int idx_ = lp_[rr_]; ST[i_] = *(const u32x4*)(ckv + ((size_t)b * 2048 + idx_) * 128 + (r16 ^ xsw(rr_ & 15)) * 8); } } } while (0)
#define DSA_WRITE(ST, bufp) do { _Pragma("unroll") for (int i_ = 0; i_ < 8; ++i_) *(LAS u32x4*)((bufp) + (4 * i_ + g) * 256 + r16 * 16) = ST[i_]; } while (0)
#define DSA_INIT(qq_) do { t = q0 + (qq_); row = (size_t)b * 2048 + t; n = ((qq_) & 1) ? n1 : n0; list = listw + ((qq_) & 1) * 256; float qn2_ = 0.f; \
        _Pragma("unroll") for (int s_ = 0; s_ < 4; ++s_) { bf16x8 v_ = {0, 0, 0, 0, 0, 0, 0, 0}; if (r16 < 8) v_ = *(const bf16x8*)(qabs + row * 1536 + s_ * 256 + r16 * 32 + 8 * g); QB[s_] = v_; \
            _Pragma("unroll") for (int e_ = 0; e_ < 8; ++e_) { const float f_ = bf2f((bf16_t)v_[e_]); qn2_ += f_ * f_; } } \
        qn2_ += __shfl_xor(qn2_, 16); qn2_ += __shfl_xor(qn2_, 32); Mh = sqrtf(qn2_) * cmax + bmax; lsum = 0.f; \
        _Pragma("unroll") for (int dt_ = 0; dt_ < 8; ++dt_) O[dt_] = (f32x4){0.f, 0.f, 0.f, 0.f}; } while (0)
#define DSA_FINAL() do { float l_ = lsum; l_ += __shfl_xor(l_, 16); l_ += __shfl_xor(l_, 32); const float linv_ = 1.f / l_; \
        _Pragma("unroll") for (int e_ = 0; e_ < 4; ++e_) { const int hrow_ = (4 * g + e_) & 7; const float inv_ = __shfl(linv_, hrow_); \
            if (g < 2) { _Pragma("unroll") for (int dt_ = 0; dt_ < 8; ++dt_) mix[row * MIXK + 512 + hrow_ * 128 + 16 * dt_ + r16] = f2bf(O[dt_][e_] * inv_); } } } while (0)
#define DSA_COMPUTE(kk, buf) do { if ((kk) == ns0) { DSA_FINAL(); DSA_INIT(2 * wave + 1); } const int step = (kk) >= ns0 ? (kk) - ns0 : (kk); \
          \
        bf16x8 af_[2][4]; \
        _Pragma("unroll") for (int G = 0; G < 2; ++G) _Pragma("unroll") for (int s = 0; s < 4; ++s) af_[G][s] = *(const LAS bf16x8*)((buf) + (16 * G + r16) * 256 + (((4 * s + g) ^ xr) * 16)); \
        const int pb0_ = step * 32 + 4 * g; const u16x4 ida_ = *(const LAS u16x4*)(list + pb0_), idb_ = *(const LAS u16x4*)(list + pb0_ + 16); \
        s16x4 tlo_[8], thi_[8]; \
        _Pragma("unroll") for (int dt = 0; dt < 8; ++dt) { const int ch = 2 * dt + (p4 >> 1); \
            tlo_[dt] = __builtin_bit_cast(s16x4, __builtin_amdgcn_ds_read_tr16_b64_v4i16((LAS s16x4*)((buf) + rra * 256 + ((ch ^ xa) * 16) + 8 * (p4 & 1)))); \
            thi_[dt] = __builtin_bit_cast(s16x4, __builtin_amdgcn_ds_read_tr16_b64_v4i16((LAS s16x4*)((buf) + rrb * 256 + ((ch ^ xb) * 16) + 8 * (p4 & 1)))); } \
        float bz_[2][4]; \
        _Pragma("unroll") for (int e = 0; e < 4; ++e) { int d0_ = t - (int)ida_[e]; d0_ = d0_ < 128 ? d0_ : 128; d0_ = d0_ < 0 ? 0 : d0_; int d1_ = t - (int)idb_[e]; d1_ = d1_ < 128 ? d1_ : 128; d1_ = d1_ < 0 ? 0 : d1_; \
            bz_[0][e] = biasT[d0_ * 8 + (r16 & 7)]; bz_[1][e] = biasT[d1_ * 8 + (r16 & 7)]; } \
        f32x4 S_[2]; \
        _Pragma("unroll") for (int G = 0; G < 2; ++G) { f32x4 acc = {0.f, 0.f, 0.f, 0.f}; \
            _Pragma("unroll") for (int s = 0; s < 4; ++s) acc = __builtin_amdgcn_mfma_f32_16x16x32_bf16(af_[G][s], QB[s], acc, 0, 0, 0); \
            S_[G] = acc; } \
        float P_[2][4]; \
        _Pragma("unroll") for (int G = 0; G < 2; ++G) _Pragma("unroll") for (int e = 0; e < 4; ++e) { const float lg = S_[G][e] + bz_[G][e] - Mh; \
                const float pv = (pb0_ + 16 * G + e < n) ? __builtin_amdgcn_exp2f(lg) : 0.f; lsum += pv; P_[G][e] = pv; } \
        u32x4 pw; pw.x = cvtpk(P_[0][0], P_[0][1]); pw.y = cvtpk(P_[0][2], P_[0][3]); pw.z = cvtpk(P_[1][0], P_[1][1]); pw.w = cvtpk(P_[1][2], P_[1][3]); \
        const bf16x8 PA = __builtin_bit_cast(bf16x8, pw); \
        _Pragma("unroll") for (int dt = 0; dt < 8; ++dt) { const bf16x8 vb = {tlo_[dt][0], tlo_[dt][1], tlo_[dt][2], tlo_[dt][3], thi_[dt][0], thi_[dt][1], thi_[dt][2], thi_[dt][3]}; \
            O[dt] = __builtin_amdgcn_mfma_f32_16x16x32_bf16(PA, vb, O[dt], 0, 0, 0); } } while (0)
    DSA_LOAD(X, 0); DSA_LOAD(Y, 1);
    __syncthreads();
    DSA_INIT(2 * wave);
    DSA_WRITE(X, buf0); DSA_LOAD(X, 2);
    if (1 < total) { DSA_WRITE(Y, buf1); DSA_LOAD(Y, 3); }
    for (int k = 0; k < total; k += 2) {
        DSA_COMPUTE(k, buf0);
        if (k + 2 < total) { DSA_WRITE(X, buf0); DSA_LOAD(X, k + 4); }
        if (k + 1 < total) { DSA_COMPUTE(k + 1, buf1); if (k + 3 < total) { DSA_WRITE(Y, buf1); DSA_LOAD(Y, k + 5); } }
    }
    DSA_FINAL();
#undef DSA_LOAD
#undef DSA_WRITE
#undef DSA_INIT
#undef DSA_FINAL
#undef DSA_COMPUTE
}
__device__ __forceinline__ void unit(LAS unsigned char* lds, int b, int q0, int tid, int wave, int lane, const bf16_t* qabs, const bf16_t* ckv, const bf16_t* kidx, const float* widx, bf16_t* mix, unsigned* dbg_flag) {
    asm volatile("" : "+v"(tid));
    lane = tid & 63;
    if (tid < 128) ((LAS float*)(lds + W_OFF))[tid] = widx[(size_t)(b * 2048 + q0) * 8 + tid];
#ifndef DSA_REP_S1
#define DSA_REP_S1 1
#define DSA_REP_S2 1
#define DSA_REP_S3 1
#endif
    if (q0 + 16 > 256) { for (int rp = 0; rp < DSA_REP_S1; ++rp) { scores(lds, b, q0, qabs, kidx, wave, lane); __syncthreads(); } }
    else __syncthreads();
    asm volatile("" : "+v"(tid)); lane = tid & 63;
#ifdef DSA_TOPK_CHECK
    for (int e2 = 0; e2 < 2; ++e2) { const int qq = 2 * wave + e2;
        topk(lds, q0, qq, lane); const LAS unsigned short* lw = (const LAS unsigned short*)(lds + LIST_OFF) + qq * 256; const int ns = ((const LAS int*)(lds + NSEL_OFF))[qq];
        unsigned h1 = 0, h2 = 0; for (int i = lane; i < ns; i += 64) { const unsigned x = lw[i]; h1 += x; h2 += x * x; }
        topk2(lds, q0, qq, wave, lane); const int ns2 = ((const LAS int*)(lds + NSEL_OFF))[qq];
        unsigned g1 = 0, g2 = 0; for (int i = lane; i < ns2; i += 64) { const unsigned x = lw[i]; g1 += x; g2 += x * x; }
#pragma unroll
        for (int o = 1; o < 64; o <<= 1) { h1 += __shfl_xor(h1, o); h2 += __shfl_xor(h2, o); g1 += __shfl_xor(g1, o); g2 += __shfl_xor(g2, o); }
        if (lane == 0 && (h1 != g1 || h2 != g2 || ns != ns2)) atomicAdd(dbg_flag, 1u); }
#else
    for (int rp = 0; rp < DSA_REP_S2; ++rp) { topk2(lds, q0, 2 * wave, wave, lane, dbg_flag); topk2(lds, q0, 2 * wave + 1, wave, lane, dbg_flag); }
#endif
    asm volatile("" : "+v"(tid)); lane = tid & 63;
    for (int rp = 0; rp < DSA_REP_S3; ++rp) { attend2(lds, b, q0, wave, lane, qabs, ckv, mix); __syncthreads(); }
}
}
#ifndef DN_REP_E
#define DN_REP_E 1
#define DN_REP_T 1
#endif
namespace dn {
typedef short bf16x8 __attribute__((ext_vector_type(8)));
typedef short s16x4 __attribute__((ext_vector_type(4)));
typedef float f32x4 __attribute__((ext_vector_type(4)));
typedef float f32x2 __attribute__((ext_vector_type(2)));
typedef unsigned u32x4 __attribute__((ext_vector_type(4)));
typedef unsigned u32x2 __attribute__((ext_vector_type(2)));
constexpr int CWL = 132096;
constexpr int QS = 0, KS = 17408, WB = 17408, KGT = 34816, VBT = 52224, KBT = 69632, LF = 87040, TB = 103680, XF = 112896, OF = 87040, QKB = 120832, GC = 130048, BT = 130304;
constexpr int QSTR = 272, TSTR = 136, LSTR = 65, TBSTR = 144, OSTR = 132;
typedef float cvf32x2_t __attribute__((ext_vector_type(2))); typedef __bf16 cvbf16x2_t __attribute__((ext_vector_type(2)));
__device__ __forceinline__ unsigned cvtpk(float lo, float hi) { cvf32x2_t v = {lo, hi}; return __builtin_bit_cast(unsigned, __builtin_convertvector(v, cvbf16x2_t)); }
__device__ __forceinline__ bf16x8 pack2(const f32x4& a, const f32x4& b) { u32x4 w; w.x = cvtpk(a[0], a[1]); w.y = cvtpk(a[2], a[3]); w.z = cvtpk(b[0], b[1]); w.w = cvtpk(b[2], b[3]); return __builtin_bit_cast(bf16x8, w); }
__device__ __forceinline__ bf16x8 frag_perm(const LAS unsigned char* rowp, int s, int g) {
    const u32x2 lo = *(const LAS u32x2*)(rowp + (32 * s + 4 * g) * 2), hi = *(const LAS u32x2*)(rowp + (32 * s + 16 + 4 * g) * 2);
    u32x4 w; w.x = lo.x; w.y = lo.y; w.z = hi.x; w.w = hi.y; return __builtin_bit_cast(bf16x8, w); }
__device__ __forceinline__ bf16x8 frag_nat8(const LAS unsigned char* rowp, int s, int g) {
    const u32x2 lo = *(const LAS u32x2*)(rowp + (32 * s + 8 * g) * 2), hi = *(const LAS u32x2*)(rowp + (32 * s + 8 * g + 4) * 2);
    u32x4 w; w.x = lo.x; w.y = lo.y; w.z = hi.x; w.w = hi.y; return __builtin_bit_cast(bf16x8, w); }
__device__ __forceinline__ float silu(float x) { return x * __builtin_amdgcn_rcpf(1.f + __builtin_amdgcn_exp2f(-LOG2E * x)); }
__device__ __forceinline__ float ex(float x) { return __builtin_amdgcn_exp2f(LOG2E * x); }

__device__ __forceinline__ void run(LAS unsigned char* lds0, int b, int h, const bf16_t* proj, const float* conv_w, const float* beta, const float* gdec, const float* gn, bf16_t* mix, int tid, int wave, int lane) {
    const int r16c = lane & 15, gc = lane >> 4;
    LAS float* cwL = (LAS float*)(lds0 + CWL);
    if (wave == 0) {
#pragma unroll
        for (int p = 0; p < 3; ++p)
#pragma unroll
            for (int e = 0; e < 2; ++e)
#pragma unroll
                for (int j = 0; j < 4; ++j) cwL[((p * 2 + e) * 4 + j) * 64 + lane] = conv_w[j * 1536 + p * 512 + h * 128 + 2 * lane + e];
    }
    __syncthreads();
    const float gn0 = gn[2 * lane], gn1 = gn[2 * lane + 1];
    f32x4 S[8];
#pragma unroll
    for (int i = 0; i < 8; ++i) S[i] = (f32x4){0.f, 0.f, 0.f, 0.f};
    const bf16_t* pbase = proj + h * 128 + 2 * lane;
    unsigned xq[11][3]; float gnext, bnext;
#define DN_LOAD_CHUNK(cn) do { const size_t Rn = (size_t)b * 2048 + 64 * (cn); \
        _Pragma("unroll") for (int a = 0; a < 11; ++a) { const int tt = 64 * (cn) + 8 * wave - 3 + a; \
            _Pragma("unroll") for (int p_ = 0; p_ < 3; ++p_) xq[a][p_] = (tt >= 0) ? *(const unsigned*)(pbase + (Rn + 8 * wave - 3 + a) * PROJ + p_ * 512) : 0u; } \
        gnext = gdec[(Rn + lane) * 4 + h]; bnext = beta[(Rn + lane) * 4 + h]; } while (0)
    DN_LOAD_CHUNK(0);
    for (int c = 0; c < 32; ++c) {
        const size_t R0 = (size_t)b * 2048 + 64 * c;
        int zoff = 0; asm volatile("" : "+v"(zoff));
        LAS unsigned char* lds = lds0 + zoff; const int r16 = r16c + zoff, g = gc + zoff;
        LAS float* Lf = (LAS float*)(lds + LF); LAS float* gcumL = (LAS float*)(lds + GC); LAS float* betaL = (LAS float*)(lds + BT);
        float gcum = gnext;
#pragma unroll
        for (int o = 1; o < 64; o <<= 1) { const float t = __shfl_up(gcum, o); if (lane >= o) gcum += t; }
        const float gl = __int_as_float(__builtin_amdgcn_readlane(__float_as_int(gcum), 63));
        const float bv = bnext;
        if (wave == 0) { gcumL[lane] = gcum; betaL[lane] = bv; }
        for (int rpE = 0; rpE < DN_REP_E; ++rpE) {
            float cw[3][2][4];
#pragma unroll
            for (int p = 0; p < 3; ++p)
#pragma unroll
                for (int e = 0; e < 2; ++e)
#pragma unroll
                    for (int j = 0; j < 4; ++j) cw[p][e][j] = cwL[((p * 2 + e) * 4 + j) * 64 + lane];
            float xw[3][3][2];
#pragma unroll
            for (int a = 0; a < 3; ++a)
#pragma unroll
                for (int p = 0; p < 3; ++p) { xw[a][p][0] = __uint_as_float(xq[a][p] << 16); xw[a][p][1] = __uint_as_float(xq[a][p] & 0xffff0000u); }
#pragma unroll
            for (int i = 0; i < 8; ++i) {
                const int r = 8 * wave + i; float x0[3][2], sv[3][2];
#pragma unroll
                for (int p = 0; p < 3; ++p) { x0[p][0] = __uint_as_float(xq[3 + i][p] << 16); x0[p][1] = __uint_as_float(xq[3 + i][p] & 0xffff0000u); }
#pragma unroll
                for (int p = 0; p < 3; ++p)
#pragma unroll
                    for (int e = 0; e < 2; ++e) { const float s = cw[p][e][0] * xw[0][p][e] + cw[p][e][1] * xw[1][p][e] + cw[p][e][2] * xw[2][p][e] + cw[p][e][3] * x0[p][e]; sv[p][e] = silu(s); }
                const float rq = rsqrtf(wave_sum(sv[0][0] * sv[0][0] + sv[0][1] * sv[0][1]) + EPS) * 0.08838834764831845f;
                const float rk = rsqrtf(wave_sum(sv[1][0] * sv[1][0] + sv[1][1] * sv[1][1]) + EPS);
                const float gr = __int_as_float(__builtin_amdgcn_readlane(__float_as_int(gcum), r)), br = __int_as_float(__builtin_amdgcn_readlane(__float_as_int(bv), r));
                const float eg = ex(gr), ekl = ex(gl - gr);
                const float k0 = sv[1][0] * rk, k1 = sv[1][1] * rk;
                *(LAS unsigned*)(lds + QS + r * QSTR + 4 * lane) = cvtpk(sv[0][0] * rq, sv[0][1] * rq);
                *(LAS unsigned*)(lds + KS + r * QSTR + 4 * lane) = cvtpk(k0, k1);
                const unsigned kg = cvtpk(k0 * ekl, k1 * ekl), kb = cvtpk(k0 * br * eg, k1 * br * eg), vb = cvtpk(sv[2][0] * br, sv[2][1] * br);
                *(LAS unsigned short*)(lds + KGT + (2 * lane) * TSTR + 2 * r) = (unsigned short)kg; *(LAS unsigned short*)(lds + KGT + (2 * lane + 1) * TSTR + 2 * r) = (unsigned short)(kg >> 16);
                *(LAS unsigned short*)(lds + KBT + (2 * lane) * TSTR + 2 * r) = (unsigned short)kb; *(LAS unsigned short*)(lds + KBT + (2 * lane + 1) * TSTR + 2 * r) = (unsigned short)(kb >> 16);
                *(LAS unsigned short*)(lds + VBT + (2 * lane) * TSTR + 2 * r) = (unsigned short)vb; *(LAS unsigned short*)(lds + VBT + (2 * lane + 1) * TSTR + 2 * r) = (unsigned short)(vb >> 16);
#pragma unroll
                for (int p = 0; p < 3; ++p)
#pragma unroll
                    for (int e = 0; e < 2; ++e) { xw[0][p][e] = xw[1][p][e]; xw[1][p][e] = xw[2][p][e]; xw[2][p][e] = x0[p][e]; }
            }
        }
        __syncthreads();
        for (int rpT = 0; rpT < DN_REP_T; ++rpT) {
        {
            const int ti = wave & 3, sel = wave >> 2;
            const LAS unsigned char* Ab = lds + (sel ? QS : KS) + (16 * ti + r16) * QSTR;
            bf16x8 A[4];
#pragma unroll
            for (int s = 0; s < 4; ++s) A[s] = *(const LAS bf16x8*)(Ab + (32 * s + 8 * g) * 2);
            const f32x4 gi4 = *(const LAS f32x4*)(gcumL + 16 * ti + 4 * g), bi4 = *(const LAS f32x4*)(betaL + 16 * ti + 4 * g);
#pragma unroll
            for (int tj = 0; tj < 4; ++tj) {
                f32x4 acc = {0.f, 0.f, 0.f, 0.f};
                if (tj <= ti) {
                    const LAS unsigned char* Bb = lds + KS + (16 * tj + r16) * QSTR; bf16x8 Bf[4];
#pragma unroll
                    for (int s = 0; s < 4; ++s) Bf[s] = *(const LAS bf16x8*)(Bb + (32 * s + 8 * g) * 2);
#pragma unroll
                    for (int s = 0; s < 4; ++s) acc = __builtin_amdgcn_mfma_f32_16x16x32_bf16(A[s], Bf[s], acc, 0, 0, 0);
                }
                const float gj = gcumL[16 * tj + r16]; const int j = 16 * tj + r16;
#pragma unroll
                for (int e = 0; e < 4; ++e) { const int i = 16 * ti + 4 * g + e; const float dec = ex(fminf(gi4[e] - gj, 0.f));
                    if (sel == 0) { const float lv = (i > j) ? bi4[e] * acc[e] * dec : 0.f;
                        if (tj == ti) Lf[i * LSTR + j] = lv; else if (tj < ti) *(LAS unsigned short*)(lds + TB + i * TBSTR + 2 * j) = f2bf(lv); }
                    else *(LAS unsigned short*)(lds + QKB + i * TBSTR + 2 * j) = f2bf((i >= j) ? acc[e] * dec : 0.f); }
            }
        }
        __syncthreads();
        if (wave == 0) {
            const LAS float* Nb = Lf + (16 * g) * LSTR + 16 * g; float x[16]; int rc = r16; asm volatile("" : "+v"(rc));
            float na[55], nb2[65];
            { int q = 0;
#pragma unroll
              for (int r = 1; r <= 10; ++r)
#pragma unroll
                  for (int j = 0; j < r; ++j) na[q++] = Nb[r * LSTR + j]; }
            { int q = 0;
#pragma unroll
              for (int r = 11; r <= 15; ++r)
#pragma unroll
                  for (int j = 0; j < r; ++j) nb2[q++] = Nb[r * LSTR + j]; }
            x[0] = (0 == rc) ? 1.f : 0.f;
            { int q = 0;
#pragma unroll
              for (int r = 1; r <= 10; ++r) { float s = (r == rc) ? 1.f : 0.f;
#pragma unroll
                  for (int j = 0; j < r; ++j) s -= na[q++] * x[j];
                  x[r] = s; } }
            { int q = 0;
#pragma unroll
              for (int r = 11; r <= 15; ++r) { float s = (r == rc) ? 1.f : 0.f;
#pragma unroll
                  for (int j = 0; j < r; ++j) s -= nb2[q++] * x[j];
                  x[r] = s; } }
#pragma unroll
            for (int r = 0; r < 16; ++r) *(LAS unsigned short*)(lds + TB + (16 * g + r) * TBSTR + 2 * (16 * g + r16)) = f2bf(x[r]);
        }
        __syncthreads();
        }
        f32x4 U[4];
        {
            const LAS unsigned char* tl = lds + TB;
#define DN_A1(b_, k_) ({ const u32x2 lo_ = *(const LAS u32x2*)(tl + (16 * (b_) + r16) * TBSTR + (16 * (k_) + 4 * g) * 2); u32x4 w_; w_.x = lo_.x; w_.y = lo_.y; w_.z = 0u; w_.w = 0u; __builtin_bit_cast(bf16x8, w_); })
#define DN_A2(b_, k0_, k1_) ({ const u32x2 lo_ = *(const LAS u32x2*)(tl + (16 * (b_) + r16) * TBSTR + (16 * (k0_) + 4 * g) * 2), hi_ = *(const LAS u32x2*)(tl + (16 * (b_) + r16) * TBSTR + (16 * (k1_) + 4 * g) * 2); \
            u32x4 w_; w_.x = lo_.x; w_.y = lo_.y; w_.z = hi_.x; w_.w = hi_.y; __builtin_bit_cast(bf16x8, w_); })
            const bf16x8 aD0 = DN_A1(0, 0), aL10 = DN_A1(1, 0), aD1 = DN_A1(1, 1), aL2 = DN_A2(2, 0, 1), aD2 = DN_A1(2, 2), aL3a = DN_A2(3, 0, 1), aL3b = DN_A1(3, 2), aD3 = DN_A1(3, 3);
            const f32x4 z4 = {0.f, 0.f, 0.f, 0.f};
#pragma unroll
            for (int which = 0; which < 2; ++which) {
                const LAS unsigned char* rp = lds + (which ? KBT : VBT) + (16 * wave + r16) * TSTR;
                f32x4 R[4];
#pragma unroll
                for (int b4 = 0; b4 < 4; ++b4) { const u32x2 w = *(const LAS u32x2*)(rp + (16 * b4 + 4 * g) * 2);
                    R[b4] = (f32x4){__uint_as_float(w.x << 16), __uint_as_float(w.x & 0xffff0000u), __uint_as_float(w.y << 16), __uint_as_float(w.y & 0xffff0000u)}; }
                f32x4 X0 = __builtin_amdgcn_mfma_f32_16x16x32_bf16(aD0, pack2(R[0], z4), z4, 0, 0, 0);
                f32x4 Y = __builtin_amdgcn_mfma_f32_16x16x32_bf16(aL10, pack2(X0, z4), z4, 0, 0, 0);
                f32x4 X1 = __builtin_amdgcn_mfma_f32_16x16x32_bf16(aD1, pack2(R[1] - Y, z4), z4, 0, 0, 0);
                const bf16x8 b01 = pack2(X0, X1);
                Y = __builtin_amdgcn_mfma_f32_16x16x32_bf16(aL2, b01, z4, 0, 0, 0);
                f32x4 X2 = __builtin_amdgcn_mfma_f32_16x16x32_bf16(aD2, pack2(R[2] - Y, z4), z4, 0, 0, 0);
                Y = __builtin_amdgcn_mfma_f32_16x16x32_bf16(aL3a, b01, z4, 0, 0, 0);
                Y = __builtin_amdgcn_mfma_f32_16x16x32_bf16(aL3b, pack2(X2, z4), Y, 0, 0, 0);
                f32x4 X3 = __builtin_amdgcn_mfma_f32_16x16x32_bf16(aD3, pack2(R[3] - Y, z4), z4, 0, 0, 0);
                if (which == 0) { U[0] = X0; U[1] = X1; U[2] = X2; U[3] = X3; }
                else { const f32x4 Xs[4] = {X0, X1, X2, X3};
#pragma unroll
                    for (int ti = 0; ti < 4; ++ti)
#pragma unroll
                        for (int e = 0; e < 4; ++e) *(LAS unsigned short*)(lds + WB + (16 * ti + 4 * g + e) * QSTR + (16 * wave + r16) * 2) = f2bf(Xs[ti][e]); }
            }
#undef DN_A1
#undef DN_A2
        }
        __syncthreads();
        if (c + 1 < 32) DN_LOAD_CHUNK(c + 1);
        unsigned dzq[8];
#pragma unroll
        for (int i = 0; i < 8; ++i) dzq[i] = *(const unsigned*)(proj + (R0 + 8 * wave + i) * PROJ + C_DZ + h * 128 + 2 * lane);
        {
            bf16x8 Sb[4];
#pragma unroll
            for (int s = 0; s < 4; ++s) Sb[s] = pack2(S[2 * s], S[2 * s + 1]);
            f32x4 Vn[4], Oa[4];
#pragma unroll
            for (int ti = 0; ti < 4; ++ti) {
                const LAS unsigned char* wp = lds + WB + (16 * ti + r16) * QSTR; const LAS unsigned char* qp = lds + QS + (16 * ti + r16) * QSTR;
                bf16x8 wf[4], qf[4];
#pragma unroll
                for (int s = 0; s < 4; ++s) { wf[s] = frag_perm(wp, s, g); qf[s] = frag_perm(qp, s, g); }
                const f32x4 gi4 = *(const LAS f32x4*)(gcumL + 16 * ti + 4 * g);
                f32x4 ws = {0.f, 0.f, 0.f, 0.f}, qs = {0.f, 0.f, 0.f, 0.f};
#pragma unroll
                for (int s = 0; s < 4; ++s) { ws = __builtin_amdgcn_mfma_f32_16x16x32_bf16(wf[s], Sb[s], ws, 0, 0, 0); qs = __builtin_amdgcn_mfma_f32_16x16x32_bf16(qf[s], Sb[s], qs, 0, 0, 0); }
                Vn[ti] = U[ti] - ws;
#pragma unroll
                for (int e = 0; e < 4; ++e) qs[e] *= ex(gi4[e]);
                Oa[ti] = qs;
            }
            bf16x8 Vb[2];
#pragma unroll
            for (int s = 0; s < 2; ++s) Vb[s] = pack2(Vn[2 * s], Vn[2 * s + 1]);
            { bf16x8 kf[4][2];
#pragma unroll
              for (int ti = 0; ti < 4; ++ti) { const LAS unsigned char* kp = lds + QKB + (16 * ti + r16) * TBSTR; kf[ti][0] = frag_perm(kp, 0, g); kf[ti][1] = frag_perm(kp, 1, g); }
#pragma unroll
              for (int ti = 0; ti < 4; ++ti)
#pragma unroll
                  for (int s = 0; s < 2; ++s) Oa[ti] = __builtin_amdgcn_mfma_f32_16x16x32_bf16(kf[ti][s], Vb[s], Oa[ti], 0, 0, 0); }
            const float egl = ex(gl);
#pragma unroll
            for (int half = 0; half < 2; ++half) { bf16x8 kf[4][2];
#pragma unroll
                for (int q = 0; q < 4; ++q) { const LAS unsigned char* kp = lds + KGT + (16 * (4 * half + q) + r16) * TSTR; kf[q][0] = frag_perm(kp, 0, g); kf[q][1] = frag_perm(kp, 1, g); }
#pragma unroll
                for (int q = 0; q < 4; ++q) { f32x4 sa = S[4 * half + q] * egl;
#pragma unroll
                    for (int s = 0; s < 2; ++s) sa = __builtin_amdgcn_mfma_f32_16x16x32_bf16(kf[q][s], Vb[s], sa, 0, 0, 0);
                    S[4 * half + q] = sa; } }
            LAS float* Of = (LAS float*)(lds + OF);
#pragma unroll
            for (int ti = 0; ti < 4; ++ti)
#pragma unroll
                for (int e = 0; e < 4; ++e) Of[(16 * ti + 4 * g + e) * OSTR + 16 * wave + r16] = Oa[ti][e];
        }
        __syncthreads();
        {
            const LAS float* Of = (const LAS float*)(lds + OF);
#pragma unroll
            for (int i = 0; i < 8; ++i) { const int r = 8 * wave + i; const f32x2 o = *(const LAS f32x2*)(Of + r * OSTR + 2 * lane);
                const float rstd = rsqrtf(wave_sum(o.x * o.x + o.y * o.y) * (1.f / 128.f) + EPS);
                const float z0 = __uint_as_float(dzq[i] << 16), z1 = __uint_as_float(dzq[i] & 0xffff0000u);
                *(unsigned*)(mix + (R0 + r) * MIXK + h * 128 + 2 * lane) = cvtpk(o.x * rstd * gn0 * silu(z0), o.y * rstd * gn1 * silu(z1)); }
        }
    }
}
#undef DN_LOAD_CHUNK
}
struct Args { const float* in[28]; float* out; unsigned char* ws; int ph_lo, ph_hi, li, pad; };
struct Frame {
    LAS unsigned char* lds; volatile LAS unsigned* MISC; int tid, lane, wave, G, vcu;
};
template <int NR> __device__ __forceinline__ void dsa_prep_rows(int row0, int lane, const bf16_t* proj, const float* kvg, const float* lng, const float* lnb, const float* a_log, const float* dt_bias,
                                             bf16_t* ckv, bf16_t* kidx, float* widx, float* beta, float* gdec) {
    unsigned cv[NR]; unsigned short kv[NR], sm[NR];
#pragma unroll
    for (int r = 0; r < NR; ++r) { const bf16_t* pr = proj + (size_t)(row0 + r) * PROJ; cv[r] = *(const unsigned*)(pr + C_CKV + lane * 2); kv[r] = pr[C_KIX + lane]; sm[r] = pr[C_WIX + (lane & 15)]; }
    const float g0 = kvg[lane * 2], g1 = kvg[lane * 2 + 1], lg = lng[lane], lb = lnb[lane], al = a_log[lane & 3], dtb = dt_bias[lane & 3];
#pragma unroll
    for (int r = 0; r < NR; ++r) { const int row = row0 + r;
        { const float a = __uint_as_float(cv[r] << 16), b = __uint_as_float(cv[r] & 0xffff0000u);
          const float rs = rsqrtf(wave_sum(a * a + b * b) * (1.f / 128.f) + EPS); *(unsigned*)(ckv + (size_t)row * 128 + lane * 2) = pk2(a * rs * g0, b * rs * g1); }
        { const float a = bf2f(kv[r]); const float mu = wave_sum(a) * (1.f / 64.f); const float xc = a - mu; const float rs = rsqrtf(wave_sum(xc * xc) * (1.f / 64.f) + EPS);
          kidx[(size_t)row * 64 + lane] = f2bf(xc * rs * lg + lb); }
        const float sv = bf2f(sm[r]);
        if (lane < 8) widx[(size_t)row * 8 + lane] = sv * 0.04419417382415922f;
        else if (lane < 12) beta[(size_t)row * 4 + (lane - 8)] = 1.f / (1.f + __expf(-sv));
        else if (lane < 16) { const float xx = sv + dtb; const float sp = xx > 20.f ? xx : log1pf(__expf(xx)); gdec[(size_t)row * 4 + (lane - 12)] = -__expf(al) * sp; }
    }
}

__global__ void __launch_bounds__(NWAVES * 64, 2) mega(Args args) {
    extern __shared__ __attribute__((aligned(16))) unsigned char lds_raw[];
    Frame F;
    F.lds = (LAS unsigned char*)lds_raw;
    F.MISC = (volatile LAS unsigned*)(F.lds + MISC_OFF);
    F.tid = threadIdx.x; F.lane = F.tid & 63; F.wave = __builtin_amdgcn_readfirstlane(F.tid >> 6);
    F.G = gridDim.x; { const int bx = blockIdx.x; F.vcu = (F.G % 8 == 0) ? (bx % 8) * (F.G / 8) + bx / 8 : bx; }
    unsigned char* ws = args.ws;
    const float* x = args.in[0]; const float* mem = args.in[1]; const float* g_mix = args.in[2]; const float* w_in = args.in[3];
    const float* conv_w = args.in[4]; const float* a_log = args.in[5]; const float* dt_bias = args.in[6];
    const float* dn_norm_g = args.in[7]; const float* q_norm_g = args.in[8]; const float* kv_norm_g = args.in[9]; const float* w_uq = args.in[10]; const float* w_uk = args.in[11];
    const float* w_uv = args.in[12]; const float* w_qidx = args.in[13]; const float* kidx_ln_g = args.in[14]; const float* kidx_ln_b = args.in[15];
    const float* rel_bias = args.in[16]; const float* w_out = args.in[17]; const float* g_xattn = args.in[18]; const float* g_mem = args.in[19];
    const float* w_xq = args.in[20]; const float* w_xkv = args.in[21]; const float* w_xo = args.in[22]; const float* g_ffn = args.in[23];
    const float* w_gate = args.in[24]; const float* w_up = args.in[25]; const float* w_down = args.in[26]; const float* g_final = args.in[27];
    float* out = args.out;
    bf16_t* Win_t = (bf16_t*)(ws + WS_WIN); bf16_t* Wkv_t = (bf16_t*)(ws + WS_WKV); bf16_t* Wdsa_t = (bf16_t*)(ws + WS_WDSA); bf16_t* Wout_t = (bf16_t*)(ws + WS_WOUT);
    bf16_t* Wxq_t = (bf16_t*)(ws + WS_WXQ); bf16_t* Wxo_t = (bf16_t*)(ws + WS_WXO); bf16_t* Wgu_t = (bf16_t*)(ws + WS_WGU); bf16_t* Wdn_t = (bf16_t*)(ws + WS_WDN);
    unsigned char* stt = ws + WS_ST;
    float* rstdx = (float*)(stt + ST_RSTDX); float* cqss = (float*)(stt + ST_CQSS); float* lpart = (float*)(stt + ST_LPART);
    float* widx = (float*)(stt + ST_WIDX); float* beta = (float*)(stt + ST_BETA); float* gdec = (float*)(stt + ST_G); float* biastab = (float*)(stt + ST_BIAS);
    bf16_t* mnb = (bf16_t*)(ws + WS_MNB); bf16_t* kx = (bf16_t*)(ws + WS_KX); bf16_t* vT = (bf16_t*)(ws + WS_VT); bf16_t* ckv = (bf16_t*)(ws + WS_CKV); bf16_t* kidx = (bf16_t*)(ws + WS_KIDX);
    float* ssq1 = (float*)(ws + WS_SSQ); float* ssq2 = ssq1 + (size_t)M * 16;
    bf16_t* proj = (bf16_t*)(ws + WS_PROJ); bf16_t* mix = (bf16_t*)(ws + WS_MIX); bf16_t* xb = (bf16_t*)(ws + WS_XB); bf16_t* qabs = (bf16_t*)out;
    bf16_t* x1b = (bf16_t*)(ws + WS_X1B); bf16_t* qx = (bf16_t*)(ws + WS_QX); bf16_t* Pb = (bf16_t*)(ws + WS_P); bf16_t* ox = (bf16_t*)(ws + WS_OX); bf16_t* x2b = (bf16_t*)(ws + WS_X2B); bf16_t* act = (bf16_t*)(ws + WS_ACT);

    for (int u = F.tid; u < (LDS_BYTES - LDSCTL_OFF) / 4; u += NWAVES * 64) ((LAS unsigned*)(F.lds + LDSCTL_OFF))[u] = 0u;
    __syncthreads();
    XcdBarrier bar = xcd_barrier_post((unsigned*)(ws + WS_CTL) + 4096 + args.li * XCD_BAR_WORDS, F.MISC + 8);
#define GRID_BAR() xcd_barrier(bar)
    const int lo = args.ph_lo, hi = args.ph_hi;
#ifdef ONLY_PHASE
#define IN(k) ((k) == ONLY_PHASE && lo <= (k) && (k) < hi)
#else
#define IN(k) (lo <= (k) && (k) < hi)
#endif
#define BOTH(k) (IN(k) && IN((k) + 1))
    const int gw = F.vcu * NWAVES + F.wave, NGW = F.G * NWAVES;
    PG8_LAS unsigned char* ring = (PG8_LAS unsigned char*)F.lds;

    if (IN(0)) {
        LAS float* scr = (LAS float*)(F.lds + F.wave * 16384);
        constexpr int I_OB = 32 * 32, I_QA = 8 * 32, I_QI = 4 * 16, I_IN = 16 * 80, I_KV = 16 * 64, I_XQ = 16 * 32, I_XO = 16 * 32, I_GU = 16 * 176, I_DN = 44 * 32, I_OA = 8 * 32;
        constexpr int NITEMS = I_OB + I_QA + I_QI + I_IN + I_KV + I_XQ + I_XO + I_GU + I_DN + I_OA;
        for (int it = gw; it < NITEMS; it += NGW) {
            int r = it;
            if (r < I_OB) { const int kb = r >> 5, nb = r & 31, k0 = 32 * kb, h = k0 >> 7;
                heavy_item(w_uv, 64, w_out + (size_t)(512 + h * 64) * 1024, 1024, nullptr, 1.f, k0, 32 * nb, 32 * nb, Wout_t, MIXK, 512, scr, F.lane); continue; } r -= I_OB;
            if (r < I_QA) { const int kb = r >> 5, nb = r & 31, n0 = 32 * nb, h = n0 >> 7;
                heavy_item(w_uq + h * 64, 512, w_uk + (size_t)(h * 64) * 128 - h * 128, 128, q_norm_g, 0.125f * LOG2E, 32 * kb, n0, ((n0 >> 5) & 3) * 256 + h * 32, Wdsa_t, 256, 0, scr, F.lane); continue; }   r -= I_QA;
            if (r < I_QI) { tr_item(SrcQidx{w_qidx, q_norm_g}, 512, Wdsa_t + (size_t)1024 * 256, 256, 0, scr, r, F.lane); continue; } r -= I_QI;
            if (r < I_IN) { tr_item(SrcWin{w_in, g_mix}, PROJ, Win_t, 1024, 0, scr, r, F.lane); continue; } r -= I_IN;
            if (r < I_KV) { tr_item(SrcPlain{w_xkv, 2048, nullptr, 1.f}, 2048, Wkv_t, 1024, 0, scr, r, F.lane); continue; } r -= I_KV;
            if (r < I_XQ) { tr_item(SrcPlain{w_xq, 1024, g_xattn, 0.0625f * LOG2E}, 1024, Wxq_t, 1024, 0, scr, r, F.lane); continue; } r -= I_XQ;
            if (r < I_XO) { tr_item(SrcPlain{w_xo, 1024, nullptr, 1.f}, 1024, Wxo_t, 1024, 0, scr, r, F.lane); continue; } r -= I_XO;
            if (r < I_GU) { tr_item(SrcGU{w_gate, w_up, g_ffn}, 2 * DFF, Wgu_t, 1024, 0, scr, r, F.lane); continue; } r -= I_GU;
            if (r < I_DN) { tr_item(SrcPlain{w_down, 1024, nullptr, 1.f}, 1024, Wdn_t, DFF, 0, scr, r, F.lane); continue; } r -= I_DN;
            tr_item(SrcPlain{w_out, 1024, nullptr, 1.f}, 1024, Wout_t, MIXK, 0, scr, r, F.lane);
        }
        for (int m = 4 * gw; m < M; m += 4 * NGW) row_prep<4>(x + (size_t)m * D, nullptr, xb + (size_t)m * D, rstdx + m, F.lane);
        for (int m = 2 * gw; m < MM; m += 2 * NGW) row_prep<2>(mem + (size_t)m * D, g_mem, mnb + (size_t)m * D, nullptr, F.lane);
        if (blockIdx.x == 0) for (int i = F.tid; i < 129 * 8; i += NWAVES * 64) {
            const int d = i >> 3, h = i & 7; int bkt;
            if (d < 16) bkt = d; else { const float lr = logf((float)d / 16.f) / 2.0794415416798357f; const int large = 16 + (int)(lr * 16.f); bkt = large < 31 ? large : 31; }
            biastab[i] = rel_bias[bkt * 8 + h] * LOG2E; }
        if (BOTH(0)) GRID_BAR();
    }
    if (IN(1)) {
        pg8::Gemm g{xb, Win_t, 1024, 1024, 1024}; pg8::StaticOrder S; S.init(M, PROJ, F.G, (int)blockIdx.x);
        pg8::EpiProj E{proj, PROJ, nullptr, cqss, 8};
        pg8::gemm_phase<pg8::EpiProj, pg8::StaticOrder, true>(ring, g, S, E);
        if (BOTH(1)) GRID_BAR();
    }
    if (IN(2)) {
        for (int m = 4 * gw; m < M; m += 4 * NGW) dsa_prep_rows<4>(m, F.lane, proj, kv_norm_g, kidx_ln_g, kidx_ln_b, a_log, dt_bias, ckv, kidx, widx, beta, gdec);
        { pg8::Gemm g{proj + C_CQ, Wdsa_t, PROJ, 256, 256}; pg8::StaticOrder S; S.init(M, 1536, F.G, (int)blockIdx.x);
          pg8::EpiNormScale<4> E{qabs, 1536, cqss, 1.f / 256.f};
          pg8::gemm_phase<pg8::EpiNormScale<4>, pg8::StaticOrder, true>(ring, g, S, E); }
        if (BOTH(2)) GRID_BAR();
    }
    if (IN(3)) {
        int tid3 = threadIdx.x; asm volatile("" : "+v"(tid3)); const int lane3 = tid3 & 63;
        if (blockIdx.x < 64) dn::run(F.lds, (int)blockIdx.x >> 2, (int)blockIdx.x & 3, proj, conv_w, beta, gdec, dn_norm_g, mix, tid3, F.wave, lane3);
        __syncthreads();
        if (blockIdx.x >= 64) { unsigned* kvq = (unsigned*)(ws + WS_CTL) + 1536;
            for (;;) {
                if (threadIdx.x == 0) F.MISC[17] = __hip_atomic_fetch_add(kvq, 1u, __ATOMIC_RELAXED, __HIP_MEMORY_SCOPE_AGENT);
                __syncthreads(); const int k = (int)F.MISC[17]; __syncthreads();
                if (k >= 128) break;
                if (k < 64) { pg8::Gemm g{mnb, Wkv_t, 1024, 1024, 1024}; pg8::OneUnit S1{{k >> 2, k & 3, 0, 0}}; pg8::EpiProj E{kx, 1024, nullptr, nullptr, -1};
                    pg8::gemm_phase<pg8::EpiProj, pg8::OneUnit, false>(ring, g, S1, E); }
                else { const int k2 = k - 64; pg8::Gemm g{Wkv_t + (size_t)1024 * 1024, mnb, 1024, 1024, 1024}; pg8::OneUnit S1{{k2 >> 4, k2 & 15, 0, 0}}; pg8::EpiProj E{vT, MM, nullptr, nullptr, -1};
                    pg8::gemm_phase<pg8::EpiProj, pg8::OneUnit, false>(ring, g, S1, E); }
            } }
        for (int pass = 0; pass <= args.pad; ++pass) {
        if (pass) GRID_BAR();
        int tid4 = threadIdx.x; asm volatile("" : "+v"(tid4)); const int lane4 = tid4 & 63;
        dsa::phase_init(F.lds, biastab, kv_norm_g, tid4);
        unsigned* qbase = (unsigned*)(ws + WS_CTL) + 2048 + 1024 * pass;
        const int myx = (int)(xb_xcc_id() & 7u);
        for (int sx = 0; sx < 8; ++sx) { const int qx8 = (myx + sx) & 7;
        for (;;) {
            if (tid4 == 0) F.MISC[16] = __hip_atomic_fetch_add(qbase + 64 * qx8, 1u, __ATOMIC_RELAXED, __HIP_MEMORY_SCOPE_AGENT);
            __syncthreads(); const int k = (int)F.MISC[16]; __syncthreads();
            if (k >= 256) break;
            dsa::unit(F.lds, 2 * qx8 + (k & 1), (127 - (k >> 1)) * 16, tid4, F.wave, lane4, qabs, ckv, kidx, widx, mix, (unsigned*)(ws + WS_CTL) + 1024);
        } }
        }
        if (BOTH(3)) GRID_BAR();
    }
    if (IN(4)) {
        pg8::Gemm g{mix, Wout_t, MIXK, MIXK, MIXK}; pg8::StaticOrder S; S.init(M, 1024, F.G, (int)blockIdx.x);
        pg8::EpiResid<true> E{nullptr, xb, x1b, ssq1, rstdx};
        pg8::gemm_phase<pg8::EpiResid<true>, pg8::StaticOrder, true>(ring, g, S, E);
        if (BOTH(4)) GRID_BAR();
    }
    if (IN(5)) {
        pg8::StaticOrder S; S.init(M, 1024, F.G, (int)blockIdx.x); pg8::Unit ua, ub; const bool h0 = S.next(0, ua), h1 = S.next(1, ub);
        if (h0) {
            { pg8::Gemm g{x1b, Wxq_t, 1024, 1024, 1024};
              pg8::EpiNormScale<16> E{qx, 1024, ssq1, 1.f / 1024.f};
              pg8::gemm_phase<pg8::EpiNormScale<16>, pg8::StaticOrder, true>(ring, g, S, E); }
            VM_WAIT(); __syncthreads();
            pg8::TwoUnits S2; S2.n = h1 ? 2 : 1;
            S2.u0 = pg8::Unit{ua.pm, ua.pm >> 3, (long)ua.pn * 512, (long)ua.pn * 512}; S2.u1 = pg8::Unit{ub.pm, ub.pm >> 3, (long)ub.pn * 512, (long)ub.pn * 512};
            { pg8::Gemm g{qx, kx, 1024, 1024, 256};
              pg8::EpiExpP E{Pb, lpart};
              pg8::gemm_phase<pg8::EpiExpP, pg8::TwoUnits, true>(ring, g, S2, E); }
            VM_WAIT(); __syncthreads();
            pg8::TwoUnits S3; S3.n = S2.n;
            S3.u0 = pg8::Unit{ua.pm, ua.pn, (long)ua.pn * 512, (long)(ua.pm >> 3) * 512}; S3.u1 = pg8::Unit{ub.pm, ub.pn, (long)ub.pn * 512, (long)(ub.pm >> 3) * 512};
            { pg8::Gemm g{Pb, vT, 1024, MM, 256};
              pg8::EpiPV E{ox, lpart};
              pg8::gemm_phase<pg8::EpiPV, pg8::TwoUnits, true>(ring, g, S3, E); }
        }
        if (BOTH(5)) GRID_BAR();
    }
    if (IN(6)) {
        pg8::Gemm g{ox, Wxo_t, 1024, 1024, 1024}; pg8::StaticOrder S; S.init(M, 1024, F.G, (int)blockIdx.x);
        pg8::EpiResid<true> E{nullptr, x1b, x2b, ssq2, nullptr};
        pg8::gemm_phase<pg8::EpiResid<true>, pg8::StaticOrder, true>(ring, g, S, E);
        if (BOTH(6)) GRID_BAR();
    }
    if (IN(7)) {
        pg8::Gemm g{x2b, Wgu_t, 1024, 1024, 1024}; pg8::StaticOrder S; S.init(M, 2 * DFF, F.G, (int)blockIdx.x);
        pg8::EpiSwiglu E{act, ssq2};
        pg8::gemm_phase<pg8::EpiSwiglu, pg8::StaticOrder, true>(ring, g, S, E);
        if (BOTH(7)) GRID_BAR();
    }
    const bool fuse_final = (F.G == 256);
    if (IN(8)) {
        pg8::Gemm g{act, Wdn_t, DFF, DFF, DFF}; pg8::StaticOrder S; S.init(M, 1024, F.G, (int)blockIdx.x);
        if (fuse_final) { pg8::EpiFinal E{x2b, out, ssq1, (unsigned*)(ws + WS_CTL) + 8192, g_final};
            pg8::gemm_phase<pg8::EpiFinal, pg8::StaticOrder, true>(ring, g, S, E); }
        else { pg8::EpiResidF32 E{x2b, out, ssq1};
            pg8::gemm_phase<pg8::EpiResidF32, pg8::StaticOrder, true>(ring, g, S, E);
            if (BOTH(8)) GRID_BAR(); }
    }
    if (IN(9) && !fuse_final) {
#ifdef DSA_FALLBACK_COUNT
        if (blockIdx.x == 0 && F.tid == 0 && __hip_atomic_load((unsigned*)(ws + WS_CTL) + 1024 + 64, __ATOMIC_RELAXED, __HIP_MEMORY_SCOPE_AGENT) > DSA_FALLBACK_COUNT) out[12345] = __builtin_nanf("");
#endif
#ifdef DSA_TOPK_CHECK
        if (blockIdx.x == 0 && F.tid == 0 && __hip_atomic_load((unsigned*)(ws + WS_CTL) + 1024, __ATOMIC_RELAXED, __HIP_MEMORY_SCOPE_AGENT) != 0u) out[12345] = __builtin_nanf("");
#endif
        for (int m = gw; m < M; m += NGW) {
            const float* pp = ssq1 + (size_t)m * 16; float s = 0.f;
#pragma unroll
            for (int q = 0; q < 4; ++q) { const f32x4 t = *(const f32x4*)(pp + 4 * q); s += (t.x + t.y) + (t.z + t.w); }
            const float rstd = rsqrtf(s * (1.f / 1024.f) + EPS);
            GAS f32x4* xr = (GAS f32x4*)(out + (size_t)m * D) + F.lane;
#pragma unroll
            for (int j = 0; j < 4; ++j) { const f32x4 gg = *((const GAS f32x4*)g_final + F.lane + 64 * j); xr[64 * j] = xr[64 * j] * gg * rstd; }
        }
    }
#undef IN
#undef BOTH
}

extern "C" void kernel_launch(void* const* d_in, const int* in_sizes, int n_in, void* d_out, int out_size, void* d_ws, size_t ws_size, hipStream_t stream) {
    static int grid = 0;
    if (grid == 0) {
        if (n_in != 28 || ws_size < WS_NEED || out_size != M * D) { fprintf(stderr, "kernel_launch: unexpected problem (n_in %d ws %zu out %d)\n", n_in, ws_size, out_size); grid = -1; return; }
        int dev = 0, cus = 0, per_cu = 0;
        if (hipGetDevice(&dev) != hipSuccess || hipDeviceGetAttribute(&cus, hipDeviceAttributeMultiprocessorCount, dev) != hipSuccess) { grid = -1; return; }
        if (hipFuncSetAttribute((const void*)mega, hipFuncAttributeMaxDynamicSharedMemorySize, LDS_BYTES) != hipSuccess) { fprintf(stderr, "kernel_launch: hipFuncSetAttribute failed\n"); grid = -1; return; }
        if (hipOccupancyMaxActiveBlocksPerMultiprocessor(&per_cu, (const void*)mega, NWAVES * 64, LDS_BYTES) != hipSuccess || per_cu < 1) { fprintf(stderr, "kernel_launch: occupancy query says %d\n", per_cu); grid = -1; (void)hipGetLastError(); return; }
        grid = cus;
        if (grid < 64) { fprintf(stderr, "kernel_launch: needs >= 64 CUs\n"); grid = -1; return; }
    }
    if (grid < 0) return;
    unsigned char* ws = (unsigned char*)d_ws;
    (void)hipMemsetAsync(ws + WS_CTL, 0, CTL_ZERO_BYTES, stream);
    Args a{}; for (int i = 0; i < 28; ++i) a.in[i] = (const float*)d_in[i]; a.out = (float*)d_out; a.ws = ws;
    a.ph_lo = 0; a.ph_hi = 10; a.li = 0;
#ifdef DSA_PASSES
    a.pad = DSA_PASSES - 1;
#endif
    void* kargs[] = {&a};
    (void)hipLaunchCooperativeKernel((const void*)mega, dim3(grid), dim3(NWAVES * 64), kargs, LDS_BYTES, stream);
}
```

```cpp
#include <hip/hip_runtime.h>
#include <cstdio>
#include <cstdint>

typedef unsigned short bf16_t;
__device__ __forceinline__ float bf2f(bf16_t h) { return __uint_as_float(((unsigned)h) << 16); }
__device__ __forceinline__ bf16_t f2bf(float f) { unsigned u = __float_as_uint(f); return (bf16_t)((u + 0x7fffu + ((u >> 16) & 1u)) >> 16); }

constexpr int D = 1024, BATCH = 16, SEQ = 2048, M = BATCH * SEQ;
constexpr int PROJ_REF = 2512, PROJ = 2560;
constexpr int MEM_LEN = 256, MM = BATCH * MEM_LEN;
constexpr int DFF = 2816;
constexpr float EPS = 1e-6f;
constexpr float LOG2E = 1.4426950408889634f;
constexpr int C_DQ = 0, C_DK = 512, C_DV = 1024, C_DZ = 1536, C_CQ = 2048, C_CKV = 2304, C_KIX = 2432, C_WIX = 2496, C_DB = 2504, C_DA = 2508;
constexpr int MIXK = 1536;

constexpr size_t MiB = 1u << 20;
constexpr size_t WS_WIN = 0, WS_WKV = 5 * MiB, WS_WDSA = 9 * MiB, WS_WOUT = 10 * MiB, WS_WXQ = 13 * MiB, WS_WXO = 15 * MiB, WS_WGU = 17 * MiB, WS_WDN = 28 * MiB;
constexpr size_t WS_CTL = 34 * MiB, CTL_ZERO_BYTES = 256 * 1024;
constexpr size_t WS_ST = 35 * MiB;
constexpr size_t ST_RSTDX = 0, ST_CQSS = 128 * 1024  , ST_LPART = 640 * 1024  , ST_WIDX = 2688 * 1024  , ST_BETA = 3712 * 1024  , ST_G = 4224 * 1024  , ST_BIAS = 4736 * 1024;
constexpr size_t WS_MNB = 40 * MiB, WS_KX = 48 * MiB, WS_VT = 56 * MiB, WS_CKV = 64 * MiB, WS_KIDX = 72 * MiB;
constexpr size_t WS_SSQ = 76 * MiB;
constexpr size_t WS_PROJ = 80 * MiB;
constexpr size_t WS_XB = 240 * MiB;
constexpr size_t WS_QABS = 240 * MiB;
constexpr size_t WS_MIX = 336 * MiB;
constexpr size_t WS_X1B = 240 * MiB, WS_QX = 304 * MiB, WS_P = 368 * MiB, WS_OX = 432 * MiB, WS_X2B = 304 * MiB, WS_ACT = 80 * MiB;
constexpr size_t WS_W8 = 496 * MiB;
constexpr int CTL_AMAX = 1600;
constexpr size_t WS_NEED = 512 * MiB;

#define DPP_ADD(v, CTRL) ((v) + __int_as_float(__builtin_amdgcn_update_dpp(0, __float_as_int(v), (CTRL), 0xF, 0xF, true)))
__device__ __forceinline__ float wave_sum(float v) {
    v = DPP_ADD(v, 0xB1);
    v = DPP_ADD(v, 0x4E);
    v = DPP_ADD(v, 0x141);
    v = DPP_ADD(v, 0x140);
    const int b = __float_as_int(v);
    const float s0 = __int_as_float(__builtin_amdgcn_readlane(b, 0)), s1 = __int_as_float(__builtin_amdgcn_readlane(b, 16)), s2 = __int_as_float(__builtin_amdgcn_readlane(b, 32)), s3 = __int_as_float(__builtin_amdgcn_readlane(b, 48));
    return (s0 + s1) + (s2 + s3);
}
namespace pg8 {
#define PG8_LAS __attribute__((address_space(3)))
typedef short bf16x8 __attribute__((ext_vector_type(8)));
typedef float f32x4 __attribute__((ext_vector_type(4)));
typedef unsigned u32x4 __attribute__((ext_vector_type(4)));
typedef unsigned u32x2 __attribute__((ext_vector_type(2)));
typedef int i32x4 __attribute__((ext_vector_type(4)));
constexpr int BM = 256, BK = 64, HALF = 128, HTB = HALF * BK * 2  , STAGE_BYTES = 8 * HTB, NXCD = 8, WGM = 8;

__host__ __device__ __forceinline__ int lds_byte(int r, int c) { const int st = (r >> 4) * 2 + (c >> 5), rr = r & 15, cc = c & 31, ob = rr * 64 + cc * 2; return st * 1024 + (ob ^ (((ob >> 9) & 1) << 5)); }
__host__ __device__ __forceinline__ void stage_rc(int b, int& R, int& C) { const int st = b / 1024, sb = b % 1024, swz = sb ^ (((sb >> 9) & 1) << 5); R = (st >> 1) * 16 + swz / 64; C = (st & 1) * 32 + (swz % 64) / 2; }
__host__ __device__ __forceinline__ int perm32(int rho) { const int n = rho >> 4, i = rho & 15; return 8 * (i >> 2) + 4 * n + (i & 3); }

struct Unit { int pm, pn; long ao, bo; };
struct Gemm { const bf16_t* A; const bf16_t* Bt; int lda, ldb, K; };

struct StaticOrder {
    int nM, nN, nwg, G, c;
    __host__ __device__ __forceinline__ void init(int M_, int N_, int G_, int c_) { nM = M_ / BM; nN = N_ / BM; nwg = nM * nN; G = G_; c = c_; }
    __host__ __device__ __forceinline__ bool next(int i, Unit& u) const {
        const long L = (long)i * G + c; if (L >= nwg) return false;
        int wgid = (int)L; { const int q = nwg / NXCD, r = nwg % NXCD, xcd = wgid % NXCD, off = wgid / NXCD; wgid = (xcd < r ? xcd * (q + 1) : r * (q + 1) + (xcd - r) * q) + off; }
        const int nig = WGM * nN, gid = wgid / nig, fm = gid * WGM, gsz = (nM - fm) < WGM ? (nM - fm) : WGM;
        u.pm = fm + ((wgid % nig) % gsz); u.pn = (wgid % nig) / gsz; u.ao = 0; u.bo = 0; return true;
    }
};
struct OneUnit { Unit u; __host__ __device__ __forceinline__ bool next(int i, Unit& o) const { if (i) return false; o = u; return true; } };
struct TwoUnits { Unit u0, u1; int n; __host__ __device__ __forceinline__ bool next(int i, Unit& o) const { if (i >= n) return false; o = i ? u1 : u0; return true; } };

typedef float cvf32x2_t __attribute__((ext_vector_type(2))); typedef __bf16 cvbf16x2_t __attribute__((ext_vector_type(2)));
__device__ __forceinline__ unsigned cvt_pk_bf16(float lo, float hi) { cvf32x2_t v = {lo, hi}; return __builtin_bit_cast(unsigned, __builtin_convertvector(v, cvbf16x2_t)); }
__device__ __forceinline__ u32x4 pack8(const f32x4& a, const f32x4& b) { u32x4 w; w.x = cvt_pk_bf16(a[0], a[1]); w.y = cvt_pk_bf16(a[2], a[3]); w.z = cvt_pk_bf16(b[0], b[1]); w.w = cvt_pk_bf16(b[2], b[3]); return w; }
__device__ __forceinline__ unsigned pack4_fp8(float a, float b, float c, float d) {
    a = __builtin_amdgcn_fmed3f(a, -448.f, 448.f); b = __builtin_amdgcn_fmed3f(b, -448.f, 448.f); c = __builtin_amdgcn_fmed3f(c, -448.f, 448.f); d = __builtin_amdgcn_fmed3f(d, -448.f, 448.f);
    int w = 0; w = __builtin_amdgcn_cvt_pk_fp8_f32(a, b, w, false); w = __builtin_amdgcn_cvt_pk_fp8_f32(c, d, w, true); return (unsigned)w; }
__device__ __forceinline__ float w8_scale(unsigned amax_bits) { const int e = (int)(amax_bits >> 23) - 127; return amax_bits ? __uint_as_float((unsigned)(127 + 6 - e) << 23) : 1.f; }
__device__ __forceinline__ float w8_inv_scale(unsigned amax_bits, int extra_shift) { const int e = (int)(amax_bits >> 23) - 127; return __uint_as_float((unsigned)(amax_bits ? 127 - 6 + e - extra_shift : 127 - extra_shift) << 23); }
__device__ __forceinline__ float dot4(const f32x4& a) { return (a[0] * a[0] + a[1] * a[1]) + (a[2] * a[2] + a[3] * a[3]); }
__device__ __forceinline__ float sum4(const f32x4& a) { return (a[0] + a[1]) + (a[2] + a[3]); }
__device__ __forceinline__ float lo_bf(unsigned w) { return __uint_as_float(w << 16); }
__device__ __forceinline__ float hi_bf(unsigned w) { return __uint_as_float(w & 0xffff0000u); }

typedef f32x4 Acc[2][2][4][2];
#define PG8_EPI_ROWS(...) _Pragma("unroll") for (int ai = 0; ai < 2; ++ai) _Pragma("unroll") for (int m = 0; m < 4; ++m) { const int rl = ai * HALF + wr * 64 + m * 16 + fr; __VA_ARGS__ }

struct EpiProj { static constexpr bool PERM = true;
    bf16_t* O; int ldc; const float* rs; float* cqss; int ssq_pn;
    __device__ __forceinline__ void operator()(const Acc& acc, const Unit& u, int wr, int wc, int fr, int fq) const {
        const int col0 = u.pn * BM + wc * 32 + 8 * fq; const bool doss = (u.pn == ssq_pn);
        PG8_EPI_ROWS( const int row = u.pm * BM + rl; const float r = rs ? rs[row] : 1.f; float ss = 0.f; bf16_t* rowp = O + (size_t)row * ldc + col0;
            _Pragma("unroll") for (int bj = 0; bj < 2; ++bj) { const f32x4 v0 = acc[ai][bj][m][0] * r, v1 = acc[ai][bj][m][1] * r; *(u32x4*)(rowp + bj * HALF) = pack8(v0, v1); ss += dot4(v0) + dot4(v1); }
            if (doss) { ss += __shfl_xor(ss, 16); ss += __shfl_xor(ss, 32); if (fq == 0) cqss[(size_t)row * 4 + wc] = ss; } )
    }
};
template <int NP> struct EpiNormScale { static constexpr bool PERM = true;
    bf16_t* O; int ldc; const float* part; float inv_dim;
    __device__ __forceinline__ void operator()(const Acc& acc, const Unit& u, int wr, int wc, int fr, int fq) const {
        const int col0 = u.pn * BM + wc * 32 + 8 * fq;
        PG8_EPI_ROWS( const int row = u.pm * BM + rl; float s = 0.f;
            _Pragma("unroll") for (int q = 0; q < NP / 4; ++q) s += sum4(*(const f32x4*)(part + (size_t)row * NP + 4 * q));
            const float r = rsqrtf(s * inv_dim + EPS); bf16_t* rowp = O + (size_t)row * ldc + col0;
            _Pragma("unroll") for (int bj = 0; bj < 2; ++bj) *(u32x4*)(rowp + bj * HALF) = pack8(acc[ai][bj][m][0] * r, acc[ai][bj][m][1] * r); )
    }
};
template <bool SRC16> struct EpiResid { static constexpr bool PERM = true;
    const float* src; const bf16_t* src16; bf16_t* xb; float* ssq; const float* rinv;
    __device__ __forceinline__ void operator()(const Acc& acc, const Unit& u, int wr, int wc, int fr, int fq) const {
        const int col0 = u.pn * BM + wc * 32 + 8 * fq;
        PG8_EPI_ROWS( const size_t row = (size_t)u.pm * BM + rl; float ss = 0.f; const size_t off = row * 1024 + col0; const float rsc = (SRC16 && rinv) ? 1.f / rinv[row] : 1.f;
            _Pragma("unroll") for (int bj = 0; bj < 2; ++bj) { f32x4 s0, s1;
                if (SRC16) { const u32x4 w = *(const u32x4*)(src16 + off + bj * HALF); s0 = (f32x4){lo_bf(w.x), hi_bf(w.x), lo_bf(w.y), hi_bf(w.y)} * rsc; s1 = (f32x4){lo_bf(w.z), hi_bf(w.z), lo_bf(w.w), hi_bf(w.w)} * rsc; }
                else { s0 = *(const f32x4*)(src + off + bj * HALF); s1 = *(const f32x4*)(src + off + bj * HALF + 4); }
                const f32x4 v0 = s0 + acc[ai][bj][m][0], v1 = s1 + acc[ai][bj][m][1];
                *(u32x4*)(xb + off + bj * HALF) = pack8(v0, v1); ss += dot4(v0) + dot4(v1); }
            ss += __shfl_xor(ss, 16); ss += __shfl_xor(ss, 32); if (fq == 0) ssq[row * 16 + u.pn * 4 + wc] = ss; )
    }
};
struct EpiResidF32 { static constexpr bool PERM = true;
    const bf16_t* src16; float* dst; float* ssq; float ascale; int pad_;
    __device__ __forceinline__ void operator()(const Acc& acc, const Unit& u, int wr, int wc, int fr, int fq) const {
        const int col0 = u.pn * BM + wc * 32 + 8 * fq;
        PG8_EPI_ROWS( const size_t row = (size_t)u.pm * BM + rl; float ss = 0.f; const size_t off = row * 1024 + col0;
            _Pragma("unroll") for (int bj = 0; bj < 2; ++bj) { const u32x4 w = *(const u32x4*)(src16 + off + bj * HALF);
                const f32x4 v0 = (f32x4){lo_bf(w.x), hi_bf(w.x), lo_bf(w.y), hi_bf(w.y)} + acc[ai][bj][m][0] * ascale, v1 = (f32x4){lo_bf(w.z), hi_bf(w.z), lo_bf(w.w), hi_bf(w.w)} + acc[ai][bj][m][1] * ascale;
                *(f32x4*)(dst + off + bj * HALF) = v0; *(f32x4*)(dst + off + bj * HALF + 4) = v1; ss += dot4(v0) + dot4(v1); }
            ss += __shfl_xor(ss, 16); ss += __shfl_xor(ss, 32); if (fq == 0) ssq[row * 16 + u.pn * 4 + wc] = ss; )
    }
};
struct EpiFinal { static constexpr bool PERM = true;
    const bf16_t* src16; float* dst; float* part; unsigned* cnt; const float* gain; float ascale; int pad_;
    __device__ __forceinline__ void operator()(Acc& acc, const Unit& u, int wr, int wc, int fr, int fq) const {
        const int col0 = u.pn * BM + wc * 32 + 8 * fq; float asl = ascale; asm volatile("" : "+s"(asl));
        PG8_EPI_ROWS( const size_t row = (size_t)u.pm * BM + rl; float ss = 0.f; const size_t off = row * 1024 + col0;
            _Pragma("unroll") for (int bj = 0; bj < 2; ++bj) { const u32x4 w = *(const u32x4*)(src16 + off + bj * HALF); const f32x4 s0 = {lo_bf(w.x), hi_bf(w.x), lo_bf(w.y), hi_bf(w.y)}, s1 = {lo_bf(w.z), hi_bf(w.z), lo_bf(w.w), hi_bf(w.w)};
                acc[ai][bj][m][0] = acc[ai][bj][m][0] * asl + s0; acc[ai][bj][m][1] = acc[ai][bj][m][1] * asl + s1; ss += dot4(acc[ai][bj][m][0]) + dot4(acc[ai][bj][m][1]); }
            ss += __shfl_xor(ss, 16); ss += __shfl_xor(ss, 32);
            if (fq == 0) __hip_atomic_store(part + row * 16 + u.pn * 4 + wc, ss, __ATOMIC_RELAXED, __HIP_MEMORY_SCOPE_AGENT); )
        asm volatile("s_waitcnt vmcnt(0)" ::: "memory");
        unsigned* c = cnt + 64 * u.pm;
        if ((fr | fq) == 0) __hip_atomic_fetch_add(c, 1u, __ATOMIC_RELAXED, __HIP_MEMORY_SCOPE_AGENT);
        for (unsigned spins = 0; spins < (1u << 22); ++spins) { if ((unsigned)__builtin_amdgcn_readfirstlane(__hip_atomic_load(c, __ATOMIC_RELAXED, __HIP_MEMORY_SCOPE_AGENT)) >= 32u) break; __builtin_amdgcn_s_sleep(4); }
        __builtin_amdgcn_fence(__ATOMIC_ACQUIRE, "agent");
        f32x4 gv[2][2];
        _Pragma("unroll") for (int bj = 0; bj < 2; ++bj) { gv[bj][0] = *(const f32x4*)(gain + col0 + bj * HALF); gv[bj][1] = *(const f32x4*)(gain + col0 + bj * HALF + 4); }
        PG8_EPI_ROWS( const size_t row = (size_t)u.pm * BM + rl; float s = 0.f;
            _Pragma("unroll") for (int q = 0; q < 4; ++q) s += sum4(*(const f32x4*)(part + row * 16 + 4 * q));
            const float r = rsqrtf(s * (1.f / 1024.f) + EPS); const size_t off = row * 1024 + col0;
            _Pragma("unroll") for (int bj = 0; bj < 2; ++bj) { *(f32x4*)(dst + off + bj * HALF) = acc[ai][bj][m][0] * gv[bj][0] * r; *(f32x4*)(dst + off + bj * HALF + 4) = acc[ai][bj][m][1] * gv[bj][1] * r; } )
    }
};
struct EpiExpP { static constexpr bool PERM = true;
    bf16_t* Pb; float* lpart;
    __device__ __forceinline__ void operator()(const Acc& acc, const Unit& u, int wr, int wc, int fr, int fq) const {
        const int h = (int)(u.ao >> 9), rowbase = u.pm * BM, col0 = wc * 32 + 8 * fq; bf16_t* O = Pb + (size_t)rowbase * 1024 + h * 256;
        PG8_EPI_ROWS( float ss = 0.f; bf16_t* rowp = O + (size_t)rl * 1024 + col0;
            _Pragma("unroll") for (int bj = 0; bj < 2; ++bj) { f32x4 v0 = acc[ai][bj][m][0], v1 = acc[ai][bj][m][1];
                _Pragma("unroll") for (int e = 0; e < 4; ++e) { v0[e] = __builtin_amdgcn_exp2f(v0[e]); v1[e] = __builtin_amdgcn_exp2f(v1[e]); }
                const u32x4 w = pack8(v0, v1); *(u32x4*)(rowp + bj * HALF) = w;
                ss += (lo_bf(w.x) + hi_bf(w.x)) + (lo_bf(w.y) + hi_bf(w.y)) + (lo_bf(w.z) + hi_bf(w.z)) + (lo_bf(w.w) + hi_bf(w.w)); }
            ss += __shfl_xor(ss, 16); ss += __shfl_xor(ss, 32); if (fq == 0) lpart[(size_t)(rowbase + rl) * 16 + h * 4 + wc] = ss; )
    }
};
struct EpiPV { static constexpr bool PERM = true;
    bf16_t* Ob; const float* lpart;
    __device__ __forceinline__ void operator()(const Acc& acc, const Unit& u, int wr, int wc, int fr, int fq) const {
        const int h = u.pn, rowbase = u.pm * BM, col0 = wc * 32 + 8 * fq; bf16_t* O = Ob + (size_t)rowbase * 1024 + h * 256;
        PG8_EPI_ROWS( const float r = 1.f / sum4(*(const f32x4*)(lpart + (size_t)(rowbase + rl) * 16 + h * 4)); bf16_t* rowp = O + (size_t)rl * 1024 + col0;
            _Pragma("unroll") for (int bj = 0; bj < 2; ++bj) *(u32x4*)(rowp + bj * HALF) = pack8(acc[ai][bj][m][0] * r, acc[ai][bj][m][1] * r); )
    }
};
constexpr float ACT_SCALE = 16.f; constexpr int ACT_SHIFT = 4;
struct EpiSwiglu { static constexpr bool PERM = true;
    unsigned char* act; const float* part;
    __device__ __forceinline__ void operator()(const Acc& acc, const Unit& u, int wr, int wc, int fr, int fq) const {
        const int col0 = u.pn * BM + wc * 32 + 8 * fq;
        PG8_EPI_ROWS( const size_t row = (size_t)u.pm * BM + rl; float s = 0.f;
            _Pragma("unroll") for (int q = 0; q < 4; ++q) s += sum4(*(const f32x4*)(part + row * 16 + 4 * q));
            const float r = rsqrtf(s * (1.f / 1024.f) + EPS); unsigned char* rowp = act + row * DFF + (col0 >> 1);
            _Pragma("unroll") for (int bj = 0; bj < 2; ++bj) { const f32x4 a = acc[ai][bj][m][0] * r, b = acc[ai][bj][m][1] * r;
                const float o0 = a[0] * __builtin_amdgcn_rcpf(1.f + __builtin_amdgcn_exp2f(-LOG2E * a[0])) * a[1], o1 = a[2] * __builtin_amdgcn_rcpf(1.f + __builtin_amdgcn_exp2f(-LOG2E * a[2])) * a[3];
                const float o2 = b[0] * __builtin_amdgcn_rcpf(1.f + __builtin_amdgcn_exp2f(-LOG2E * b[0])) * b[1], o3 = b[2] * __builtin_amdgcn_rcpf(1.f + __builtin_amdgcn_exp2f(-LOG2E * b[2])) * b[3];
                *(unsigned*)(rowp + bj * (HALF / 2)) = pack4_fp8(o0 * ACT_SCALE, o1 * ACT_SCALE, o2 * ACT_SCALE, o3 * ACT_SCALE); } )
    }
};

template <class Epi, class Sched, bool ALIGN_EPI, bool F8 = false>
__device__ __forceinline__ void gemm_phase(PG8_LAS unsigned char* lds, const Gemm g, const Sched& S, const Epi& E, int wave_id = 0) {
    int tid = 0; if constexpr (!F8) { tid = threadIdx.x; asm volatile("" : "+v"(tid)); }
    if constexpr (F8) { int l_; asm volatile("v_mbcnt_lo_u32_b32 %0, -1, 0\n\tv_mbcnt_hi_u32_b32 %0, -1, %0" : "=v"(l_)); tid = wave_id * 64 + l_; }
    const int wid = __builtin_amdgcn_readfirstlane(tid >> 6), lane = tid & 63, wr = wid >> 2, wc = wid & 3, fr = lane & 15, fq = lane >> 4;
    int Kop = g.K; asm volatile("" : "+s"(Kop));
    constexpr int ES = F8 ? 1 : 2;
    const int nt = Kop * ES / (BK * 2);
    unsigned voffA[2], voffB[2];
#pragma unroll
    for (int i = 0; i < 2; ++i) { int R, C; stage_rc(tid * 16 + i * 8192, R, C); const int Rb = Epi::PERM ? ((R & ~31) + perm32(R & 31)) : R;
        voffA[i] = (unsigned)(R * g.lda * ES + C * 2); voffB[i] = (unsigned)(Rb * g.ldb * ES + C * 2); }
    const size_t kstep = (size_t)(BK * 2);
    const size_t hstepA = (size_t)HALF * g.lda * ES, hstepB = (size_t)HALF * g.ldb * ES;
    const size_t tstepA = 2 * hstepA, tstepB = 2 * hstepB;
    const unsigned ldsw = (unsigned)wid * 1024u;
    const int aoff = lds_byte(wr * 64 + fr, fq * 8), boff = lds_byte(wc * 32 + fr, fq * 8);
#define PG8_SA(b, h) (((b) * 2 + (h)) * HTB)
#define PG8_SB(b, h) ((4 + (b) * 2 + (h)) * HTB)
#define PG8_STAGE(bufoff, gbase, voff, rs) do { _Pragma("unroll") for (int _i = 0; _i < 2; ++_i) { \
        if constexpr (F8) __builtin_amdgcn_raw_ptr_buffer_load_lds(rs, (PG8_LAS void*)(lds + (bufoff) + ldsw + _i * 8192), 16, (int)(voff)[_i], (int)(unsigned)(size_t)(gbase), 0, 0); \
        else __builtin_amdgcn_global_load_lds((const unsigned*)((const char*)(gbase) + (voff)[_i]), (PG8_LAS unsigned*)(lds + (bufoff) + ldsw + _i * 8192), 16, 0, 0); } } while (0)
#define PG8_LDA(dst, b, h) do { _Pragma("unroll") for (int m = 0; m < 4; ++m) _Pragma("unroll") for (int k = 0; k < 2; ++k) dst[m][k] = *(const PG8_LAS bf16x8*)(lds + PG8_SA(b, h) + aoff + m * 2048 + k * 1024); } while (0)
#define PG8_LDB(dst, b, h) do { _Pragma("unroll") for (int n = 0; n < 2; ++n) _Pragma("unroll") for (int k = 0; k < 2; ++k) dst[n][k] = *(const PG8_LAS bf16x8*)(lds + PG8_SB(b, h) + boff + n * 2048 + k * 1024); } while (0)
#define PG8_CAT8(x, y) __builtin_shufflevector(__builtin_bit_cast(i32x4, x), __builtin_bit_cast(i32x4, y), 0, 1, 2, 3, 4, 5, 6, 7)
#define PG8_MMA(ai, bj, At, Bt) do { __builtin_amdgcn_s_setprio(1); _Pragma("unroll") for (int m = 0; m < 4; ++m) _Pragma("unroll") for (int n = 0; n < 2; ++n) { \
        if constexpr (F8) acc[ai][bj][m][n] = __builtin_amdgcn_mfma_scale_f32_16x16x128_f8f6f4(PG8_CAT8(Bt[n][0], Bt[n][1]), PG8_CAT8(At[m][0], At[m][1]), acc[ai][bj][m][n], 0, 0, 0, 0, 0, 0); \
        else { _Pragma("unroll") for (int k = 0; k < 2; ++k) acc[ai][bj][m][n] = __builtin_amdgcn_mfma_f32_16x16x32_bf16(Bt[n][k], At[m][k], acc[ai][bj][m][n], 0, 0, 0); } } \
        __builtin_amdgcn_s_setprio(0); } while (0)
#define PG8_WAIT_V(n) asm volatile("s_waitcnt vmcnt(" #n ")" ::: "memory")
#define PG8_WAIT_L(n) asm volatile("s_waitcnt lgkmcnt(" #n ")" ::: "memory")
#define PG8_BAR __builtin_amdgcn_s_barrier()
#define PG8_SCHED __builtin_amdgcn_sched_barrier(0)
    Unit cur, nxt; int ui = 0;
    if (!S.next(0, cur)) return;
    Acc acc;
#pragma unroll
    for (int a = 0; a < 2; ++a)
#pragma unroll
        for (int b = 0; b < 2; ++b)
#pragma unroll
            for (int m = 0; m < 4; ++m)
#pragma unroll
                for (int n = 0; n < 2; ++n) acc[a][b][m][n] = (f32x4){0.f, 0.f, 0.f, 0.f};
    bf16x8 At[4][2], B0[2][2], B1[2][2];
    const __amdgpu_buffer_rsrc_t rsA = __builtin_amdgcn_make_buffer_rsrc((void*)g.A, 0, -1, 0x00020000), rsB = __builtin_amdgcn_make_buffer_rsrc((void*)g.Bt, 0, -1, 0x00020000);
    const char* const baseA = F8 ? (const char*)(size_t)0 : (const char*)g.A; const char* const baseB = F8 ? (const char*)(size_t)0 : (const char*)g.Bt;
    const char* cA = baseA + (size_t)cur.pm * tstepA + cur.ao; const char* cB = baseB + (size_t)cur.pn * tstepB + cur.bo;
    PG8_STAGE(PG8_SB(0, 0), cB, voffB, rsB); PG8_STAGE(PG8_SB(0, 1), cB + hstepB, voffB, rsB); PG8_STAGE(PG8_SA(0, 0), cA, voffA, rsA); PG8_STAGE(PG8_SA(0, 1), cA + hstepA, voffA, rsA);
    if (wr == 1) PG8_BAR;
    PG8_WAIT_V(2); PG8_BAR;
    PG8_STAGE(PG8_SB(1, 0), cB + kstep, voffB, rsB); PG8_STAGE(PG8_SA(1, 0), cA + kstep, voffA, rsA); PG8_STAGE(PG8_SB(1, 1), cB + hstepB + kstep, voffB, rsB);
    PG8_WAIT_V(6); PG8_BAR;
    for (;;) {
        const bool has_next = S.next(ui + 1, nxt);
        const char* nA = has_next ? baseA + (size_t)nxt.pm * tstepA + nxt.ao : cA; const char* nB = has_next ? baseB + (size_t)nxt.pn * tstepB + nxt.bo : cB;
        for (int t = 0; t < nt; t += 2) {
            const bool last = (t == nt - 2);
            const char* a1 = cA + (size_t)(t + 1) * kstep;
            const char* a2 = last ? nA : cA + (size_t)(t + 2) * kstep; const char* b2 = last ? nB : cB + (size_t)(t + 2) * kstep;
            const char* a3 = a2 + kstep; const char* b3 = b2 + kstep;
            PG8_LDB(B0, 0, 0); PG8_LDB(B1, 0, 1); PG8_SCHED; PG8_LDA(At, 0, 0); PG8_STAGE(PG8_SA(1, 1), a1 + hstepA, voffA, rsA);
            PG8_WAIT_V(8); PG8_WAIT_L(0); PG8_BAR; PG8_MMA(0, 0, At, B0); PG8_MMA(0, 1, At, B1); PG8_BAR; PG8_SCHED;
            PG8_LDA(At, 0, 1); PG8_STAGE(PG8_SB(0, 0), b2, voffB, rsB); PG8_STAGE(PG8_SB(0, 1), b2 + hstepB, voffB, rsB); PG8_STAGE(PG8_SA(0, 0), a2, voffA, rsA);
            PG8_WAIT_V(8); PG8_WAIT_L(0); PG8_BAR; PG8_MMA(1, 0, At, B0); PG8_MMA(1, 1, At, B1); PG8_BAR; PG8_SCHED;
            PG8_LDB(B0, 1, 0); PG8_LDB(B1, 1, 1); PG8_SCHED; PG8_LDA(At, 1, 0); PG8_STAGE(PG8_SA(0, 1), a2 + hstepA, voffA, rsA);
            PG8_WAIT_V(8); PG8_WAIT_L(0); PG8_BAR; PG8_MMA(0, 0, At, B0); PG8_MMA(0, 1, At, B1); PG8_BAR; PG8_SCHED;
            PG8_LDA(At, 1, 1); PG8_STAGE(PG8_SB(1, 0), b3, voffB, rsB); PG8_STAGE(PG8_SB(1, 1), b3 + hstepB, voffB, rsB); PG8_STAGE(PG8_SA(1, 0), a3, voffA, rsA);
            PG8_WAIT_V(8); PG8_WAIT_L(0); PG8_BAR; PG8_MMA(1, 0, At, B0); PG8_MMA(1, 1, At, B1); PG8_BAR; PG8_SCHED;
        }
        if constexpr (ALIGN_EPI) { if (wr == 0) PG8_BAR; }
        { int fr_e = fr, fq_e = fq;
          if constexpr (F8) { int l_e; asm volatile("v_mbcnt_lo_u32_b32 %0, -1, 0\n\tv_mbcnt_hi_u32_b32 %0, -1, %0" : "=v"(l_e)); fr_e = l_e & 15; fq_e = l_e >> 4; }
          E(acc, cur, wr, wc, fr_e, fq_e); }
        if (!has_next) break;
#pragma unroll
        for (int a = 0; a < 2; ++a)
#pragma unroll
            for (int b = 0; b < 2; ++b)
#pragma unroll
                for (int m = 0; m < 4; ++m)
#pragma unroll
                    for (int n = 0; n < 2; ++n) acc[a][b][m][n] = (f32x4){0.f, 0.f, 0.f, 0.f};
        cur = nxt; cA = nA; cB = nB; ++ui;
        if constexpr (ALIGN_EPI) { if (wr == 1) PG8_BAR; }
    }
    PG8_WAIT_V(0);
    if constexpr (!ALIGN_EPI) { if (wr == 0) PG8_BAR; }
    PG8_BAR;
#undef PG8_SA
#undef PG8_SB
#undef PG8_STAGE
#undef PG8_LDA
#undef PG8_LDB
#undef PG8_MMA
#undef PG8_CAT8
#undef PG8_WAIT_V
#undef PG8_WAIT_L
#undef PG8_BAR
#undef PG8_SCHED
}
}
constexpr int NWAVES = 8;
constexpr int RING_BYTES = 131072;
constexpr int LDSCTL_OFF = RING_BYTES, MISC_OFF = LDSCTL_OFF + 320;
constexpr int LDS_BYTES = 147456;
#define GAS __attribute__((address_space(1)))
#define LAS __attribute__((address_space(3)))
typedef unsigned v4u __attribute__((ext_vector_type(4)));
typedef float f32x4 __attribute__((ext_vector_type(4)));
typedef GAS unsigned gu32;
#define RLX_AGENT __ATOMIC_RELAXED, __HIP_MEMORY_SCOPE_AGENT
#define LDS_WAIT() asm volatile("s_waitcnt lgkmcnt(0)" ::: "memory")
#define VM_WAIT() asm volatile("s_waitcnt vmcnt(0)" ::: "memory")
__device__ __forceinline__ unsigned pk2(float lo, float hi) { return (unsigned)f2bf(lo) | ((unsigned)f2bf(hi) << 16); }

#define XB_TMO      128
#define XB_XCNT(j)  (256  + 64 * (j))
#define XB_XSUB(j)  (1280 + 64 * (j))
#define XB_XGEN(j)  (2304 + 64 * (j))
#define XB_TOP      3328
#define XB_TOPGEN   3392
#define XCD_BAR_WORDS 3456
#define XB_SPIN_CAP (1u << 18)
__device__ __forceinline__ unsigned xb_ld(unsigned* p)              { return __hip_atomic_load(p, __ATOMIC_RELAXED, __HIP_MEMORY_SCOPE_AGENT); }
__device__ __forceinline__ unsigned xb_add(unsigned* p, unsigned v) { return __hip_atomic_fetch_add(p, v, __ATOMIC_RELAXED, __HIP_MEMORY_SCOPE_AGENT); }
__device__ __forceinline__ unsigned xb_xcc_id() { return (unsigned)__builtin_amdgcn_s_getreg((3 << 11) | 20) & 0xFu; }
#define XB_SPIN(cond, bar) do { unsigned _sp = 0; while (cond) { __builtin_amdgcn_s_sleep(1); \
    if ((++_sp & 255u) == 0u) { if (xb_ld(&(bar)[XB_TMO])) break; if (_sp > XB_SPIN_CAP) { atomicAdd(&(bar)[XB_TMO], 1u); break; } } } } while (0)
struct XcdBarrier { unsigned* bar; unsigned x; volatile LAS unsigned* st; };
__device__ __forceinline__ XcdBarrier xcd_barrier_post(unsigned* bar, volatile LAS unsigned* st) {
    XcdBarrier b; b.bar = bar; b.x = xb_xcc_id(); b.st = st;
    if (threadIdx.x == 0) (void)xb_add(&bar[XB_XCNT(b.x)], 1u);
    return b;
}
__device__ __forceinline__ void xcd_barrier_complete(unsigned* bar, unsigned x, unsigned& nloc, unsigned& nx) {
    const unsigned G = gridDim.x * gridDim.y * gridDim.z;
    unsigned sum, cnt, mine, sp = 0u;
    for (;;) {
        sum = 0u; cnt = 0u; mine = 0u;
#pragma unroll
        for (unsigned j = 0; j < 16; ++j) { const unsigned c = xb_ld(&bar[XB_XCNT(j)]); sum += c; cnt += (c > 0u) ? 1u : 0u; mine = (j == x) ? c : mine; }
        if (sum == G) break;
        __builtin_amdgcn_s_sleep(1);
        if ((++sp & 255u) == 0u) { if (xb_ld(&bar[XB_TMO])) break; if (sp > XB_SPIN_CAP) { atomicAdd(&bar[XB_TMO], 1u); break; } }
    }
    nloc = mine > 0u ? mine : 1u; nx = cnt > 0u ? cnt : 1u;
}
__device__ __forceinline__ void xcd_barrier(const XcdBarrier& b) {
    asm volatile("s_waitcnt vmcnt(0)" ::: "memory");
    __syncthreads();
    if (threadIdx.x == 0) {
        unsigned* bar = b.bar;
        __builtin_amdgcn_s_waitcnt(0);
        unsigned nloc = b.st[0], nx = b.st[1];
        if (nloc == 0u) { xcd_barrier_complete(bar, b.x, nloc, nx); b.st[0] = nloc; b.st[1] = nx; }
        const unsigned old = xb_add(&bar[XB_XSUB(b.x)], 1u);
        const unsigned gen = old / nloc;
        if (old + 1u == (gen + 1u) * nloc) {
            __builtin_amdgcn_fence(__ATOMIC_RELEASE, "agent");
            asm volatile("s_waitcnt vmcnt(0)" ::: "memory");
            const unsigned og = xb_add(&bar[XB_TOP], 1u);
            const unsigned tg = og / nx;
            if (og + 1u == (tg + 1u) * nx) xb_add(&bar[XB_TOPGEN], 1u);
            else XB_SPIN(xb_ld(&bar[XB_TOPGEN]) == tg, bar);
            __builtin_amdgcn_fence(__ATOMIC_ACQUIRE, "agent");
            xb_add(&bar[XB_XGEN(b.x)], 1u);
            asm volatile("s_waitcnt vmcnt(0)" ::: "memory");
        } else {
            XB_SPIN(xb_ld(&bar[XB_XGEN(b.x)]) == gen, bar);
            __builtin_amdgcn_fence(__ATOMIC_ACQUIRE, "agent");
            asm volatile("s_waitcnt vmcnt(0)" ::: "memory");
        }
    }
    __syncthreads();
}

struct SrcWin { const float* w; const float* g;
    __device__ __forceinline__ float at(int k, int n) const {
        int src;
        if (n < 2048) src = n; else if (n < C_CKV) src = 2056 + (n - C_CQ); else if (n < C_KIX) src = 2312 + (n - C_CKV); else if (n < C_WIX) src = 2440 + (n - C_KIX);
        else if (n < C_DB) src = 2504 + (n - C_WIX); else if (n < C_DA) src = 2048 + (n - C_DB); else if (n < 2512) src = 2052 + (n - C_DA); else src = -1;
        return src >= 0 ? w[(size_t)k * PROJ_REF + src] * g[k] : 0.f; } };
struct SrcPlain { const float* w; int ld; const float* g; float cs;
    __device__ __forceinline__ float at(int k, int n) const { return w[(size_t)k * ld + n] * (g ? g[k] : 1.f) * cs; } };
struct SrcQidx { const float* w; const float* g;
    __device__ __forceinline__ float at(int k, int n) const { const int s = n >> 7, head = (n >> 4) & 7, r = n & 15; return w[(size_t)k * 512 + head * 64 + 16 * s + r] * g[k]; } };
struct SrcGU { const float* wg; const float* wu; const float* g;
    __device__ __forceinline__ float at(int k, int n) const { const size_t i = (size_t)k * DFF + (n >> 1); const float a = wg[i], b = wu[i]; return ((n & 1) ? b : a) * g[k]; } };
template <class Src> __device__ __forceinline__ void tr_item(const Src& S, int Nsz, bf16_t* WT, int ldo, int koff, LAS float* scr, int item, int lane, unsigned* amax = nullptr) {
    const int nblk = Nsz / 32, kb = item / nblk, nb = item % nblk, k0 = 64 * kb, n0 = 32 * nb;
    float t[32];
#pragma unroll
    for (int i = 0; i < 32; ++i) t[i] = S.at(k0 + 2 * i + (lane >> 5), n0 + (lane & 31));
    if (amax) { float mx = 0.f;
#pragma unroll
        for (int i = 0; i < 32; ++i) mx = fmaxf(mx, fabsf(t[i]));
#pragma unroll
        for (int o = 1; o < 64; o <<= 1) mx = fmaxf(mx, __shfl_xor(mx, o));
        if (lane == 0) (void)__hip_atomic_fetch_max(amax, __float_as_uint(mx), __ATOMIC_RELAXED, __HIP_MEMORY_SCOPE_AGENT); }
#pragma unroll
    for (int i = 0; i < 32; ++i) scr[(2 * i + (lane >> 5)) * 33 + (lane & 31)] = t[i];
    LDS_WAIT(); asm volatile("" ::: "memory");
    const int c = lane & 7;
#pragma unroll
    for (int j = 0; j < 4; ++j) { const int n = (lane >> 3) + 8 * j; const LAS float* s = scr + (8 * c) * 33 + n;
        v4u o; o.x = pk2(s[0 * 33], s[1 * 33]); o.y = pk2(s[2 * 33], s[3 * 33]); o.z = pk2(s[4 * 33], s[5 * 33]); o.w = pk2(s[6 * 33], s[7 * 33]);
        *(GAS v4u*)(WT + (size_t)(n0 + n) * ldo + koff + k0 + 8 * c) = o; }
    LDS_WAIT(); asm volatile("" ::: "memory");
}
__device__ __forceinline__ void heavy_item(const float* Ap, int lda, const float* Bp, int ldb, const float* cs, float cmul, int k0, int n0, int n0out, bf16_t* WT, int ldo, int koff, LAS float* scr, int lane) {
    LAS float* At = scr; LAS float* tt = scr + 2048;
#pragma unroll
    for (int i = 0; i < 8; ++i) { const int e = (i * 64 + lane) * 4, r = e >> 6, d = e & 63; *(LAS f32x4*)(At + e) = *(const GAS f32x4*)(Ap + (size_t)(k0 + r) * lda + d); }
    float bc[64];
#pragma unroll
    for (int d = 0; d < 64; ++d) bc[d] = Bp[(size_t)d * ldb + n0 + (lane & 31)];
    LDS_WAIT(); asm volatile("" ::: "memory");
#pragma unroll 2
    for (int i = 0; i < 16; ++i) { const int kk = 2 * i + (lane >> 5); const LAS f32x4* ar = (const LAS f32x4*)(At + kk * 64); float s0 = 0.f, s1 = 0.f;
#pragma unroll
        for (int q = 0; q < 16; q += 2) { const f32x4 a = ar[q], b2 = ar[q + 1]; s0 += a.x * bc[4 * q] + a.y * bc[4 * q + 1] + a.z * bc[4 * q + 2] + a.w * bc[4 * q + 3]; s1 += b2.x * bc[4 * q + 4] + b2.y * bc[4 * q + 5] + b2.z * bc[4 * q + 6] + b2.w * bc[4 * q + 7]; }
        tt[kk * 33 + (lane & 31)] = (s0 + s1) * (cs ? cs[k0 + kk] : 1.f) * cmul; }
    LDS_WAIT(); asm volatile("" ::: "memory");
    const int c = lane & 3;
#pragma unroll
    for (int j = 0; j < 2; ++j) { const int n = (lane >> 2) + 16 * j; const LAS float* s = tt + (8 * c) * 33 + n;
        v4u o; o.x = pk2(s[0 * 33], s[1 * 33]); o.y = pk2(s[2 * 33], s[3 * 33]); o.z = pk2(s[4 * 33], s[5 * 33]); o.w = pk2(s[6 * 33], s[7 * 33]);
        *(GAS v4u*)(WT + (size_t)(n0out + n) * ldo + koff + k0 + 8 * c) = o; }
    LDS_WAIT(); asm volatile("" ::: "memory");
}
template <int NR> __device__ __forceinline__ void row_prep(const float* xrow, const float* gain, bf16_t* orow, float* rstd_out, int lane) {
    f32x4 v[NR][4]; float s[NR];
#pragma unroll
    for (int r = 0; r < NR; ++r)
#pragma unroll
        for (int j = 0; j < 4; ++j) v[r][j] = *((const GAS f32x4*)(xrow + (size_t)r * 1024) + lane + 64 * j);
#pragma unroll
    for (int r = 0; r < NR; ++r) { float a = 0.f;
#pragma unroll
        for (int j = 0; j < 4; ++j) a += (v[r][j].x * v[r][j].x + v[r][j].y * v[r][j].y) + (v[r][j].z * v[r][j].z + v[r][j].w * v[r][j].w);
        s[r] = a; }
#pragma unroll
    for (int r = 0; r < NR; ++r) { const float rstd = rsqrtf(wave_sum(s[r]) * (1.f / 1024.f) + EPS);
        if (rstd_out && lane == 0) rstd_out[r] = rstd;
        GAS unsigned long long* o8 = (GAS unsigned long long*)(orow + (size_t)r * 1024) + lane;
#pragma unroll
        for (int j = 0; j < 4; ++j) { f32x4 a = v[r][j];
            if (gain) { const f32x4 gg = *((const GAS f32x4*)gain + lane + 64 * j); a = a * gg * rstd; } else a = a * rstd;
            o8[64 * j] = (unsigned long long)pk2(a.x, a.y) | ((unsigned long long)pk2(a.z, a.w) << 32); } }
}
__device__ __forceinline__ void cvt_w8(const bf16_t* src, unsigned char* dst, int n16, unsigned amax_bits, int gtid, int nthr) {
    const float sc = pg8::w8_scale(amax_bits);
    for (int i = gtid; i < n16; i += nthr) { const v4u a = *((const GAS v4u*)src + 2 * i), b = *((const GAS v4u*)src + 2 * i + 1); v4u o;
        o.x = pg8::pack4_fp8(pg8::lo_bf(a.x) * sc, pg8::hi_bf(a.x) * sc, pg8::lo_bf(a.y) * sc, pg8::hi_bf(a.y) * sc); o.y = pg8::pack4_fp8(pg8::lo_bf(a.z) * sc, pg8::hi_bf(a.z) * sc, pg8::lo_bf(a.w) * sc, pg8::hi_bf(a.w) * sc);
        o.z = pg8::pack4_fp8(pg8::lo_bf(b.x) * sc, pg8::hi_bf(b.x) * sc, pg8::lo_bf(b.y) * sc, pg8::hi_bf(b.y) * sc); o.w = pg8::pack4_fp8(pg8::lo_bf(b.z) * sc, pg8::hi_bf(b.z) * sc, pg8::lo_bf(b.w) * sc, pg8::hi_bf(b.w) * sc);
        *((GAS v4u*)dst + i) = o; }
}
namespace dsa {
typedef short bf16x8 __attribute__((ext_vector_type(8)));
typedef short s16x4 __attribute__((ext_vector_type(4)));
typedef float f32x16 __attribute__((ext_vector_type(16)));
typedef float f32x4 __attribute__((ext_vector_type(4)));
typedef unsigned u32x4 __attribute__((ext_vector_type(4)));
typedef unsigned short u16x4 __attribute__((ext_vector_type(4)));
constexpr int HIST_OFF = 145152;
constexpr int SC_OFF = 0, LIST_OFF = 132096, BIAS_OFF = 140288, W_OFF = 144416, NSEL_OFF = 144928, BMAX_OFF = 144992, CMAX_OFF = 145024;
__device__ __forceinline__ int xsw(int rr) { return rr < 8 ? 2 * rr : 2 * ((rr + 4) & 7) + 1; }
typedef float cvf32x2_t __attribute__((ext_vector_type(2))); typedef __bf16 cvbf16x2_t __attribute__((ext_vector_type(2)));
__device__ __forceinline__ unsigned cvtpk(float lo, float hi) { cvf32x2_t v = {lo, hi}; return __builtin_bit_cast(unsigned, __builtin_convertvector(v, cvbf16x2_t)); }
__device__ __forceinline__ int mbcnt64(unsigned long long m) { return (int)__builtin_amdgcn_mbcnt_hi((unsigned)(m >> 32), __builtin_amdgcn_mbcnt_lo((unsigned)m, 0u)); }

__device__ __forceinline__ void phase_init(LAS unsigned char* lds, const float* biastab, const float* kvg, int tid) {
    LAS float* bt = (LAS float*)(lds + BIAS_OFF);
    for (int i = tid; i < 129 * 8; i += 512) bt[i] = biastab[i];
    if (tid < 64) { float m = fmaxf(fabsf(kvg[tid]), fabsf(kvg[tid + 64]));
#pragma unroll
        for (int o = 1; o < 64; o <<= 1) m = fmaxf(m, __shfl_xor(m, o));
        if (tid == 0) *(LAS float*)(lds + CMAX_OFF) = m * 11.313708499f * 1.01f; }
    __syncthreads();
    if (tid < 8) { float m = -1e30f; for (int d = 0; d < 129; ++d) m = fmaxf(m, bt[d * 8 + tid]); ((LAS float*)(lds + BMAX_OFF))[tid] = m; }
    __syncthreads();
}

__device__ __forceinline__ void scores(LAS unsigned char* lds, int b, int q0, const bf16_t* qabs, const bf16_t* kidx, int wave, int lane) {
    const int hi = lane >> 5, c32 = lane & 31;
    const int a_ = c32 >> 3, hp = (c32 >> 2) & 1, r3 = c32 & 3;
    const int head = 4 * (a_ & 1) + r3, qt = 2 * hp + (a_ >> 1);
    bf16x8 A[4][4];
#pragma unroll
    for (int rt = 0; rt < 4; ++rt)
#pragma unroll
        for (int s = 0; s < 4; ++s) A[rt][s] = *(const bf16x8*)(qabs + (size_t)(b * 2048 + q0 + 4 * rt + qt) * 1536 + 1024 + s * 128 + head * 16 + 8 * hi);
    const int nkt = (q0 + 16 + 31) >> 5;
    LAS float* SC = (LAS float*)(lds + SC_OFF); const LAS float* Wl = (const LAS float*)(lds + W_OFF);
    bf16x8 Bn[4];
    { const bf16_t* kr = kidx + (size_t)(b * 2048 + (wave < nkt ? wave : 0) * 32 + c32) * 64 + 8 * hi;
#pragma unroll
      for (int s = 0; s < 4; ++s) Bn[s] = *(const bf16x8*)(kr + 16 * s); }
    __syncthreads();
    for (int kt = wave; kt < nkt; kt += 8) {
        bf16x8 B[4];
#pragma unroll
        for (int s = 0; s < 4; ++s) B[s] = Bn[s];
        if (kt + 8 < nkt) { const bf16_t* kr = kidx + (size_t)(b * 2048 + (kt + 8) * 32 + c32) * 64 + 8 * hi;
#pragma unroll
            for (int s = 0; s < 4; ++s) Bn[s] = *(const bf16x8*)(kr + 16 * s); }
        const int key = kt * 32 + c32;
        f32x16 acc[4];
#pragma unroll
        for (int rt = 0; rt < 4; ++rt) acc[rt] = (f32x16){0.f, 0.f, 0.f, 0.f, 0.f, 0.f, 0.f, 0.f, 0.f, 0.f, 0.f, 0.f, 0.f, 0.f, 0.f, 0.f};
#pragma unroll
        for (int s = 0; s < 4; ++s)
#pragma unroll
            for (int rt = 0; rt < 4; ++rt) acc[rt] = __builtin_amdgcn_mfma_f32_32x32x16_bf16(A[rt][s], B[s], acc[rt], 0, 0, 0);
        f32x4 wv[4][4];
#pragma unroll
        for (int rt = 0; rt < 4; ++rt) { const LAS f32x4* wp = (const LAS f32x4*)(Wl + (4 * rt + 2 * hi) * 8);
#pragma unroll
            for (int q = 0; q < 4; ++q) wv[rt][q] = wp[q]; }
#pragma unroll
        for (int rt = 0; rt < 4; ++rt) {
            const f32x4 w0 = wv[rt][0], w1 = wv[rt][1], w2 = wv[rt][2], w3 = wv[rt][3]; const f32x16 a = acc[rt];
            float s0 = w0.x * fmaxf(a[0], 0.f); s0 += w0.y * fmaxf(a[1], 0.f); s0 += w0.z * fmaxf(a[2], 0.f); s0 += w0.w * fmaxf(a[3], 0.f);
            s0 += w1.x * fmaxf(a[4], 0.f); s0 += w1.y * fmaxf(a[5], 0.f); s0 += w1.z * fmaxf(a[6], 0.f); s0 += w1.w * fmaxf(a[7], 0.f);
            float s1 = w2.x * fmaxf(a[8], 0.f); s1 += w2.y * fmaxf(a[9], 0.f); s1 += w2.z * fmaxf(a[10], 0.f); s1 += w2.w * fmaxf(a[11], 0.f);
            s1 += w3.x * fmaxf(a[12], 0.f); s1 += w3.y * fmaxf(a[13], 0.f); s1 += w3.z * fmaxf(a[14], 0.f); s1 += w3.w * fmaxf(a[15], 0.f);
            const int ql = 4 * rt + 2 * hi, t0 = q0 + ql;
            SC[ql * 2048 + key] = key <= t0 ? s0 : -INFINITY; SC[(ql + 1) * 2048 + key] = key <= t0 + 1 ? s1 : -INFINITY;
        }
    }
}
__device__ __forceinline__ void topk(LAS unsigned char* lds, int q0, int qq, int lane) {
    const int t = q0 + qq, n = t + 1;
    LAS unsigned short* list = (LAS unsigned short*)(lds + LIST_OFF) + qq * 256; LAS int* nsel = (LAS int*)(lds + NSEL_OFF);
    if (n <= 256) { for (int i = lane; i < 256; i += 64) list[i] = (unsigned short)(i < n ? i : t); if (lane == 0) nsel[qq] = n; return; }
    const int nk = ((q0 + 16 + 31) >> 5) * 32;
    const LAS float* SC = (const LAS float*)(lds + SC_OFF) + qq * 2048;
    unsigned u[32];
#pragma unroll
    for (int j = 0; j < 32; ++j) { const int key = lane + 64 * j; unsigned v = 0u; if (key < nk) { const unsigned bts = __float_as_uint(SC[key]); v = (bts & 0x80000000u) ? ~bts : (bts | 0x80000000u); } u[j] = v; }
    unsigned tau = 0u;
    for (int bit = 31; bit >= 0; --bit) {
        const unsigned cand = tau | (1u << bit); int cnt = 0;
#pragma unroll
        for (int j = 0; j < 32; ++j) cnt += __popcll(__ballot(u[j] >= cand));
        if (cnt >= 256) tau = cand;
        if (cnt == 256) break;
    }
    int cgt = 0;
#pragma unroll
    for (int j = 0; j < 32; ++j) cgt += __popcll(__ballot(u[j] > tau));
    const int r = 256 - cgt; int base = 0, eqb = 0;
#pragma unroll
    for (int j = 0; j < 32; ++j) {
        const bool gt = u[j] > tau, eq = u[j] == tau; const unsigned long long em = __ballot(eq);
        const bool sel = gt || (eq && (eqb + mbcnt64(em)) < r); const unsigned long long sm = __ballot(sel);
        if (sel) list[base + mbcnt64(sm)] = (unsigned short)(lane + 64 * j);
        base += __popcll(sm); eqb += __popcll(em);
    }
    if (lane == 0) nsel[qq] = 256;
}
__device__ __forceinline__ int wave_scan_incl(int x) {
    x += __builtin_amdgcn_update_dpp(0, x, 0x111, 0xF, 0xF, true);
    x += __builtin_amdgcn_update_dpp(0, x, 0x112, 0xF, 0xF, true);
    x += __builtin_amdgcn_update_dpp(0, x, 0x114, 0xF, 0xF, true);
    x += __builtin_amdgcn_update_dpp(0, x, 0x118, 0xF, 0xF, true);
    x += __builtin_amdgcn_update_dpp(0, x, 0x142, 0xA, 0xF, false);
    x += __builtin_amdgcn_update_dpp(0, x, 0x143, 0xC, 0xF, false);
    return x;
}
__device__ __forceinline__ void topk2(LAS unsigned char* lds, int q0, int qq, int wave, int lane, unsigned* dbg_flag_g = nullptr) {
    const int t = q0 + qq, n = t + 1;
    LAS unsigned short* list = (LAS unsigned short*)(lds + LIST_OFF) + qq * 256; LAS int* nsel = (LAS int*)(lds + NSEL_OFF);
    if (n <= 256) { for (int i = lane; i < 256; i += 64) list[i] = (unsigned short)(i < n ? i : t); if (lane == 0) nsel[qq] = n; return; }
    const int nk = ((q0 + 16 + 31) >> 5) * 32;
    const LAS float* SC = (const LAS float*)(lds + SC_OFF) + qq * 2048;
    LAS int* hist = (LAS int*)(lds + HIST_OFF) + wave * 64;
    float v[32]; float lo = INFINITY, hi = -INFINITY;
#pragma unroll
    for (int j = 0; j < 8; ++j) { f32x4 x = {-INFINITY, -INFINITY, -INFINITY, -INFINITY}; if (256 * j + 4 * lane < nk) x = *(const LAS f32x4*)(SC + 256 * j + 4 * lane);
#pragma unroll
        for (int e = 0; e < 4; ++e) { v[4 * j + e] = x[e]; hi = fmaxf(hi, x[e]); lo = fminf(lo, x[e] == -INFINITY ? INFINITY : x[e]); } }
#pragma unroll
    for (int o = 1; o < 64; o <<= 1) { hi = fmaxf(hi, __shfl_xor(hi, o)); lo = fminf(lo, __shfl_xor(lo, o)); }
    bool ok = hi > lo;
    float sc = 0.f, off = 0.f; int B = 0, B2 = 0, need2 = 0, ncand = 0;
    if (ok) {
        sc = 63.99f / (hi - lo); off = -lo * sc;
        hist[lane] = 0;
#pragma unroll
        for (int j = 0; j < 8; ++j) if (256 * j < nk) {
#pragma unroll
            for (int e = 0; e < 4; ++e) { const int i = 4 * j + e; int bb = (int)__builtin_fmaf(v[i], sc, off); bb = bb < 0 ? 0 : (bb > 63 ? 63 : bb); (void)__hip_atomic_fetch_add((LAS unsigned*)&hist[bb], 1u, __ATOMIC_RELAXED, __HIP_MEMORY_SCOPE_WORKGROUP); } }
        int c = hist[lane]; int incl = wave_scan_incl(c); int tot = __builtin_amdgcn_readlane(incl, 63); int suf = tot - incl + c;
        unsigned long long m = __ballot(suf >= 256); B = 63 - __builtin_clzll(m);
        const int above = (B < 63) ? __builtin_amdgcn_readlane(suf, (B + 1) & 63) : 0; const int need1 = 256 - above;
        ok = (B > 0);
        if (ok) {
            const float fB = (float)B;
            hist[lane] = 0;
#pragma unroll
            for (int j = 0; j < 8; ++j) if (256 * j < nk) {
#pragma unroll
              for (int e = 0; e < 4; ++e) { const int i = 4 * j + e; const float f = __builtin_fmaf(v[i], sc, off); int bb = (int)f; bb = bb > 63 ? 63 : bb; if (bb == B) { int b2 = (int)((f - fB) * 64.f); b2 = b2 < 0 ? 0 : (b2 > 63 ? 63 : b2); (void)__hip_atomic_fetch_add((LAS unsigned*)&hist[b2], 1u, __ATOMIC_RELAXED, __HIP_MEMORY_SCOPE_WORKGROUP); } } }
            c = hist[lane]; incl = wave_scan_incl(c); tot = __builtin_amdgcn_readlane(incl, 63); suf = tot - incl + c;
            m = __ballot(suf >= need1); B2 = 63 - __builtin_clzll(m);
            const int above2 = (B2 < 63) ? __builtin_amdgcn_readlane(suf, (B2 + 1) & 63) : 0; need2 = need1 - above2; ncand = __builtin_amdgcn_readlane(c, B2);
            ok = (ncand <= 64) && (B < 63 || B2 < 63);
        }
    }
#ifdef DSA_FALLBACK_COUNT
    if (!ok && lane == 0) atomicAdd(dbg_flag_g + 64, 1u);
#endif
    if (!ok) { topk(lds, q0, qq, lane); return; }
    const float thrLo = (float)B + (float)B2 * (1.f / 64.f), thrHi = (float)B + (float)(B2 + 1) * (1.f / 64.f);
    LAS float* cv = (LAS float*)list; LAS unsigned short* ck = list + 128;
    int base = 0;
#pragma unroll
    for (int j = 0; j < 8; ++j) if (256 * j < nk) {
#pragma unroll
      for (int e = 0; e < 4; ++e) { const int i = 4 * j + e; const float f = __builtin_fmaf(v[i], sc, off); const bool isc = (f >= thrLo) && (f < thrHi); const unsigned long long cm = __ballot(isc);
        if (cm) { if (isc) { const int pos = base + mbcnt64(cm); cv[pos] = v[i]; ck[pos] = (unsigned short)(256 * j + 4 * lane + e); } base += __popcll(cm); } } }
    const float myv = lane < ncand ? cv[lane] : -INFINITY; const int myk = lane < ncand ? (int)ck[lane] : 0x7fffffff; int rank = 0;
    for (int k = 0; k < ncand; ++k) { const float vk = __int_as_float(__builtin_amdgcn_readlane(__float_as_int(myv), k)); const int kk = __builtin_amdgcn_readlane(myk, k); rank += (vk > myv || (vk == myv && kk < myk)) ? 1 : 0; }
    const unsigned long long lm = __ballot(lane < ncand && rank == need2 - 1); const int ll = (int)__builtin_ctzll(lm);
    const float tauv = __int_as_float(__builtin_amdgcn_readlane(__float_as_int(myv), ll)); const int tauk = __builtin_amdgcn_readlane(myk, ll);
    base = 0;
#pragma unroll
    for (int j = 0; j < 8; ++j) if (256 * j < nk) {
#pragma unroll
      for (int e = 0; e < 4; ++e) { const int i = 4 * j + e; const int key = 256 * j + 4 * lane + e; const bool sel = (v[i] > tauv) || (v[i] == tauv && key <= tauk); const unsigned long long sm = __ballot(sel);
        if (sel) list[base + mbcnt64(sm)] = (unsigned short)key; base += __popcll(sm); } }
    if (lane == 0) nsel[qq] = 256;
}
__device__ __forceinline__ void attend2(LAS unsigned char* lds, int b, int q0, int wave, int lane, const bf16_t* qabs, const bf16_t* ckv, bf16_t* mix) {
    const int r16 = lane & 15, g = lane >> 4;
    LAS unsigned char* buf0 = lds + wave * 16384; LAS unsigned char* buf1 = buf0 + 8192;
    const LAS unsigned short* listw = (const LAS unsigned short*)(lds + LIST_OFF) + (2 * wave) * 256;
    const LAS float* biasT = (const LAS float*)(lds + BIAS_OFF);
    const int n0 = ((const LAS int*)(lds + NSEL_OFF))[2 * wave], n1 = ((const LAS int*)(lds + NSEL_OFF))[2 * wave + 1];
    const int ns0 = (n0 + 31) >> 5, total = ns0 + ((n1 + 31) >> 5);
    const float cmax = *(const LAS float*)(lds + CMAX_OFF), bmax = ((const LAS float*)(lds + BMAX_OFF))[r16 & 7];
    const int xr = xsw(r16);
    const int q4 = r16 >> 2, p4 = r16 & 3; const int rra = 4 * g + q4, rrb = 16 + 4 * g + q4; const int xa = xsw(rra & 15), xb = xsw(rrb & 15);
    int t = 0, n = 0; size_t row = 0; const LAS unsigned short* list = listw; bf16x8 QB[4]; float Mh = 0.f, lsum = 0.f; f32x4 O[8];
    u32x4 X[8], Y[8];
#define DSA_LOAD(ST, kk) do { if ((kk) < total) { const int sel_ = (kk) >= ns0 ? 1 : 0; const LAS unsigned short* lp_ = listw + sel_ * 256 + ((kk) - (sel_ ? ns0 : 0)) * 32; \
        _Pragma("unroll") for (int i_ = 0; i_ < 8; ++i_) { const int rr_ = 4 * i_ + g; const int idx_ = lp_[rr_]; ST[i_] = *(const u32x4*)(ckv + ((size_t)b * 2048 + idx_) * 128 + (r16 ^ xsw(rr_ & 15)) * 8); } } } while (0)
#define DSA_WRITE(ST, bufp) do { _Pragma("unroll") for (int i_ = 0; i_ < 8; ++i_) *(LAS u32x4*)((bufp) + (4 * i_ + g) * 256 + r16 * 16) = ST[i_]; } while (0)
#define DSA_INIT(qq_) do { t = q0 + (qq_); row = (size_t)b * 2048 + t; n = ((qq_) & 1) ? n1 : n0; list = listw + ((qq_) & 1) * 256; float qn2_ = 0.f; \
        _Pragma("unroll") for (int s_ = 0; s_ < 4; ++s_) { bf16x8 v_ = {0, 0, 0, 0, 0, 0, 0, 0}; if (r16 < 8) v_ = *(const bf16x8*)(qabs + row * 1536 + s_ * 256 + r16 * 32 + 8 * g); QB[s_] = v_; \
            _Pragma("unroll") for (int e_ = 0; e_ < 8; ++e_) { const float f_ = bf2f((bf16_t)v_[e_]); qn2_ += f_ * f_; } } \
        qn2_ += __shfl_xor(qn2_, 16); qn2_ += __shfl_xor(qn2_, 32); Mh = sqrtf(qn2_) * cmax + bmax; lsum = 0.f; \
        _Pragma("unroll") for (int dt_ = 0; dt_ < 8; ++dt_) O[dt_] = (f32x4){0.f, 0.f, 0.f, 0.f}; } while (0)
#define DSA_FINAL() do { float l_ = lsum; l_ += __shfl_xor(l_, 16); l_ += __shfl_xor(l_, 32); const float linv_ = 1.f / l_; \
        _Pragma("unroll") for (int e_ = 0; e_ < 4; ++e_) { const int hrow_ = (4 * g + e_) & 7; const float inv_ = __shfl(linv_, hrow_); \
            if (g < 2) { _Pragma("unroll") for (int dt_ = 0; dt_ < 8; ++dt_) mix[row * MIXK + 512 + hrow_ * 128 + 16 * dt_ + r16] = f2bf(O[dt_][e_] * inv_); } } } while (0)
#define DSA_COMPUTE(kk, buf) do { if ((kk) == ns0) { DSA_FINAL(); DSA_INIT(2 * wave + 1); } const int step = (kk) >= ns0 ? (kk) - ns0 : (kk); \
          \
        bf16x8 af_[2][4]; \
        _Pragma("unroll") for (int G = 0; G < 2; ++G) _Pragma("unroll") for (int s = 0; s < 4; ++s) af_[G][s] = *(const LAS bf16x8*)((buf) + (16 * G + r16) * 256 + (((4 * s + g) ^ xr) * 16)); \
        const int pb0_ = step * 32 + 4 * g; const u16x4 ida_ = *(const LAS u16x4*)(list + pb0_), idb_ = *(const LAS u16x4*)(list + pb0_ + 16); \
        s16x4 tlo_[8], thi_[8]; \
        _Pragma("unroll") for (int dt = 0; dt < 8; ++dt) { const int ch = 2 * dt + (p4 >> 1); \
            tlo_[dt] = __builtin_bit_cast(s16x4, __builtin_amdgcn_ds_read_tr16_b64_v4i16((LAS s16x4*)((buf) + rra * 256 + ((ch ^ xa) * 16) + 8 * (p4 & 1)))); \
            thi_[dt] = __builtin_bit_cast(s16x4, __builtin_amdgcn_ds_read_tr16_b64_v4i16((LAS s16x4*)((buf) + rrb * 256 + ((ch ^ xb) * 16) + 8 * (p4 & 1)))); } \
        float bz_[2][4]; \
        _Pragma("unroll") for (int e = 0; e < 4; ++e) { int d0_ = t - (int)ida_[e]; d0_ = d0_ < 128 ? d0_ : 128; d0_ = d0_ < 0 ? 0 : d0_; int d1_ = t - (int)idb_[e]; d1_ = d1_ < 128 ? d1_ : 128; d1_ = d1_ < 0 ? 0 : d1_; \
            bz_[0][e] = biasT[d0_ * 8 + (r16 & 7)]; bz_[1][e] = biasT[d1_ * 8 + (r16 & 7)]; } \
        f32x4 S_[2]; \
        _Pragma("unroll") for (int G = 0; G < 2; ++G) { f32x4 acc = {0.f, 0.f, 0.f, 0.f}; \
            _Pragma("unroll") for (int s = 0; s < 4; ++s) acc = __builtin_amdgcn_mfma_f32_16x16x32_bf16(af_[G][s], QB[s], acc, 0, 0, 0); \
            S_[G] = acc; } \
        float P_[2][4]; \
        _Pragma("unroll") for (int G = 0; G < 2; ++G) _Pragma("unroll") for (int e = 0; e < 4; ++e) { const float lg = S_[G][e] + bz_[G][e] - Mh; \
                const float pv = (pb0_ + 16 * G + e < n) ? __builtin_amdgcn_exp2f(lg) : 0.f; lsum += pv; P_[G][e] = pv; } \
        u32x4 pw; pw.x = cvtpk(P_[0][0], P_[0][1]); pw.y = cvtpk(P_[0][2], P_[0][3]); pw.z = cvtpk(P_[1][0], P_[1][1]); pw.w = cvtpk(P_[1][2], P_[1][3]); \
        const bf16x8 PA = __builtin_bit_cast(bf16x8, pw); \
        _Pragma("unroll") for (int dt = 0; dt < 8; ++dt) { const bf16x8 vb = {tlo_[dt][0], tlo_[dt][1], tlo_[dt][2], tlo_[dt][3], thi_[dt][0], thi_[dt][1], thi_[dt][2], thi_[dt][3]}; \
            O[dt] = __builtin_amdgcn_mfma_f32_16x16x32_bf16(PA, vb, O[dt], 0, 0, 0); } } while (0)
    DSA_LOAD(X, 0); DSA_LOAD(Y, 1);
    __syncthreads();
    DSA_INIT(2 * wave);
    DSA_WRITE(X, buf0); DSA_LOAD(X, 2);
    if (1 < total) { DSA_WRITE(Y, buf1); DSA_LOAD(Y, 3); }
    for (int k = 0; k < total; k += 2) {
        DSA_COMPUTE(k, buf0);
        if (k + 2 < total) { DSA_WRITE(X, buf0); DSA_LOAD(X, k + 4); }
        if (k + 1 < total) { DSA_COMPUTE(k + 1, buf1); if (k + 3 < total) { DSA_WRITE(Y, buf1); DSA_LOAD(Y, k + 5); } }
    }
    DSA_FINAL();
#undef DSA_LOAD
#undef DSA_WRITE
#undef DSA_INIT
#undef DSA_FINAL
#undef DSA_COMPUTE
}
__device__ __forceinline__ void unit(LAS unsigned char* lds, int b, int q0, int tid, int wave, int lane, const bf16_t* qabs, const bf16_t* ckv, const bf16_t* kidx, const float* widx, bf16_t* mix, unsigned* dbg_flag) {
    asm volatile("" : "+v"(tid));
    lane = tid & 63;
    if (tid < 128) ((LAS float*)(lds + W_OFF))[tid] = widx[(size_t)(b * 2048 + q0) * 8 + tid];
#ifndef DSA_REP_S1
#define DSA_REP_S1 1
#define DSA_REP_S2 1
#define DSA_REP_S3 1
#endif
    if (q0 + 16 > 256) { for (int rp = 0; rp < DSA_REP_S1; ++rp) { scores(lds, b, q0, qabs, kidx, wave, lane); __syncthreads(); } }
    else __syncthreads();
    asm volatile("" : "+v"(tid)); lane = tid & 63;
#ifdef DSA_TOPK_CHECK
    for (int e2 = 0; e2 < 2; ++e2) { const int qq = 2 * wave + e2;
        topk(lds, q0, qq, lane); const LAS unsigned short* lw = (const LAS unsigned short*)(lds + LIST_OFF) + qq * 256; const int ns = ((const LAS int*)(lds + NSEL_OFF))[qq];
        unsigned h1 = 0, h2 = 0; for (int i = lane; i < ns; i += 64) { const unsigned x = lw[i]; h1 += x; h2 += x * x; }
        topk2(lds, q0, qq, wave, lane); const int ns2 = ((const LAS int*)(lds + NSEL_OFF))[qq];
        unsigned g1 = 0, g2 = 0; for (int i = lane; i < ns2; i += 64) { const unsigned x = lw[i]; g1 += x; g2 += x * x; }
#pragma unroll
        for (int o = 1; o < 64; o <<= 1) { h1 += __shfl_xor(h1, o); h2 += __shfl_xor(h2, o); g1 += __shfl_xor(g1, o); g2 += __shfl_xor(g2, o); }
        if (lane == 0 && (h1 != g1 || h2 != g2 || ns != ns2)) atomicAdd(dbg_flag, 1u); }
#else
    for (int rp = 0; rp < DSA_REP_S2; ++rp) { topk2(lds, q0, 2 * wave, wave, lane, dbg_flag); topk2(lds, q0, 2 * wave + 1, wave, lane, dbg_flag); }
#endif
    asm volatile("" : "+v"(tid)); lane = tid & 63;
    for (int rp = 0; rp < DSA_REP_S3; ++rp) { attend2(lds, b, q0, wave, lane, qabs, ckv, mix); __syncthreads(); }
}
}
#ifndef DN_REP_E
#define DN_REP_E 1
#define DN_REP_T 1
#endif
namespace dn {
typedef short bf16x8 __attribute__((ext_vector_type(8)));
typedef short s16x4 __attribute__((ext_vector_type(4)));
typedef float f32x4 __attribute__((ext_vector_type(4)));
typedef float f32x2 __attribute__((ext_vector_type(2)));
typedef unsigned u32x4 __attribute__((ext_vector_type(4)));
typedef unsigned u32x2 __attribute__((ext_vector_type(2)));
constexpr int CWL = 132096;
constexpr int QS = 0, KS = 17408, WB = 17408, KGT = 34816, VBT = 52224, KBT = 69632, LF = 87040, TB = 103680, XF = 112896, OF = 87040, QKB = 120832, GC = 130048, BT = 130304;
constexpr int QSTR = 272, TSTR = 136, LSTR = 65, TBSTR = 144, OSTR = 132;
typedef float cvf32x2_t __attribute__((ext_vector_type(2))); typedef __bf16 cvbf16x2_t __attribute__((ext_vector_type(2)));
__device__ __forceinline__ unsigned cvtpk(float lo, float hi) { cvf32x2_t v = {lo, hi}; return __builtin_bit_cast(unsigned, __builtin_convertvector(v, cvbf16x2_t)); }
__device__ __forceinline__ bf16x8 pack2(const f32x4& a, const f32x4& b) { u32x4 w; w.x = cvtpk(a[0], a[1]); w.y = cvtpk(a[2], a[3]); w.z = cvtpk(b[0], b[1]); w.w = cvtpk(b[2], b[3]); return __builtin_bit_cast(bf16x8, w); }
__device__ __forceinline__ bf16x8 frag_perm(const LAS unsigned char* rowp, int s, int g) {
    const u32x2 lo = *(const LAS u32x2*)(rowp + (32 * s + 4 * g) * 2), hi = *(const LAS u32x2*)(rowp + (32 * s + 16 + 4 * g) * 2);
    u32x4 w; w.x = lo.x; w.y = lo.y; w.z = hi.x; w.w = hi.y; return __builtin_bit_cast(bf16x8, w); }
__device__ __forceinline__ bf16x8 frag_nat8(const LAS unsigned char* rowp, int s, int g) {
    const u32x2 lo = *(const LAS u32x2*)(rowp + (32 * s + 8 * g) * 2), hi = *(const LAS u32x2*)(rowp + (32 * s + 8 * g + 4) * 2);
    u32x4 w; w.x = lo.x; w.y = lo.y; w.z = hi.x; w.w = hi.y; return __builtin_bit_cast(bf16x8, w); }
__device__ __forceinline__ float silu(float x) { return x * __builtin_amdgcn_rcpf(1.f + __builtin_amdgcn_exp2f(-LOG2E * x)); }
__device__ __forceinline__ float ex(float x) { return __builtin_amdgcn_exp2f(LOG2E * x); }

__device__ __forceinline__ void run(LAS unsigned char* lds0, int b, int h, const bf16_t* proj, const float* conv_w, const float* beta, const float* gdec, const float* gn, bf16_t* mix, int tid, int wave, int lane) {
    const int r16c = lane & 15, gc = lane >> 4;
    LAS float* cwL = (LAS float*)(lds0 + CWL);
    if (wave == 0) {
#pragma unroll
        for (int p = 0; p < 3; ++p)
#pragma unroll
            for (int e = 0; e < 2; ++e)
#pragma unroll
                for (int j = 0; j < 4; ++j) cwL[((p * 2 + e) * 4 + j) * 64 + lane] = conv_w[j * 1536 + p * 512 + h * 128 + 2 * lane + e];
    }
    __syncthreads();
    const float gn0 = gn[2 * lane], gn1 = gn[2 * lane + 1];
    f32x4 S[8];
#pragma unroll
    for (int i = 0; i < 8; ++i) S[i] = (f32x4){0.f, 0.f, 0.f, 0.f};
    const bf16_t* pbase = proj + h * 128 + 2 * lane;
    unsigned xq[11][3]; float gnext, bnext;
#define DN_LOAD_CHUNK(cn) do { const size_t Rn = (size_t)b * 2048 + 64 * (cn); \
        _Pragma("unroll") for (int a = 0; a < 11; ++a) { const int tt = 64 * (cn) + 8 * wave - 3 + a; \
            _Pragma("unroll") for (int p_ = 0; p_ < 3; ++p_) xq[a][p_] = (tt >= 0) ? *(const unsigned*)(pbase + (Rn + 8 * wave - 3 + a) * PROJ + p_ * 512) : 0u; } \
        gnext = gdec[(Rn + lane) * 4 + h]; bnext = beta[(Rn + lane) * 4 + h]; } while (0)
    DN_LOAD_CHUNK(0);
    for (int c = 0; c < 32; ++c) {
        const size_t R0 = (size_t)b * 2048 + 64 * c;
        int zoff = 0; asm volatile("" : "+v"(zoff));
        LAS unsigned char* lds = lds0 + zoff; const int r16 = r16c + zoff, g = gc + zoff;
        LAS float* Lf = (LAS float*)(lds + LF); LAS float* gcumL = (LAS float*)(lds + GC); LAS float* betaL = (LAS float*)(lds + BT);
        float gcum = gnext;
#pragma unroll
        for (int o = 1; o < 64; o <<= 1) { const float t = __shfl_up(gcum, o); if (lane >= o) gcum += t; }
        const float gl = __int_as_float(__builtin_amdgcn_readlane(__float_as_int(gcum), 63));
        const float bv = bnext;
        if (wave == 0) { gcumL[lane] = gcum; betaL[lane] = bv; }
        for (int rpE = 0; rpE < DN_REP_E; ++rpE) {
            float cw[3][2][4];
#pragma unroll
            for (int p = 0; p < 3; ++p)
#pragma unroll
                for (int e = 0; e < 2; ++e)
#pragma unroll
                    for (int j = 0; j < 4; ++j) cw[p][e][j] = cwL[((p * 2 + e) * 4 + j) * 64 + lane];
            float xw[3][3][2];
#pragma unroll
            for (int a = 0; a < 3; ++a)
#pragma unroll
                for (int p = 0; p < 3; ++p) { xw[a][p][0] = __uint_as_float(xq[a][p] << 16); xw[a][p][1] = __uint_as_float(xq[a][p] & 0xffff0000u); }
#pragma unroll
            for (int i = 0; i < 8; ++i) {
                const int r = 8 * wave + i; float x0[3][2], sv[3][2];
#pragma unroll
                for (int p = 0; p < 3; ++p) { x0[p][0] = __uint_as_float(xq[3 + i][p] << 16); x0[p][1] = __uint_as_float(xq[3 + i][p] & 0xffff0000u); }
#pragma unroll
                for (int p = 0; p < 3; ++p)
#pragma unroll
                    for (int e = 0; e < 2; ++e) { const float s = cw[p][e][0] * xw[0][p][e] + cw[p][e][1] * xw[1][p][e] + cw[p][e][2] * xw[2][p][e] + cw[p][e][3] * x0[p][e]; sv[p][e] = silu(s); }
                const float rq = rsqrtf(wave_sum(sv[0][0] * sv[0][0] + sv[0][1] * sv[0][1]) + EPS) * 0.08838834764831845f;
                const float rk = rsqrtf(wave_sum(sv[1][0] * sv[1][0] + sv[1][1] * sv[1][1]) + EPS);
                const float gr = __int_as_float(__builtin_amdgcn_readlane(__float_as_int(gcum), r)), br = __int_as_float(__builtin_amdgcn_readlane(__float_as_int(bv), r));
                const float eg = ex(gr), ekl = ex(gl - gr);
                const float k0 = sv[1][0] * rk, k1 = sv[1][1] * rk;
                *(LAS unsigned*)(lds + QS + r * QSTR + 4 * lane) = cvtpk(sv[0][0] * rq, sv[0][1] * rq);
                *(LAS unsigned*)(lds + KS + r * QSTR + 4 * lane) = cvtpk(k0, k1);
                const unsigned kg = cvtpk(k0 * ekl, k1 * ekl), kb = cvtpk(k0 * br * eg, k1 * br * eg), vb = cvtpk(sv[2][0] * br, sv[2][1] * br);
                *(LAS unsigned short*)(lds + KGT + (2 * lane) * TSTR + 2 * r) = (unsigned short)kg; *(LAS unsigned short*)(lds + KGT + (2 * lane + 1) * TSTR + 2 * r) = (unsigned short)(kg >> 16);
                *(LAS unsigned short*)(lds + KBT + (2 * lane) * TSTR + 2 * r) = (unsigned short)kb; *(LAS unsigned short*)(lds + KBT + (2 * lane + 1) * TSTR + 2 * r) = (unsigned short)(kb >> 16);
                *(LAS unsigned short*)(lds + VBT + (2 * lane) * TSTR + 2 * r) = (unsigned short)vb; *(LAS unsigned short*)(lds + VBT + (2 * lane + 1) * TSTR + 2 * r) = (unsigned short)(vb >> 16);
#pragma unroll
                for (int p = 0; p < 3; ++p)
#pragma unroll
                    for (int e = 0; e < 2; ++e) { xw[0][p][e] = xw[1][p][e]; xw[1][p][e] = xw[2][p][e]; xw[2][p][e] = x0[p][e]; }
            }
        }
        __syncthreads();
        for (int rpT = 0; rpT < DN_REP_T; ++rpT) {
        {
            const int ti = wave & 3, sel = wave >> 2;
            const LAS unsigned char* Ab = lds + (sel ? QS : KS) + (16 * ti + r16) * QSTR;
            bf16x8 A[4];
#pragma unroll
            for (int s = 0; s < 4; ++s) A[s] = *(const LAS bf16x8*)(Ab + (32 * s + 8 * g) * 2);
            const f32x4 gi4 = *(const LAS f32x4*)(gcumL + 16 * ti + 4 * g), bi4 = *(const LAS f32x4*)(betaL + 16 * ti + 4 * g);
#pragma unroll
            for (int tj = 0; tj < 4; ++tj) {
                f32x4 acc = {0.f, 0.f, 0.f, 0.f};
                if (tj <= ti) {
                    const LAS unsigned char* Bb = lds + KS + (16 * tj + r16) * QSTR; bf16x8 Bf[4];
#pragma unroll
                    for (int s = 0; s < 4; ++s) Bf[s] = *(const LAS bf16x8*)(Bb + (32 * s + 8 * g) * 2);
#pragma unroll
                    for (int s = 0; s < 4; ++s) acc = __builtin_amdgcn_mfma_f32_16x16x32_bf16(A[s], Bf[s], acc, 0, 0, 0);
                }
                const float gj = gcumL[16 * tj + r16]; const int j = 16 * tj + r16;
#pragma unroll
                for (int e = 0; e < 4; ++e) { const int i = 16 * ti + 4 * g + e; const float dec = ex(fminf(gi4[e] - gj, 0.f));
                    if (sel == 0) { const float lv = (i > j) ? bi4[e] * acc[e] * dec : 0.f;
                        if (tj == ti) Lf[i * LSTR + j] = lv; else if (tj < ti) *(LAS unsigned short*)(lds + TB + i * TBSTR + 2 * j) = f2bf(lv); }
                    else *(LAS unsigned short*)(lds + QKB + i * TBSTR + 2 * j) = f2bf((i >= j) ? acc[e] * dec : 0.f); }
            }
        }
        __syncthreads();
        if (wave == 0) {
            const LAS float* Nb = Lf + (16 * g) * LSTR + 16 * g; float x[16]; int rc = r16; asm volatile("" : "+v"(rc));
            float na[55], nb2[65];
            { int q = 0;
#pragma unroll
              for (int r = 1; r <= 10; ++r)
#pragma unroll
                  for (int j = 0; j < r; ++j) na[q++] = Nb[r * LSTR + j]; }
            { int q = 0;
#pragma unroll
              for (int r = 11; r <= 15; ++r)
#pragma unroll
                  for (int j = 0; j < r; ++j) nb2[q++] = Nb[r * LSTR + j]; }
            x[0] = (0 == rc) ? 1.f : 0.f;
            { int q = 0;
#pragma unroll
              for (int r = 1; r <= 10; ++r) { float s = (r == rc) ? 1.f : 0.f;
#pragma unroll
                  for (int j = 0; j < r; ++j) s -= na[q++] * x[j];
                  x[r] = s; } }
            { int q = 0;
#pragma unroll
              for (int r = 11; r <= 15; ++r) { float s = (r == rc) ? 1.f : 0.f;
#pragma unroll
                  for (int j = 0; j < r; ++j) s -= nb2[q++] * x[j];
                  x[r] = s; } }
#pragma unroll
            for (int r = 0; r < 16; ++r) *(LAS unsigned short*)(lds + TB + (16 * g + r) * TBSTR + 2 * (16 * g + r16)) = f2bf(x[r]);
        }
        __syncthreads();
        }
        f32x4 U[4];
        {
            const LAS unsigned char* tl = lds + TB;
#define DN_A1(b_, k_) ({ const u32x2 lo_ = *(const LAS u32x2*)(tl + (16 * (b_) + r16) * TBSTR + (16 * (k_) + 4 * g) * 2); u32x4 w_; w_.x = lo_.x; w_.y = lo_.y; w_.z = 0u; w_.w = 0u; __builtin_bit_cast(bf16x8, w_); })
#define DN_A2(b_, k0_, k1_) ({ const u32x2 lo_ = *(const LAS u32x2*)(tl + (16 * (b_) + r16) * TBSTR + (16 * (k0_) + 4 * g) * 2), hi_ = *(const LAS u32x2*)(tl + (16 * (b_) + r16) * TBSTR + (16 * (k1_) + 4 * g) * 2); \
            u32x4 w_; w_.x = lo_.x; w_.y = lo_.y; w_.z = hi_.x; w_.w = hi_.y; __builtin_bit_cast(bf16x8, w_); })
            const bf16x8 aD0 = DN_A1(0, 0), aL10 = DN_A1(1, 0), aD1 = DN_A1(1, 1), aL2 = DN_A2(2, 0, 1), aD2 = DN_A1(2, 2), aL3a = DN_A2(3, 0, 1), aL3b = DN_A1(3, 2), aD3 = DN_A1(3, 3);
            const f32x4 z4 = {0.f, 0.f, 0.f, 0.f};
#pragma unroll
            for (int which = 0; which < 2; ++which) {
                const LAS unsigned char* rp = lds + (which ? KBT : VBT) + (16 * wave + r16) * TSTR;
                f32x4 R[4];
#pragma unroll
                for (int b4 = 0; b4 < 4; ++b4) { const u32x2 w = *(const LAS u32x2*)(rp + (16 * b4 + 4 * g) * 2);
                    R[b4] = (f32x4){__uint_as_float(w.x << 16), __uint_as_float(w.x & 0xffff0000u), __uint_as_float(w.y << 16), __uint_as_float(w.y & 0xffff0000u)}; }
                f32x4 X0 = __builtin_amdgcn_mfma_f32_16x16x32_bf16(aD0, pack2(R[0], z4), z4, 0, 0, 0);
                f32x4 Y = __builtin_amdgcn_mfma_f32_16x16x32_bf16(aL10, pack2(X0, z4), z4, 0, 0, 0);
                f32x4 X1 = __builtin_amdgcn_mfma_f32_16x16x32_bf16(aD1, pack2(R[1] - Y, z4), z4, 0, 0, 0);
                const bf16x8 b01 = pack2(X0, X1);
                Y = __builtin_amdgcn_mfma_f32_16x16x32_bf16(aL2, b01, z4, 0, 0, 0);
                f32x4 X2 = __builtin_amdgcn_mfma_f32_16x16x32_bf16(aD2, pack2(R[2] - Y, z4), z4, 0, 0, 0);
                Y = __builtin_amdgcn_mfma_f32_16x16x32_bf16(aL3a, b01, z4, 0, 0, 0);
                Y = __builtin_amdgcn_mfma_f32_16x16x32_bf16(aL3b, pack2(X2, z4), Y, 0, 0, 0);
                f32x4 X3 = __builtin_amdgcn_mfma_f32_16x16x32_bf16(aD3, pack2(R[3] - Y, z4), z4, 0, 0, 0);
                if (which == 0) { U[0] = X0; U[1] = X1; U[2] = X2; U[3] = X3; }
                else { const f32x4 Xs[4] = {X0, X1, X2, X3};
#pragma unroll
                    for (int ti = 0; ti < 4; ++ti)
#pragma unroll
                        for (int e = 0; e < 4; ++e) *(LAS unsigned short*)(lds + WB + (16 * ti + 4 * g + e) * QSTR + (16 * wave + r16) * 2) = f2bf(Xs[ti][e]); }
            }
#undef DN_A1
#undef DN_A2
        }
        __syncthreads();
        if (c + 1 < 32) DN_LOAD_CHUNK(c + 1);
        unsigned dzq[8];
#pragma unroll
        for (int i = 0; i < 8; ++i) dzq[i] = *(const unsigned*)(proj + (R0 + 8 * wave + i) * PROJ + C_DZ + h * 128 + 2 * lane);
        {
            bf16x8 Sb[4];
#pragma unroll
            for (int s = 0; s < 4; ++s) Sb[s] = pack2(S[2 * s], S[2 * s + 1]);
            f32x4 Vn[4], Oa[4];
#pragma unroll
            for (int ti = 0; ti < 4; ++ti) {
                const LAS unsigned char* wp = lds + WB + (16 * ti + r16) * QSTR; const LAS unsigned char* qp = lds + QS + (16 * ti + r16) * QSTR;
                bf16x8 wf[4], qf[4];
#pragma unroll
                for (int s = 0; s < 4; ++s) { wf[s] = frag_perm(wp, s, g); qf[s] = frag_perm(qp, s, g); }
                const f32x4 gi4 = *(const LAS f32x4*)(gcumL + 16 * ti + 4 * g);
                f32x4 ws = {0.f, 0.f, 0.f, 0.f}, qs = {0.f, 0.f, 0.f, 0.f};
#pragma unroll
                for (int s = 0; s < 4; ++s) { ws = __builtin_amdgcn_mfma_f32_16x16x32_bf16(wf[s], Sb[s], ws, 0, 0, 0); qs = __builtin_amdgcn_mfma_f32_16x16x32_bf16(qf[s], Sb[s], qs, 0, 0, 0); }
                Vn[ti] = U[ti] - ws;
#pragma unroll
                for (int e = 0; e < 4; ++e) qs[e] *= ex(gi4[e]);
                Oa[ti] = qs;
            }
            bf16x8 Vb[2];
#pragma unroll
            for (int s = 0; s < 2; ++s) Vb[s] = pack2(Vn[2 * s], Vn[2 * s + 1]);
            { bf16x8 kf[4][2];
#pragma unroll
              for (int ti = 0; ti < 4; ++ti) { const LAS unsigned char* kp = lds + QKB + (16 * ti + r16) * TBSTR; kf[ti][0] = frag_perm(kp, 0, g); kf[ti][1] = frag_perm(kp, 1, g); }
#pragma unroll
              for (int ti = 0; ti < 4; ++ti)
#pragma unroll
                  for (int s = 0; s < 2; ++s) Oa[ti] = __builtin_amdgcn_mfma_f32_16x16x32_bf16(kf[ti][s], Vb[s], Oa[ti], 0, 0, 0); }
            const float egl = ex(gl);
#pragma unroll
            for (int half = 0; half < 2; ++half) { bf16x8 kf[4][2];
#pragma unroll
                for (int q = 0; q < 4; ++q) { const LAS unsigned char* kp = lds + KGT + (16 * (4 * half + q) + r16) * TSTR; kf[q][0] = frag_perm(kp, 0, g); kf[q][1] = frag_perm(kp, 1, g); }
#pragma unroll
                for (int q = 0; q < 4; ++q) { f32x4 sa = S[4 * half + q] * egl;
#pragma unroll
                    for (int s = 0; s < 2; ++s) sa = __builtin_amdgcn_mfma_f32_16x16x32_bf16(kf[q][s], Vb[s], sa, 0, 0, 0);
                    S[4 * half + q] = sa; } }
            LAS float* Of = (LAS float*)(lds + OF);
#pragma unroll
            for (int ti = 0; ti < 4; ++ti)
#pragma unroll
                for (int e = 0; e < 4; ++e) Of[(16 * ti + 4 * g + e) * OSTR + 16 * wave + r16] = Oa[ti][e];
        }
        __syncthreads();
        {
            const LAS float* Of = (const LAS float*)(lds + OF);
#pragma unroll
            for (int i = 0; i < 8; ++i) { const int r = 8 * wave + i; const f32x2 o = *(const LAS f32x2*)(Of + r * OSTR + 2 * lane);
                const float rstd = rsqrtf(wave_sum(o.x * o.x + o.y * o.y) * (1.f / 128.f) + EPS);
                const float z0 = __uint_as_float(dzq[i] << 16), z1 = __uint_as_float(dzq[i] & 0xffff0000u);
                *(unsigned*)(mix + (R0 + r) * MIXK + h * 128 + 2 * lane) = cvtpk(o.x * rstd * gn0 * silu(z0), o.y * rstd * gn1 * silu(z1)); }
        }
    }
}
#undef DN_LOAD_CHUNK
}
struct Args { const float* in[28]; float* out; unsigned char* ws; int ph_lo, ph_hi, li, pad; };
struct Frame {
    LAS unsigned char* lds; volatile LAS unsigned* MISC; int tid, lane, wave, G, vcu;
};
template <int NR> __device__ __forceinline__ void dsa_prep_rows(int row0, int lane, const bf16_t* proj, const float* kvg, const float* lng, const float* lnb, const float* a_log, const float* dt_bias,
                                             bf16_t* ckv, bf16_t* kidx, float* widx, float* beta, float* gdec) {
    unsigned cv[NR]; unsigned short kv[NR], sm[NR];
#pragma unroll
    for (int r = 0; r < NR; ++r) { const bf16_t* pr = proj + (size_t)(row0 + r) * PROJ; cv[r] = *(const unsigned*)(pr + C_CKV + lane * 2); kv[r] = pr[C_KIX + lane]; sm[r] = pr[C_WIX + (lane & 15)]; }
    const float g0 = kvg[lane * 2], g1 = kvg[lane * 2 + 1], lg = lng[lane], lb = lnb[lane], al = a_log[lane & 3], dtb = dt_bias[lane & 3];
#pragma unroll
    for (int r = 0; r < NR; ++r) { const int row = row0 + r;
        { const float a = __uint_as_float(cv[r] << 16), b = __uint_as_float(cv[r] & 0xffff0000u);
          const float rs = rsqrtf(wave_sum(a * a + b * b) * (1.f / 128.f) + EPS); *(unsigned*)(ckv + (size_t)row * 128 + lane * 2) = pk2(a * rs * g0, b * rs * g1); }
        { const float a = bf2f(kv[r]); const float mu = wave_sum(a) * (1.f / 64.f); const float xc = a - mu; const float rs = rsqrtf(wave_sum(xc * xc) * (1.f / 64.f) + EPS);
          kidx[(size_t)row * 64 + lane] = f2bf(xc * rs * lg + lb); }
        const float sv = bf2f(sm[r]);
        if (lane < 8) widx[(size_t)row * 8 + lane] = sv * 0.04419417382415922f;
        else if (lane < 12) beta[(size_t)row * 4 + (lane - 8)] = 1.f / (1.f + __expf(-sv));
        else if (lane < 16) { const float xx = sv + dtb; const float sp = xx > 20.f ? xx : log1pf(__expf(xx)); gdec[(size_t)row * 4 + (lane - 12)] = -__expf(al) * sp; }
    }
}

__global__ void __launch_bounds__(NWAVES * 64, 2) mega(Args args) {
    extern __shared__ __attribute__((aligned(16))) unsigned char lds_raw[];
    Frame F;
    F.lds = (LAS unsigned char*)lds_raw;
    F.MISC = (volatile LAS unsigned*)(F.lds + MISC_OFF);
    F.tid = threadIdx.x; F.lane = F.tid & 63; F.wave = __builtin_amdgcn_readfirstlane(F.tid >> 6);
    F.G = gridDim.x; { const int bx = blockIdx.x; F.vcu = (F.G % 8 == 0) ? (bx % 8) * (F.G / 8) + bx / 8 : bx; }
    unsigned char* ws = args.ws;
    const float* x = args.in[0]; const float* mem = args.in[1]; const float* g_mix = args.in[2]; const float* w_in = args.in[3];
    const float* conv_w = args.in[4]; const float* a_log = args.in[5]; const float* dt_bias = args.in[6];
    const float* dn_norm_g = args.in[7]; const float* q_norm_g = args.in[8]; const float* kv_norm_g = args.in[9]; const float* w_uq = args.in[10]; const float* w_uk = args.in[11];
    const float* w_uv = args.in[12]; const float* w_qidx = args.in[13]; const float* kidx_ln_g = args.in[14]; const float* kidx_ln_b = args.in[15];
    const float* rel_bias = args.in[16]; const float* w_out = args.in[17]; const float* g_xattn = args.in[18]; const float* g_mem = args.in[19];
    const float* w_xq = args.in[20]; const float* w_xkv = args.in[21]; const float* w_xo = args.in[22]; const float* g_ffn = args.in[23];
    const float* w_gate = args.in[24]; const float* w_up = args.in[25]; const float* w_down = args.in[26]; const float* g_final = args.in[27];
    float* out = args.out;
    bf16_t* Win_t = (bf16_t*)(ws + WS_WIN); bf16_t* Wkv_t = (bf16_t*)(ws + WS_WKV); bf16_t* Wdsa_t = (bf16_t*)(ws + WS_WDSA); bf16_t* Wout_t = (bf16_t*)(ws + WS_WOUT);
    bf16_t* Wxq_t = (bf16_t*)(ws + WS_WXQ); bf16_t* Wxo_t = (bf16_t*)(ws + WS_WXO); bf16_t* Wgu_t = (bf16_t*)(ws + WS_WGU); bf16_t* Wdn_t = (bf16_t*)(ws + WS_WDN);
    unsigned char* stt = ws + WS_ST;
    float* rstdx = (float*)(stt + ST_RSTDX); float* cqss = (float*)(stt + ST_CQSS); float* lpart = (float*)(stt + ST_LPART);
    float* widx = (float*)(stt + ST_WIDX); float* beta = (float*)(stt + ST_BETA); float* gdec = (float*)(stt + ST_G); float* biastab = (float*)(stt + ST_BIAS);
    bf16_t* mnb = (bf16_t*)(ws + WS_MNB); bf16_t* kx = (bf16_t*)(ws + WS_KX); bf16_t* vT = (bf16_t*)(ws + WS_VT); bf16_t* ckv = (bf16_t*)(ws + WS_CKV); bf16_t* kidx = (bf16_t*)(ws + WS_KIDX);
    float* ssq1 = (float*)(ws + WS_SSQ); float* ssq2 = ssq1 + (size_t)M * 16;
    bf16_t* proj = (bf16_t*)(ws + WS_PROJ); bf16_t* mix = (bf16_t*)(ws + WS_MIX); bf16_t* xb = (bf16_t*)(ws + WS_XB); bf16_t* qabs = (bf16_t*)out;
    bf16_t* x1b = (bf16_t*)(ws + WS_X1B); bf16_t* qx = (bf16_t*)(ws + WS_QX); bf16_t* Pb = (bf16_t*)(ws + WS_P); bf16_t* ox = (bf16_t*)(ws + WS_OX); bf16_t* x2b = (bf16_t*)(ws + WS_X2B); unsigned char* act = ws + WS_ACT; unsigned char* Wdn8 = ws + WS_W8;

    for (int u = F.tid; u < (LDS_BYTES - LDSCTL_OFF) / 4; u += NWAVES * 64) ((LAS unsigned*)(F.lds + LDSCTL_OFF))[u] = 0u;
    __syncthreads();
    XcdBarrier bar = xcd_barrier_post((unsigned*)(ws + WS_CTL) + 4096 + args.li * XCD_BAR_WORDS, F.MISC + 8);
#define GRID_BAR() xcd_barrier(bar)
    const int lo = args.ph_lo, hi = args.ph_hi;
#ifdef ONLY_PHASE
#define IN(k) ((k) == ONLY_PHASE && lo <= (k) && (k) < hi)
#else
#define IN(k) (lo <= (k) && (k) < hi)
#endif
#define BOTH(k) (IN(k) && IN((k) + 1))
    const int gw = F.vcu * NWAVES + F.wave, NGW = F.G * NWAVES;
    PG8_LAS unsigned char* ring = (PG8_LAS unsigned char*)F.lds;

    if (IN(0)) {
        LAS float* scr = (LAS float*)(F.lds + F.wave * 16384);
        constexpr int I_OB = 32 * 32, I_QA = 8 * 32, I_QI = 4 * 16, I_IN = 16 * 80, I_KV = 16 * 64, I_XQ = 16 * 32, I_XO = 16 * 32, I_GU = 16 * 176, I_DN = 44 * 32, I_OA = 8 * 32;
        constexpr int NITEMS = I_OB + I_QA + I_QI + I_IN + I_KV + I_XQ + I_XO + I_GU + I_DN + I_OA;
        for (int it = gw; it < NITEMS; it += NGW) {
            int r = it;
            if (r < I_OB) { const int kb = r >> 5, nb = r & 31, k0 = 32 * kb, h = k0 >> 7;
                heavy_item(w_uv, 64, w_out + (size_t)(512 + h * 64) * 1024, 1024, nullptr, 1.f, k0, 32 * nb, 32 * nb, Wout_t, MIXK, 512, scr, F.lane); continue; } r -= I_OB;
            if (r < I_QA) { const int kb = r >> 5, nb = r & 31, n0 = 32 * nb, h = n0 >> 7;
                heavy_item(w_uq + h * 64, 512, w_uk + (size_t)(h * 64) * 128 - h * 128, 128, q_norm_g, 0.125f * LOG2E, 32 * kb, n0, ((n0 >> 5) & 3) * 256 + h * 32, Wdsa_t, 256, 0, scr, F.lane); continue; }   r -= I_QA;
            if (r < I_QI) { tr_item(SrcQidx{w_qidx, q_norm_g}, 512, Wdsa_t + (size_t)1024 * 256, 256, 0, scr, r, F.lane); continue; } r -= I_QI;
            if (r < I_IN) { tr_item(SrcWin{w_in, g_mix}, PROJ, Win_t, 1024, 0, scr, r, F.lane); continue; } r -= I_IN;
            if (r < I_KV) { tr_item(SrcPlain{w_xkv, 2048, nullptr, 1.f}, 2048, Wkv_t, 1024, 0, scr, r, F.lane); continue; } r -= I_KV;
            if (r < I_XQ) { tr_item(SrcPlain{w_xq, 1024, g_xattn, 0.0625f * LOG2E}, 1024, Wxq_t, 1024, 0, scr, r, F.lane); continue; } r -= I_XQ;
            if (r < I_XO) { tr_item(SrcPlain{w_xo, 1024, nullptr, 1.f}, 1024, Wxo_t, 1024, 0, scr, r, F.lane); continue; } r -= I_XO;
            if (r < I_GU) { tr_item(SrcGU{w_gate, w_up, g_ffn}, 2 * DFF, Wgu_t, 1024, 0, scr, r, F.lane); continue; } r -= I_GU;
            if (r < I_DN) { tr_item(SrcPlain{w_down, 1024, nullptr, 1.f}, 1024, Wdn_t, DFF, 0, scr, r, F.lane, (unsigned*)(ws + WS_CTL) + CTL_AMAX); continue; } r -= I_DN;
            tr_item(SrcPlain{w_out, 1024, nullptr, 1.f}, 1024, Wout_t, MIXK, 0, scr, r, F.lane);
        }
        for (int m = 4 * gw; m < M; m += 4 * NGW) row_prep<4>(x + (size_t)m * D, nullptr, xb + (size_t)m * D, rstdx + m, F.lane);
        for (int m = 2 * gw; m < MM; m += 2 * NGW) row_prep<2>(mem + (size_t)m * D, g_mem, mnb + (size_t)m * D, nullptr, F.lane);
        if (blockIdx.x == 0) for (int i = F.tid; i < 129 * 8; i += NWAVES * 64) {
            const int d = i >> 3, h = i & 7; int bkt;
            if (d < 16) bkt = d; else { const float lr = logf((float)d / 16.f) / 2.0794415416798357f; const int large = 16 + (int)(lr * 16.f); bkt = large < 31 ? large : 31; }
            biastab[i] = rel_bias[bkt * 8 + h] * LOG2E; }
        if (BOTH(0)) GRID_BAR();
    }
    if (IN(1)) {
        pg8::Gemm g{xb, Win_t, 1024, 1024, 1024}; pg8::StaticOrder S; S.init(M, PROJ, F.G, (int)blockIdx.x);
        pg8::EpiProj E{proj, PROJ, nullptr, cqss, 8};
        pg8::gemm_phase<pg8::EpiProj, pg8::StaticOrder, true>(ring, g, S, E);
        if (BOTH(1)) GRID_BAR();
    }
    if (IN(2)) {
        for (int m = 4 * gw; m < M; m += 4 * NGW) dsa_prep_rows<4>(m, F.lane, proj, kv_norm_g, kidx_ln_g, kidx_ln_b, a_log, dt_bias, ckv, kidx, widx, beta, gdec);
        cvt_w8(Wdn_t, Wdn8, DFF * 1024 / 16, __hip_atomic_load((unsigned*)(ws + WS_CTL) + CTL_AMAX, __ATOMIC_RELAXED, __HIP_MEMORY_SCOPE_AGENT), gw * 64 + F.lane, NGW * 64);
        { pg8::Gemm g{proj + C_CQ, Wdsa_t, PROJ, 256, 256}; pg8::StaticOrder S; S.init(M, 1536, F.G, (int)blockIdx.x);
          pg8::EpiNormScale<4> E{qabs, 1536, cqss, 1.f / 256.f};
          pg8::gemm_phase<pg8::EpiNormScale<4>, pg8::StaticOrder, true>(ring, g, S, E); }
        if (BOTH(2)) GRID_BAR();
    }
    if (IN(3)) {
        int tid3 = threadIdx.x; asm volatile("" : "+v"(tid3)); const int lane3 = tid3 & 63;
        if (blockIdx.x < 64) dn::run(F.lds, (int)blockIdx.x >> 2, (int)blockIdx.x & 3, proj, conv_w, beta, gdec, dn_norm_g, mix, tid3, F.wave, lane3);
        __syncthreads();
        if (blockIdx.x >= 64) { unsigned* kvq = (unsigned*)(ws + WS_CTL) + 1536;
            for (;;) {
                if (threadIdx.x == 0) F.MISC[17] = __hip_atomic_fetch_add(kvq, 1u, __ATOMIC_RELAXED, __HIP_MEMORY_SCOPE_AGENT);
                __syncthreads(); const int k = (int)F.MISC[17]; __syncthreads();
                if (k >= 128) break;
                if (k < 64) { pg8::Gemm g{mnb, Wkv_t, 1024, 1024, 1024}; pg8::OneUnit S1{{k >> 2, k & 3, 0, 0}}; pg8::EpiProj E{kx, 1024, nullptr, nullptr, -1};
                    pg8::gemm_phase<pg8::EpiProj, pg8::OneUnit, false>(ring, g, S1, E); }
                else { const int k2 = k - 64; pg8::Gemm g{Wkv_t + (size_t)1024 * 1024, mnb, 1024, 1024, 1024}; pg8::OneUnit S1{{k2 >> 4, k2 & 15, 0, 0}}; pg8::EpiProj E{vT, MM, nullptr, nullptr, -1};
                    pg8::gemm_phase<pg8::EpiProj, pg8::OneUnit, false>(ring, g, S1, E); }
            } }
        for (int pass = 0; pass <= args.pad; ++pass) {
        if (pass) GRID_BAR();
        int tid4 = threadIdx.x; asm volatile("" : "+v"(tid4)); const int lane4 = tid4 & 63;
        dsa::phase_init(F.lds, biastab, kv_norm_g, tid4);
        unsigned* qbase = (unsigned*)(ws + WS_CTL) + 2048 + 1024 * pass;
        const int myx = (int)(xb_xcc_id() & 7u);
        for (int sx = 0; sx < 8; ++sx) { const int qx8 = (myx + sx) & 7;
        for (;;) {
            if (tid4 == 0) F.MISC[16] = __hip_atomic_fetch_add(qbase + 64 * qx8, 1u, __ATOMIC_RELAXED, __HIP_MEMORY_SCOPE_AGENT);
            __syncthreads(); const int k = (int)F.MISC[16]; __syncthreads();
            if (k >= 256) break;
            dsa::unit(F.lds, 2 * qx8 + (k & 1), (127 - (k >> 1)) * 16, tid4, F.wave, lane4, qabs, ckv, kidx, widx, mix, (unsigned*)(ws + WS_CTL) + 1024);
        } }
        }
        if (BOTH(3)) GRID_BAR();
    }
    if (IN(4)) {
        pg8::Gemm g{mix, Wout_t, MIXK, MIXK, MIXK}; pg8::StaticOrder S; S.init(M, 1024, F.G, (int)blockIdx.x);
        pg8::EpiResid<true> E{nullptr, xb, x1b, ssq1, rstdx};
        pg8::gemm_phase<pg8::EpiResid<true>, pg8::StaticOrder, true>(ring, g, S, E);
        if (BOTH(4)) GRID_BAR();
    }
    if (IN(5)) {
        pg8::StaticOrder S; S.init(M, 1024, F.G, (int)blockIdx.x); pg8::Unit ua, ub; const bool h0 = S.next(0, ua), h1 = S.next(1, ub);
        if (h0) {
            { pg8::Gemm g{x1b, Wxq_t, 1024, 1024, 1024};
              pg8::EpiNormScale<16> E{qx, 1024, ssq1, 1.f / 1024.f};
              pg8::gemm_phase<pg8::EpiNormScale<16>, pg8::StaticOrder, true>(ring, g, S, E); }
            VM_WAIT(); __syncthreads();
            pg8::TwoUnits S2; S2.n = h1 ? 2 : 1;
            S2.u0 = pg8::Unit{ua.pm, ua.pm >> 3, (long)ua.pn * 512, (long)ua.pn * 512}; S2.u1 = pg8::Unit{ub.pm, ub.pm >> 3, (long)ub.pn * 512, (long)ub.pn * 512};
            { pg8::Gemm g{qx, kx, 1024, 1024, 256};
              pg8::EpiExpP E{Pb, lpart};
              pg8::gemm_phase<pg8::EpiExpP, pg8::TwoUnits, true>(ring, g, S2, E); }
            VM_WAIT(); __syncthreads();
            pg8::TwoUnits S3; S3.n = S2.n;
            S3.u0 = pg8::Unit{ua.pm, ua.pn, (long)ua.pn * 512, (long)(ua.pm >> 3) * 512}; S3.u1 = pg8::Unit{ub.pm, ub.pn, (long)ub.pn * 512, (long)(ub.pm >> 3) * 512};
            { pg8::Gemm g{Pb, vT, 1024, MM, 256};
              pg8::EpiPV E{ox, lpart};
              pg8::gemm_phase<pg8::EpiPV, pg8::TwoUnits, true>(ring, g, S3, E); }
        }
        if (BOTH(5)) GRID_BAR();
    }
    if (IN(6)) {
        pg8::Gemm g{ox, Wxo_t, 1024, 1024, 1024}; pg8::StaticOrder S; S.init(M, 1024, F.G, (int)blockIdx.x);
        pg8::EpiResid<true> E{nullptr, x1b, x2b, ssq2, nullptr};
        pg8::gemm_phase<pg8::EpiResid<true>, pg8::StaticOrder, true>(ring, g, S, E);
        if (BOTH(6)) GRID_BAR();
    }
    if (IN(7)) {
        pg8::Gemm g{x2b, Wgu_t, 1024, 1024, 1024}; pg8::StaticOrder S; S.init(M, 2 * DFF, F.G, (int)blockIdx.x);
        pg8::EpiSwiglu E{act, ssq2};
        pg8::gemm_phase<pg8::EpiSwiglu, pg8::StaticOrder, true>(ring, g, S, E);
        if (BOTH(7)) GRID_BAR();
    }
    const bool fuse_final = (F.G == 256);
    if (IN(8)) {
        pg8::Gemm g{(const bf16_t*)act, (const bf16_t*)Wdn8, DFF, DFF, DFF}; pg8::StaticOrder S; S.init(M, 1024, F.G, (int)blockIdx.x);
        const float asc = pg8::w8_inv_scale((unsigned)__builtin_amdgcn_readfirstlane((int)__hip_atomic_load((unsigned*)(ws + WS_CTL) + CTL_AMAX, __ATOMIC_RELAXED, __HIP_MEMORY_SCOPE_AGENT)), pg8::ACT_SHIFT);
        if (fuse_final) { pg8::EpiFinal E{x2b, out, ssq1, (unsigned*)(ws + WS_CTL) + 8192, g_final, asc};
            pg8::gemm_phase<pg8::EpiFinal, pg8::StaticOrder, true, true>(ring, g, S, E, F.wave); }
        else { pg8::EpiResidF32 E{x2b, out, ssq1, asc};
            pg8::gemm_phase<pg8::EpiResidF32, pg8::StaticOrder, true, true>(ring, g, S, E, F.wave);
            if (BOTH(8)) GRID_BAR(); }
    }
    if (IN(9) && !fuse_final) {
#ifdef DSA_FALLBACK_COUNT
        if (blockIdx.x == 0 && F.tid == 0 && __hip_atomic_load((unsigned*)(ws + WS_CTL) + 1024 + 64, __ATOMIC_RELAXED, __HIP_MEMORY_SCOPE_AGENT) > DSA_FALLBACK_COUNT) out[12345] = __builtin_nanf("");
#endif
#ifdef DSA_TOPK_CHECK
        if (blockIdx.x == 0 && F.tid == 0 && __hip_atomic_load((unsigned*)(ws + WS_CTL) + 1024, __ATOMIC_RELAXED, __HIP_MEMORY_SCOPE_AGENT) != 0u) out[12345] = __builtin_nanf("");
#endif
        int lane9; asm volatile("v_mbcnt_lo_u32_b32 %0, -1, 0\n\tv_mbcnt_hi_u32_b32 %0, -1, %0" : "=v"(lane9));
        for (int m = gw; m < M; m += NGW) {
            const float* pp = ssq1 + (size_t)m * 16; float s = 0.f;
#pragma unroll
            for (int q = 0; q < 4; ++q) { const f32x4 t = *(const f32x4*)(pp + 4 * q); s += (t.x + t.y) + (t.z + t.w); }
            const float rstd = rsqrtf(s * (1.f / 1024.f) + EPS);
            GAS f32x4* xr = (GAS f32x4*)(out + (size_t)m * D) + lane9;
#pragma unroll
            for (int j = 0; j < 4; ++j) { const f32x4 gg = *((const GAS f32x4*)g_final + lane9 + 64 * j); xr[64 * j] = xr[64 * j] * gg * rstd; }
        }
    }
#undef IN
#undef BOTH
}

extern "C" void kernel_launch(void* const* d_in, const int* in_sizes, int n_in, void* d_out, int out_size, void* d_ws, size_t ws_size, hipStream_t stream) {
    static int grid = 0;
    if (grid == 0) {
        if (n_in != 28 || ws_size < WS_NEED || out_size != M * D) { fprintf(stderr, "kernel_launch: unexpected problem (n_in %d ws %zu out %d)\n", n_in, ws_size, out_size); grid = -1; return; }
        int dev = 0, cus = 0, per_cu = 0;
        if (hipGetDevice(&dev) != hipSuccess || hipDeviceGetAttribute(&cus, hipDeviceAttributeMultiprocessorCount, dev) != hipSuccess) { grid = -1; return; }
        if (hipFuncSetAttribute((const void*)mega, hipFuncAttributeMaxDynamicSharedMemorySize, LDS_BYTES) != hipSuccess) { fprintf(stderr, "kernel_launch: hipFuncSetAttribute failed\n"); grid = -1; return; }
        if (hipOccupancyMaxActiveBlocksPerMultiprocessor(&per_cu, (const void*)mega, NWAVES * 64, LDS_BYTES) != hipSuccess || per_cu < 1) { fprintf(stderr, "kernel_launch: occupancy query says %d\n", per_cu); grid = -1; (void)hipGetLastError(); return; }
        grid = cus;
        if (grid < 64) { fprintf(stderr, "kernel_launch: needs >= 64 CUs\n"); grid = -1; return; }
    }
    if (grid < 0) return;
    unsigned char* ws = (unsigned char*)d_ws;
    (void)hipMemsetAsync(ws + WS_CTL, 0, CTL_ZERO_BYTES, stream);
    Args a{}; for (int i = 0; i < 28; ++i) a.in[i] = (const float*)d_in[i]; a.out = (float*)d_out; a.ws = ws;
    a.ph_lo = 0; a.ph_hi = 10; a.li = 0;
#ifdef DSA_PASSES
    a.pad = DSA_PASSES - 1;
#endif
    void* kargs[] = {&a};
    (void)hipLaunchCooperativeKernel((const void*)mega, dim3(grid), dim3(NWAVES * 64), kargs, LDS_BYTES, stream);
}
```

```cpp
#include <hip/hip_runtime.h>
#include <cstdio>
#include <cstdint>

typedef unsigned short bf16_t;
__device__ __forceinline__ float bf2f(bf16_t h) { return __uint_as_float(((unsigned)h) << 16); }
__device__ __forceinline__ bf16_t f2bf(float f) { unsigned u = __float_as_uint(f); return (bf16_t)((u + 0x7fffu + ((u >> 16) & 1u)) >> 16); }

constexpr int D = 1024, BATCH = 16, SEQ = 2048, M = BATCH * SEQ;
constexpr int PROJ_REF = 2512, PROJ = 2560;
constexpr int MEM_LEN = 256, MM = BATCH * MEM_LEN;
constexpr int DFF = 2816;
constexpr float EPS = 1e-6f;
constexpr float LOG2E = 1.4426950408889634f;
constexpr int C_DQ = 0, C_DK = 512, C_DV = 1024, C_DZ = 1536, C_CQ = 2048, C_CKV = 2304, C_KIX = 2432, C_WIX = 2496, C_DB = 2504, C_DA = 2508;
constexpr int MIXK = 1536;

constexpr size_t MiB = 1u << 20;
constexpr size_t WS_WIN = 0, WS_WKV = 5 * MiB, WS_WDSA = 9 * MiB, WS_WOUT = 10 * MiB, WS_WXQ = 13 * MiB, WS_WXO = 15 * MiB, WS_WGU = 17 * MiB, WS_WDN = 28 * MiB;
constexpr size_t WS_CTL = 34 * MiB, CTL_ZERO_BYTES = 256 * 1024;
constexpr size_t WS_ST = 35 * MiB;
constexpr size_t ST_RSTDX = 0, ST_CQSS = 128 * 1024  , ST_LPART = 640 * 1024  , ST_WIDX = 2688 * 1024  , ST_BETA = 3712 * 1024  , ST_G = 4224 * 1024  , ST_BIAS = 4736 * 1024;
constexpr size_t WS_MNB = 40 * MiB, WS_KX = 48 * MiB, WS_VT = 56 * MiB, WS_CKV = 64 * MiB, WS_KIDX = 72 * MiB;
constexpr size_t WS_SSQ = 76 * MiB;
constexpr size_t WS_PROJ = 80 * MiB;
constexpr size_t WS_XB = 240 * MiB;
constexpr size_t WS_QABS = 240 * MiB;
constexpr size_t WS_MIX = 336 * MiB;
constexpr size_t WS_X1B = 240 * MiB, WS_QX = 304 * MiB, WS_P = 368 * MiB, WS_OX = 432 * MiB, WS_X2B = 304 * MiB, WS_ACT = 80 * MiB;
constexpr size_t WS_W8 = 496 * MiB;
constexpr int CTL_AMAX = 1600;
constexpr size_t WS_NEED = 512 * MiB;

#define DPP_ADD(v, CTRL) ((v) + __int_as_float(__builtin_amdgcn_update_dpp(0, __float_as_int(v), (CTRL), 0xF, 0xF, true)))
__device__ __forceinline__ float wave_sum(float v) {
    v = DPP_ADD(v, 0xB1);
    v = DPP_ADD(v, 0x4E);
    v = DPP_ADD(v, 0x141);
    v = DPP_ADD(v, 0x140);
    const int b = __float_as_int(v);
    const float s0 = __int_as_float(__builtin_amdgcn_readlane(b, 0)), s1 = __int_as_float(__builtin_amdgcn_readlane(b, 16)), s2 = __int_as_float(__builtin_amdgcn_readlane(b, 32)), s3 = __int_as_float(__builtin_amdgcn_readlane(b, 48));
    return (s0 + s1) + (s2 + s3);
}
namespace pg8 {
#define PG8_LAS __attribute__((address_space(3)))
typedef short bf16x8 __attribute__((ext_vector_type(8)));
typedef float f32x4 __attribute__((ext_vector_type(4)));
typedef unsigned u32x4 __attribute__((ext_vector_type(4)));
typedef unsigned u32x2 __attribute__((ext_vector_type(2)));
typedef int i32x4 __attribute__((ext_vector_type(4)));
constexpr int BM = 256, BK = 64, HALF = 128, HTB = HALF * BK * 2  , STAGE_BYTES = 8 * HTB, NXCD = 8, WGM = 8;

__host__ __device__ __forceinline__ int lds_byte(int r, int c) { const int st = (r >> 4) * 2 + (c >> 5), rr = r & 15, cc = c & 31, ob = rr * 64 + cc * 2; return st * 1024 + (ob ^ (((ob >> 9) & 1) << 5)); }
__host__ __device__ __forceinline__ void stage_rc(int b, int& R, int& C) { const int st = b / 1024, sb = b % 1024, swz = sb ^ (((sb >> 9) & 1) << 5); R = (st >> 1) * 16 + swz / 64; C = (st & 1) * 32 + (swz % 64) / 2; }
__host__ __device__ __forceinline__ int perm32(int rho) { const int n = rho >> 4, i = rho & 15; return 8 * (i >> 2) + 4 * n + (i & 3); }

struct Unit { int pm, pn; long ao, bo; };
struct Gemm { const bf16_t* A; const bf16_t* Bt; int lda, ldb, K; };

struct StaticOrder {
    int nM, nN, nwg, G, c;
    __host__ __device__ __forceinline__ void init(int M_, int N_, int G_, int c_) { nM = M_ / BM; nN = N_ / BM; nwg = nM * nN; G = G_; c = c_; }
    __host__ __device__ __forceinline__ bool next(int i, Unit& u) const {
        const long L = (long)i * G + c; if (L >= nwg) return false;
        int wgid = (int)L; { const int q = nwg / NXCD, r = nwg % NXCD, xcd = wgid % NXCD, off = wgid / NXCD; wgid = (xcd < r ? xcd * (q + 1) : r * (q + 1) + (xcd - r) * q) + off; }
        const int nig = WGM * nN, gid = wgid / nig, fm = gid * WGM, gsz = (nM - fm) < WGM ? (nM - fm) : WGM;
        u.pm = fm + ((wgid % nig) % gsz); u.pn = (wgid % nig) / gsz; u.ao = 0; u.bo = 0; return true;
    }
};
struct OneUnit { Unit u; __host__ __device__ __forceinline__ bool next(int i, Unit& o) const { if (i) return false; o = u; return true; } };
struct TwoUnits { Unit u0, u1; int n; __host__ __device__ __forceinline__ bool next(int i, Unit& o) const { if (i >= n) return false; o = i ? u1 : u0; return true; } };

typedef float cvf32x2_t __attribute__((ext_vector_type(2))); typedef __bf16 cvbf16x2_t __attribute__((ext_vector_type(2)));
__device__ __forceinline__ unsigned cvt_pk_bf16(float lo, float hi) { cvf32x2_t v = {lo, hi}; return __builtin_bit_cast(unsigned, __builtin_convertvector(v, cvbf16x2_t)); }
__device__ __forceinline__ u32x4 pack8(const f32x4& a, const f32x4& b) { u32x4 w; w.x = cvt_pk_bf16(a[0], a[1]); w.y = cvt_pk_bf16(a[2], a[3]); w.z = cvt_pk_bf16(b[0], b[1]); w.w = cvt_pk_bf16(b[2], b[3]); return w; }
__device__ __forceinline__ unsigned pack4_fp8(float a, float b, float c, float d) {
    a = __builtin_amdgcn_fmed3f(a, -448.f, 448.f); b = __builtin_amdgcn_fmed3f(b, -448.f, 448.f); c = __builtin_amdgcn_fmed3f(c, -448.f, 448.f); d = __builtin_amdgcn_fmed3f(d, -448.f, 448.f);
    int w = 0; w = __builtin_amdgcn_cvt_pk_fp8_f32(a, b, w, false); w = __builtin_amdgcn_cvt_pk_fp8_f32(c, d, w, true); return (unsigned)w; }
__device__ __forceinline__ u32x2 pack8_fp8(const f32x4& a, const f32x4& b) { u32x2 w; w.x = pack4_fp8(a[0], a[1], a[2], a[3]); w.y = pack4_fp8(b[0], b[1], b[2], b[3]); return w; }
__device__ __forceinline__ float w8_scale(unsigned amax_bits) { const int e = (int)(amax_bits >> 23) - 127; return amax_bits ? __uint_as_float((unsigned)(127 + 6 - e) << 23) : 1.f; }
__device__ __forceinline__ float w8_inv_scale(unsigned amax_bits, int extra_shift) { const int e = (int)(amax_bits >> 23) - 127; return __uint_as_float((unsigned)(amax_bits ? 127 - 6 + e - extra_shift : 127 - extra_shift) << 23); }
__device__ __forceinline__ float dot4(const f32x4& a) { return (a[0] * a[0] + a[1] * a[1]) + (a[2] * a[2] + a[3] * a[3]); }
__device__ __forceinline__ float sum4(const f32x4& a) { return (a[0] + a[1]) + (a[2] + a[3]); }
__device__ __forceinline__ float lo_bf(unsigned w) { return __uint_as_float(w << 16); }
__device__ __forceinline__ float hi_bf(unsigned w) { return __uint_as_float(w & 0xffff0000u); }

typedef f32x4 Acc[2][2][4][2];
#define PG8_EPI_ROWS(...) _Pragma("unroll") for (int ai = 0; ai < 2; ++ai) _Pragma("unroll") for (int m = 0; m < 4; ++m) { const int rl = ai * HALF + wr * 64 + m * 16 + fr; __VA_ARGS__ }

struct EpiProj { static constexpr bool PERM = true;
    bf16_t* O; int ldc; const float* rs; float* cqss; int ssq_pn;
    __device__ __forceinline__ void operator()(const Acc& acc, const Unit& u, int wr, int wc, int fr, int fq) const {
        const int col0 = u.pn * BM + wc * 32 + 8 * fq; const bool doss = (u.pn == ssq_pn);
        PG8_EPI_ROWS( const int row = u.pm * BM + rl; const float r = rs ? rs[row] : 1.f; float ss = 0.f; bf16_t* rowp = O + (size_t)row * ldc + col0;
            _Pragma("unroll") for (int bj = 0; bj < 2; ++bj) { const f32x4 v0 = acc[ai][bj][m][0] * r, v1 = acc[ai][bj][m][1] * r; *(u32x4*)(rowp + bj * HALF) = pack8(v0, v1); ss += dot4(v0) + dot4(v1); }
            if (doss) { ss += __shfl_xor(ss, 16); ss += __shfl_xor(ss, 32); if (fq == 0) cqss[(size_t)row * 4 + wc] = ss; } )
    }
};
template <int NP> struct EpiNormScale { static constexpr bool PERM = true;
    bf16_t* O; int ldc; const float* part; float inv_dim; float ascale;
    __device__ __forceinline__ void operator()(const Acc& acc, const Unit& u, int wr, int wc, int fr, int fq) const {
        const int col0 = u.pn * BM + wc * 32 + 8 * fq;
        PG8_EPI_ROWS( const int row = u.pm * BM + rl; float s = 0.f;
            _Pragma("unroll") for (int q = 0; q < NP / 4; ++q) s += sum4(*(const f32x4*)(part + (size_t)row * NP + 4 * q));
            const float r = rsqrtf(s * inv_dim + EPS) * ascale; bf16_t* rowp = O + (size_t)row * ldc + col0;
            _Pragma("unroll") for (int bj = 0; bj < 2; ++bj) *(u32x4*)(rowp + bj * HALF) = pack8(acc[ai][bj][m][0] * r, acc[ai][bj][m][1] * r); )
    }
};
constexpr float X8_SCALE = 8.f; constexpr int X8_SHIFT = 3;
template <bool SRC16, bool X8 = false> struct EpiResid { static constexpr bool PERM = true;
    const float* src; const bf16_t* src16; bf16_t* xb; float* ssq; const float* rinv; unsigned char* x8; float ascale; int pad_;
    __device__ __forceinline__ void operator()(const Acc& acc, const Unit& u, int wr, int wc, int fr, int fq) const {
        const int col0 = u.pn * BM + wc * 32 + 8 * fq;
        PG8_EPI_ROWS( const size_t row = (size_t)u.pm * BM + rl; float ss = 0.f; const size_t off = row * 1024 + col0; const float rsc = (SRC16 && rinv) ? 1.f / rinv[row] : 1.f;
            _Pragma("unroll") for (int bj = 0; bj < 2; ++bj) { f32x4 s0, s1;
                if (SRC16) { const u32x4 w = *(const u32x4*)(src16 + off + bj * HALF); s0 = (f32x4){lo_bf(w.x), hi_bf(w.x), lo_bf(w.y), hi_bf(w.y)} * rsc; s1 = (f32x4){lo_bf(w.z), hi_bf(w.z), lo_bf(w.w), hi_bf(w.w)} * rsc; }
                else { s0 = *(const f32x4*)(src + off + bj * HALF); s1 = *(const f32x4*)(src + off + bj * HALF + 4); }
                const f32x4 v0 = s0 + acc[ai][bj][m][0] * ascale, v1 = s1 + acc[ai][bj][m][1] * ascale;
                *(u32x4*)(xb + off + bj * HALF) = pack8(v0, v1); ss += dot4(v0) + dot4(v1);
                if constexpr (X8) *(u32x2*)(x8 + off + bj * HALF) = pack8_fp8(v0 * X8_SCALE, v1 * X8_SCALE); }
            ss += __shfl_xor(ss, 16); ss += __shfl_xor(ss, 32); if (fq == 0) ssq[row * 16 + u.pn * 4 + wc] = ss; )
    }
};
struct EpiResidF32 { static constexpr bool PERM = true;
    const bf16_t* src16; float* dst; float* ssq; float ascale; int pad_;
    __device__ __forceinline__ void operator()(const Acc& acc, const Unit& u, int wr, int wc, int fr, int fq) const {
        const int col0 = u.pn * BM + wc * 32 + 8 * fq;
        PG8_EPI_ROWS( const size_t row = (size_t)u.pm * BM + rl; float ss = 0.f; const size_t off = row * 1024 + col0;
            _Pragma("unroll") for (int bj = 0; bj < 2; ++bj) { const u32x4 w = *(const u32x4*)(src16 + off + bj * HALF);
                const f32x4 v0 = (f32x4){lo_bf(w.x), hi_bf(w.x), lo_bf(w.y), hi_bf(w.y)} + acc[ai][bj][m][0] * ascale, v1 = (f32x4){lo_bf(w.z), hi_bf(w.z), lo_bf(w.w), hi_bf(w.w)} + acc[ai][bj][m][1] * ascale;
                *(f32x4*)(dst + off + bj * HALF) = v0; *(f32x4*)(dst + off + bj * HALF + 4) = v1; ss += dot4(v0) + dot4(v1); }
            ss += __shfl_xor(ss, 16); ss += __shfl_xor(ss, 32); if (fq == 0) ssq[row * 16 + u.pn * 4 + wc] = ss; )
    }
};
struct EpiFinal { static constexpr bool PERM = true;
    const bf16_t* src16; float* dst; float* part; unsigned* cnt; const float* gain; float ascale; int pad_;
    __device__ __forceinline__ void operator()(Acc& acc, const Unit& u, int wr, int wc, int fr, int fq) const {
        const int col0 = u.pn * BM + wc * 32 + 8 * fq; float asl = ascale; asm volatile("" : "+s"(asl));
        PG8_EPI_ROWS( const size_t row = (size_t)u.pm * BM + rl; float ss = 0.f; const size_t off = row * 1024 + col0;
            _Pragma("unroll") for (int bj = 0; bj < 2; ++bj) { const u32x4 w = *(const u32x4*)(src16 + off + bj * HALF); const f32x4 s0 = {lo_bf(w.x), hi_bf(w.x), lo_bf(w.y), hi_bf(w.y)}, s1 = {lo_bf(w.z), hi_bf(w.z), lo_bf(w.w), hi_bf(w.w)};
                acc[ai][bj][m][0] = acc[ai][bj][m][0] * asl + s0; acc[ai][bj][m][1] = acc[ai][bj][m][1] * asl + s1; ss += dot4(acc[ai][bj][m][0]) + dot4(acc[ai][bj][m][1]); }
            ss += __shfl_xor(ss, 16); ss += __shfl_xor(ss, 32);
            if (fq == 0) __hip_atomic_store(part + row * 16 + u.pn * 4 + wc, ss, __ATOMIC_RELAXED, __HIP_MEMORY_SCOPE_AGENT); )
        asm volatile("s_waitcnt vmcnt(0)" ::: "memory");
        unsigned* c = cnt + 64 * u.pm;
        if ((fr | fq) == 0) __hip_atomic_fetch_add(c, 1u, __ATOMIC_RELAXED, __HIP_MEMORY_SCOPE_AGENT);
        for (unsigned spins = 0; spins < (1u << 22); ++spins) { if ((unsigned)__builtin_amdgcn_readfirstlane(__hip_atomic_load(c, __ATOMIC_RELAXED, __HIP_MEMORY_SCOPE_AGENT)) >= 32u) break; __builtin_amdgcn_s_sleep(4); }
        __builtin_amdgcn_fence(__ATOMIC_ACQUIRE, "agent");
        f32x4 gv[2][2];
        _Pragma("unroll") for (int bj = 0; bj < 2; ++bj) { gv[bj][0] = *(const f32x4*)(gain + col0 + bj * HALF); gv[bj][1] = *(const f32x4*)(gain + col0 + bj * HALF + 4); }
        PG8_EPI_ROWS( const size_t row = (size_t)u.pm * BM + rl; float s = 0.f;
            _Pragma("unroll") for (int q = 0; q < 4; ++q) s += sum4(*(const f32x4*)(part + row * 16 + 4 * q));
            const float r = rsqrtf(s * (1.f / 1024.f) + EPS); const size_t off = row * 1024 + col0;
            _Pragma("unroll") for (int bj = 0; bj < 2; ++bj) { *(f32x4*)(dst + off + bj * HALF) = acc[ai][bj][m][0] * gv[bj][0] * r; *(f32x4*)(dst + off + bj * HALF + 4) = acc[ai][bj][m][1] * gv[bj][1] * r; } )
    }
};
struct EpiExpP { static constexpr bool PERM = true;
    bf16_t* Pb; float* lpart;
    __device__ __forceinline__ void operator()(const Acc& acc, const Unit& u, int wr, int wc, int fr, int fq) const {
        const int h = (int)(u.ao >> 9), rowbase = u.pm * BM, col0 = wc * 32 + 8 * fq; bf16_t* O = Pb + (size_t)rowbase * 1024 + h * 256;
        PG8_EPI_ROWS( float ss = 0.f; bf16_t* rowp = O + (size_t)rl * 1024 + col0;
            _Pragma("unroll") for (int bj = 0; bj < 2; ++bj) { f32x4 v0 = acc[ai][bj][m][0], v1 = acc[ai][bj][m][1];
                _Pragma("unroll") for (int e = 0; e < 4; ++e) { v0[e] = __builtin_amdgcn_exp2f(v0[e]); v1[e] = __builtin_amdgcn_exp2f(v1[e]); }
                const u32x4 w = pack8(v0, v1); *(u32x4*)(rowp + bj * HALF) = w;
                ss += (lo_bf(w.x) + hi_bf(w.x)) + (lo_bf(w.y) + hi_bf(w.y)) + (lo_bf(w.z) + hi_bf(w.z)) + (lo_bf(w.w) + hi_bf(w.w)); }
            ss += __shfl_xor(ss, 16); ss += __shfl_xor(ss, 32); if (fq == 0) lpart[(size_t)(rowbase + rl) * 16 + h * 4 + wc] = ss; )
    }
};
constexpr float OX_SCALE = 32.f; constexpr int OX_SHIFT = 5;
struct EpiPV { static constexpr bool PERM = true;
    unsigned char* Ob; const float* lpart;
    __device__ __forceinline__ void operator()(const Acc& acc, const Unit& u, int wr, int wc, int fr, int fq) const {
        const int h = u.pn, rowbase = u.pm * BM, col0 = wc * 32 + 8 * fq; unsigned char* O = Ob + (size_t)rowbase * 1024 + h * 256;
        PG8_EPI_ROWS( const float r = OX_SCALE / sum4(*(const f32x4*)(lpart + (size_t)(rowbase + rl) * 16 + h * 4)); unsigned char* rowp = O + (size_t)rl * 1024 + col0;
            _Pragma("unroll") for (int bj = 0; bj < 2; ++bj) *(u32x2*)(rowp + bj * HALF) = pack8_fp8(acc[ai][bj][m][0] * r, acc[ai][bj][m][1] * r); )
    }
};
constexpr float ACT_SCALE = 16.f; constexpr int ACT_SHIFT = 4;
struct EpiSwiglu { static constexpr bool PERM = true;
    unsigned char* act; const float* part;
    __device__ __forceinline__ void operator()(const Acc& acc, const Unit& u, int wr, int wc, int fr, int fq) const {
        const int col0 = u.pn * BM + wc * 32 + 8 * fq;
        PG8_EPI_ROWS( const size_t row = (size_t)u.pm * BM + rl; float s = 0.f;
            _Pragma("unroll") for (int q = 0; q < 4; ++q) s += sum4(*(const f32x4*)(part + row * 16 + 4 * q));
            const float r = rsqrtf(s * (1.f / 1024.f) + EPS); unsigned char* rowp = act + row * DFF + (col0 >> 1);
            _Pragma("unroll") for (int bj = 0; bj < 2; ++bj) { const f32x4 a = acc[ai][bj][m][0] * r, b = acc[ai][bj][m][1] * r;
                const float o0 = a[0] * __builtin_amdgcn_rcpf(1.f + __builtin_amdgcn_exp2f(-LOG2E * a[0])) * a[1], o1 = a[2] * __builtin_amdgcn_rcpf(1.f + __builtin_amdgcn_exp2f(-LOG2E * a[2])) * a[3];
                const float o2 = b[0] * __builtin_amdgcn_rcpf(1.f + __builtin_amdgcn_exp2f(-LOG2E * b[0])) * b[1], o3 = b[2] * __builtin_amdgcn_rcpf(1.f + __builtin_amdgcn_exp2f(-LOG2E * b[2])) * b[3];
                *(unsigned*)(rowp + bj * (HALF / 2)) = pack4_fp8(o0 * ACT_SCALE, o1 * ACT_SCALE, o2 * ACT_SCALE, o3 * ACT_SCALE); } )
    }
};

template <class Epi, class Sched, bool ALIGN_EPI, bool F8 = false>
__device__ __forceinline__ void gemm_phase(PG8_LAS unsigned char* lds, const Gemm g, const Sched& S, const Epi& E, int wave_id = 0) {
    int tid = 0; if constexpr (!F8) { tid = threadIdx.x; asm volatile("" : "+v"(tid)); }
    if constexpr (F8) { int l_; asm volatile("v_mbcnt_lo_u32_b32 %0, -1, 0\n\tv_mbcnt_hi_u32_b32 %0, -1, %0" : "=v"(l_)); tid = wave_id * 64 + l_; }
    const int wid = __builtin_amdgcn_readfirstlane(tid >> 6), lane = tid & 63, wr = wid >> 2, wc = wid & 3, fr = lane & 15, fq = lane >> 4;
    int Kop = g.K; asm volatile("" : "+s"(Kop));
    constexpr int ES = F8 ? 1 : 2;
    const int nt = Kop * ES / (BK * 2);
    unsigned voffA[2], voffB[2];
#pragma unroll
    for (int i = 0; i < 2; ++i) { int R, C; stage_rc(tid * 16 + i * 8192, R, C); const int Rb = Epi::PERM ? ((R & ~31) + perm32(R & 31)) : R;
        voffA[i] = (unsigned)(R * g.lda * ES + C * 2); voffB[i] = (unsigned)(Rb * g.ldb * ES + C * 2); }
    const size_t kstep = (size_t)(BK * 2);
    const size_t hstepA = (size_t)HALF * g.lda * ES, hstepB = (size_t)HALF * g.ldb * ES;
    const size_t tstepA = 2 * hstepA, tstepB = 2 * hstepB;
    const unsigned ldsw = (unsigned)wid * 1024u;
    const int aoff = lds_byte(wr * 64 + fr, fq * 8), boff = lds_byte(wc * 32 + fr, fq * 8);
#define PG8_SA(b, h) (((b) * 2 + (h)) * HTB)
#define PG8_SB(b, h) ((4 + (b) * 2 + (h)) * HTB)
#define PG8_STAGE(bufoff, gbase, voff, rs) do { _Pragma("unroll") for (int _i = 0; _i < 2; ++_i) { \
        if constexpr (F8) __builtin_amdgcn_raw_ptr_buffer_load_lds(rs, (PG8_LAS void*)(lds + (bufoff) + ldsw + _i * 8192), 16, (int)(voff)[_i], (int)(unsigned)(size_t)(gbase), 0, 0); \
        else __builtin_amdgcn_global_load_lds((const unsigned*)((const char*)(gbase) + (voff)[_i]), (PG8_LAS unsigned*)(lds + (bufoff) + ldsw + _i * 8192), 16, 0, 0); } } while (0)
#define PG8_LDA(dst, b, h) do { _Pragma("unroll") for (int m = 0; m < 4; ++m) _Pragma("unroll") for (int k = 0; k < 2; ++k) dst[m][k] = *(const PG8_LAS bf16x8*)(lds + PG8_SA(b, h) + aoff + m * 2048 + k * 1024); } while (0)
#define PG8_LDB(dst, b, h) do { _Pragma("unroll") for (int n = 0; n < 2; ++n) _Pragma("unroll") for (int k = 0; k < 2; ++k) dst[n][k] = *(const PG8_LAS bf16x8*)(lds + PG8_SB(b, h) + boff + n * 2048 + k * 1024); } while (0)
#define PG8_CAT8(x, y) __builtin_shufflevector(__builtin_bit_cast(i32x4, x), __builtin_bit_cast(i32x4, y), 0, 1, 2, 3, 4, 5, 6, 7)
#define PG8_MMA(ai, bj, At, Bt) do { __builtin_amdgcn_s_setprio(1); _Pragma("unroll") for (int m = 0; m < 4; ++m) _Pragma("unroll") for (int n = 0; n < 2; ++n) { \
        if constexpr (F8) acc[ai][bj][m][n] = __builtin_amdgcn_mfma_scale_f32_16x16x128_f8f6f4(PG8_CAT8(Bt[n][0], Bt[n][1]), PG8_CAT8(At[m][0], At[m][1]), acc[ai][bj][m][n], 0, 0, 0, 0, 0, 0); \
        else { _Pragma("unroll") for (int k = 0; k < 2; ++k) acc[ai][bj][m][n] = __builtin_amdgcn_mfma_f32_16x16x32_bf16(Bt[n][k], At[m][k], acc[ai][bj][m][n], 0, 0, 0); } } \
        __builtin_amdgcn_s_setprio(0); } while (0)
#define PG8_WAIT_V(n) asm volatile("s_waitcnt vmcnt(" #n ")" ::: "memory")
#define PG8_WAIT_L(n) asm volatile("s_waitcnt lgkmcnt(" #n ")" ::: "memory")
#define PG8_BAR __builtin_amdgcn_s_barrier()
#define PG8_SCHED __builtin_amdgcn_sched_barrier(0)
    Unit cur, nxt; int ui = 0;
    if (!S.next(0, cur)) return;
    Acc acc;
#pragma unroll
    for (int a = 0; a < 2; ++a)
#pragma unroll
        for (int b = 0; b < 2; ++b)
#pragma unroll
            for (int m = 0; m < 4; ++m)
#pragma unroll
                for (int n = 0; n < 2; ++n) acc[a][b][m][n] = (f32x4){0.f, 0.f, 0.f, 0.f};
    bf16x8 At[4][2], B0[2][2], B1[2][2];
    const __amdgpu_buffer_rsrc_t rsA = __builtin_amdgcn_make_buffer_rsrc((void*)g.A, 0, -1, 0x00020000), rsB = __builtin_amdgcn_make_buffer_rsrc((void*)g.Bt, 0, -1, 0x00020000);
    const char* const baseA = F8 ? (const char*)(size_t)0 : (const char*)g.A; const char* const baseB = F8 ? (const char*)(size_t)0 : (const char*)g.Bt;
    const char* cA = baseA + (size_t)cur.pm * tstepA + cur.ao; const char* cB = baseB + (size_t)cur.pn * tstepB + cur.bo;
    PG8_STAGE(PG8_SB(0, 0), cB, voffB, rsB); PG8_STAGE(PG8_SB(0, 1), cB + hstepB, voffB, rsB); PG8_STAGE(PG8_SA(0, 0), cA, voffA, rsA); PG8_STAGE(PG8_SA(0, 1), cA + hstepA, voffA, rsA);
    if (wr == 1) PG8_BAR;
    PG8_WAIT_V(2); PG8_BAR;
    PG8_STAGE(PG8_SB(1, 0), cB + kstep, voffB, rsB); PG8_STAGE(PG8_SA(1, 0), cA + kstep, voffA, rsA); PG8_STAGE(PG8_SB(1, 1), cB + hstepB + kstep, voffB, rsB);
    PG8_WAIT_V(6); PG8_BAR;
    for (;;) {
        const bool has_next = S.next(ui + 1, nxt);
        const char* nA = has_next ? baseA + (size_t)nxt.pm * tstepA + nxt.ao : cA; const char* nB = has_next ? baseB + (size_t)nxt.pn * tstepB + nxt.bo : cB;
        for (int t = 0; t < nt; t += 2) {
            const bool last = (t == nt - 2);
            const char* a1 = cA + (size_t)(t + 1) * kstep;
            const char* a2 = last ? nA : cA + (size_t)(t + 2) * kstep; const char* b2 = last ? nB : cB + (size_t)(t + 2) * kstep;
            const char* a3 = a2 + kstep; const char* b3 = b2 + kstep;
            PG8_LDB(B0, 0, 0); PG8_LDB(B1, 0, 1); PG8_SCHED; PG8_LDA(At, 0, 0); PG8_STAGE(PG8_SA(1, 1), a1 + hstepA, voffA, rsA);
            PG8_WAIT_V(8); PG8_WAIT_L(0); PG8_BAR; PG8_MMA(0, 0, At, B0); PG8_MMA(0, 1, At, B1); PG8_BAR; PG8_SCHED;
            PG8_LDA(At, 0, 1); PG8_STAGE(PG8_SB(0, 0), b2, voffB, rsB); PG8_STAGE(PG8_SB(0, 1), b2 + hstepB, voffB, rsB); PG8_STAGE(PG8_SA(0, 0), a2, voffA, rsA);
            PG8_WAIT_V(8); PG8_WAIT_L(0); PG8_BAR; PG8_MMA(1, 0, At, B0); PG8_MMA(1, 1, At, B1); PG8_BAR; PG8_SCHED;
            PG8_LDB(B0, 1, 0); PG8_LDB(B1, 1, 1); PG8_SCHED; PG8_LDA(At, 1, 0); PG8_STAGE(PG8_SA(0, 1), a2 + hstepA, voffA, rsA);
            PG8_WAIT_V(8); PG8_WAIT_L(0); PG8_BAR; PG8_MMA(0, 0, At, B0); PG8_MMA(0, 1, At, B1); PG8_BAR; PG8_SCHED;
            PG8_LDA(At, 1, 1); PG8_STAGE(PG8_SB(1, 0), b3, voffB, rsB); PG8_STAGE(PG8_SB(1, 1), b3 + hstepB, voffB, rsB); PG8_STAGE(PG8_SA(1, 0), a3, voffA, rsA);
            PG8_WAIT_V(8); PG8_WAIT_L(0); PG8_BAR; PG8_MMA(1, 0, At, B0); PG8_MMA(1, 1, At, B1); PG8_BAR; PG8_SCHED;
        }
        if constexpr (ALIGN_EPI) { if (wr == 0) PG8_BAR; }
        { int fr_e = fr, fq_e = fq;
          if constexpr (F8) { int l_e; asm volatile("v_mbcnt_lo_u32_b32 %0, -1, 0\n\tv_mbcnt_hi_u32_b32 %0, -1, %0" : "=v"(l_e)); fr_e = l_e & 15; fq_e = l_e >> 4; }
          E(acc, cur, wr, wc, fr_e, fq_e); }
        if (!has_next) break;
#pragma unroll
        for (int a = 0; a < 2; ++a)
#pragma unroll
            for (int b = 0; b < 2; ++b)
#pragma unroll
                for (int m = 0; m < 4; ++m)
#pragma unroll
                    for (int n = 0; n < 2; ++n) acc[a][b][m][n] = (f32x4){0.f, 0.f, 0.f, 0.f};
        cur = nxt; cA = nA; cB = nB; ++ui;
        if constexpr (ALIGN_EPI) { if (wr == 1) PG8_BAR; }
    }
    PG8_WAIT_V(0);
    if constexpr (!ALIGN_EPI) { if (wr == 0) PG8_BAR; }
    PG8_BAR;
#undef PG8_SA
#undef PG8_SB
#undef PG8_STAGE
#undef PG8_LDA
#undef PG8_LDB
#undef PG8_MMA
#undef PG8_CAT8
#undef PG8_WAIT_V
#undef PG8_WAIT_L
#undef PG8_BAR
#undef PG8_SCHED
}
}
constexpr int NWAVES = 8;
constexpr int RING_BYTES = 131072;
constexpr int LDSCTL_OFF = RING_BYTES, MISC_OFF = LDSCTL_OFF + 320;
constexpr int LDS_BYTES = 147456;
#define GAS __attribute__((address_space(1)))
#define LAS __attribute__((address_space(3)))
typedef unsigned v4u __attribute__((ext_vector_type(4)));
typedef float f32x4 __attribute__((ext_vector_type(4)));
typedef GAS unsigned gu32;
#define RLX_AGENT __ATOMIC_RELAXED, __HIP_MEMORY_SCOPE_AGENT
#define LDS_WAIT() asm volatile("s_waitcnt lgkmcnt(0)" ::: "memory")
#define VM_WAIT() asm volatile("s_waitcnt vmcnt(0)" ::: "memory")
__device__ __forceinline__ unsigned pk2(float lo, float hi) { return (unsigned)f2bf(lo) | ((unsigned)f2bf(hi) << 16); }

#define XB_TMO      128
#define XB_XCNT(j)  (256  + 64 * (j))
#define XB_XSUB(j)  (1280 + 64 * (j))
#define XB_XGEN(j)  (2304 + 64 * (j))
#define XB_TOP      3328
#define XB_TOPGEN   3392
#define XCD_BAR_WORDS 3456
#define XB_SPIN_CAP (1u << 18)
__device__ __forceinline__ unsigned xb_ld(unsigned* p)              { return __hip_atomic_load(p, __ATOMIC_RELAXED, __HIP_MEMORY_SCOPE_AGENT); }
__device__ __forceinline__ unsigned xb_add(unsigned* p, unsigned v) { return __hip_atomic_fetch_add(p, v, __ATOMIC_RELAXED, __HIP_MEMORY_SCOPE_AGENT); }
__device__ __forceinline__ unsigned xb_xcc_id() { return (unsigned)__builtin_amdgcn_s_getreg((3 << 11) | 20) & 0xFu; }
#define XB_SPIN(cond, bar) do { unsigned _sp = 0; while (cond) { __builtin_amdgcn_s_sleep(1); \
    if ((++_sp & 255u) == 0u) { if (xb_ld(&(bar)[XB_TMO])) break; if (_sp > XB_SPIN_CAP) { atomicAdd(&(bar)[XB_TMO], 1u); break; } } } } while (0)
struct XcdBarrier { unsigned* bar; unsigned x; volatile LAS unsigned* st; };
__device__ __forceinline__ XcdBarrier xcd_barrier_post(unsigned* bar, volatile LAS unsigned* st) {
    XcdBarrier b; b.bar = bar; b.x = xb_xcc_id(); b.st = st;
    if (threadIdx.x == 0) (void)xb_add(&bar[XB_XCNT(b.x)], 1u);
    return b;
}
__device__ __forceinline__ void xcd_barrier_complete(unsigned* bar, unsigned x, unsigned& nloc, unsigned& nx) {
    const unsigned G = gridDim.x * gridDim.y * gridDim.z;
    unsigned sum, cnt, mine, sp = 0u;
    for (;;) {
        sum = 0u; cnt = 0u; mine = 0u;
#pragma unroll
        for (unsigned j = 0; j < 16; ++j) { const unsigned c = xb_ld(&bar[XB_XCNT(j)]); sum += c; cnt += (c > 0u) ? 1u : 0u; mine = (j == x) ? c : mine; }
        if (sum == G) break;
        __builtin_amdgcn_s_sleep(1);
        if ((++sp & 255u) == 0u) { if (xb_ld(&bar[XB_TMO])) break; if (sp > XB_SPIN_CAP) { atomicAdd(&bar[XB_TMO], 1u); break; } }
    }
    nloc = mine > 0u ? mine : 1u; nx = cnt > 0u ? cnt : 1u;
}
__device__ __forceinline__ void xcd_barrier(const XcdBarrier& b) {
    asm volatile("s_waitcnt vmcnt(0)" ::: "memory");
    __syncthreads();
    if (threadIdx.x == 0) {
        unsigned* bar = b.bar;
        __builtin_amdgcn_s_waitcnt(0);
        unsigned nloc = b.st[0], nx = b.st[1];
        if (nloc == 0u) { xcd_barrier_complete(bar, b.x, nloc, nx); b.st[0] = nloc; b.st[1] = nx; }
        const unsigned old = xb_add(&bar[XB_XSUB(b.x)], 1u);
        const unsigned gen = old / nloc;
        if (old + 1u == (gen + 1u) * nloc) {
            __builtin_amdgcn_fence(__ATOMIC_RELEASE, "agent");
            asm volatile("s_waitcnt vmcnt(0)" ::: "memory");
            const unsigned og = xb_add(&bar[XB_TOP], 1u);
            const unsigned tg = og / nx;
            if (og + 1u == (tg + 1u) * nx) xb_add(&bar[XB_TOPGEN], 1u);
            else XB_SPIN(xb_ld(&bar[XB_TOPGEN]) == tg, bar);
            __builtin_amdgcn_fence(__ATOMIC_ACQUIRE, "agent");
            xb_add(&bar[XB_XGEN(b.x)], 1u);
            asm volatile("s_waitcnt vmcnt(0)" ::: "memory");
        } else {
            XB_SPIN(xb_ld(&bar[XB_XGEN(b.x)]) == gen, bar);
            __builtin_amdgcn_fence(__ATOMIC_ACQUIRE, "agent");
            asm volatile("s_waitcnt vmcnt(0)" ::: "memory");
        }
    }
    __syncthreads();
}

struct SrcWin { const float* w; const float* g;
    __device__ __forceinline__ float at(int k, int n) const {
        int src;
        if (n < 2048) src = n; else if (n < C_CKV) src = 2056 + (n - C_CQ); else if (n < C_KIX) src = 2312 + (n - C_CKV); else if (n < C_WIX) src = 2440 + (n - C_KIX);
        else if (n < C_DB) src = 2504 + (n - C_WIX); else if (n < C_DA) src = 2048 + (n - C_DB); else if (n < 2512) src = 2052 + (n - C_DA); else src = -1;
        return src >= 0 ? w[(size_t)k * PROJ_REF + src] * g[k] : 0.f; } };
struct SrcPlain { const float* w; int ld; const float* g; float cs;
    __device__ __forceinline__ float at(int k, int n) const { return w[(size_t)k * ld + n] * (g ? g[k] : 1.f) * cs; } };
struct SrcQidx { const float* w; const float* g;
    __device__ __forceinline__ float at(int k, int n) const { const int s = n >> 7, head = (n >> 4) & 7, r = n & 15; return w[(size_t)k * 512 + head * 64 + 16 * s + r] * g[k]; } };
struct SrcGU { const float* wg; const float* wu; const float* g;
    __device__ __forceinline__ float at(int k, int n) const { const size_t i = (size_t)k * DFF + (n >> 1); const float a = wg[i], b = wu[i]; return ((n & 1) ? b : a) * g[k]; } };
template <class Src> __device__ __forceinline__ void tr_item(const Src& S, int Nsz, bf16_t* WT, int ldo, int koff, LAS float* scr, int item, int lane, unsigned* amax = nullptr) {
    const int nblk = Nsz / 32, kb = item / nblk, nb = item % nblk, k0 = 64 * kb, n0 = 32 * nb;
    float t[32];
#pragma unroll
    for (int i = 0; i < 32; ++i) t[i] = S.at(k0 + 2 * i + (lane >> 5), n0 + (lane & 31));
    if (amax) { float mx = 0.f;
#pragma unroll
        for (int i = 0; i < 32; ++i) mx = fmaxf(mx, fabsf(t[i]));
#pragma unroll
        for (int o = 1; o < 64; o <<= 1) mx = fmaxf(mx, __shfl_xor(mx, o));
        if (lane == 0) (void)__hip_atomic_fetch_max(amax, __float_as_uint(mx), __ATOMIC_RELAXED, __HIP_MEMORY_SCOPE_AGENT); }
#pragma unroll
    for (int i = 0; i < 32; ++i) scr[(2 * i + (lane >> 5)) * 33 + (lane & 31)] = t[i];
    LDS_WAIT(); asm volatile("" ::: "memory");
    const int c = lane & 7;
#pragma unroll
    for (int j = 0; j < 4; ++j) { const int n = (lane >> 3) + 8 * j; const LAS float* s = scr + (8 * c) * 33 + n;
        v4u o; o.x = pk2(s[0 * 33], s[1 * 33]); o.y = pk2(s[2 * 33], s[3 * 33]); o.z = pk2(s[4 * 33], s[5 * 33]); o.w = pk2(s[6 * 33], s[7 * 33]);
        *(GAS v4u*)(WT + (size_t)(n0 + n) * ldo + koff + k0 + 8 * c) = o; }
    LDS_WAIT(); asm volatile("" ::: "memory");
}
__device__ __forceinline__ void heavy_item(const float* Ap, int lda, const float* Bp, int ldb, const float* cs, float cmul, int k0, int n0, int n0out, bf16_t* WT, int ldo, int koff, LAS float* scr, int lane) {
    LAS float* At = scr; LAS float* tt = scr + 2048;
#pragma unroll
    for (int i = 0; i < 8; ++i) { const int e = (i * 64 + lane) * 4, r = e >> 6, d = e & 63; *(LAS f32x4*)(At + e) = *(const GAS f32x4*)(Ap + (size_t)(k0 + r) * lda + d); }
    float bc[64];
#pragma unroll
    for (int d = 0; d < 64; ++d) bc[d] = Bp[(size_t)d * ldb + n0 + (lane & 31)];
    LDS_WAIT(); asm volatile("" ::: "memory");
#pragma unroll 2
    for (int i = 0; i < 16; ++i) { const int kk = 2 * i + (lane >> 5); const LAS f32x4* ar = (const LAS f32x4*)(At + kk * 64); float s0 = 0.f, s1 = 0.f;
#pragma unroll
        for (int q = 0; q < 16; q += 2) { const f32x4 a = ar[q], b2 = ar[q + 1]; s0 += a.x * bc[4 * q] + a.y * bc[4 * q + 1] + a.z * bc[4 * q + 2] + a.w * bc[4 * q + 3]; s1 += b2.x * bc[4 * q + 4] + b2.y * bc[4 * q + 5] + b2.z * bc[4 * q + 6] + b2.w * bc[4 * q + 7]; }
        tt[kk * 33 + (lane & 31)] = (s0 + s1) * (cs ? cs[k0 + kk] : 1.f) * cmul; }
    LDS_WAIT(); asm volatile("" ::: "memory");
    const int c = lane & 3;
#pragma unroll
    for (int j = 0; j < 2; ++j) { const int n = (lane >> 2) + 16 * j; const LAS float* s = tt + (8 * c) * 33 + n;
        v4u o; o.x = pk2(s[0 * 33], s[1 * 33]); o.y = pk2(s[2 * 33], s[3 * 33]); o.z = pk2(s[4 * 33], s[5 * 33]); o.w = pk2(s[6 * 33], s[7 * 33]);
        *(GAS v4u*)(WT + (size_t)(n0out + n) * ldo + koff + k0 + 8 * c) = o; }
    LDS_WAIT(); asm volatile("" ::: "memory");
}
template <int NR> __device__ __forceinline__ void row_prep(const float* xrow, const float* gain, bf16_t* orow, float* rstd_out, int lane) {
    f32x4 v[NR][4]; float s[NR];
#pragma unroll
    for (int r = 0; r < NR; ++r)
#pragma unroll
        for (int j = 0; j < 4; ++j) v[r][j] = *((const GAS f32x4*)(xrow + (size_t)r * 1024) + lane + 64 * j);
#pragma unroll
    for (int r = 0; r < NR; ++r) { float a = 0.f;
#pragma unroll
        for (int j = 0; j < 4; ++j) a += (v[r][j].x * v[r][j].x + v[r][j].y * v[r][j].y) + (v[r][j].z * v[r][j].z + v[r][j].w * v[r][j].w);
        s[r] = a; }
#pragma unroll
    for (int r = 0; r < NR; ++r) { const float rstd = rsqrtf(wave_sum(s[r]) * (1.f / 1024.f) + EPS);
        if (rstd_out && lane == 0) rstd_out[r] = rstd;
        GAS unsigned long long* o8 = (GAS unsigned long long*)(orow + (size_t)r * 1024) + lane;
#pragma unroll
        for (int j = 0; j < 4; ++j) { f32x4 a = v[r][j];
            if (gain) { const f32x4 gg = *((const GAS f32x4*)gain + lane + 64 * j); a = a * gg * rstd; } else a = a * rstd;
            o8[64 * j] = (unsigned long long)pk2(a.x, a.y) | ((unsigned long long)pk2(a.z, a.w) << 32); } }
}
__device__ __forceinline__ void cvt_w8(const bf16_t* src, unsigned char* dst, int n16, unsigned amax_bits, int gtid, int nthr) {
    const float sc = pg8::w8_scale(amax_bits);
    for (int i = gtid; i < n16; i += nthr) { const v4u a = *((const GAS v4u*)src + 2 * i), b = *((const GAS v4u*)src + 2 * i + 1); v4u o;
        o.x = pg8::pack4_fp8(pg8::lo_bf(a.x) * sc, pg8::hi_bf(a.x) * sc, pg8::lo_bf(a.y) * sc, pg8::hi_bf(a.y) * sc); o.y = pg8::pack4_fp8(pg8::lo_bf(a.z) * sc, pg8::hi_bf(a.z) * sc, pg8::lo_bf(a.w) * sc, pg8::hi_bf(a.w) * sc);
        o.z = pg8::pack4_fp8(pg8::lo_bf(b.x) * sc, pg8::hi_bf(b.x) * sc, pg8::lo_bf(b.y) * sc, pg8::hi_bf(b.y) * sc); o.w = pg8::pack4_fp8(pg8::lo_bf(b.z) * sc, pg8::hi_bf(b.z) * sc, pg8::lo_bf(b.w) * sc, pg8::hi_bf(b.w) * sc);
        *((GAS v4u*)dst + i) = o; }
}
namespace dsa {
typedef short bf16x8 __attribute__((ext_vector_type(8)));
typedef short s16x4 __attribute__((ext_vector_type(4)));
typedef float f32x16 __attribute__((ext_vector_type(16)));
typedef float f32x4 __attribute__((ext_vector_type(4)));
typedef unsigned u32x4 __attribute__((ext_vector_type(4)));
typedef unsigned short u16x4 __attribute__((ext_vector_type(4)));
constexpr int HIST_OFF = 145152;
constexpr int SC_OFF = 0, LIST_OFF = 132096, BIAS_OFF = 140288, W_OFF = 144416, NSEL_OFF = 144928, BMAX_OFF = 144992, CMAX_OFF = 145024;
__device__ __forceinline__ int xsw(int rr) { return rr < 8 ? 2 * rr : 2 * ((rr + 4) & 7) + 1; }
typedef float cvf32x2_t __attribute__((ext_vector_type(2))); typedef __bf16 cvbf16x2_t __attribute__((ext_vector_type(2)));
__device__ __forceinline__ unsigned cvtpk(float lo, float hi) { cvf32x2_t v = {lo, hi}; return __builtin_bit_cast(unsigned, __builtin_convertvector(v, cvbf16x2_t)); }
__device__ __forceinline__ int mbcnt64(unsigned long long m) { return (int)__builtin_amdgcn_mbcnt_hi((unsigned)(m >> 32), __builtin_amdgcn_mbcnt_lo((unsigned)m, 0u)); }

__device__ __forceinline__ void phase_init(LAS unsigned char* lds, const float* biastab, const float* kvg, int tid) {
    LAS float* bt = (LAS float*)(lds + BIAS_OFF);
    for (int i = tid; i < 129 * 8; i += 512) bt[i] = biastab[i];
    if (tid < 64) { float m = fmaxf(fabsf(kvg[tid]), fabsf(kvg[tid + 64]));
#pragma unroll
        for (int o = 1; o < 64; o <<= 1) m = fmaxf(m, __shfl_xor(m, o));
        if (tid == 0) *(LAS float*)(lds + CMAX_OFF) = m * 11.313708499f * 1.01f; }
    __syncthreads();
    if (tid < 8) { float m = -1e30f; for (int d = 0; d < 129; ++d) m = fmaxf(m, bt[d * 8 + tid]); ((LAS float*)(lds + BMAX_OFF))[tid] = m; }
    __syncthreads();
}

__device__ __forceinline__ void scores(LAS unsigned char* lds, int b, int q0, const bf16_t* qabs, const bf16_t* kidx, int wave, int lane) {
    const int hi = lane >> 5, c32 = lane & 31;
    const int a_ = c32 >> 3, hp = (c32 >> 2) & 1, r3 = c32 & 3;
    const int head = 4 * (a_ & 1) + r3, qt = 2 * hp + (a_ >> 1);
    bf16x8 A[4][4];
#pragma unroll
    for (int rt = 0; rt < 4; ++rt)
#pragma unroll
        for (int s = 0; s < 4; ++s) A[rt][s] = *(const bf16x8*)(qabs + (size_t)(b * 2048 + q0 + 4 * rt + qt) * 1536 + 1024 + s * 128 + head * 16 + 8 * hi);
    const int nkt = (q0 + 16 + 31) >> 5;
    LAS float* SC = (LAS float*)(lds + SC_OFF); const LAS float* Wl = (const LAS float*)(lds + W_OFF);
    bf16x8 Bn[4];
    { const bf16_t* kr = kidx + (size_t)(b * 2048 + (wave < nkt ? wave : 0) * 32 + c32) * 64 + 8 * hi;
#pragma unroll
      for (int s = 0; s < 4; ++s) Bn[s] = *(const bf16x8*)(kr + 16 * s); }
    __syncthreads();
    for (int kt = wave; kt < nkt; kt += 8) {
        bf16x8 B[4];
#pragma unroll
        for (int s = 0; s < 4; ++s) B[s] = Bn[s];
        if (kt + 8 < nkt) { const bf16_t* kr = kidx + (size_t)(b * 2048 + (kt + 8) * 32 + c32) * 64 + 8 * hi;
#pragma unroll
            for (int s = 0; s < 4; ++s) Bn[s] = *(const bf16x8*)(kr + 16 * s); }
        const int key = kt * 32 + c32;
        f32x16 acc[4];
#pragma unroll
        for (int rt = 0; rt < 4; ++rt) acc[rt] = (f32x16){0.f, 0.f, 0.f, 0.f, 0.f, 0.f, 0.f, 0.f, 0.f, 0.f, 0.f, 0.f, 0.f, 0.f, 0.f, 0.f};
#pragma unroll
        for (int s = 0; s < 4; ++s)
#pragma unroll
            for (int rt = 0; rt < 4; ++rt) acc[rt] = __builtin_amdgcn_mfma_f32_32x32x16_bf16(A[rt][s], B[s], acc[rt], 0, 0, 0);
        f32x4 wv[4][4];
#pragma unroll
        for (int rt = 0; rt < 4; ++rt) { const LAS f32x4* wp = (const LAS f32x4*)(Wl + (4 * rt + 2 * hi) * 8);
#pragma unroll
            for (int q = 0; q < 4; ++q) wv[rt][q] = wp[q]; }
#pragma unroll
        for (int rt = 0; rt < 4; ++rt) {
            const f32x4 w0 = wv[rt][0], w1 = wv[rt][1], w2 = wv[rt][2], w3 = wv[rt][3]; const f32x16 a = acc[rt];
            float s0 = w0.x * fmaxf(a[0], 0.f); s0 += w0.y * fmaxf(a[1], 0.f); s0 += w0.z * fmaxf(a[2], 0.f); s0 += w0.w * fmaxf(a[3], 0.f);
            s0 += w1.x * fmaxf(a[4], 0.f); s0 += w1.y * fmaxf(a[5], 0.f); s0 += w1.z * fmaxf(a[6], 0.f); s0 += w1.w * fmaxf(a[7], 0.f);
            float s1 = w2.x * fmaxf(a[8], 0.f); s1 += w2.y * fmaxf(a[9], 0.f); s1 += w2.z * fmaxf(a[10], 0.f); s1 += w2.w * fmaxf(a[11], 0.f);
            s1 += w3.x * fmaxf(a[12], 0.f); s1 += w3.y * fmaxf(a[13], 0.f); s1 += w3.z * fmaxf(a[14], 0.f); s1 += w3.w * fmaxf(a[15], 0.f);
            const int ql = 4 * rt + 2 * hi, t0 = q0 + ql;
            SC[ql * 2048 + key] = key <= t0 ? s0 : -INFINITY; SC[(ql + 1) * 2048 + key] = key <= t0 + 1 ? s1 : -INFINITY;
        }
    }
}
__device__ __forceinline__ void topk(LAS unsigned char* lds, int q0, int qq, int lane) {
    const int t = q0 + qq, n = t + 1;
    LAS unsigned short* list = (LAS unsigned short*)(lds + LIST_OFF) + qq * 256; LAS int* nsel = (LAS int*)(lds + NSEL_OFF);
    if (n <= 256) { for (int i = lane; i < 256; i += 64) list[i] = (unsigned short)(i < n ? i : t); if (lane == 0) nsel[qq] = n; return; }
    const int nk = ((q0 + 16 + 31) >> 5) * 32;
    const LAS float* SC = (const LAS float*)(lds + SC_OFF) + qq * 2048;
    unsigned u[32];
#pragma unroll
    for (int j = 0; j < 32; ++j) { const int key = lane + 64 * j; unsigned v = 0u; if (key < nk) { const unsigned bts = __float_as_uint(SC[key]); v = (bts & 0x80000000u) ? ~bts : (bts | 0x80000000u); } u[j] = v; }
    unsigned tau = 0u;
    for (int bit = 31; bit >= 0; --bit) {
        const unsigned cand = tau | (1u << bit); int cnt = 0;
#pragma unroll
        for (int j = 0; j < 32; ++j) cnt += __popcll(__ballot(u[j] >= cand));
        if (cnt >= 256) tau = cand;
        if (cnt == 256) break;
    }
    int cgt = 0;
#pragma unroll
    for (int j = 0; j < 32; ++j) cgt += __popcll(__ballot(u[j] > tau));
    const int r = 256 - cgt; int base = 0, eqb = 0;
#pragma unroll
    for (int j = 0; j < 32; ++j) {
        const bool gt = u[j] > tau, eq = u[j] == tau; const unsigned long long em = __ballot(eq);
        const bool sel = gt || (eq && (eqb + mbcnt64(em)) < r); const unsigned long long sm = __ballot(sel);
        if (sel) list[base + mbcnt64(sm)] = (unsigned short)(lane + 64 * j);
        base += __popcll(sm); eqb += __popcll(em);
    }
    if (lane == 0) nsel[qq] = 256;
}
__device__ __forceinline__ int wave_scan_incl(int x) {
    x += __builtin_amdgcn_update_dpp(0, x, 0x111, 0xF, 0xF, true);
    x += __builtin_amdgcn_update_dpp(0, x, 0x112, 0xF, 0xF, true);
    x += __builtin_amdgcn_update_dpp(0, x, 0x114, 0xF, 0xF, true);
    x += __builtin_amdgcn_update_dpp(0, x, 0x118, 0xF, 0xF, true);
    x += __builtin_amdgcn_update_dpp(0, x, 0x142, 0xA, 0xF, false);
    x += __builtin_amdgcn_update_dpp(0, x, 0x143, 0xC, 0xF, false);
    return x;
}
__device__ __forceinline__ void topk2(LAS unsigned char* lds, int q0, int qq, int wave, int lane, unsigned* dbg_flag_g = nullptr) {
    const int t = q0 + qq, n = t + 1;
    LAS unsigned short* list = (LAS unsigned short*)(lds + LIST_OFF) + qq * 256; LAS int* nsel = (LAS int*)(lds + NSEL_OFF);
    if (n <= 256) { for (int i = lane; i < 256; i += 64) list[i] = (unsigned short)(i < n ? i : t); if (lane == 0) nsel[qq] = n; return; }
    const int nk = ((q0 + 16 + 31) >> 5) * 32;
    const LAS float* SC = (const LAS float*)(lds + SC_OFF) + qq * 2048;
    LAS int* hist = (LAS int*)(lds + HIST_OFF) + wave * 64;
    float v[32]; float lo = INFINITY, hi = -INFINITY;
#pragma unroll
    for (int j = 0; j < 8; ++j) { f32x4 x = {-INFINITY, -INFINITY, -INFINITY, -INFINITY}; if (256 * j + 4 * lane < nk) x = *(const LAS f32x4*)(SC + 256 * j + 4 * lane);
#pragma unroll
        for (int e = 0; e < 4; ++e) { v[4 * j + e] = x[e]; hi = fmaxf(hi, x[e]); lo = fminf(lo, x[e] == -INFINITY ? INFINITY : x[e]); } }
#pragma unroll
    for (int o = 1; o < 64; o <<= 1) { hi = fmaxf(hi, __shfl_xor(hi, o)); lo = fminf(lo, __shfl_xor(lo, o)); }
    bool ok = hi > lo;
    float sc = 0.f, off = 0.f; int B = 0, B2 = 0, need2 = 0, ncand = 0;
    if (ok) {
        sc = 63.99f / (hi - lo); off = -lo * sc;
        hist[lane] = 0;
#pragma unroll
        for (int j = 0; j < 8; ++j) if (256 * j < nk) {
#pragma unroll
            for (int e = 0; e < 4; ++e) { const int i = 4 * j + e; int bb = (int)__builtin_fmaf(v[i], sc, off); bb = bb < 0 ? 0 : (bb > 63 ? 63 : bb); (void)__hip_atomic_fetch_add((LAS unsigned*)&hist[bb], 1u, __ATOMIC_RELAXED, __HIP_MEMORY_SCOPE_WORKGROUP); } }
        int c = hist[lane]; int incl = wave_scan_incl(c); int tot = __builtin_amdgcn_readlane(incl, 63); int suf = tot - incl + c;
        unsigned long long m = __ballot(suf >= 256); B = 63 - __builtin_clzll(m);
        const int above = (B < 63) ? __builtin_amdgcn_readlane(suf, (B + 1) & 63) : 0; const int need1 = 256 - above;
        ok = (B > 0);
        if (ok) {
            const float fB = (float)B;
            hist[lane] = 0;
#pragma unroll
            for (int j = 0; j < 8; ++j) if (256 * j < nk) {
#pragma unroll
              for (int e = 0; e < 4; ++e) { const int i = 4 * j + e; const float f = __builtin_fmaf(v[i], sc, off); int bb = (int)f; bb = bb > 63 ? 63 : bb; if (bb == B) { int b2 = (int)((f - fB) * 64.f); b2 = b2 < 0 ? 0 : (b2 > 63 ? 63 : b2); (void)__hip_atomic_fetch_add((LAS unsigned*)&hist[b2], 1u, __ATOMIC_RELAXED, __HIP_MEMORY_SCOPE_WORKGROUP); } } }
            c = hist[lane]; incl = wave_scan_incl(c); tot = __builtin_amdgcn_readlane(incl, 63); suf = tot - incl + c;
            m = __ballot(suf >= need1); B2 = 63 - __builtin_clzll(m);
            const int above2 = (B2 < 63) ? __builtin_amdgcn_readlane(suf, (B2 + 1) & 63) : 0; need2 = need1 - above2; ncand = __builtin_amdgcn_readlane(c, B2);
            ok = (ncand <= 64) && (B < 63 || B2 < 63);
        }
    }
#ifdef DSA_FALLBACK_COUNT
    if (!ok && lane == 0) atomicAdd(dbg_flag_g + 64, 1u);
#endif
    if (!ok) { topk(lds, q0, qq, lane); return; }
    const float thrLo = (float)B + (float)B2 * (1.f / 64.f), thrHi = (float)B + (float)(B2 + 1) * (1.f / 64.f);
    LAS float* cv = (LAS float*)list; LAS unsigned short* ck = list + 128;
    int base = 0;
#pragma unroll
    for (int j = 0; j < 8; ++j) if (256 * j < nk) {
#pragma unroll
      for (int e = 0; e < 4; ++e) { const int i = 4 * j + e; const float f = __builtin_fmaf(v[i], sc, off); const bool isc = (f >= thrLo) && (f < thrHi); const unsigned long long cm = __ballot(isc);
        if (cm) { if (isc) { const int pos = base + mbcnt64(cm); cv[pos] = v[i]; ck[pos] = (unsigned short)(256 * j + 4 * lane + e); } base += __popcll(cm); } } }
    const float myv = lane < ncand ? cv[lane] : -INFINITY; const int myk = lane < ncand ? (int)ck[lane] : 0x7fffffff; int rank = 0;
    for (int k = 0; k < ncand; ++k) { const float vk = __int_as_float(__builtin_amdgcn_readlane(__float_as_int(myv), k)); const int kk = __builtin_amdgcn_readlane(myk, k); rank += (vk > myv || (vk == myv && kk < myk)) ? 1 : 0; }
    const unsigned long long lm = __ballot(lane < ncand && rank == need2 - 1); const int ll = (int)__builtin_ctzll(lm);
    const float tauv = __int_as_float(__builtin_amdgcn_readlane(__float_as_int(myv), ll)); const int tauk = __builtin_amdgcn_readlane(myk, ll);
    base = 0;
#pragma unroll
    for (int j = 0; j < 8; ++j) if (256 * j < nk) {
#pragma unroll
      for (int e = 0; e < 4; ++e) { const int i = 4 * j + e; const int key = 256 * j + 4 * lane + e; const bool sel = (v[i] > tauv) || (v[i] == tauv && key <= tauk); const unsigned long long sm = __ballot(sel);
        if (sel) list[base + mbcnt64(sm)] = (unsigned short)key; base += __popcll(sm); } }
    if (lane == 0) nsel[qq] = 256;
}
__device__ __forceinline__ void attend2(LAS unsigned char* lds, int b, int q0, int wave, int lane, const bf16_t* qabs, const bf16_t* ckv, bf16_t* mix) {
    const int r16 = lane & 15, g = lane >> 4;
    LAS unsigned char* buf0 = lds + wave * 16384; LAS unsigned char* buf1 = buf0 + 8192;
    const LAS unsigned short* listw = (const LAS unsigned short*)(lds + LIST_OFF) + (2 * wave) * 256;
    const LAS float* biasT = (const LAS float*)(lds + BIAS_OFF);
    const int n0 = ((const LAS int*)(lds + NSEL_OFF))[2 * wave], n1 = ((const LAS int*)(lds + NSEL_OFF))[2 * wave + 1];
    const int ns0 = (n0 + 31) >> 5, total = ns0 + ((n1 + 31) >> 5);
    const float cmax = *(const LAS float*)(lds + CMAX_OFF), bmax = ((const LAS float*)(lds + BMAX_OFF))[r16 & 7];
    const int xr = xsw(r16);
    const int q4 = r16 >> 2, p4 = r16 & 3; const int rra = 4 * g + q4, rrb = 16 + 4 * g + q4; const int xa = xsw(rra & 15), xb = xsw(rrb & 15);
    int t = 0, n = 0; size_t row = 0; const LAS unsigned short* list = listw; bf16x8 QB[4]; float Mh = 0.f, lsum = 0.f; f32x4 O[8];
    u32x4 X[8], Y[8];
#define DSA_LOAD(ST, kk) do { if ((kk) < total) { const int sel_ = (kk) >= ns0 ? 1 : 0; const LAS unsigned short* lp_ = listw + sel_ * 256 + ((kk) - (sel_ ? ns0 : 0)) * 32; \
        _Pragma("unroll") for (int i_ = 0; i_ < 8; ++i_) { const int rr_ = 4 * i_ + g; const int idx_ = lp_[rr_]; ST[i_] = *(const u32x4*)(ckv + ((size_t)b * 2048 + idx_) * 128 + (r16 ^ xsw(rr_ & 15)) * 8); } } } while (0)
#define DSA_WRITE(ST, bufp) do { _Pragma("unroll") for (int i_ = 0; i_ < 8; ++i_) *(LAS u32x4*)((bufp) + (4 * i_ + g) * 256 + r16 * 16) = ST[i_]; } while (0)
#define DSA_INIT(qq_) do { t = q0 + (qq_); row = (size_t)b * 2048 + t; n = ((qq_) & 1) ? n1 : n0; list = listw + ((qq_) & 1) * 256; float qn2_ = 0.f; \
        _Pragma("unroll") for (int s_ = 0; s_ < 4; ++s_) { bf16x8 v_ = {0, 0, 0, 0, 0, 0, 0, 0}; if (r16 < 8) v_ = *(const bf16x8*)(qabs + row * 1536 + s_ * 256 + r16 * 32 + 8 * g); QB[s_] = v_; \
            _Pragma("unroll") for (int e_ = 0; e_ < 8; ++e_) { const float f_ = bf2f((bf16_t)v_[e_]); qn2_ += f_ * f_; } } \
        qn2_ += __shfl_xor(qn2_, 16); qn2_ += __shfl_xor(qn2_, 32); Mh = sqrtf(qn2_) * cmax + bmax; lsum = 0.f; \
        _Pragma("unroll") for (int dt_ = 0; dt_ < 8; ++dt_) O[dt_] = (f32x4){0.f, 0.f, 0.f, 0.f}; } while (0)
#define DSA_FINAL() do { float l_ = lsum; l_ += __shfl_xor(l_, 16); l_ += __shfl_xor(l_, 32); const float linv_ = 1.f / l_; \
        _Pragma("unroll") for (int e_ = 0; e_ < 4; ++e_) { const int hrow_ = (4 * g + e_) & 7; const float inv_ = __shfl(linv_, hrow_); \
            if (g < 2) { _Pragma("unroll") for (int dt_ = 0; dt_ < 8; ++dt_) mix[row * MIXK + 512 + hrow_ * 128 + 16 * dt_ + r16] = f2bf(O[dt_][e_] * inv_); } } } while (0)
#define DSA_COMPUTE(kk, buf) do { if ((kk) == ns0) { DSA_FINAL(); DSA_INIT(2 * wave + 1); } const int step = (kk) >= ns0 ? (kk) - ns0 : (kk); \
          \
        bf16x8 af_[2][4]; \
        _Pragma("unroll") for (int G = 0; G < 2; ++G) _Pragma("unroll") for (int s = 0; s < 4; ++s) af_[G][s] = *(const LAS bf16x8*)((buf) + (16 * G + r16) * 256 + (((4 * s + g) ^ xr) * 16)); \
        const int pb0_ = step * 32 + 4 * g; const u16x4 ida_ = *(const LAS u16x4*)(list + pb0_), idb_ = *(const LAS u16x4*)(list + pb0_ + 16); \
        s16x4 tlo_[8], thi_[8]; \
        _Pragma("unroll") for (int dt = 0; dt < 8; ++dt) { const int ch = 2 * dt + (p4 >> 1); \
            tlo_[dt] = __builtin_bit_cast(s16x4, __builtin_amdgcn_ds_read_tr16_b64_v4i16((LAS s16x4*)((buf) + rra * 256 + ((ch ^ xa) * 16) + 8 * (p4 & 1)))); \
            thi_[dt] = __builtin_bit_cast(s16x4, __builtin_amdgcn_ds_read_tr16_b64_v4i16((LAS s16x4*)((buf) + rrb * 256 + ((ch ^ xb) * 16) + 8 * (p4 & 1)))); } \
        float bz_[2][4]; \
        _Pragma("unroll") for (int e = 0; e < 4; ++e) { int d0_ = t - (int)ida_[e]; d0_ = d0_ < 128 ? d0_ : 128; d0_ = d0_ < 0 ? 0 : d0_; int d1_ = t - (int)idb_[e]; d1_ = d1_ < 128 ? d1_ : 128; d1_ = d1_ < 0 ? 0 : d1_; \
            bz_[0][e] = biasT[d0_ * 8 + (r16 & 7)]; bz_[1][e] = biasT[d1_ * 8 + (r16 & 7)]; } \
        f32x4 S_[2]; \
        _Pragma("unroll") for (int G = 0; G < 2; ++G) { f32x4 acc = {0.f, 0.f, 0.f, 0.f}; \
            _Pragma("unroll") for (int s = 0; s < 4; ++s) acc = __builtin_amdgcn_mfma_f32_16x16x32_bf16(af_[G][s], QB[s], acc, 0, 0, 0); \
            S_[G] = acc; } \
        float P_[2][4]; \
        _Pragma("unroll") for (int G = 0; G < 2; ++G) _Pragma("unroll") for (int e = 0; e < 4; ++e) { const float lg = S_[G][e] + bz_[G][e] - Mh; \
                const float pv = (pb0_ + 16 * G + e < n) ? __builtin_amdgcn_exp2f(lg) : 0.f; lsum += pv; P_[G][e] = pv; } \
        u32x4 pw; pw.x = cvtpk(P_[0][0], P_[0][1]); pw.y = cvtpk(P_[0][2], P_[0][3]); pw.z = cvtpk(P_[1][0], P_[1][1]); pw.w = cvtpk(P_[1][2], P_[1][3]); \
        const bf16x8 PA = __builtin_bit_cast(bf16x8, pw); \
        _Pragma("unroll") for (int dt = 0; dt < 8; ++dt) { const bf16x8 vb = {tlo_[dt][0], tlo_[dt][1], tlo_[dt][2], tlo_[dt][3], thi_[dt][0], thi_[dt][1], thi_[dt][2], thi_[dt][3]}; \
            O[dt] = __builtin_amdgcn_mfma_f32_16x16x32_bf16(PA, vb, O[dt], 0, 0, 0); } } while (0)
    DSA_LOAD(X, 0); DSA_LOAD(Y, 1);
    __syncthreads();
    DSA_INIT(2 * wave);
    DSA_WRITE(X, buf0); DSA_LOAD(X, 2);
    if (1 < total) { DSA_WRITE(Y, buf1); DSA_LOAD(Y, 3); }
    for (int k = 0; k < total; k += 2) {
        DSA_COMPUTE(k, buf0);
        if (k + 2 < total) { DSA_WRITE(X, buf0); DSA_LOAD(X, k + 4); }
        if (k + 1 < total) { DSA_COMPUTE(k + 1, buf1); if (k + 3 < total) { DSA_WRITE(Y, buf1); DSA_LOAD(Y, k + 5); } }
    }
    DSA_FINAL();
#undef DSA_LOAD
#undef DSA_WRITE
#undef DSA_INIT
#undef DSA_FINAL
#undef DSA_COMPUTE
}
__device__ __forceinline__ void unit(LAS unsigned char* lds, int b, int q0, int tid, int wave, int lane, const bf16_t* qabs, const bf16_t* ckv, const bf16_t* kidx, const float* widx, bf16_t* mix, unsigned* dbg_flag) {
    asm volatile("" : "+v"(tid));
    lane = tid & 63;
    if (tid < 128) ((LAS float*)(lds + W_OFF))[tid] = widx[(size_t)(b * 2048 + q0) * 8 + tid];
#ifndef DSA_REP_S1
#define DSA_REP_S1 1
#define DSA_REP_S2 1
#define DSA_REP_S3 1
#endif
    if (q0 + 16 > 256) { for (int rp = 0; rp < DSA_REP_S1; ++rp) { scores(lds, b, q0, qabs, kidx, wave, lane); __syncthreads(); } }
    else __syncthreads();
    asm volatile("" : "+v"(tid)); lane = tid & 63;
#ifdef DSA_TOPK_CHECK
    for (int e2 = 0; e2 < 2; ++e2) { const int qq = 2 * wave + e2;
        topk(lds, q0, qq, lane); const LAS unsigned short* lw = (const LAS unsigned short*)(lds + LIST_OFF) + qq * 256; const int ns = ((const LAS int*)(lds + NSEL_OFF))[qq];
        unsigned h1 = 0, h2 = 0; for (int i = lane; i < ns; i += 64) { const unsigned x = lw[i]; h1 += x; h2 += x * x; }
        topk2(lds, q0, qq, wave, lane); const int ns2 = ((const LAS int*)(lds + NSEL_OFF))[qq];
        unsigned g1 = 0, g2 = 0; for (int i = lane; i < ns2; i += 64) { const unsigned x = lw[i]; g1 += x; g2 += x * x; }
#pragma unroll
        for (int o = 1; o < 64; o <<= 1) { h1 += __shfl_xor(h1, o); h2 += __shfl_xor(h2, o); g1 += __shfl_xor(g1, o); g2 += __shfl_xor(g2, o); }
        if (lane == 0 && (h1 != g1 || h2 != g2 || ns != ns2)) atomicAdd(dbg_flag, 1u); }
#else
    for (int rp = 0; rp < DSA_REP_S2; ++rp) { topk2(lds, q0, 2 * wave, wave, lane, dbg_flag); topk2(lds, q0, 2 * wave + 1, wave, lane, dbg_flag); }
#endif
    asm volatile("" : "+v"(tid)); lane = tid & 63;
    for (int rp = 0; rp < DSA_REP_S3; ++rp) { attend2(lds, b, q0, wave, lane, qabs, ckv, mix); __syncthreads(); }
}
}
#ifndef DN_REP_E
#define DN_REP_E 1
#define DN_REP_T 1
#endif
namespace dn {
typedef short bf16x8 __attribute__((ext_vector_type(8)));
typedef short s16x4 __attribute__((ext_vector_type(4)));
typedef float f32x4 __attribute__((ext_vector_type(4)));
typedef float f32x2 __attribute__((ext_vector_type(2)));
typedef unsigned u32x4 __attribute__((ext_vector_type(4)));
typedef unsigned u32x2 __attribute__((ext_vector_type(2)));
constexpr int CWL = 132096;
constexpr int QS = 0, KS = 17408, WB = 17408, KGT = 34816, VBT = 52224, KBT = 69632, LF = 87040, TB = 103680, XF = 112896, OF = 87040, QKB = 120832, GC = 130048, BT = 130304;
constexpr int QSTR = 272, TSTR = 136, LSTR = 65, TBSTR = 144, OSTR = 132;
typedef float cvf32x2_t __attribute__((ext_vector_type(2))); typedef __bf16 cvbf16x2_t __attribute__((ext_vector_type(2)));
__device__ __forceinline__ unsigned cvtpk(float lo, float hi) { cvf32x2_t v = {lo, hi}; return __builtin_bit_cast(unsigned, __builtin_convertvector(v, cvbf16x2_t)); }
__device__ __forceinline__ bf16x8 pack2(const f32x4& a, const f32x4& b) { u32x4 w; w.x = cvtpk(a[0], a[1]); w.y = cvtpk(a[2], a[3]); w.z = cvtpk(b[0], b[1]); w.w = cvtpk(b[2], b[3]); return __builtin_bit_cast(bf16x8, w); }
__device__ __forceinline__ bf16x8 frag_perm(const LAS unsigned char* rowp, int s, int g) {
    const u32x2 lo = *(const LAS u32x2*)(rowp + (32 * s + 4 * g) * 2), hi = *(const LAS u32x2*)(rowp + (32 * s + 16 + 4 * g) * 2);
    u32x4 w; w.x = lo.x; w.y = lo.y; w.z = hi.x; w.w = hi.y; return __builtin_bit_cast(bf16x8, w); }
__device__ __forceinline__ bf16x8 frag_nat8(const LAS unsigned char* rowp, int s, int g) {
    const u32x2 lo = *(const LAS u32x2*)(rowp + (32 * s + 8 * g) * 2), hi = *(const LAS u32x2*)(rowp + (32 * s + 8 * g + 4) * 2);
    u32x4 w; w.x = lo.x; w.y = lo.y; w.z = hi.x; w.w = hi.y; return __builtin_bit_cast(bf16x8, w); }
__device__ __forceinline__ float silu(float x) { return x * __builtin_amdgcn_rcpf(1.f + __builtin_amdgcn_exp2f(-LOG2E * x)); }
__device__ __forceinline__ float ex(float x) { return __builtin_amdgcn_exp2f(LOG2E * x); }

__device__ __forceinline__ void run(LAS unsigned char* lds0, int b, int h, const bf16_t* proj, const float* conv_w, const float* beta, const float* gdec, const float* gn, bf16_t* mix, int tid, int wave, int lane) {
    const int r16c = lane & 15, gc = lane >> 4;
    LAS float* cwL = (LAS float*)(lds0 + CWL);
    if (wave == 0) {
#pragma unroll
        for (int p = 0; p < 3; ++p)
#pragma unroll
            for (int e = 0; e < 2; ++e)
#pragma unroll
                for (int j = 0; j < 4; ++j) cwL[((p * 2 + e) * 4 + j) * 64 + lane] = conv_w[j * 1536 + p * 512 + h * 128 + 2 * lane + e];
    }
    __syncthreads();
    const float gn0 = gn[2 * lane], gn1 = gn[2 * lane + 1];
    f32x4 S[8];
#pragma unroll
    for (int i = 0; i < 8; ++i) S[i] = (f32x4){0.f, 0.f, 0.f, 0.f};
    const bf16_t* pbase = proj + h * 128 + 2 * lane;
    unsigned xq[11][3]; float gnext, bnext;
#define DN_LOAD_CHUNK(cn) do { const size_t Rn = (size_t)b * 2048 + 64 * (cn); \
        _Pragma("unroll") for (int a = 0; a < 11; ++a) { const int tt = 64 * (cn) + 8 * wave - 3 + a; \
            _Pragma("unroll") for (int p_ = 0; p_ < 3; ++p_) xq[a][p_] = (tt >= 0) ? *(const unsigned*)(pbase + (Rn + 8 * wave - 3 + a) * PROJ + p_ * 512) : 0u; } \
        gnext = gdec[(Rn + lane) * 4 + h]; bnext = beta[(Rn + lane) * 4 + h]; } while (0)
    DN_LOAD_CHUNK(0);
    for (int c = 0; c < 32; ++c) {
        const size_t R0 = (size_t)b * 2048 + 64 * c;
        int zoff = 0; asm volatile("" : "+v"(zoff));
        LAS unsigned char* lds = lds0 + zoff; const int r16 = r16c + zoff, g = gc + zoff;
        LAS float* Lf = (LAS float*)(lds + LF); LAS float* gcumL = (LAS float*)(lds + GC); LAS float* betaL = (LAS float*)(lds + BT);
        float gcum = gnext;
#pragma unroll
        for (int o = 1; o < 64; o <<= 1) { const float t = __shfl_up(gcum, o); if (lane >= o) gcum += t; }
        const float gl = __int_as_float(__builtin_amdgcn_readlane(__float_as_int(gcum), 63));
        const float bv = bnext;
        if (wave == 0) { gcumL[lane] = gcum; betaL[lane] = bv; }
        for (int rpE = 0; rpE < DN_REP_E; ++rpE) {
            float cw[3][2][4];
#pragma unroll
            for (int p = 0; p < 3; ++p)
#pragma unroll
                for (int e = 0; e < 2; ++e)
#pragma unroll
                    for (int j = 0; j < 4; ++j) cw[p][e][j] = cwL[((p * 2 + e) * 4 + j) * 64 + lane];
            float xw[3][3][2];
#pragma unroll
            for (int a = 0; a < 3; ++a)
#pragma unroll
                for (int p = 0; p < 3; ++p) { xw[a][p][0] = __uint_as_float(xq[a][p] << 16); xw[a][p][1] = __uint_as_float(xq[a][p] & 0xffff0000u); }
#pragma unroll
            for (int i = 0; i < 8; ++i) {
                const int r = 8 * wave + i; float x0[3][2], sv[3][2];
#pragma unroll
                for (int p = 0; p < 3; ++p) { x0[p][0] = __uint_as_float(xq[3 + i][p] << 16); x0[p][1] = __uint_as_float(xq[3 + i][p] & 0xffff0000u); }
#pragma unroll
                for (int p = 0; p < 3; ++p)
#pragma unroll
                    for (int e = 0; e < 2; ++e) { const float s = cw[p][e][0] * xw[0][p][e] + cw[p][e][1] * xw[1][p][e] + cw[p][e][2] * xw[2][p][e] + cw[p][e][3] * x0[p][e]; sv[p][e] = silu(s); }
                const float rq = rsqrtf(wave_sum(sv[0][0] * sv[0][0] + sv[0][1] * sv[0][1]) + EPS) * 0.08838834764831845f;
                const float rk = rsqrtf(wave_sum(sv[1][0] * sv[1][0] + sv[1][1] * sv[1][1]) + EPS);
                const float gr = __int_as_float(__builtin_amdgcn_readlane(__float_as_int(gcum), r)), br = __int_as_float(__builtin_amdgcn_readlane(__float_as_int(bv), r));
                const float eg = ex(gr), ekl = ex(gl - gr);
                const float k0 = sv[1][0] * rk, k1 = sv[1][1] * rk;
                *(LAS unsigned*)(lds + QS + r * QSTR + 4 * lane) = cvtpk(sv[0][0] * rq, sv[0][1] * rq);
                *(LAS unsigned*)(lds + KS + r * QSTR + 4 * lane) = cvtpk(k0, k1);
                const unsigned kg = cvtpk(k0 * ekl, k1 * ekl), kb = cvtpk(k0 * br * eg, k1 * br * eg), vb = cvtpk(sv[2][0] * br, sv[2][1] * br);
                *(LAS unsigned short*)(lds + KGT + (2 * lane) * TSTR + 2 * r) = (unsigned short)kg; *(LAS unsigned short*)(lds + KGT + (2 * lane + 1) * TSTR + 2 * r) = (unsigned short)(kg >> 16);
                *(LAS unsigned short*)(lds + KBT + (2 * lane) * TSTR + 2 * r) = (unsigned short)kb; *(LAS unsigned short*)(lds + KBT + (2 * lane + 1) * TSTR + 2 * r) = (unsigned short)(kb >> 16);
                *(LAS unsigned short*)(lds + VBT + (2 * lane) * TSTR + 2 * r) = (unsigned short)vb; *(LAS unsigned short*)(lds + VBT + (2 * lane + 1) * TSTR + 2 * r) = (unsigned short)(vb >> 16);
#pragma unroll
                for (int p = 0; p < 3; ++p)
#pragma unroll
                    for (int e = 0; e < 2; ++e) { xw[0][p][e] = xw[1][p][e]; xw[1][p][e] = xw[2][p][e]; xw[2][p][e] = x0[p][e]; }
            }
        }
        __syncthreads();
        for (int rpT = 0; rpT < DN_REP_T; ++rpT) {
        {
            const int ti = wave & 3, sel = wave >> 2;
            const LAS unsigned char* Ab = lds + (sel ? QS : KS) + (16 * ti + r16) * QSTR;
            bf16x8 A[4];
#pragma unroll
            for (int s = 0; s < 4; ++s) A[s] = *(const LAS bf16x8*)(Ab + (32 * s + 8 * g) * 2);
            const f32x4 gi4 = *(const LAS f32x4*)(gcumL + 16 * ti + 4 * g), bi4 = *(const LAS f32x4*)(betaL + 16 * ti + 4 * g);
#pragma unroll
            for (int tj = 0; tj < 4; ++tj) {
                f32x4 acc = {0.f, 0.f, 0.f, 0.f};
                if (tj <= ti) {
                    const LAS unsigned char* Bb = lds + KS + (16 * tj + r16) * QSTR; bf16x8 Bf[4];
#pragma unroll
                    for (int s = 0; s < 4; ++s) Bf[s] = *(const LAS bf16x8*)(Bb + (32 * s + 8 * g) * 2);
#pragma unroll
                    for (int s = 0; s < 4; ++s) acc = __builtin_amdgcn_mfma_f32_16x16x32_bf16(A[s], Bf[s], acc, 0, 0, 0);
                }
                const float gj = gcumL[16 * tj + r16]; const int j = 16 * tj + r16;
#pragma unroll
                for (int e = 0; e < 4; ++e) { const int i = 16 * ti + 4 * g + e; const float dec = ex(fminf(gi4[e] - gj, 0.f));
                    if (sel == 0) { const float lv = (i > j) ? bi4[e] * acc[e] * dec : 0.f;
                        if (tj == ti) Lf[i * LSTR + j] = lv; else if (tj < ti) *(LAS unsigned short*)(lds + TB + i * TBSTR + 2 * j) = f2bf(lv); }
                    else *(LAS unsigned short*)(lds + QKB + i * TBSTR + 2 * j) = f2bf((i >= j) ? acc[e] * dec : 0.f); }
            }
        }
        __syncthreads();
        if (wave == 0) {
            const LAS float* Nb = Lf + (16 * g) * LSTR + 16 * g; float x[16]; int rc = r16; asm volatile("" : "+v"(rc));
            float na[55], nb2[65];
            { int q = 0;
#pragma unroll
              for (int r = 1; r <= 10; ++r)
#pragma unroll
                  for (int j = 0; j < r; ++j) na[q++] = Nb[r * LSTR + j]; }
            { int q = 0;
#pragma unroll
              for (int r = 11; r <= 15; ++r)
#pragma unroll
                  for (int j = 0; j < r; ++j) nb2[q++] = Nb[r * LSTR + j]; }
            x[0] = (0 == rc) ? 1.f : 0.f;
            { int q = 0;
#pragma unroll
              for (int r = 1; r <= 10; ++r) { float s = (r == rc) ? 1.f : 0.f;
#pragma unroll
                  for (int j = 0; j < r; ++j) s -= na[q++] * x[j];
                  x[r] = s; } }
            { int q = 0;
#pragma unroll
              for (int r = 11; r <= 15; ++r) { float s = (r == rc) ? 1.f : 0.f;
#pragma unroll
                  for (int j = 0; j < r; ++j) s -= nb2[q++] * x[j];
                  x[r] = s; } }
#pragma unroll
            for (int r = 0; r < 16; ++r) *(LAS unsigned short*)(lds + TB + (16 * g + r) * TBSTR + 2 * (16 * g + r16)) = f2bf(x[r]);
        }
        __syncthreads();
        }
        f32x4 U[4];
        {
            const LAS unsigned char* tl = lds + TB;
#define DN_A1(b_, k_) ({ const u32x2 lo_ = *(const LAS u32x2*)(tl + (16 * (b_) + r16) * TBSTR + (16 * (k_) + 4 * g) * 2); u32x4 w_; w_.x = lo_.x; w_.y = lo_.y; w_.z = 0u; w_.w = 0u; __builtin_bit_cast(bf16x8, w_); })
#define DN_A2(b_, k0_, k1_) ({ const u32x2 lo_ = *(const LAS u32x2*)(tl + (16 * (b_) + r16) * TBSTR + (16 * (k0_) + 4 * g) * 2), hi_ = *(const LAS u32x2*)(tl + (16 * (b_) + r16) * TBSTR + (16 * (k1_) + 4 * g) * 2); \
            u32x4 w_; w_.x = lo_.x; w_.y = lo_.y; w_.z = hi_.x; w_.w = hi_.y; __builtin_bit_cast(bf16x8, w_); })
            const bf16x8 aD0 = DN_A1(0, 0), aL10 = DN_A1(1, 0), aD1 = DN_A1(1, 1), aL2 = DN_A2(2, 0, 1), aD2 = DN_A1(2, 2), aL3a = DN_A2(3, 0, 1), aL3b = DN_A1(3, 2), aD3 = DN_A1(3, 3);
            const f32x4 z4 = {0.f, 0.f, 0.f, 0.f};
#pragma unroll
            for (int which = 0; which < 2; ++which) {
                const LAS unsigned char* rp = lds + (which ? KBT : VBT) + (16 * wave + r16) * TSTR;
                f32x4 R[4];
#pragma unroll
                for (int b4 = 0; b4 < 4; ++b4) { const u32x2 w = *(const LAS u32x2*)(rp + (16 * b4 + 4 * g) * 2);
                    R[b4] = (f32x4){__uint_as_float(w.x << 16), __uint_as_float(w.x & 0xffff0000u), __uint_as_float(w.y << 16), __uint_as_float(w.y & 0xffff0000u)}; }
                f32x4 X0 = __builtin_amdgcn_mfma_f32_16x16x32_bf16(aD0, pack2(R[0], z4), z4, 0, 0, 0);
                f32x4 Y = __builtin_amdgcn_mfma_f32_16x16x32_bf16(aL10, pack2(X0, z4), z4, 0, 0, 0);
                f32x4 X1 = __builtin_amdgcn_mfma_f32_16x16x32_bf16(aD1, pack2(R[1] - Y, z4), z4, 0, 0, 0);
                const bf16x8 b01 = pack2(X0, X1);
                Y = __builtin_amdgcn_mfma_f32_16x16x32_bf16(aL2, b01, z4, 0, 0, 0);
                f32x4 X2 = __builtin_amdgcn_mfma_f32_16x16x32_bf16(aD2, pack2(R[2] - Y, z4), z4, 0, 0, 0);
                Y = __builtin_amdgcn_mfma_f32_16x16x32_bf16(aL3a, b01, z4, 0, 0, 0);
                Y = __builtin_amdgcn_mfma_f32_16x16x32_bf16(aL3b, pack2(X2, z4), Y, 0, 0, 0);
                f32x4 X3 = __builtin_amdgcn_mfma_f32_16x16x32_bf16(aD3, pack2(R[3] - Y, z4), z4, 0, 0, 0);
                if (which == 0) { U[0] = X0; U[1] = X1; U[2] = X2; U[3] = X3; }
                else { const f32x4 Xs[4] = {X0, X1, X2, X3};
#pragma unroll
                    for (int ti = 0; ti < 4; ++ti)
#pragma unroll
                        for (int e = 0; e < 4; ++e) *(LAS unsigned short*)(lds + WB + (16 * ti + 4 * g + e) * QSTR + (16 * wave + r16) * 2) = f2bf(Xs[ti][e]); }
            }
#undef DN_A1
#undef DN_A2
        }
        __syncthreads();
        if (c + 1 < 32) DN_LOAD_CHUNK(c + 1);
        unsigned dzq[8];
#pragma unroll
        for (int i = 0; i < 8; ++i) dzq[i] = *(const unsigned*)(proj + (R0 + 8 * wave + i) * PROJ + C_DZ + h * 128 + 2 * lane);
        {
            bf16x8 Sb[4];
#pragma unroll
            for (int s = 0; s < 4; ++s) Sb[s] = pack2(S[2 * s], S[2 * s + 1]);
            f32x4 Vn[4], Oa[4];
#pragma unroll
            for (int ti = 0; ti < 4; ++ti) {
                const LAS unsigned char* wp = lds + WB + (16 * ti + r16) * QSTR; const LAS unsigned char* qp = lds + QS + (16 * ti + r16) * QSTR;
                bf16x8 wf[4], qf[4];
#pragma unroll
                for (int s = 0; s < 4; ++s) { wf[s] = frag_perm(wp, s, g); qf[s] = frag_perm(qp, s, g); }
                const f32x4 gi4 = *(const LAS f32x4*)(gcumL + 16 * ti + 4 * g);
                f32x4 ws = {0.f, 0.f, 0.f, 0.f}, qs = {0.f, 0.f, 0.f, 0.f};
#pragma unroll
                for (int s = 0; s < 4; ++s) { ws = __builtin_amdgcn_mfma_f32_16x16x32_bf16(wf[s], Sb[s], ws, 0, 0, 0); qs = __builtin_amdgcn_mfma_f32_16x16x32_bf16(qf[s], Sb[s], qs, 0, 0, 0); }
                Vn[ti] = U[ti] - ws;
#pragma unroll
                for (int e = 0; e < 4; ++e) qs[e] *= ex(gi4[e]);
                Oa[ti] = qs;
            }
            bf16x8 Vb[2];
#pragma unroll
            for (int s = 0; s < 2; ++s) Vb[s] = pack2(Vn[2 * s], Vn[2 * s + 1]);
            { bf16x8 kf[4][2];
#pragma unroll
              for (int ti = 0; ti < 4; ++ti) { const LAS unsigned char* kp = lds + QKB + (16 * ti + r16) * TBSTR; kf[ti][0] = frag_perm(kp, 0, g); kf[ti][1] = frag_perm(kp, 1, g); }
#pragma unroll
              for (int ti = 0; ti < 4; ++ti)
#pragma unroll
                  for (int s = 0; s < 2; ++s) Oa[ti] = __builtin_amdgcn_mfma_f32_16x16x32_bf16(kf[ti][s], Vb[s], Oa[ti], 0, 0, 0); }
            const float egl = ex(gl);
#pragma unroll
            for (int half = 0; half < 2; ++half) { bf16x8 kf[4][2];
#pragma unroll
                for (int q = 0; q < 4; ++q) { const LAS unsigned char* kp = lds + KGT + (16 * (4 * half + q) + r16) * TSTR; kf[q][0] = frag_perm(kp, 0, g); kf[q][1] = frag_perm(kp, 1, g); }
#pragma unroll
                for (int q = 0; q < 4; ++q) { f32x4 sa = S[4 * half + q] * egl;
#pragma unroll
                    for (int s = 0; s < 2; ++s) sa = __builtin_amdgcn_mfma_f32_16x16x32_bf16(kf[q][s], Vb[s], sa, 0, 0, 0);
                    S[4 * half + q] = sa; } }
            LAS float* Of = (LAS float*)(lds + OF);
#pragma unroll
            for (int ti = 0; ti < 4; ++ti)
#pragma unroll
                for (int e = 0; e < 4; ++e) Of[(16 * ti + 4 * g + e) * OSTR + 16 * wave + r16] = Oa[ti][e];
        }
        __syncthreads();
        {
            const LAS float* Of = (const LAS float*)(lds + OF);
#pragma unroll
            for (int i = 0; i < 8; ++i) { const int r = 8 * wave + i; const f32x2 o = *(const LAS f32x2*)(Of + r * OSTR + 2 * lane);
                const float rstd = rsqrtf(wave_sum(o.x * o.x + o.y * o.y) * (1.f / 128.f) + EPS);
                const float z0 = __uint_as_float(dzq[i] << 16), z1 = __uint_as_float(dzq[i] & 0xffff0000u);
                *(unsigned*)(mix + (R0 + r) * MIXK + h * 128 + 2 * lane) = cvtpk(o.x * rstd * gn0 * silu(z0), o.y * rstd * gn1 * silu(z1)); }
        }
    }
}
#undef DN_LOAD_CHUNK
}
struct Args { const float* in[28]; float* out; unsigned char* ws; int ph_lo, ph_hi, li, pad; };
struct Frame {
    LAS unsigned char* lds; volatile LAS unsigned* MISC; int tid, lane, wave, G, vcu;
};
template <int NR> __device__ __forceinline__ void dsa_prep_rows(int row0, int lane, const bf16_t* proj, const float* kvg, const float* lng, const float* lnb, const float* a_log, const float* dt_bias,
                                             bf16_t* ckv, bf16_t* kidx, float* widx, float* beta, float* gdec) {
    unsigned cv[NR]; unsigned short kv[NR], sm[NR];
#pragma unroll
    for (int r = 0; r < NR; ++r) { const bf16_t* pr = proj + (size_t)(row0 + r) * PROJ; cv[r] = *(const unsigned*)(pr + C_CKV + lane * 2); kv[r] = pr[C_KIX + lane]; sm[r] = pr[C_WIX + (lane & 15)]; }
    const float g0 = kvg[lane * 2], g1 = kvg[lane * 2 + 1], lg = lng[lane], lb = lnb[lane], al = a_log[lane & 3], dtb = dt_bias[lane & 3];
#pragma unroll
    for (int r = 0; r < NR; ++r) { const int row = row0 + r;
        { const float a = __uint_as_float(cv[r] << 16), b = __uint_as_float(cv[r] & 0xffff0000u);
          const float rs = rsqrtf(wave_sum(a * a + b * b) * (1.f / 128.f) + EPS); *(unsigned*)(ckv + (size_t)row * 128 + lane * 2) = pk2(a * rs * g0, b * rs * g1); }
        { const float a = bf2f(kv[r]); const float mu = wave_sum(a) * (1.f / 64.f); const float xc = a - mu; const float rs = rsqrtf(wave_sum(xc * xc) * (1.f / 64.f) + EPS);
          kidx[(size_t)row * 64 + lane] = f2bf(xc * rs * lg + lb); }
        const float sv = bf2f(sm[r]);
        if (lane < 8) widx[(size_t)row * 8 + lane] = sv * 0.04419417382415922f;
        else if (lane < 12) beta[(size_t)row * 4 + (lane - 8)] = 1.f / (1.f + __expf(-sv));
        else if (lane < 16) { const float xx = sv + dtb; const float sp = xx > 20.f ? xx : log1pf(__expf(xx)); gdec[(size_t)row * 4 + (lane - 12)] = -__expf(al) * sp; }
    }
}

__global__ void __launch_bounds__(NWAVES * 64, 2) mega(Args args) {
    extern __shared__ __attribute__((aligned(16))) unsigned char lds_raw[];
    Frame F;
    F.lds = (LAS unsigned char*)lds_raw;
    F.MISC = (volatile LAS unsigned*)(F.lds + MISC_OFF);
    F.tid = threadIdx.x; F.lane = F.tid & 63; F.wave = __builtin_amdgcn_readfirstlane(F.tid >> 6);
    F.G = gridDim.x; { const int bx = blockIdx.x; F.vcu = (F.G % 8 == 0) ? (bx % 8) * (F.G / 8) + bx / 8 : bx; }
    unsigned char* ws = args.ws;
    const float* x = args.in[0]; const float* mem = args.in[1]; const float* g_mix = args.in[2]; const float* w_in = args.in[3];
    const float* conv_w = args.in[4]; const float* a_log = args.in[5]; const float* dt_bias = args.in[6];
    const float* dn_norm_g = args.in[7]; const float* q_norm_g = args.in[8]; const float* kv_norm_g = args.in[9]; const float* w_uq = args.in[10]; const float* w_uk = args.in[11];
    const float* w_uv = args.in[12]; const float* w_qidx = args.in[13]; const float* kidx_ln_g = args.in[14]; const float* kidx_ln_b = args.in[15];
    const float* rel_bias = args.in[16]; const float* w_out = args.in[17]; const float* g_xattn = args.in[18]; const float* g_mem = args.in[19];
    const float* w_xq = args.in[20]; const float* w_xkv = args.in[21]; const float* w_xo = args.in[22]; const float* g_ffn = args.in[23];
    const float* w_gate = args.in[24]; const float* w_up = args.in[25]; const float* w_down = args.in[26]; const float* g_final = args.in[27];
    float* out = args.out;
    bf16_t* Win_t = (bf16_t*)(ws + WS_WIN); bf16_t* Wkv_t = (bf16_t*)(ws + WS_WKV); bf16_t* Wdsa_t = (bf16_t*)(ws + WS_WDSA); bf16_t* Wout_t = (bf16_t*)(ws + WS_WOUT);
    bf16_t* Wxq_t = (bf16_t*)(ws + WS_WXQ); bf16_t* Wxo_t = (bf16_t*)(ws + WS_WXO); bf16_t* Wgu_t = (bf16_t*)(ws + WS_WGU); bf16_t* Wdn_t = (bf16_t*)(ws + WS_WDN);
    unsigned char* stt = ws + WS_ST;
    float* rstdx = (float*)(stt + ST_RSTDX); float* cqss = (float*)(stt + ST_CQSS); float* lpart = (float*)(stt + ST_LPART);
    float* widx = (float*)(stt + ST_WIDX); float* beta = (float*)(stt + ST_BETA); float* gdec = (float*)(stt + ST_G); float* biastab = (float*)(stt + ST_BIAS);
    bf16_t* mnb = (bf16_t*)(ws + WS_MNB); bf16_t* kx = (bf16_t*)(ws + WS_KX); bf16_t* vT = (bf16_t*)(ws + WS_VT); bf16_t* ckv = (bf16_t*)(ws + WS_CKV); bf16_t* kidx = (bf16_t*)(ws + WS_KIDX);
    float* ssq1 = (float*)(ws + WS_SSQ); float* ssq2 = ssq1 + (size_t)M * 16;
    bf16_t* proj = (bf16_t*)(ws + WS_PROJ); bf16_t* mix = (bf16_t*)(ws + WS_MIX); bf16_t* xb = (bf16_t*)(ws + WS_XB); bf16_t* qabs = (bf16_t*)out;
    bf16_t* x1b = (bf16_t*)(ws + WS_X1B); bf16_t* qx = (bf16_t*)(ws + WS_QX); bf16_t* Pb = (bf16_t*)(ws + WS_P); bf16_t* ox = (bf16_t*)(ws + WS_OX); bf16_t* x2b = (bf16_t*)(ws + WS_X2B); unsigned char* act = ws + WS_ACT; unsigned char* Wdn8 = ws + WS_W8; unsigned char* Wxq8 = ws + WS_W8 + 3 * MiB; unsigned char* Wxo8 = ws + WS_W8 + 4 * MiB;
    unsigned char* x1f8 = (unsigned char*)out;
    unsigned char* ox8 = ws + WS_OX;

    for (int u = F.tid; u < (LDS_BYTES - LDSCTL_OFF) / 4; u += NWAVES * 64) ((LAS unsigned*)(F.lds + LDSCTL_OFF))[u] = 0u;
    __syncthreads();
    XcdBarrier bar = xcd_barrier_post((unsigned*)(ws + WS_CTL) + 4096 + args.li * XCD_BAR_WORDS, F.MISC + 8);
#define GRID_BAR() xcd_barrier(bar)
    const int lo = args.ph_lo, hi = args.ph_hi;
#ifdef ONLY_PHASE
#define IN(k) ((k) == ONLY_PHASE && lo <= (k) && (k) < hi)
#else
#define IN(k) (lo <= (k) && (k) < hi)
#endif
#define BOTH(k) (IN(k) && IN((k) + 1))
    const int gw = F.vcu * NWAVES + F.wave, NGW = F.G * NWAVES;
    PG8_LAS unsigned char* ring = (PG8_LAS unsigned char*)F.lds;

    if (IN(0)) {
        LAS float* scr = (LAS float*)(F.lds + F.wave * 16384);
        constexpr int I_OB = 32 * 32, I_QA = 8 * 32, I_QI = 4 * 16, I_IN = 16 * 80, I_KV = 16 * 64, I_XQ = 16 * 32, I_XO = 16 * 32, I_GU = 16 * 176, I_DN = 44 * 32, I_OA = 8 * 32;
        constexpr int NITEMS = I_OB + I_QA + I_QI + I_IN + I_KV + I_XQ + I_XO + I_GU + I_DN + I_OA;
        for (int it = gw; it < NITEMS; it += NGW) {
            int r = it;
            if (r < I_OB) { const int kb = r >> 5, nb = r & 31, k0 = 32 * kb, h = k0 >> 7;
                heavy_item(w_uv, 64, w_out + (size_t)(512 + h * 64) * 1024, 1024, nullptr, 1.f, k0, 32 * nb, 32 * nb, Wout_t, MIXK, 512, scr, F.lane); continue; } r -= I_OB;
            if (r < I_QA) { const int kb = r >> 5, nb = r & 31, n0 = 32 * nb, h = n0 >> 7;
                heavy_item(w_uq + h * 64, 512, w_uk + (size_t)(h * 64) * 128 - h * 128, 128, q_norm_g, 0.125f * LOG2E, 32 * kb, n0, ((n0 >> 5) & 3) * 256 + h * 32, Wdsa_t, 256, 0, scr, F.lane); continue; }   r -= I_QA;
            if (r < I_QI) { tr_item(SrcQidx{w_qidx, q_norm_g}, 512, Wdsa_t + (size_t)1024 * 256, 256, 0, scr, r, F.lane); continue; } r -= I_QI;
            if (r < I_IN) { tr_item(SrcWin{w_in, g_mix}, PROJ, Win_t, 1024, 0, scr, r, F.lane); continue; } r -= I_IN;
            if (r < I_KV) { tr_item(SrcPlain{w_xkv, 2048, nullptr, 1.f}, 2048, Wkv_t, 1024, 0, scr, r, F.lane); continue; } r -= I_KV;
            if (r < I_XQ) { tr_item(SrcPlain{w_xq, 1024, g_xattn, 0.0625f * LOG2E}, 1024, Wxq_t, 1024, 0, scr, r, F.lane, (unsigned*)(ws + WS_CTL) + CTL_AMAX + 1); continue; } r -= I_XQ;
            if (r < I_XO) { tr_item(SrcPlain{w_xo, 1024, nullptr, 1.f}, 1024, Wxo_t, 1024, 0, scr, r, F.lane, (unsigned*)(ws + WS_CTL) + CTL_AMAX + 2); continue; } r -= I_XO;
            if (r < I_GU) { tr_item(SrcGU{w_gate, w_up, g_ffn}, 2 * DFF, Wgu_t, 1024, 0, scr, r, F.lane); continue; } r -= I_GU;
            if (r < I_DN) { tr_item(SrcPlain{w_down, 1024, nullptr, 1.f}, 1024, Wdn_t, DFF, 0, scr, r, F.lane, (unsigned*)(ws + WS_CTL) + CTL_AMAX); continue; } r -= I_DN;
            tr_item(SrcPlain{w_out, 1024, nullptr, 1.f}, 1024, Wout_t, MIXK, 0, scr, r, F.lane);
        }
        for (int m = 4 * gw; m < M; m += 4 * NGW) row_prep<4>(x + (size_t)m * D, nullptr, xb + (size_t)m * D, rstdx + m, F.lane);
        for (int m = 2 * gw; m < MM; m += 2 * NGW) row_prep<2>(mem + (size_t)m * D, g_mem, mnb + (size_t)m * D, nullptr, F.lane);
        if (blockIdx.x == 0) for (int i = F.tid; i < 129 * 8; i += NWAVES * 64) {
            const int d = i >> 3, h = i & 7; int bkt;
            if (d < 16) bkt = d; else { const float lr = logf((float)d / 16.f) / 2.0794415416798357f; const int large = 16 + (int)(lr * 16.f); bkt = large < 31 ? large : 31; }
            biastab[i] = rel_bias[bkt * 8 + h] * LOG2E; }
        if (BOTH(0)) GRID_BAR();
    }
    if (IN(1)) {
        pg8::Gemm g{xb, Win_t, 1024, 1024, 1024}; pg8::StaticOrder S; S.init(M, PROJ, F.G, (int)blockIdx.x);
        pg8::EpiProj E{proj, PROJ, nullptr, cqss, 8};
        pg8::gemm_phase<pg8::EpiProj, pg8::StaticOrder, true>(ring, g, S, E);
        if (BOTH(1)) GRID_BAR();
    }
    if (IN(2)) {
        for (int m = 4 * gw; m < M; m += 4 * NGW) dsa_prep_rows<4>(m, F.lane, proj, kv_norm_g, kidx_ln_g, kidx_ln_b, a_log, dt_bias, ckv, kidx, widx, beta, gdec);
        { unsigned* am = (unsigned*)(ws + WS_CTL) + CTL_AMAX;
          cvt_w8(Wdn_t, Wdn8, DFF * 1024 / 16, __hip_atomic_load(am, __ATOMIC_RELAXED, __HIP_MEMORY_SCOPE_AGENT), gw * 64 + F.lane, NGW * 64);
          cvt_w8(Wxq_t, Wxq8, 1024 * 1024 / 16, __hip_atomic_load(am + 1, __ATOMIC_RELAXED, __HIP_MEMORY_SCOPE_AGENT), gw * 64 + F.lane, NGW * 64);
          cvt_w8(Wxo_t, Wxo8, 1024 * 1024 / 16, __hip_atomic_load(am + 2, __ATOMIC_RELAXED, __HIP_MEMORY_SCOPE_AGENT), gw * 64 + F.lane, NGW * 64); }
        { pg8::Gemm g{proj + C_CQ, Wdsa_t, PROJ, 256, 256}; pg8::StaticOrder S; S.init(M, 1536, F.G, (int)blockIdx.x);
          pg8::EpiNormScale<4> E{qabs, 1536, cqss, 1.f / 256.f, 1.f};
          pg8::gemm_phase<pg8::EpiNormScale<4>, pg8::StaticOrder, true>(ring, g, S, E); }
        if (BOTH(2)) GRID_BAR();
    }
    if (IN(3)) {
        int tid3 = threadIdx.x; asm volatile("" : "+v"(tid3)); const int lane3 = tid3 & 63;
        if (blockIdx.x < 64) dn::run(F.lds, (int)blockIdx.x >> 2, (int)blockIdx.x & 3, proj, conv_w, beta, gdec, dn_norm_g, mix, tid3, F.wave, lane3);
        __syncthreads();
        if (blockIdx.x >= 64) { unsigned* kvq = (unsigned*)(ws + WS_CTL) + 1536;
            for (;;) {
                if (threadIdx.x == 0) F.MISC[17] = __hip_atomic_fetch_add(kvq, 1u, __ATOMIC_RELAXED, __HIP_MEMORY_SCOPE_AGENT);
                __syncthreads(); const int k = (int)F.MISC[17]; __syncthreads();
                if (k >= 128) break;
                if (k < 64) { pg8::Gemm g{mnb, Wkv_t, 1024, 1024, 1024}; pg8::OneUnit S1{{k >> 2, k & 3, 0, 0}}; pg8::EpiProj E{kx, 1024, nullptr, nullptr, -1};
                    pg8::gemm_phase<pg8::EpiProj, pg8::OneUnit, false>(ring, g, S1, E); }
                else { const int k2 = k - 64; pg8::Gemm g{Wkv_t + (size_t)1024 * 1024, mnb, 1024, 1024, 1024}; pg8::OneUnit S1{{k2 >> 4, k2 & 15, 0, 0}}; pg8::EpiProj E{vT, MM, nullptr, nullptr, -1};
                    pg8::gemm_phase<pg8::EpiProj, pg8::OneUnit, false>(ring, g, S1, E); }
            } }
        for (int pass = 0; pass <= args.pad; ++pass) {
        if (pass) GRID_BAR();
        int tid4 = threadIdx.x; asm volatile("" : "+v"(tid4)); const int lane4 = tid4 & 63;
        dsa::phase_init(F.lds, biastab, kv_norm_g, tid4);
        unsigned* qbase = (unsigned*)(ws + WS_CTL) + 2048 + 1024 * pass;
        const int myx = (int)(xb_xcc_id() & 7u);
        for (int sx = 0; sx < 8; ++sx) { const int qx8 = (myx + sx) & 7;
        for (;;) {
            if (tid4 == 0) F.MISC[16] = __hip_atomic_fetch_add(qbase + 64 * qx8, 1u, __ATOMIC_RELAXED, __HIP_MEMORY_SCOPE_AGENT);
            __syncthreads(); const int k = (int)F.MISC[16]; __syncthreads();
            if (k >= 256) break;
            dsa::unit(F.lds, 2 * qx8 + (k & 1), (127 - (k >> 1)) * 16, tid4, F.wave, lane4, qabs, ckv, kidx, widx, mix, (unsigned*)(ws + WS_CTL) + 1024);
        } }
        }
        if (BOTH(3)) GRID_BAR();
    }
    if (IN(4)) {
        pg8::Gemm g{mix, Wout_t, MIXK, MIXK, MIXK}; pg8::StaticOrder S; S.init(M, 1024, F.G, (int)blockIdx.x);
        pg8::EpiResid<true, true> E{nullptr, xb, x1b, ssq1, rstdx, x1f8, 1.f};
        pg8::gemm_phase<pg8::EpiResid<true, true>, pg8::StaticOrder, true>(ring, g, S, E);
        if (BOTH(4)) GRID_BAR();
    }
    if (IN(5)) {
        pg8::StaticOrder S; S.init(M, 1024, F.G, (int)blockIdx.x); pg8::Unit ua, ub; const bool h0 = S.next(0, ua), h1 = S.next(1, ub);
        if (h0) {
            { pg8::Gemm g{(const bf16_t*)x1f8, (const bf16_t*)Wxq8, 1024, 1024, 1024};
              const float asc = pg8::w8_inv_scale((unsigned)__builtin_amdgcn_readfirstlane((int)__hip_atomic_load((unsigned*)(ws + WS_CTL) + CTL_AMAX + 1, __ATOMIC_RELAXED, __HIP_MEMORY_SCOPE_AGENT)), pg8::X8_SHIFT);
              pg8::EpiNormScale<16> E{qx, 1024, ssq1, 1.f / 1024.f, asc};
              pg8::gemm_phase<pg8::EpiNormScale<16>, pg8::StaticOrder, true, true>(ring, g, S, E, F.wave); }
            VM_WAIT(); __syncthreads();
            pg8::TwoUnits S2; S2.n = h1 ? 2 : 1;
            S2.u0 = pg8::Unit{ua.pm, ua.pm >> 3, (long)ua.pn * 512, (long)ua.pn * 512}; S2.u1 = pg8::Unit{ub.pm, ub.pm >> 3, (long)ub.pn * 512, (long)ub.pn * 512};
            { pg8::Gemm g{qx, kx, 1024, 1024, 256};
              pg8::EpiExpP E{Pb, lpart};
              pg8::gemm_phase<pg8::EpiExpP, pg8::TwoUnits, true>(ring, g, S2, E); }
            VM_WAIT(); __syncthreads();
            pg8::TwoUnits S3; S3.n = S2.n;
            S3.u0 = pg8::Unit{ua.pm, ua.pn, (long)ua.pn * 512, (long)(ua.pm >> 3) * 512}; S3.u1 = pg8::Unit{ub.pm, ub.pn, (long)ub.pn * 512, (long)(ub.pm >> 3) * 512};
            { pg8::Gemm g{Pb, vT, 1024, MM, 256};
              pg8::EpiPV E{ox8, lpart};
              pg8::gemm_phase<pg8::EpiPV, pg8::TwoUnits, true>(ring, g, S3, E); }
        }
        if (BOTH(5)) GRID_BAR();
    }
    if (IN(6)) {
        pg8::Gemm g{(const bf16_t*)ox8, (const bf16_t*)Wxo8, 1024, 1024, 1024}; pg8::StaticOrder S; S.init(M, 1024, F.G, (int)blockIdx.x);
        const float asc = pg8::w8_inv_scale((unsigned)__builtin_amdgcn_readfirstlane((int)__hip_atomic_load((unsigned*)(ws + WS_CTL) + CTL_AMAX + 2, __ATOMIC_RELAXED, __HIP_MEMORY_SCOPE_AGENT)), pg8::OX_SHIFT);
        pg8::EpiResid<true> E{nullptr, x1b, x2b, ssq2, nullptr, nullptr, asc};
        pg8::gemm_phase<pg8::EpiResid<true>, pg8::StaticOrder, true, true>(ring, g, S, E, F.wave);
        if (BOTH(6)) GRID_BAR();
    }
    if (IN(7)) {
        pg8::Gemm g{x2b, Wgu_t, 1024, 1024, 1024}; pg8::StaticOrder S; S.init(M, 2 * DFF, F.G, (int)blockIdx.x);
        pg8::EpiSwiglu E{act, ssq2};
        pg8::gemm_phase<pg8::EpiSwiglu, pg8::StaticOrder, true>(ring, g, S, E);
        if (BOTH(7)) GRID_BAR();
    }
    const bool fuse_final = (F.G == 256);
    if (IN(8)) {
        pg8::Gemm g{(const bf16_t*)act, (const bf16_t*)Wdn8, DFF, DFF, DFF}; pg8::StaticOrder S; S.init(M, 1024, F.G, (int)blockIdx.x);
        const float asc = pg8::w8_inv_scale((unsigned)__builtin_amdgcn_readfirstlane((int)__hip_atomic_load((unsigned*)(ws + WS_CTL) + CTL_AMAX, __ATOMIC_RELAXED, __HIP_MEMORY_SCOPE_AGENT)), pg8::ACT_SHIFT);
        if (fuse_final) { pg8::EpiFinal E{x2b, out, ssq1, (unsigned*)(ws + WS_CTL) + 8192, g_final, asc};
            pg8::gemm_phase<pg8::EpiFinal, pg8::StaticOrder, true, true>(ring, g, S, E, F.wave); }
        else { pg8::EpiResidF32 E{x2b, out, ssq1, asc};
            pg8::gemm_phase<pg8::EpiResidF32, pg8::StaticOrder, true, true>(ring, g, S, E, F.wave);
            if (BOTH(8)) GRID_BAR(); }
    }
    if (IN(9) && !fuse_final) {
#ifdef DSA_FALLBACK_COUNT
        if (blockIdx.x == 0 && F.tid == 0 && __hip_atomic_load((unsigned*)(ws + WS_CTL) + 1024 + 64, __ATOMIC_RELAXED, __HIP_MEMORY_SCOPE_AGENT) > DSA_FALLBACK_COUNT) out[12345] = __builtin_nanf("");
#endif
#ifdef DSA_TOPK_CHECK
        if (blockIdx.x == 0 && F.tid == 0 && __hip_atomic_load((unsigned*)(ws + WS_CTL) + 1024, __ATOMIC_RELAXED, __HIP_MEMORY_SCOPE_AGENT) != 0u) out[12345] = __builtin_nanf("");
#endif
        int lane9; asm volatile("v_mbcnt_lo_u32_b32 %0, -1, 0\n\tv_mbcnt_hi_u32_b32 %0, -1, %0" : "=v"(lane9));
        for (int m = gw; m < M; m += NGW) {
            const float* pp = ssq1 + (size_t)m * 16; float s = 0.f;
#pragma unroll
            for (int q = 0; q < 4; ++q) { const f32x4 t = *(const f32x4*)(pp + 4 * q); s += (t.x + t.y) + (t.z + t.w); }
            const float rstd = rsqrtf(s * (1.f / 1024.f) + EPS);
            GAS f32x4* xr = (GAS f32x4*)(out + (size_t)m * D) + lane9;
#pragma unroll
            for (int j = 0; j < 4; ++j) { const f32x4 gg = *((const GAS f32x4*)g_final + lane9 + 64 * j); xr[64 * j] = xr[64 * j] * gg * rstd; }
        }
    }
#undef IN
#undef BOTH
}

extern "C" void kernel_launch(void* const* d_in, const int* in_sizes, int n_in, void* d_out, int out_size, void* d_ws, size_t ws_size, hipStream_t stream) {
    static int grid = 0;
    if (grid == 0) {
        if (n_in != 28 || ws_size < WS_NEED || out_size != M * D) { fprintf(stderr, "kernel_launch: unexpected problem (n_in %d ws %zu out %d)\n", n_in, ws_size, out_size); grid = -1; return; }
        int dev = 0, cus = 0, per_cu = 0;
        if (hipGetDevice(&dev) != hipSuccess || hipDeviceGetAttribute(&cus, hipDeviceAttributeMultiprocessorCount, dev) != hipSuccess) { grid = -1; return; }
        if (hipFuncSetAttribute((const void*)mega, hipFuncAttributeMaxDynamicSharedMemorySize, LDS_BYTES) != hipSuccess) { fprintf(stderr, "kernel_launch: hipFuncSetAttribute failed\n"); grid = -1; return; }
        if (hipOccupancyMaxActiveBlocksPerMultiprocessor(&per_cu, (const void*)mega, NWAVES * 64, LDS_BYTES) != hipSuccess || per_cu < 1) { fprintf(stderr, "kernel_launch: occupancy query says %d\n", per_cu); grid = -1; (void)hipGetLastError(); return; }
        grid = cus;
        if (grid < 64) { fprintf(stderr, "kernel_launch: needs >= 64 CUs\n"); grid = -1; return; }
    }
    if (grid < 0) return;
    unsigned char* ws = (unsigned char*)d_ws;
    (void)hipMemsetAsync(ws + WS_CTL, 0, CTL_ZERO_BYTES, stream);
    Args a{}; for (int i = 0; i < 28; ++i) a.in[i] = (const float*)d_in[i]; a.out = (float*)d_out; a.ws = ws;
    a.ph_lo = 0; a.ph_hi = 10; a.li = 0;
#ifdef DSA_PASSES
    a.pad = DSA_PASSES - 1;
#endif
    void* kargs[] = {&a};
    (void)hipLaunchCooperativeKernel((const void*)mega, dim3(grid), dim3(NWAVES * 64), kargs, LDS_BYTES, stream);
}
```

```cpp
#include <hip/hip_runtime.h>
#include <cstdio>
#include <cstdint>

typedef unsigned short bf16_t;
__device__ __forceinline__ float bf2f(bf16_t h) { return __uint_as_float(((unsigned)h) << 16); }
__device__ __forceinline__ bf16_t f2bf(float f) { unsigned u = __float_as_uint(f); return (bf16_t)((u + 0x7fffu + ((u >> 16) & 1u)) >> 16); }

constexpr int D = 1024, BATCH = 16, SEQ = 2048, M = BATCH * SEQ;
constexpr int PROJ_REF = 2512, PROJ = 2560;
constexpr int MEM_LEN = 256, MM = BATCH * MEM_LEN;
constexpr int DFF = 2816;
constexpr float EPS = 1e-6f;
constexpr float LOG2E = 1.4426950408889634f;
constexpr int C_DQ = 0, C_DK = 512, C_DV = 1024, C_DZ = 1536, C_CQ = 2048, C_CKV = 2304, C_KIX = 2432, C_WIX = 2496, C_DB = 2504, C_DA = 2508;
constexpr int MIXK = 1536;

constexpr size_t MiB = 1u << 20;
constexpr size_t WS_WIN = 0, WS_WKV = 5 * MiB, WS_WDSA = 9 * MiB, WS_WOUT = 10 * MiB, WS_WXQ = 13 * MiB, WS_WXO = 15 * MiB, WS_WGU = 17 * MiB, WS_WDN = 28 * MiB;
constexpr size_t WS_CTL = 34 * MiB, CTL_ZERO_BYTES = 256 * 1024;
constexpr size_t WS_ST = 35 * MiB;
constexpr size_t ST_RSTDX = 0, ST_CQSS = 128 * 1024  , ST_LPART = 640 * 1024  , ST_WIDX = 2688 * 1024  , ST_BETA = 3712 * 1024  , ST_G = 4224 * 1024  , ST_BIAS = 4736 * 1024;
constexpr size_t WS_MNB = 40 * MiB, WS_KX = 48 * MiB, WS_VT = 56 * MiB, WS_CKV = 64 * MiB, WS_KIDX = 72 * MiB;
constexpr size_t WS_SSQ = 76 * MiB;
constexpr size_t WS_PROJ = 80 * MiB;
constexpr size_t WS_XB = 240 * MiB;
constexpr size_t WS_QABS = 240 * MiB;
constexpr size_t WS_MIX = 336 * MiB;
constexpr size_t WS_X1B = 240 * MiB, WS_QX = 304 * MiB, WS_P = 368 * MiB, WS_OX = 432 * MiB, WS_X2B = 304 * MiB, WS_ACT = 80 * MiB;
constexpr size_t WS_W8 = 496 * MiB;
constexpr int CTL_AMAX = 1600;
constexpr size_t WS_NEED = 512 * MiB;

#define DPP_ADD(v, CTRL) ((v) + __int_as_float(__builtin_amdgcn_update_dpp(0, __float_as_int(v), (CTRL), 0xF, 0xF, true)))
__device__ __forceinline__ float wave_sum(float v) {
    v = DPP_ADD(v, 0xB1);
    v = DPP_ADD(v, 0x4E);
    v = DPP_ADD(v, 0x141);
    v = DPP_ADD(v, 0x140);
    const int b = __float_as_int(v);
    const float s0 = __int_as_float(__builtin_amdgcn_readlane(b, 0)), s1 = __int_as_float(__builtin_amdgcn_readlane(b, 16)), s2 = __int_as_float(__builtin_amdgcn_readlane(b, 32)), s3 = __int_as_float(__builtin_amdgcn_readlane(b, 48));
    return (s0 + s1) + (s2 + s3);
}
__device__ __forceinline__ int lane_now() { int l; asm volatile("v_mbcnt_lo_u32_b32 %0, -1, 0\n\tv_mbcnt_hi_u32_b32 %0, -1, %0" : "=v"(l)); return l; }
namespace pg8 {
#define PG8_LAS __attribute__((address_space(3)))
typedef short bf16x8 __attribute__((ext_vector_type(8)));
typedef float f32x4 __attribute__((ext_vector_type(4)));
typedef unsigned u32x4 __attribute__((ext_vector_type(4)));
typedef unsigned u32x2 __attribute__((ext_vector_type(2)));
typedef int i32x4 __attribute__((ext_vector_type(4)));
constexpr int BM = 256, BK = 64, HALF = 128, HTB = HALF * BK * 2  , STAGE_BYTES = 8 * HTB, NXCD = 8, WGM = 8;

__host__ __device__ __forceinline__ int lds_byte(int r, int c) { const int st = (r >> 4) * 2 + (c >> 5), rr = r & 15, cc = c & 31, ob = rr * 64 + cc * 2; return st * 1024 + (ob ^ (((ob >> 9) & 1) << 5)); }
__host__ __device__ __forceinline__ void stage_rc(int b, int& R, int& C) { const int st = b / 1024, sb = b % 1024, swz = sb ^ (((sb >> 9) & 1) << 5); R = (st >> 1) * 16 + swz / 64; C = (st & 1) * 32 + (swz % 64) / 2; }
__host__ __device__ __forceinline__ int perm32(int rho) { const int n = rho >> 4, i = rho & 15; return 8 * (i >> 2) + 4 * n + (i & 3); }

struct Unit { int pm, pn; long ao, bo; };
struct Gemm { const bf16_t* A; const bf16_t* Bt; int lda, ldb, K; };

struct StaticOrder {
    int nM, nN, nwg, G, c;
    __host__ __device__ __forceinline__ void init(int M_, int N_, int G_, int c_) { nM = M_ / BM; nN = N_ / BM; nwg = nM * nN; G = G_; c = c_; }
    __host__ __device__ __forceinline__ bool next(int i, Unit& u) const {
        const long L = (long)i * G + c; if (L >= nwg) return false;
        int wgid = (int)L; { const int q = nwg / NXCD, r = nwg % NXCD, xcd = wgid % NXCD, off = wgid / NXCD; wgid = (xcd < r ? xcd * (q + 1) : r * (q + 1) + (xcd - r) * q) + off; }
        const int nig = WGM * nN, gid = wgid / nig, fm = gid * WGM, gsz = (nM - fm) < WGM ? (nM - fm) : WGM;
        u.pm = fm + ((wgid % nig) % gsz); u.pn = (wgid % nig) / gsz; u.ao = 0; u.bo = 0; return true;
    }
};
struct OneUnit { Unit u; __host__ __device__ __forceinline__ bool next(int i, Unit& o) const { if (i) return false; o = u; return true; } };
struct TwoUnits { Unit u0, u1; int n; __host__ __device__ __forceinline__ bool next(int i, Unit& o) const { if (i >= n) return false; o = i ? u1 : u0; return true; } };

typedef float cvf32x2_t __attribute__((ext_vector_type(2))); typedef __bf16 cvbf16x2_t __attribute__((ext_vector_type(2)));
__device__ __forceinline__ unsigned cvt_pk_bf16(float lo, float hi) { cvf32x2_t v = {lo, hi}; return __builtin_bit_cast(unsigned, __builtin_convertvector(v, cvbf16x2_t)); }
__device__ __forceinline__ u32x4 pack8(const f32x4& a, const f32x4& b) { u32x4 w; w.x = cvt_pk_bf16(a[0], a[1]); w.y = cvt_pk_bf16(a[2], a[3]); w.z = cvt_pk_bf16(b[0], b[1]); w.w = cvt_pk_bf16(b[2], b[3]); return w; }
__device__ __forceinline__ unsigned pack4_fp8(float a, float b, float c, float d) {
    a = __builtin_amdgcn_fmed3f(a, -448.f, 448.f); b = __builtin_amdgcn_fmed3f(b, -448.f, 448.f); c = __builtin_amdgcn_fmed3f(c, -448.f, 448.f); d = __builtin_amdgcn_fmed3f(d, -448.f, 448.f);
    int w = 0; w = __builtin_amdgcn_cvt_pk_fp8_f32(a, b, w, false); w = __builtin_amdgcn_cvt_pk_fp8_f32(c, d, w, true); return (unsigned)w; }
__device__ __forceinline__ u32x2 pack8_fp8(const f32x4& a, const f32x4& b) { u32x2 w; w.x = pack4_fp8(a[0], a[1], a[2], a[3]); w.y = pack4_fp8(b[0], b[1], b[2], b[3]); return w; }
__device__ __forceinline__ float w8_scale(unsigned amax_bits) { const int e = (int)(amax_bits >> 23) - 127; return amax_bits ? __uint_as_float((unsigned)(127 + 6 - e) << 23) : 1.f; }
__device__ __forceinline__ float w8_inv_scale(unsigned amax_bits, int extra_shift) { const int e = (int)(amax_bits >> 23) - 127; return __uint_as_float((unsigned)(amax_bits ? 127 - 6 + e - extra_shift : 127 - extra_shift) << 23); }
__device__ __forceinline__ float dot4(const f32x4& a) { return (a[0] * a[0] + a[1] * a[1]) + (a[2] * a[2] + a[3] * a[3]); }
__device__ __forceinline__ float sum4(const f32x4& a) { return (a[0] + a[1]) + (a[2] + a[3]); }
__device__ __forceinline__ float lo_bf(unsigned w) { return __uint_as_float(w << 16); }
__device__ __forceinline__ float hi_bf(unsigned w) { return __uint_as_float(w & 0xffff0000u); }

typedef f32x4 Acc[2][2][4][2];
#define PG8_EPI_ROWS(...) _Pragma("unroll") for (int ai = 0; ai < 2; ++ai) _Pragma("unroll") for (int m = 0; m < 4; ++m) { const int rl = ai * HALF + wr * 64 + m * 16 + fr; __VA_ARGS__ }

struct EpiProj { static constexpr bool PERM = true;
    bf16_t* O; int ldc; const float* rs; float* cqss; int ssq_pn;
    __device__ __forceinline__ void operator()(const Acc& acc, const Unit& u, int wr, int wc, int fr, int fq) const {
        const int col0 = u.pn * BM + wc * 32 + 8 * fq; const bool doss = (u.pn == ssq_pn);
        PG8_EPI_ROWS( const int row = u.pm * BM + rl; const float r = rs ? rs[row] : 1.f; float ss = 0.f; bf16_t* rowp = O + (size_t)row * ldc + col0;
            _Pragma("unroll") for (int bj = 0; bj < 2; ++bj) { const f32x4 v0 = acc[ai][bj][m][0] * r, v1 = acc[ai][bj][m][1] * r; *(u32x4*)(rowp + bj * HALF) = pack8(v0, v1); ss += dot4(v0) + dot4(v1); }
            if (doss) { ss += __shfl_xor(ss, 16); ss += __shfl_xor(ss, 32); if (fq == 0) cqss[(size_t)row * 4 + wc] = ss; } )
    }
};
template <int NP> struct EpiNormScale { static constexpr bool PERM = true;
    bf16_t* O; int ldc; const float* part; float inv_dim; float ascale;
    __device__ __forceinline__ void operator()(const Acc& acc, const Unit& u, int wr, int wc, int fr, int fq) const {
        const int col0 = u.pn * BM + wc * 32 + 8 * fq;
        PG8_EPI_ROWS( const int row = u.pm * BM + rl; float s = 0.f;
            _Pragma("unroll") for (int q = 0; q < NP / 4; ++q) s += sum4(*(const f32x4*)(part + (size_t)row * NP + 4 * q));
            const float r = rsqrtf(s * inv_dim + EPS) * ascale; bf16_t* rowp = O + (size_t)row * ldc + col0;
            _Pragma("unroll") for (int bj = 0; bj < 2; ++bj) *(u32x4*)(rowp + bj * HALF) = pack8(acc[ai][bj][m][0] * r, acc[ai][bj][m][1] * r); )
    }
};
constexpr float X8_SCALE = 8.f; constexpr int X8_SHIFT = 3;
template <bool SRC16, bool X8 = false> struct EpiResid { static constexpr bool PERM = true;
    const float* src; const bf16_t* src16; bf16_t* xb; float* ssq; const float* rinv; unsigned char* x8; float ascale; int pad_;
    __device__ __forceinline__ void operator()(const Acc& acc, const Unit& u, int wr, int wc, int fr, int fq) const {
        const int col0 = u.pn * BM + wc * 32 + 8 * fq;
        PG8_EPI_ROWS( const size_t row = (size_t)u.pm * BM + rl; float ss = 0.f; const size_t off = row * 1024 + col0; const float rsc = (SRC16 && rinv) ? 1.f / rinv[row] : 1.f;
            _Pragma("unroll") for (int bj = 0; bj < 2; ++bj) { f32x4 s0, s1;
                if (SRC16) { const u32x4 w = *(const u32x4*)(src16 + off + bj * HALF); s0 = (f32x4){lo_bf(w.x), hi_bf(w.x), lo_bf(w.y), hi_bf(w.y)} * rsc; s1 = (f32x4){lo_bf(w.z), hi_bf(w.z), lo_bf(w.w), hi_bf(w.w)} * rsc; }
                else { s0 = *(const f32x4*)(src + off + bj * HALF); s1 = *(const f32x4*)(src + off + bj * HALF + 4); }
                const f32x4 v0 = s0 + acc[ai][bj][m][0] * ascale, v1 = s1 + acc[ai][bj][m][1] * ascale;
                *(u32x4*)(xb + off + bj * HALF) = pack8(v0, v1); ss += dot4(v0) + dot4(v1);
                if constexpr (X8) *(u32x2*)(x8 + off + bj * HALF) = pack8_fp8(v0 * X8_SCALE, v1 * X8_SCALE); }
            ss += __shfl_xor(ss, 16); ss += __shfl_xor(ss, 32); if (fq == 0) ssq[row * 16 + u.pn * 4 + wc] = ss; )
    }
};
struct EpiResidF32 { static constexpr bool PERM = true;
    const bf16_t* src16; float* dst; float* ssq; float ascale; int pad_;
    __device__ __forceinline__ void operator()(const Acc& acc, const Unit& u, int wr, int wc, int fr, int fq) const {
        const int col0 = u.pn * BM + wc * 32 + 8 * fq;
        PG8_EPI_ROWS( const size_t row = (size_t)u.pm * BM + rl; float ss = 0.f; const size_t off = row * 1024 + col0;
            _Pragma("unroll") for (int bj = 0; bj < 2; ++bj) { const u32x4 w = *(const u32x4*)(src16 + off + bj * HALF);
                const f32x4 v0 = (f32x4){lo_bf(w.x), hi_bf(w.x), lo_bf(w.y), hi_bf(w.y)} + acc[ai][bj][m][0] * ascale, v1 = (f32x4){lo_bf(w.z), hi_bf(w.z), lo_bf(w.w), hi_bf(w.w)} + acc[ai][bj][m][1] * ascale;
                *(f32x4*)(dst + off + bj * HALF) = v0; *(f32x4*)(dst + off + bj * HALF + 4) = v1; ss += dot4(v0) + dot4(v1); }
            ss += __shfl_xor(ss, 16); ss += __shfl_xor(ss, 32); if (fq == 0) ssq[row * 16 + u.pn * 4 + wc] = ss; )
    }
};
struct EpiFinal { static constexpr bool PERM = true;
    const bf16_t* src16; float* dst; float* part; unsigned* cnt; const float* gain; float ascale; int pad_;
    __device__ __forceinline__ void operator()(Acc& acc, const Unit& u, int wr, int wc, int fr, int fq) const {
        const int col0 = u.pn * BM + wc * 32 + 8 * fq; float asl = ascale; asm volatile("" : "+s"(asl));
        PG8_EPI_ROWS( const size_t row = (size_t)u.pm * BM + rl; float ss = 0.f; const size_t off = row * 1024 + col0;
            _Pragma("unroll") for (int bj = 0; bj < 2; ++bj) { const u32x4 w = *(const u32x4*)(src16 + off + bj * HALF); const f32x4 s0 = {lo_bf(w.x), hi_bf(w.x), lo_bf(w.y), hi_bf(w.y)}, s1 = {lo_bf(w.z), hi_bf(w.z), lo_bf(w.w), hi_bf(w.w)};
                acc[ai][bj][m][0] = acc[ai][bj][m][0] * asl + s0; acc[ai][bj][m][1] = acc[ai][bj][m][1] * asl + s1; ss += dot4(acc[ai][bj][m][0]) + dot4(acc[ai][bj][m][1]); }
            ss += __shfl_xor(ss, 16); ss += __shfl_xor(ss, 32);
            if (fq == 0) __hip_atomic_store(part + row * 16 + u.pn * 4 + wc, ss, __ATOMIC_RELAXED, __HIP_MEMORY_SCOPE_AGENT); )
        asm volatile("s_waitcnt vmcnt(0)" ::: "memory");
        unsigned* c = cnt + 64 * u.pm;
        if ((fr | fq) == 0) __hip_atomic_fetch_add(c, 1u, __ATOMIC_RELAXED, __HIP_MEMORY_SCOPE_AGENT);
        for (unsigned spins = 0; spins < (1u << 22); ++spins) { if ((unsigned)__builtin_amdgcn_readfirstlane(__hip_atomic_load(c, __ATOMIC_RELAXED, __HIP_MEMORY_SCOPE_AGENT)) >= 32u) break; __builtin_amdgcn_s_sleep(4); }
        __builtin_amdgcn_fence(__ATOMIC_ACQUIRE, "agent");
        f32x4 gv[2][2];
        _Pragma("unroll") for (int bj = 0; bj < 2; ++bj) { gv[bj][0] = *(const f32x4*)(gain + col0 + bj * HALF); gv[bj][1] = *(const f32x4*)(gain + col0 + bj * HALF + 4); }
        PG8_EPI_ROWS( const size_t row = (size_t)u.pm * BM + rl; float s = 0.f;
            _Pragma("unroll") for (int q = 0; q < 4; ++q) s += sum4(*(const f32x4*)(part + row * 16 + 4 * q));
            const float r = rsqrtf(s * (1.f / 1024.f) + EPS); const size_t off = row * 1024 + col0;
            _Pragma("unroll") for (int bj = 0; bj < 2; ++bj) { *(f32x4*)(dst + off + bj * HALF) = acc[ai][bj][m][0] * gv[bj][0] * r; *(f32x4*)(dst + off + bj * HALF + 4) = acc[ai][bj][m][1] * gv[bj][1] * r; } )
    }
};
struct EpiExpP { static constexpr bool PERM = true;
    bf16_t* Pb; float* lpart;
    __device__ __forceinline__ void operator()(const Acc& acc, const Unit& u, int wr, int wc, int fr, int fq) const {
        const int h = (int)(u.ao >> 9), rowbase = u.pm * BM, col0 = wc * 32 + 8 * fq; bf16_t* O = Pb + (size_t)rowbase * 1024 + h * 256;
        PG8_EPI_ROWS( float ss = 0.f; bf16_t* rowp = O + (size_t)rl * 1024 + col0;
            _Pragma("unroll") for (int bj = 0; bj < 2; ++bj) { f32x4 v0 = acc[ai][bj][m][0], v1 = acc[ai][bj][m][1];
                _Pragma("unroll") for (int e = 0; e < 4; ++e) { v0[e] = __builtin_amdgcn_exp2f(v0[e]); v1[e] = __builtin_amdgcn_exp2f(v1[e]); }
                const u32x4 w = pack8(v0, v1); *(u32x4*)(rowp + bj * HALF) = w;
                ss += (lo_bf(w.x) + hi_bf(w.x)) + (lo_bf(w.y) + hi_bf(w.y)) + (lo_bf(w.z) + hi_bf(w.z)) + (lo_bf(w.w) + hi_bf(w.w)); }
            ss += __shfl_xor(ss, 16); ss += __shfl_xor(ss, 32); if (fq == 0) lpart[(size_t)(rowbase + rl) * 16 + h * 4 + wc] = ss; )
    }
};
constexpr float OX_SCALE = 32.f; constexpr int OX_SHIFT = 5;
struct EpiPV { static constexpr bool PERM = true;
    unsigned char* Ob; const float* lpart;
    __device__ __forceinline__ void operator()(const Acc& acc, const Unit& u, int wr, int wc, int fr, int fq) const {
        const int h = u.pn, rowbase = u.pm * BM, col0 = wc * 32 + 8 * fq; unsigned char* O = Ob + (size_t)rowbase * 1024 + h * 256;
        PG8_EPI_ROWS( const float r = OX_SCALE / sum4(*(const f32x4*)(lpart + (size_t)(rowbase + rl) * 16 + h * 4)); unsigned char* rowp = O + (size_t)rl * 1024 + col0;
            _Pragma("unroll") for (int bj = 0; bj < 2; ++bj) *(u32x2*)(rowp + bj * HALF) = pack8_fp8(acc[ai][bj][m][0] * r, acc[ai][bj][m][1] * r); )
    }
};
constexpr float ACT_SCALE = 16.f; constexpr int ACT_SHIFT = 4;
struct EpiSwiglu { static constexpr bool PERM = true;
    unsigned char* act; const float* part;
    __device__ __forceinline__ void operator()(const Acc& acc, const Unit& u, int wr, int wc, int fr, int fq) const {
        const int col0 = u.pn * BM + wc * 32 + 8 * fq;
        PG8_EPI_ROWS( const size_t row = (size_t)u.pm * BM + rl; float s = 0.f;
            _Pragma("unroll") for (int q = 0; q < 4; ++q) s += sum4(*(const f32x4*)(part + row * 16 + 4 * q));
            const float r = rsqrtf(s * (1.f / 1024.f) + EPS); unsigned char* rowp = act + row * DFF + (col0 >> 1);
            _Pragma("unroll") for (int bj = 0; bj < 2; ++bj) { const f32x4 a = acc[ai][bj][m][0] * r, b = acc[ai][bj][m][1] * r;
                const float o0 = a[0] * __builtin_amdgcn_rcpf(1.f + __builtin_amdgcn_exp2f(-LOG2E * a[0])) * a[1], o1 = a[2] * __builtin_amdgcn_rcpf(1.f + __builtin_amdgcn_exp2f(-LOG2E * a[2])) * a[3];
                const float o2 = b[0] * __builtin_amdgcn_rcpf(1.f + __builtin_amdgcn_exp2f(-LOG2E * b[0])) * b[1], o3 = b[2] * __builtin_amdgcn_rcpf(1.f + __builtin_amdgcn_exp2f(-LOG2E * b[2])) * b[3];
                *(unsigned*)(rowp + bj * (HALF / 2)) = pack4_fp8(o0 * ACT_SCALE, o1 * ACT_SCALE, o2 * ACT_SCALE, o3 * ACT_SCALE); } )
    }
};

template <class Epi, class Sched, bool ALIGN_EPI, bool F8 = false>
__device__ __forceinline__ void gemm_phase(PG8_LAS unsigned char* lds, const Gemm g, const Sched& S, const Epi& E, int wave_id) {
    const int tid = wave_id * 64 + lane_now();
    const int wid = __builtin_amdgcn_readfirstlane(tid >> 6), lane = tid & 63, wr = wid >> 2, wc = wid & 3, fr = lane & 15, fq = lane >> 4;
    int Kop = g.K; asm volatile("" : "+s"(Kop));
    constexpr int ES = F8 ? 1 : 2;
    const int nt = Kop * ES / (BK * 2);
    unsigned voffA[2], voffB[2];
#pragma unroll
    for (int i = 0; i < 2; ++i) { int R, C; stage_rc(tid * 16 + i * 8192, R, C); const int Rb = Epi::PERM ? ((R & ~31) + perm32(R & 31)) : R;
        voffA[i] = (unsigned)(R * g.lda * ES + C * 2); voffB[i] = (unsigned)(Rb * g.ldb * ES + C * 2); }
    const size_t kstep = (size_t)(BK * 2);
    const size_t hstepA = (size_t)HALF * g.lda * ES, hstepB = (size_t)HALF * g.ldb * ES;
    const size_t tstepA = 2 * hstepA, tstepB = 2 * hstepB;
    const unsigned ldsw = (unsigned)wid * 1024u;
    const int aoff = lds_byte(wr * 64 + fr, fq * 8), boff = lds_byte(wc * 32 + fr, fq * 8);
#define PG8_SA(b, h) (((b) * 2 + (h)) * HTB)
#define PG8_SB(b, h) ((4 + (b) * 2 + (h)) * HTB)
#define PG8_STAGE(bufoff, gbase, voff, rs) do { _Pragma("unroll") for (int _i = 0; _i < 2; ++_i) { \
        if constexpr (F8) __builtin_amdgcn_raw_ptr_buffer_load_lds(rs, (PG8_LAS void*)(lds + (bufoff) + ldsw + _i * 8192), 16, (int)(voff)[_i], (int)(unsigned)(size_t)(gbase), 0, 0); \
        else __builtin_amdgcn_global_load_lds((const unsigned*)((const char*)(gbase) + (voff)[_i]), (PG8_LAS unsigned*)(lds + (bufoff) + ldsw + _i * 8192), 16, 0, 0); } } while (0)
#define PG8_LDA(dst, b, h) do { _Pragma("unroll") for (int m = 0; m < 4; ++m) _Pragma("unroll") for (int k = 0; k < 2; ++k) dst[m][k] = *(const PG8_LAS bf16x8*)(lds + PG8_SA(b, h) + aoff + m * 2048 + k * 1024); } while (0)
#define PG8_LDB(dst, b, h) do { _Pragma("unroll") for (int n = 0; n < 2; ++n) _Pragma("unroll") for (int k = 0; k < 2; ++k) dst[n][k] = *(const PG8_LAS bf16x8*)(lds + PG8_SB(b, h) + boff + n * 2048 + k * 1024); } while (0)
#define PG8_CAT8(x, y) __builtin_shufflevector(__builtin_bit_cast(i32x4, x), __builtin_bit_cast(i32x4, y), 0, 1, 2, 3, 4, 5, 6, 7)
#define PG8_MMA(ai, bj, At, Bt) do { __builtin_amdgcn_s_setprio(1); _Pragma("unroll") for (int m = 0; m < 4; ++m) _Pragma("unroll") for (int n = 0; n < 2; ++n) { \
        if constexpr (F8) acc[ai][bj][m][n] = __builtin_amdgcn_mfma_scale_f32_16x16x128_f8f6f4(PG8_CAT8(Bt[n][0], Bt[n][1]), PG8_CAT8(At[m][0], At[m][1]), acc[ai][bj][m][n], 0, 0, 0, 0, 0, 0); \
        else { _Pragma("unroll") for (int k = 0; k < 2; ++k) acc[ai][bj][m][n] = __builtin_amdgcn_mfma_f32_16x16x32_bf16(Bt[n][k], At[m][k], acc[ai][bj][m][n], 0, 0, 0); } } \
        __builtin_amdgcn_s_setprio(0); } while (0)
#define PG8_WAIT_V(n) asm volatile("s_waitcnt vmcnt(" #n ")" ::: "memory")
#define PG8_WAIT_L(n) asm volatile("s_waitcnt lgkmcnt(" #n ")" ::: "memory")
#define PG8_BAR __builtin_amdgcn_s_barrier()
#define PG8_SCHED __builtin_amdgcn_sched_barrier(0)
    Unit cur, nxt; int ui = 0;
    if (!S.next(0, cur)) return;
    Acc acc;
#pragma unroll
    for (int a = 0; a < 2; ++a)
#pragma unroll
        for (int b = 0; b < 2; ++b)
#pragma unroll
            for (int m = 0; m < 4; ++m)
#pragma unroll
                for (int n = 0; n < 2; ++n) acc[a][b][m][n] = (f32x4){0.f, 0.f, 0.f, 0.f};
    bf16x8 At[4][2], B0[2][2], B1[2][2];
    const __amdgpu_buffer_rsrc_t rsA = __builtin_amdgcn_make_buffer_rsrc((void*)g.A, 0, -1, 0x00020000), rsB = __builtin_amdgcn_make_buffer_rsrc((void*)g.Bt, 0, -1, 0x00020000);
    const char* const baseA = F8 ? (const char*)(size_t)0 : (const char*)g.A; const char* const baseB = F8 ? (const char*)(size_t)0 : (const char*)g.Bt;
    const char* cA = baseA + (size_t)cur.pm * tstepA + cur.ao; const char* cB = baseB + (size_t)cur.pn * tstepB + cur.bo;
    PG8_STAGE(PG8_SB(0, 0), cB, voffB, rsB); PG8_STAGE(PG8_SB(0, 1), cB + hstepB, voffB, rsB); PG8_STAGE(PG8_SA(0, 0), cA, voffA, rsA); PG8_STAGE(PG8_SA(0, 1), cA + hstepA, voffA, rsA);
    if (wr == 1) PG8_BAR;
    PG8_WAIT_V(2); PG8_BAR;
    PG8_STAGE(PG8_SB(1, 0), cB + kstep, voffB, rsB); PG8_STAGE(PG8_SA(1, 0), cA + kstep, voffA, rsA); PG8_STAGE(PG8_SB(1, 1), cB + hstepB + kstep, voffB, rsB);
    PG8_WAIT_V(6); PG8_BAR;
    for (;;) {
        const bool has_next = S.next(ui + 1, nxt);
        const char* nA = has_next ? baseA + (size_t)nxt.pm * tstepA + nxt.ao : cA; const char* nB = has_next ? baseB + (size_t)nxt.pn * tstepB + nxt.bo : cB;
        for (int t = 0; t < nt; t += 2) {
            const bool last = (t == nt - 2);
            const char* a1 = cA + (size_t)(t + 1) * kstep;
            const char* a2 = last ? nA : cA + (size_t)(t + 2) * kstep; const char* b2 = last ? nB : cB + (size_t)(t + 2) * kstep;
            const char* a3 = a2 + kstep; const char* b3 = b2 + kstep;
            PG8_LDB(B0, 0, 0); PG8_LDB(B1, 0, 1); PG8_SCHED; PG8_LDA(At, 0, 0); PG8_STAGE(PG8_SA(1, 1), a1 + hstepA, voffA, rsA);
            PG8_WAIT_V(8); PG8_WAIT_L(0); PG8_BAR; PG8_MMA(0, 0, At, B0); PG8_MMA(0, 1, At, B1); PG8_BAR; PG8_SCHED;
            PG8_LDA(At, 0, 1); PG8_STAGE(PG8_SB(0, 0), b2, voffB, rsB); PG8_STAGE(PG8_SB(0, 1), b2 + hstepB, voffB, rsB); PG8_STAGE(PG8_SA(0, 0), a2, voffA, rsA);
            PG8_WAIT_V(8); PG8_WAIT_L(0); PG8_BAR; PG8_MMA(1, 0, At, B0); PG8_MMA(1, 1, At, B1); PG8_BAR; PG8_SCHED;
            PG8_LDB(B0, 1, 0); PG8_LDB(B1, 1, 1); PG8_SCHED; PG8_LDA(At, 1, 0); PG8_STAGE(PG8_SA(0, 1), a2 + hstepA, voffA, rsA);
            PG8_WAIT_V(8); PG8_WAIT_L(0); PG8_BAR; PG8_MMA(0, 0, At, B0); PG8_MMA(0, 1, At, B1); PG8_BAR; PG8_SCHED;
            PG8_LDA(At, 1, 1); PG8_STAGE(PG8_SB(1, 0), b3, voffB, rsB); PG8_STAGE(PG8_SB(1, 1), b3 + hstepB, voffB, rsB); PG8_STAGE(PG8_SA(1, 0), a3, voffA, rsA);
            PG8_WAIT_V(8); PG8_WAIT_L(0); PG8_BAR; PG8_MMA(1, 0, At, B0); PG8_MMA(1, 1, At, B1); PG8_BAR; PG8_SCHED;
        }
        if constexpr (ALIGN_EPI) { if (wr == 0) PG8_BAR; }
        { int fr_e = fr, fq_e = fq;
          if constexpr (F8) { const int l_e = lane_now(); fr_e = l_e & 15; fq_e = l_e >> 4; }
          E(acc, cur, wr, wc, fr_e, fq_e); }
        if (!has_next) break;
#pragma unroll
        for (int a = 0; a < 2; ++a)
#pragma unroll
            for (int b = 0; b < 2; ++b)
#pragma unroll
                for (int m = 0; m < 4; ++m)
#pragma unroll
                    for (int n = 0; n < 2; ++n) acc[a][b][m][n] = (f32x4){0.f, 0.f, 0.f, 0.f};
        cur = nxt; cA = nA; cB = nB; ++ui;
        if constexpr (ALIGN_EPI) { if (wr == 1) PG8_BAR; }
    }
    PG8_WAIT_V(0);
    if constexpr (!ALIGN_EPI) { if (wr == 0) PG8_BAR; }
    PG8_BAR;
#undef PG8_SA
#undef PG8_SB
#undef PG8_STAGE
#undef PG8_LDA
#undef PG8_LDB
#undef PG8_MMA
#undef PG8_CAT8
#undef PG8_WAIT_V
#undef PG8_WAIT_L
#undef PG8_BAR
#undef PG8_SCHED
}
}
constexpr int NWAVES = 8;
constexpr int RING_BYTES = 131072;
constexpr int LDSCTL_OFF = RING_BYTES, MISC_OFF = LDSCTL_OFF + 320;
constexpr int LDS_BYTES = 147456;
#define GAS __attribute__((address_space(1)))
#define LAS __attribute__((address_space(3)))
typedef unsigned v4u __attribute__((ext_vector_type(4)));
typedef float f32x4 __attribute__((ext_vector_type(4)));
typedef GAS unsigned gu32;
#define RLX_AGENT __ATOMIC_RELAXED, __HIP_MEMORY_SCOPE_AGENT
#define LDS_WAIT() asm volatile("s_waitcnt lgkmcnt(0)" ::: "memory")
#define VM_WAIT() asm volatile("s_waitcnt vmcnt(0)" ::: "memory")
__device__ __forceinline__ unsigned pk2(float lo, float hi) { return (unsigned)f2bf(lo) | ((unsigned)f2bf(hi) << 16); }

#define XB_TMO      128
#define XB_XCNT(j)  (256  + 64 * (j))
#define XB_XSUB(j)  (1280 + 64 * (j))
#define XB_XGEN(j)  (2304 + 64 * (j))
#define XB_TOP      3328
#define XB_TOPGEN   3392
#define XCD_BAR_WORDS 3456
#define XB_SPIN_CAP (1u << 18)
__device__ __forceinline__ unsigned xb_ld(unsigned* p)              { return __hip_atomic_load(p, __ATOMIC_RELAXED, __HIP_MEMORY_SCOPE_AGENT); }
__device__ __forceinline__ unsigned xb_add(unsigned* p, unsigned v) { return __hip_atomic_fetch_add(p, v, __ATOMIC_RELAXED, __HIP_MEMORY_SCOPE_AGENT); }
__device__ __forceinline__ unsigned xb_xcc_id() { return (unsigned)__builtin_amdgcn_s_getreg((3 << 11) | 20) & 0xFu; }
#define XB_SPIN(cond, bar) do { unsigned _sp = 0; while (cond) { __builtin_amdgcn_s_sleep(1); \
    if ((++_sp & 255u) == 0u) { if (xb_ld(&(bar)[XB_TMO])) break; if (_sp > XB_SPIN_CAP) { atomicAdd(&(bar)[XB_TMO], 1u); break; } } } } while (0)
struct XcdBarrier { unsigned* bar; unsigned x; volatile LAS unsigned* st; };
__device__ __forceinline__ XcdBarrier xcd_barrier_post(unsigned* bar, volatile LAS unsigned* st) {
    XcdBarrier b; b.bar = bar; b.x = xb_xcc_id(); b.st = st;
    if (threadIdx.x == 0) (void)xb_add(&bar[XB_XCNT(b.x)], 1u);
    return b;
}
__device__ __forceinline__ void xcd_barrier_complete(unsigned* bar, unsigned x, unsigned& nloc, unsigned& nx) {
    const unsigned G = gridDim.x * gridDim.y * gridDim.z;
    unsigned sum, cnt, mine, sp = 0u;
    for (;;) {
        sum = 0u; cnt = 0u; mine = 0u;
#pragma unroll
        for (unsigned j = 0; j < 16; ++j) { const unsigned c = xb_ld(&bar[XB_XCNT(j)]); sum += c; cnt += (c > 0u) ? 1u : 0u; mine = (j == x) ? c : mine; }
        if (sum == G) break;
        __builtin_amdgcn_s_sleep(1);
        if ((++sp & 255u) == 0u) { if (xb_ld(&bar[XB_TMO])) break; if (sp > XB_SPIN_CAP) { atomicAdd(&bar[XB_TMO], 1u); break; } }
    }
    nloc = mine > 0u ? mine : 1u; nx = cnt > 0u ? cnt : 1u;
}
__device__ __forceinline__ void xcd_barrier(const XcdBarrier& b, int wave) {
    asm volatile("s_waitcnt vmcnt(0)" ::: "memory");
    __syncthreads();
    if (wave == 0 && lane_now() == 0) {
        unsigned* bar = b.bar;
        __builtin_amdgcn_s_waitcnt(0);
        unsigned nloc = b.st[0], nx = b.st[1];
        if (nloc == 0u) { xcd_barrier_complete(bar, b.x, nloc, nx); b.st[0] = nloc; b.st[1] = nx; }
        const unsigned old = xb_add(&bar[XB_XSUB(b.x)], 1u);
        const unsigned gen = old / nloc;
        if (old + 1u == (gen + 1u) * nloc) {
            __builtin_amdgcn_fence(__ATOMIC_RELEASE, "agent");
            asm volatile("s_waitcnt vmcnt(0)" ::: "memory");
            const unsigned og = xb_add(&bar[XB_TOP], 1u);
            const unsigned tg = og / nx;
            if (og + 1u == (tg + 1u) * nx) xb_add(&bar[XB_TOPGEN], 1u);
            else XB_SPIN(xb_ld(&bar[XB_TOPGEN]) == tg, bar);
            __builtin_amdgcn_fence(__ATOMIC_ACQUIRE, "agent");
            xb_add(&bar[XB_XGEN(b.x)], 1u);
            asm volatile("s_waitcnt vmcnt(0)" ::: "memory");
        } else {
            XB_SPIN(xb_ld(&bar[XB_XGEN(b.x)]) == gen, bar);
            __builtin_amdgcn_fence(__ATOMIC_ACQUIRE, "agent");
            asm volatile("s_waitcnt vmcnt(0)" ::: "memory");
        }
    }
    __syncthreads();
}

struct SrcWin { const float* w; const float* g;
    __device__ __forceinline__ float at(int k, int n) const {
        int src;
        if (n < 2048) src = n; else if (n < C_CKV) src = 2056 + (n - C_CQ); else if (n < C_KIX) src = 2312 + (n - C_CKV); else if (n < C_WIX) src = 2440 + (n - C_KIX);
        else if (n < C_DB) src = 2504 + (n - C_WIX); else if (n < C_DA) src = 2048 + (n - C_DB); else if (n < 2512) src = 2052 + (n - C_DA); else src = -1;
        return src >= 0 ? w[(size_t)k * PROJ_REF + src] * g[k] : 0.f; } };
struct SrcPlain { const float* w; int ld; const float* g; float cs;
    __device__ __forceinline__ float at(int k, int n) const { return w[(size_t)k * ld + n] * (g ? g[k] : 1.f) * cs; } };
struct SrcQidx { const float* w; const float* g;
    __device__ __forceinline__ float at(int k, int n) const { const int s = n >> 7, head = (n >> 4) & 7, r = n & 15; return w[(size_t)k * 512 + head * 64 + 16 * s + r] * g[k]; } };
struct SrcGU { const float* wg; const float* wu; const float* g;
    __device__ __forceinline__ float at(int k, int n) const { const size_t i = (size_t)k * DFF + (n >> 1); const float a = wg[i], b = wu[i]; return ((n & 1) ? b : a) * g[k]; } };
template <class Src> __device__ __forceinline__ void tr_item(const Src& S, int Nsz, bf16_t* WT, int ldo, int koff, LAS float* scr, int item, int lane, unsigned* amax = nullptr) {
    const int nblk = Nsz / 32, kb = item / nblk, nb = item % nblk, k0 = 64 * kb, n0 = 32 * nb;
    float t[32];
#pragma unroll
    for (int i = 0; i < 32; ++i) t[i] = S.at(k0 + 2 * i + (lane >> 5), n0 + (lane & 31));
    if (amax) { float mx = 0.f;
#pragma unroll
        for (int i = 0; i < 32; ++i) mx = fmaxf(mx, fabsf(t[i]));
#pragma unroll
        for (int o = 1; o < 64; o <<= 1) mx = fmaxf(mx, __shfl_xor(mx, o));
        if (lane == 0) (void)__hip_atomic_fetch_max(amax, __float_as_uint(mx), __ATOMIC_RELAXED, __HIP_MEMORY_SCOPE_AGENT); }
#pragma unroll
    for (int i = 0; i < 32; ++i) scr[(2 * i + (lane >> 5)) * 33 + (lane & 31)] = t[i];
    LDS_WAIT(); asm volatile("" ::: "memory");
    const int c = lane & 7;
#pragma unroll
    for (int j = 0; j < 4; ++j) { const int n = (lane >> 3) + 8 * j; const LAS float* s = scr + (8 * c) * 33 + n;
        v4u o; o.x = pk2(s[0 * 33], s[1 * 33]); o.y = pk2(s[2 * 33], s[3 * 33]); o.z = pk2(s[4 * 33], s[5 * 33]); o.w = pk2(s[6 * 33], s[7 * 33]);
        *(GAS v4u*)(WT + (size_t)(n0 + n) * ldo + koff + k0 + 8 * c) = o; }
    LDS_WAIT(); asm volatile("" ::: "memory");
}
__device__ __forceinline__ void heavy_item(const float* Ap, int lda, const float* Bp, int ldb, const float* cs, float cmul, int k0, int n0, int n0out, bf16_t* WT, int ldo, int koff, LAS float* scr, int lane) {
    LAS float* At = scr; LAS float* tt = scr + 2048;
#pragma unroll
    for (int i = 0; i < 8; ++i) { const int e = (i * 64 + lane) * 4, r = e >> 6, d = e & 63; *(LAS f32x4*)(At + e) = *(const GAS f32x4*)(Ap + (size_t)(k0 + r) * lda + d); }
    float bc[64];
#pragma unroll
    for (int d = 0; d < 64; ++d) bc[d] = Bp[(size_t)d * ldb + n0 + (lane & 31)];
    LDS_WAIT(); asm volatile("" ::: "memory");
#pragma unroll 2
    for (int i = 0; i < 16; ++i) { const int kk = 2 * i + (lane >> 5); const LAS f32x4* ar = (const LAS f32x4*)(At + kk * 64); float s0 = 0.f, s1 = 0.f;
#pragma unroll
        for (int q = 0; q < 16; q += 2) { const f32x4 a = ar[q], b2 = ar[q + 1]; s0 += a.x * bc[4 * q] + a.y * bc[4 * q + 1] + a.z * bc[4 * q + 2] + a.w * bc[4 * q + 3]; s1 += b2.x * bc[4 * q + 4] + b2.y * bc[4 * q + 5] + b2.z * bc[4 * q + 6] + b2.w * bc[4 * q + 7]; }
        tt[kk * 33 + (lane & 31)] = (s0 + s1) * (cs ? cs[k0 + kk] : 1.f) * cmul; }
    LDS_WAIT(); asm volatile("" ::: "memory");
    const int c = lane & 3;
#pragma unroll
    for (int j = 0; j < 2; ++j) { const int n = (lane >> 2) + 16 * j; const LAS float* s = tt + (8 * c) * 33 + n;
        v4u o; o.x = pk2(s[0 * 33], s[1 * 33]); o.y = pk2(s[2 * 33], s[3 * 33]); o.z = pk2(s[4 * 33], s[5 * 33]); o.w = pk2(s[6 * 33], s[7 * 33]);
        *(GAS v4u*)(WT + (size_t)(n0out + n) * ldo + koff + k0 + 8 * c) = o; }
    LDS_WAIT(); asm volatile("" ::: "memory");
}
template <int NR> __device__ __forceinline__ void row_prep(const float* xrow, const float* gain, bf16_t* orow, float* rstd_out, int lane) {
    f32x4 v[NR][4]; float s[NR];
#pragma unroll
    for (int r = 0; r < NR; ++r)
#pragma unroll
        for (int j = 0; j < 4; ++j) v[r][j] = *((const GAS f32x4*)(xrow + (size_t)r * 1024) + lane + 64 * j);
#pragma unroll
    for (int r = 0; r < NR; ++r) { float a = 0.f;
#pragma unroll
        for (int j = 0; j < 4; ++j) a += (v[r][j].x * v[r][j].x + v[r][j].y * v[r][j].y) + (v[r][j].z * v[r][j].z + v[r][j].w * v[r][j].w);
        s[r] = a; }
#pragma unroll
    for (int r = 0; r < NR; ++r) { const float rstd = rsqrtf(wave_sum(s[r]) * (1.f / 1024.f) + EPS);
        if (rstd_out && lane == 0) rstd_out[r] = rstd;
        GAS unsigned long long* o8 = (GAS unsigned long long*)(orow + (size_t)r * 1024) + lane;
#pragma unroll
        for (int j = 0; j < 4; ++j) { f32x4 a = v[r][j];
            if (gain) { const f32x4 gg = *((const GAS f32x4*)gain + lane + 64 * j); a = a * gg * rstd; } else a = a * rstd;
            o8[64 * j] = (unsigned long long)pk2(a.x, a.y) | ((unsigned long long)pk2(a.z, a.w) << 32); } }
}
__device__ __forceinline__ void cvt_w8(const bf16_t* src, unsigned char* dst, int n16, unsigned amax_bits, int gtid, int nthr) {
    const float sc = pg8::w8_scale(amax_bits);
    for (int i = gtid; i < n16; i += nthr) { const v4u a = *((const GAS v4u*)src + 2 * i), b = *((const GAS v4u*)src + 2 * i + 1); v4u o;
        o.x = pg8::pack4_fp8(pg8::lo_bf(a.x) * sc, pg8::hi_bf(a.x) * sc, pg8::lo_bf(a.y) * sc, pg8::hi_bf(a.y) * sc); o.y = pg8::pack4_fp8(pg8::lo_bf(a.z) * sc, pg8::hi_bf(a.z) * sc, pg8::lo_bf(a.w) * sc, pg8::hi_bf(a.w) * sc);
        o.z = pg8::pack4_fp8(pg8::lo_bf(b.x) * sc, pg8::hi_bf(b.x) * sc, pg8::lo_bf(b.y) * sc, pg8::hi_bf(b.y) * sc); o.w = pg8::pack4_fp8(pg8::lo_bf(b.z) * sc, pg8::hi_bf(b.z) * sc, pg8::lo_bf(b.w) * sc, pg8::hi_bf(b.w) * sc);
        *((GAS v4u*)dst + i) = o; }
}
namespace dsa {
typedef short bf16x8 __attribute__((ext_vector_type(8)));
typedef short s16x4 __attribute__((ext_vector_type(4)));
typedef float f32x16 __attribute__((ext_vector_type(16)));
typedef float f32x4 __attribute__((ext_vector_type(4)));
typedef unsigned u32x4 __attribute__((ext_vector_type(4)));
typedef unsigned short u16x4 __attribute__((ext_vector_type(4)));
constexpr int HIST_OFF = 145152;
constexpr int SC_OFF = 0, LIST_OFF = 132096, BIAS_OFF = 140288, W_OFF = 144416, NSEL_OFF = 144928, BMAX_OFF = 144992, CMAX_OFF = 145024;
__device__ __forceinline__ int xsw(int rr) { return rr < 8 ? 2 * rr : 2 * ((rr + 4) & 7) + 1; }
typedef float cvf32x2_t __attribute__((ext_vector_type(2))); typedef __bf16 cvbf16x2_t __attribute__((ext_vector_type(2)));
__device__ __forceinline__ unsigned cvtpk(float lo, float hi) { cvf32x2_t v = {lo, hi}; return __builtin_bit_cast(unsigned, __builtin_convertvector(v, cvbf16x2_t)); }
__device__ __forceinline__ int mbcnt64(unsigned long long m) { return (int)__builtin_amdgcn_mbcnt_hi((unsigned)(m >> 32), __builtin_amdgcn_mbcnt_lo((unsigned)m, 0u)); }

__device__ __forceinline__ void phase_init(LAS unsigned char* lds, const float* biastab, const float* kvg, int tid) {
    LAS float* bt = (LAS float*)(lds + BIAS_OFF);
    for (int i = tid; i < 129 * 8; i += 512) bt[i] = biastab[i];
    if (tid < 64) { float m = fmaxf(fabsf(kvg[tid]), fabsf(kvg[tid + 64]));
#pragma unroll
        for (int o = 1; o < 64; o <<= 1) m = fmaxf(m, __shfl_xor(m, o));
        if (tid == 0) *(LAS float*)(lds + CMAX_OFF) = m * 11.313708499f * 1.01f; }
    __syncthreads();
    if (tid < 8) { float m = -1e30f; for (int d = 0; d < 129; ++d) m = fmaxf(m, bt[d * 8 + tid]); ((LAS float*)(lds + BMAX_OFF))[tid] = m; }
    __syncthreads();
}

__device__ __forceinline__ void scores(LAS unsigned char* lds, int b, int q0, const bf16_t* qabs, const bf16_t* kidx, int wave, int lane) {
    const int hi = lane >> 5, c32 = lane & 31;
    const int a_ = c32 >> 3, hp = (c32 >> 2) & 1, r3 = c32 & 3;
    const int head = 4 * (a_ & 1) + r3, qt = 2 * hp + (a_ >> 1);
    bf16x8 A[4][4];
#pragma unroll
    for (int rt = 0; rt < 4; ++rt)
#pragma unroll
        for (int s = 0; s < 4; ++s) A[rt][s] = *(const bf16x8*)(qabs + (size_t)(b * 2048 + q0 + 4 * rt + qt) * 1536 + 1024 + s * 128 + head * 16 + 8 * hi);
    const int nkt = (q0 + 16 + 31) >> 5;
    LAS float* SC = (LAS float*)(lds + SC_OFF); const LAS float* Wl = (const LAS float*)(lds + W_OFF);
    bf16x8 Bn[4];
    { const bf16_t* kr = kidx + (size_t)(b * 2048 + (wave < nkt ? wave : 0) * 32 + c32) * 64 + 8 * hi;
#pragma unroll
      for (int s = 0; s < 4; ++s) Bn[s] = *(const bf16x8*)(kr + 16 * s); }
    __syncthreads();
    for (int kt = wave; kt < nkt; kt += 8) {
        bf16x8 B[4];
#pragma unroll
        for (int s = 0; s < 4; ++s) B[s] = Bn[s];
        if (kt + 8 < nkt) { const bf16_t* kr = kidx + (size_t)(b * 2048 + (kt + 8) * 32 + c32) * 64 + 8 * hi;
#pragma unroll
            for (int s = 0; s < 4; ++s) Bn[s] = *(const bf16x8*)(kr + 16 * s); }
        const int key = kt * 32 + c32;
        f32x16 acc[4];
#pragma unroll
        for (int rt = 0; rt < 4; ++rt) acc[rt] = (f32x16){0.f, 0.f, 0.f, 0.f, 0.f, 0.f, 0.f, 0.f, 0.f, 0.f, 0.f, 0.f, 0.f, 0.f, 0.f, 0.f};
#pragma unroll
        for (int s = 0; s < 4; ++s)
#pragma unroll
            for (int rt = 0; rt < 4; ++rt) acc[rt] = __builtin_amdgcn_mfma_f32_32x32x16_bf16(A[rt][s], B[s], acc[rt], 0, 0, 0);
        f32x4 wv[4][4];
#pragma unroll
        for (int rt = 0; rt < 4; ++rt) { const LAS f32x4* wp = (const LAS f32x4*)(Wl + (4 * rt + 2 * hi) * 8);
#pragma unroll
            for (int q = 0; q < 4; ++q) wv[rt][q] = wp[q]; }
#pragma unroll
        for (int rt = 0; rt < 4; ++rt) {
            const f32x4 w0 = wv[rt][0], w1 = wv[rt][1], w2 = wv[rt][2], w3 = wv[rt][3]; const f32x16 a = acc[rt];
            float s0 = w0.x * fmaxf(a[0], 0.f); s0 += w0.y * fmaxf(a[1], 0.f); s0 += w0.z * fmaxf(a[2], 0.f); s0 += w0.w * fmaxf(a[3], 0.f);
            s0 += w1.x * fmaxf(a[4], 0.f); s0 += w1.y * fmaxf(a[5], 0.f); s0 += w1.z * fmaxf(a[6], 0.f); s0 += w1.w * fmaxf(a[7], 0.f);
            float s1 = w2.x * fmaxf(a[8], 0.f); s1 += w2.y * fmaxf(a[9], 0.f); s1 += w2.z * fmaxf(a[10], 0.f); s1 += w2.w * fmaxf(a[11], 0.f);
            s1 += w3.x * fmaxf(a[12], 0.f); s1 += w3.y * fmaxf(a[13], 0.f); s1 += w3.z * fmaxf(a[14], 0.f); s1 += w3.w * fmaxf(a[15], 0.f);
            const int ql = 4 * rt + 2 * hi, t0 = q0 + ql;
            SC[ql * 2048 + key] = key <= t0 ? s0 : -INFINITY; SC[(ql + 1) * 2048 + key] = key <= t0 + 1 ? s1 : -INFINITY;
        }
    }
}
__device__ __forceinline__ void topk(LAS unsigned char* lds, int q0, int qq, int lane) {
    const int t = q0 + qq, n = t + 1;
    LAS unsigned short* list = (LAS unsigned short*)(lds + LIST_OFF) + qq * 256; LAS int* nsel = (LAS int*)(lds + NSEL_OFF);
    if (n <= 256) { for (int i = lane; i < 256; i += 64) list[i] = (unsigned short)(i < n ? i : t); if (lane == 0) nsel[qq] = n; return; }
    const int nk = ((q0 + 16 + 31) >> 5) * 32;
    const LAS float* SC = (const LAS float*)(lds + SC_OFF) + qq * 2048;
    unsigned u[32];
#pragma unroll
    for (int j = 0; j < 32; ++j) { const int key = lane + 64 * j; unsigned v = 0u; if (key < nk) { const unsigned bts = __float_as_uint(SC[key]); v = (bts & 0x80000000u) ? ~bts : (bts | 0x80000000u); } u[j] = v; }
    unsigned tau = 0u;
    for (int bit = 31; bit >= 0; --bit) {
        const unsigned cand = tau | (1u << bit); int cnt = 0;
#pragma unroll
        for (int j = 0; j < 32; ++j) cnt += __popcll(__ballot(u[j] >= cand));
        if (cnt >= 256) tau = cand;
        if (cnt == 256) break;
    }
    int cgt = 0;
#pragma unroll
    for (int j = 0; j < 32; ++j) cgt += __popcll(__ballot(u[j] > tau));
    const int r = 256 - cgt; int base = 0, eqb = 0;
#pragma unroll
    for (int j = 0; j < 32; ++j) {
        const bool gt = u[j] > tau, eq = u[j] == tau; const unsigned long long em = __ballot(eq);
        const bool sel = gt || (eq && (eqb + mbcnt64(em)) < r); const unsigned long long sm = __ballot(sel);
        if (sel) list[base + mbcnt64(sm)] = (unsigned short)(lane + 64 * j);
        base += __popcll(sm); eqb += __popcll(em);
    }
    if (lane == 0) nsel[qq] = 256;
}
__device__ __forceinline__ int wave_scan_incl(int x) {
    x += __builtin_amdgcn_update_dpp(0, x, 0x111, 0xF, 0xF, true);
    x += __builtin_amdgcn_update_dpp(0, x, 0x112, 0xF, 0xF, true);
    x += __builtin_amdgcn_update_dpp(0, x, 0x114, 0xF, 0xF, true);
    x += __builtin_amdgcn_update_dpp(0, x, 0x118, 0xF, 0xF, true);
    x += __builtin_amdgcn_update_dpp(0, x, 0x142, 0xA, 0xF, false);
    x += __builtin_amdgcn_update_dpp(0, x, 0x143, 0xC, 0xF, false);
    return x;
}
#define DPP_F32(v, CTRL) __int_as_float(__builtin_amdgcn_update_dpp(0, __float_as_int(v), (CTRL), 0xF, 0xF, true))
__device__ __forceinline__ float wave_max(float v) {
    v = fmaxf(v, DPP_F32(v, 0xB1)); v = fmaxf(v, DPP_F32(v, 0x4E)); v = fmaxf(v, DPP_F32(v, 0x141)); v = fmaxf(v, DPP_F32(v, 0x140));
    const int b = __float_as_int(v);
    return fmaxf(fmaxf(__int_as_float(__builtin_amdgcn_readlane(b, 0)), __int_as_float(__builtin_amdgcn_readlane(b, 16))), fmaxf(__int_as_float(__builtin_amdgcn_readlane(b, 32)), __int_as_float(__builtin_amdgcn_readlane(b, 48))));
}
__device__ __forceinline__ float wave_min(float v) {
    v = fminf(v, DPP_F32(v, 0xB1)); v = fminf(v, DPP_F32(v, 0x4E)); v = fminf(v, DPP_F32(v, 0x141)); v = fminf(v, DPP_F32(v, 0x140));
    const int b = __float_as_int(v);
    return fminf(fminf(__int_as_float(__builtin_amdgcn_readlane(b, 0)), __int_as_float(__builtin_amdgcn_readlane(b, 16))), fminf(__int_as_float(__builtin_amdgcn_readlane(b, 32)), __int_as_float(__builtin_amdgcn_readlane(b, 48))));
}
__device__ __forceinline__ void topk3(LAS unsigned char* lds, int q0, int qq, int wave, int lane, unsigned* dbg_flag_g = nullptr) {
    const int t = q0 + qq, n = t + 1;
    LAS unsigned short* list = (LAS unsigned short*)(lds + LIST_OFF) + qq * 256; LAS int* nsel = (LAS int*)(lds + NSEL_OFF);
    if (n <= 256) { for (int i = lane; i < 256; i += 64) list[i] = (unsigned short)(i < n ? i : t); if (lane == 0) nsel[qq] = n; return; }
    const int nk = ((q0 + 16 + 31) >> 5) * 32;
    LAS float* SC = (LAS float*)(lds + SC_OFF) + qq * 2048;
    LAS unsigned char* H = (LAS unsigned char*)SC;
    float v[32]; float hi = -INFINITY;
#pragma unroll
    for (int j = 0; j < 8; ++j) { f32x4 x = {-INFINITY, -INFINITY, -INFINITY, -INFINITY}; if (256 * j + 4 * lane < nk) x = *(const LAS f32x4*)(SC + 256 * j + 4 * lane);
#pragma unroll
        for (int e = 0; e < 4; ++e) { v[4 * j + e] = x[e]; hi = fmaxf(hi, x[e]); } }
    const float lo = wave_min(fminf(fminf(v[0], v[1]), fminf(v[2], v[3])));
    hi = wave_max(hi);
    const float sc = 8191.f / (hi - lo), off = __builtin_fmaf(-lo, sc, 0.25f);
    bool ok = (hi - lo) > 1e-30f && __builtin_fmaf(hi, sc, off) < 8191.9f && __builtin_fmaf(hi, sc, off) > 8190.f;
    unsigned B4 = 0u; int need2 = 0, ncand = 0;
    if (ok) {
        asm volatile("" ::: "memory");
        const u32x4 z4 = {0u, 0u, 0u, 0u};
#pragma unroll
        for (int j = 0; j < 8; ++j) *(LAS u32x4*)(H + 1024 * j + 16 * lane) = z4;
        asm volatile("" ::: "memory");
#pragma unroll
        for (int j = 0; j < 8; ++j) if (256 * j < nk) {
#pragma unroll
            for (int e = 0; e < 4; ++e) { const unsigned b = (unsigned)__builtin_fmaf(v[4 * j + e], sc, off); (void)__hip_atomic_fetch_add((LAS unsigned*)(H + (b & 0x1FFCu)), 1u, __ATOMIC_RELAXED, __HIP_MEMORY_SCOPE_WORKGROUP); } }
        asm volatile("" ::: "memory");
        const unsigned x4 = 4u * (unsigned)(lane & 31), hb = 128u * (unsigned)lane; int c[32];
#pragma unroll
        for (int k = 0; k < 32; ++k) c[k] = *(const LAS int*)(H + hb + (x4 ^ (4u * k)));
        __builtin_amdgcn_sched_barrier(0);
        int s = 0;
#pragma unroll
        for (int k = 0; k < 32; ++k) s += c[k];
        const int incl = wave_scan_incl(s), tot = __builtin_amdgcn_readlane(incl, 63), suf = tot - incl + s;
        const unsigned long long m = __ballot(suf >= 256); const int L = 63 - __builtin_clzll(m);
        const int aboveL = (L < 63) ? __builtin_amdgcn_readlane(suf, (L + 1) & 63) : 0; const int need1 = 256 - aboveL;
        const int cj = lane < 32 ? *(const LAS int*)(H + 128 * L + 4 * lane) : 0;
        const int incl2 = wave_scan_incl(cj), tot2 = __builtin_amdgcn_readlane(incl2, 63), suf2 = tot2 - incl2 + cj;
        const unsigned long long m2 = __ballot(lane < 32 && suf2 >= need1); const int J = 63 - __builtin_clzll(m2);
        const int above2 = (J < 31) ? __builtin_amdgcn_readlane(suf2, (J + 1) & 63) : 0; need2 = need1 - above2; ncand = __builtin_amdgcn_readlane(cj, J);
        B4 = (unsigned)(32 * L + J) * 4u;
        ok = (m != 0ull) && (m2 != 0ull) && (B4 > 0u) && (ncand <= 64);
    }
#ifdef DSA_FALLBACK_COUNT
    if (!ok && lane == 0) atomicAdd(dbg_flag_g + 64, 1u);
#endif
    if (!ok) {
        asm volatile("" ::: "memory");
#pragma unroll
        for (int j = 0; j < 8; ++j) if (256 * j + 4 * lane < nk) *(LAS f32x4*)(SC + 256 * j + 4 * lane) = (f32x4){v[4 * j], v[4 * j + 1], v[4 * j + 2], v[4 * j + 3]};
        asm volatile("" ::: "memory");
        topk(lds, q0, qq, lane); return; }
    LAS float* cv = (LAS float*)list; LAS unsigned short* ck = list + 128;
    int base = 0;
#pragma unroll
    for (int j = 0; j < 8; ++j) if (256 * j < nk) {
        bool isc[4];
#pragma unroll
        for (int e = 0; e < 4; ++e) { const unsigned b = (unsigned)__builtin_fmaf(v[4 * j + e], sc, off); isc[e] = (b & 0x1FFCu) == B4; }
        if (__ballot(isc[0] || isc[1] || isc[2] || isc[3])) {
#pragma unroll
            for (int e = 0; e < 4; ++e) { const unsigned long long cm = __ballot(isc[e]);
                if (isc[e]) { const int pos = base + mbcnt64(cm); cv[pos] = v[4 * j + e]; ck[pos] = (unsigned short)(256 * j + 4 * lane + e); } base += __popcll(cm); } } }
    const float myv = lane < ncand ? cv[lane] : -INFINITY; const int myk = lane < ncand ? (int)ck[lane] : 0x7fffffff; int rank = 0;
    for (int k = 0; k < ncand; ++k) { const float vk = __int_as_float(__builtin_amdgcn_readlane(__float_as_int(myv), k)); const int kk = __builtin_amdgcn_readlane(myk, k); rank += (vk > myv || (vk == myv && kk < myk)) ? 1 : 0; }
    const unsigned long long lm = __ballot(lane < ncand && rank == need2 - 1); const int ll = (int)__builtin_ctzll(lm);
    const float tauv = __int_as_float(__builtin_amdgcn_readlane(__float_as_int(myv), ll)); const int tauk = __builtin_amdgcn_readlane(myk, ll);
    int cnt = 0;
#pragma unroll
    for (int j = 0; j < 8; ++j) if (256 * j < nk) {
#pragma unroll
      for (int e = 0; e < 4; ++e) cnt += (v[4 * j + e] > tauv) ? 1 : 0; }
    const int incl3 = wave_scan_incl(cnt), ngt = __builtin_amdgcn_readlane(incl3, 63);
    LAS unsigned short* lp = list + (incl3 - cnt); LAS unsigned short* const dp = (LAS unsigned short*)(lds + HIST_OFF) + wave * 64 + lane;
#pragma unroll
    for (int j = 0; j < 8; ++j) if (256 * j < nk) {
#pragma unroll
      for (int e = 0; e < 4; ++e) { const bool sel = v[4 * j + e] > tauv; LAS unsigned short* p = sel ? lp : dp; *p = (unsigned short)(256 * j + 4 * lane + e); lp += sel ? 1 : 0; } }
    const bool csel = lane < ncand && myv == tauv && myk <= tauk; const unsigned long long sm = __ballot(csel);
    if (csel) list[ngt + mbcnt64(sm)] = (unsigned short)myk;
    if (lane == 0) nsel[qq] = 256;
#ifdef DSA_S2_RESTORE
    asm volatile("" ::: "memory");
#pragma unroll
    for (int j = 0; j < 8; ++j) if (256 * j + 4 * lane < nk) *(LAS f32x4*)(SC + 256 * j + 4 * lane) = (f32x4){v[4 * j], v[4 * j + 1], v[4 * j + 2], v[4 * j + 3]};
    asm volatile("" ::: "memory");
#endif
}
__device__ __forceinline__ void attend2(LAS unsigned char* lds, int b, int q0, int wave, int lane, const bf16_t* qabs, const bf16_t* ckv, bf16_t* mix) {
    const int r16 = lane & 15, g = lane >> 4;
    LAS unsigned char* buf0 = lds + wave * 16384; LAS unsigned char* buf1 = buf0 + 8192;
    const LAS unsigned short* listw = (const LAS unsigned short*)(lds + LIST_OFF) + (2 * wave) * 256;
    const LAS float* biasT = (const LAS float*)(lds + BIAS_OFF);
    const int n0 = ((const LAS int*)(lds + NSEL_OFF))[2 * wave], n1 = ((const LAS int*)(lds + NSEL_OFF))[2 * wave + 1];
    const int ns0 = (n0 + 31) >> 5, total = ns0 + ((n1 + 31) >> 5);
    const float cmax = *(const LAS float*)(lds + CMAX_OFF), bmax = ((const LAS float*)(lds + BMAX_OFF))[r16 & 7];
    const int xr = xsw(r16);
    const int q4 = r16 >> 2, p4 = r16 & 3; const int rra = 4 * g + q4, rrb = 16 + 4 * g + q4; const int xa = xsw(rra & 15), xb = xsw(rrb & 15);
    int t = 0, n = 0; size_t row = 0; const LAS unsigned short* list = listw; bf16x8 QB[4]; float Mh = 0.f, lsum = 0.f; f32x4 O[8];
    u32x4 X[8], Y[8];
#define DSA_LOAD(ST, kk) do { if ((kk) < total) { const int sel_ = (kk) >= ns0 ? 1 : 0; const LAS unsigned short* lp_ = listw + sel_ * 256 + ((kk) - (sel_ ? ns0 : 0)) * 32; \
        _Pragma("unroll") for (int i_ = 0; i_ < 8; ++i_) { const int rr_ = 4 * i_ + g; const int idx_ = lp_[rr_]; ST[i_] = *(const u32x4*)(ckv + ((size_t)b * 2048 + idx_) * 128 + (r16 ^ xsw(rr_ & 15)) * 8); } } } while (0)
#define DSA_WRITE(ST, bufp) do { _Pragma("unroll") for (int i_ = 0; i_ < 8; ++i_) *(LAS u32x4*)((bufp) + (4 * i_ + g) * 256 + r16 * 16) = ST[i_]; } while (0)
#define DSA_INIT(qq_) do { t = q0 + (qq_); row = (size_t)b * 2048 + t; n = ((qq_) & 1) ? n1 : n0; list = listw + ((qq_) & 1) * 256; float qn2_ = 0.f; \
        _Pragma("unroll") for (int s_ = 0; s_ < 4; ++s_) { bf16x8 v_ = {0, 0, 0, 0, 0, 0, 0, 0}; if (r16 < 8) v_ = *(const bf16x8*)(qabs + row * 1536 + s_ * 256 + r16 * 32 + 8 * g); QB[s_] = v_; \
            _Pragma("unroll") for (int e_ = 0; e_ < 8; ++e_) { const float f_ = bf2f((bf16_t)v_[e_]); qn2_ += f_ * f_; } } \
        qn2_ += __shfl_xor(qn2_, 16); qn2_ += __shfl_xor(qn2_, 32); Mh = sqrtf(qn2_) * cmax + bmax; lsum = 0.f; \
        _Pragma("unroll") for (int dt_ = 0; dt_ < 8; ++dt_) O[dt_] = (f32x4){0.f, 0.f, 0.f, 0.f}; } while (0)
#define DSA_FINAL() do { float l_ = lsum; l_ += __shfl_xor(l_, 16); l_ += __shfl_xor(l_, 32); const float linv_ = 1.f / l_; \
        _Pragma("unroll") for (int e_ = 0; e_ < 4; ++e_) { const int hrow_ = (4 * g + e_) & 7; const float inv_ = __shfl(linv_, hrow_); \
            if (g < 2) { _Pragma("unroll") for (int dt_ = 0; dt_ < 8; ++dt_) mix[row * MIXK + 512 + hrow_ * 128 + 16 * dt_ + r16] = f2bf(O[dt_][e_] * inv_); } } } while (0)
#define DSA_COMPUTE(kk, buf) do { if ((kk) == ns0) { DSA_FINAL(); DSA_INIT(2 * wave + 1); } const int step = (kk) >= ns0 ? (kk) - ns0 : (kk); \
          \
        bf16x8 af_[2][4]; \
        _Pragma("unroll") for (int G = 0; G < 2; ++G) _Pragma("unroll") for (int s = 0; s < 4; ++s) af_[G][s] = *(const LAS bf16x8*)((buf) + (16 * G + r16) * 256 + (((4 * s + g) ^ xr) * 16)); \
        const int pb0_ = step * 32 + 4 * g; const u16x4 ida_ = *(const LAS u16x4*)(list + pb0_), idb_ = *(const LAS u16x4*)(list + pb0_ + 16); \
        s16x4 tlo_[8], thi_[8]; \
        _Pragma("unroll") for (int dt = 0; dt < 8; ++dt) { const int ch = 2 * dt + (p4 >> 1); \
            tlo_[dt] = __builtin_bit_cast(s16x4, __builtin_amdgcn_ds_read_tr16_b64_v4i16((LAS s16x4*)((buf) + rra * 256 + ((ch ^ xa) * 16) + 8 * (p4 & 1)))); \
            thi_[dt] = __builtin_bit_cast(s16x4, __builtin_amdgcn_ds_read_tr16_b64_v4i16((LAS s16x4*)((buf) + rrb * 256 + ((ch ^ xb) * 16) + 8 * (p4 & 1)))); } \
        float bz_[2][4]; \
        _Pragma("unroll") for (int e = 0; e < 4; ++e) { int d0_ = t - (int)ida_[e]; d0_ = d0_ < 128 ? d0_ : 128; d0_ = d0_ < 0 ? 0 : d0_; int d1_ = t - (int)idb_[e]; d1_ = d1_ < 128 ? d1_ : 128; d1_ = d1_ < 0 ? 0 : d1_; \
            bz_[0][e] = biasT[d0_ * 8 + (r16 & 7)]; bz_[1][e] = biasT[d1_ * 8 + (r16 & 7)]; } \
        f32x4 S_[2]; \
        _Pragma("unroll") for (int G = 0; G < 2; ++G) { f32x4 acc = {0.f, 0.f, 0.f, 0.f}; \
            _Pragma("unroll") for (int s = 0; s < 4; ++s) acc = __builtin_amdgcn_mfma_f32_16x16x32_bf16(af_[G][s], QB[s], acc, 0, 0, 0); \
            S_[G] = acc; } \
        float P_[2][4]; \
        _Pragma("unroll") for (int G = 0; G < 2; ++G) _Pragma("unroll") for (int e = 0; e < 4; ++e) { const float lg = S_[G][e] + bz_[G][e] - Mh; \
                const float pv = (pb0_ + 16 * G + e < n) ? __builtin_amdgcn_exp2f(lg) : 0.f; lsum += pv; P_[G][e] = pv; } \
        u32x4 pw; pw.x = cvtpk(P_[0][0], P_[0][1]); pw.y = cvtpk(P_[0][2], P_[0][3]); pw.z = cvtpk(P_[1][0], P_[1][1]); pw.w = cvtpk(P_[1][2], P_[1][3]); \
        const bf16x8 PA = __builtin_bit_cast(bf16x8, pw); \
        _Pragma("unroll") for (int dt = 0; dt < 8; ++dt) { const bf16x8 vb = {tlo_[dt][0], tlo_[dt][1], tlo_[dt][2], tlo_[dt][3], thi_[dt][0], thi_[dt][1], thi_[dt][2], thi_[dt][3]}; \
            O[dt] = __builtin_amdgcn_mfma_f32_16x16x32_bf16(PA, vb, O[dt], 0, 0, 0); } } while (0)
    DSA_LOAD(X, 0); DSA_LOAD(Y, 1);
    __syncthreads();
    DSA_INIT(2 * wave);
    DSA_WRITE(X, buf0); DSA_LOAD(X, 2);
    if (1 < total) { DSA_WRITE(Y, buf1); DSA_LOAD(Y, 3); }
    for (int k = 0; k < total; k += 2) {
        DSA_COMPUTE(k, buf0);
        if (k + 2 < total) { DSA_WRITE(X, buf0); DSA_LOAD(X, k + 4); }
        if (k + 1 < total) { DSA_COMPUTE(k + 1, buf1); if (k + 3 < total) { DSA_WRITE(Y, buf1); DSA_LOAD(Y, k + 5); } }
    }
    DSA_FINAL();
#undef DSA_LOAD
#undef DSA_WRITE
#undef DSA_INIT
#undef DSA_FINAL
#undef DSA_COMPUTE
}
__device__ __forceinline__ void unit(LAS unsigned char* lds, int b, int q0, int tid, int wave, int lane, const bf16_t* qabs, const bf16_t* ckv, const bf16_t* kidx, const float* widx, bf16_t* mix, unsigned* dbg_flag) {
    asm volatile("" : "+v"(tid));
    lane = tid & 63;
    if (tid < 128) ((LAS float*)(lds + W_OFF))[tid] = widx[(size_t)(b * 2048 + q0) * 8 + tid];
#ifndef DSA_REP_S1
#define DSA_REP_S1 1
#define DSA_REP_S2 1
#define DSA_REP_S3 1
#endif
    if (q0 + 16 > 256) { for (int rp = 0; rp < DSA_REP_S1; ++rp) { scores(lds, b, q0, qabs, kidx, wave, lane); __syncthreads(); } }
    else __syncthreads();
    asm volatile("" : "+v"(tid)); lane = tid & 63;
#ifdef DSA_TOPK_CHECK
    for (int e2 = 0; e2 < 2; ++e2) { const int qq = 2 * wave + e2;
        topk(lds, q0, qq, lane); const LAS unsigned short* lw = (const LAS unsigned short*)(lds + LIST_OFF) + qq * 256; const int ns = ((const LAS int*)(lds + NSEL_OFF))[qq];
        unsigned h1 = 0, h2 = 0; for (int i = lane; i < ns; i += 64) { const unsigned x = lw[i]; h1 += x; h2 += x * x; }
        topk3(lds, q0, qq, wave, lane); const int ns2 = ((const LAS int*)(lds + NSEL_OFF))[qq];
        unsigned g1 = 0, g2 = 0; for (int i = lane; i < ns2; i += 64) { const unsigned x = lw[i]; g1 += x; g2 += x * x; }
#pragma unroll
        for (int o = 1; o < 64; o <<= 1) { h1 += __shfl_xor(h1, o); h2 += __shfl_xor(h2, o); g1 += __shfl_xor(g1, o); g2 += __shfl_xor(g2, o); }
        if (lane == 0 && (h1 != g1 || h2 != g2 || ns != ns2)) atomicAdd(dbg_flag, 1u); }
#else
    for (int rp = 0; rp < DSA_REP_S2; ++rp) { topk3(lds, q0, 2 * wave, wave, lane, dbg_flag); topk3(lds, q0, 2 * wave + 1, wave, lane, dbg_flag); }
#endif
    asm volatile("" : "+v"(tid)); lane = tid & 63;
    for (int rp = 0; rp < DSA_REP_S3; ++rp) { attend2(lds, b, q0, wave, lane, qabs, ckv, mix); __syncthreads(); }
}
}
#ifndef DN_REP_E
#define DN_REP_E 1
#define DN_REP_T 1
#endif
namespace dn {
typedef short bf16x8 __attribute__((ext_vector_type(8)));
typedef short s16x4 __attribute__((ext_vector_type(4)));
typedef float f32x4 __attribute__((ext_vector_type(4)));
typedef float f32x2 __attribute__((ext_vector_type(2)));
typedef unsigned u32x4 __attribute__((ext_vector_type(4)));
typedef unsigned u32x2 __attribute__((ext_vector_type(2)));
constexpr int CWL = 132096;
constexpr int QS = 0, KS = 17408, WB = 17408, KGT = 34816, VBT = 52224, KBT = 69632, LF = 87040, TB = 103680, XF = 112896, OF = 87040, QKB = 120832, GC = 130048, BT = 130304;
constexpr int QSTR = 272, TSTR = 136, LSTR = 65, TBSTR = 144, OSTR = 132;
typedef float cvf32x2_t __attribute__((ext_vector_type(2))); typedef __bf16 cvbf16x2_t __attribute__((ext_vector_type(2)));
__device__ __forceinline__ unsigned cvtpk(float lo, float hi) { cvf32x2_t v = {lo, hi}; return __builtin_bit_cast(unsigned, __builtin_convertvector(v, cvbf16x2_t)); }
__device__ __forceinline__ bf16x8 pack2(const f32x4& a, const f32x4& b) { u32x4 w; w.x = cvtpk(a[0], a[1]); w.y = cvtpk(a[2], a[3]); w.z = cvtpk(b[0], b[1]); w.w = cvtpk(b[2], b[3]); return __builtin_bit_cast(bf16x8, w); }
__device__ __forceinline__ bf16x8 frag_perm(const LAS unsigned char* rowp, int s, int g) {
    const u32x2 lo = *(const LAS u32x2*)(rowp + (32 * s + 4 * g) * 2), hi = *(const LAS u32x2*)(rowp + (32 * s + 16 + 4 * g) * 2);
    u32x4 w; w.x = lo.x; w.y = lo.y; w.z = hi.x; w.w = hi.y; return __builtin_bit_cast(bf16x8, w); }
__device__ __forceinline__ bf16x8 frag_nat8(const LAS unsigned char* rowp, int s, int g) {
    const u32x2 lo = *(const LAS u32x2*)(rowp + (32 * s + 8 * g) * 2), hi = *(const LAS u32x2*)(rowp + (32 * s + 8 * g + 4) * 2);
    u32x4 w; w.x = lo.x; w.y = lo.y; w.z = hi.x; w.w = hi.y; return __builtin_bit_cast(bf16x8, w); }
__device__ __forceinline__ float silu(float x) { return x * __builtin_amdgcn_rcpf(1.f + __builtin_amdgcn_exp2f(-LOG2E * x)); }
__device__ __forceinline__ float ex(float x) { return __builtin_amdgcn_exp2f(LOG2E * x); }

__device__ __forceinline__ void run(LAS unsigned char* lds0, int b, int h, const bf16_t* proj, const float* conv_w, const float* beta, const float* gdec, const float* gn, bf16_t* mix, int tid, int wave, int lane) {
    const int r16c = lane & 15, gc = lane >> 4;
    LAS float* cwL = (LAS float*)(lds0 + CWL);
    if (wave == 0) {
#pragma unroll
        for (int p = 0; p < 3; ++p)
#pragma unroll
            for (int e = 0; e < 2; ++e)
#pragma unroll
                for (int j = 0; j < 4; ++j) cwL[((p * 2 + e) * 4 + j) * 64 + lane] = conv_w[j * 1536 + p * 512 + h * 128 + 2 * lane + e];
    }
    __syncthreads();
    const float gn0 = gn[2 * lane], gn1 = gn[2 * lane + 1];
    f32x4 S[8];
#pragma unroll
    for (int i = 0; i < 8; ++i) S[i] = (f32x4){0.f, 0.f, 0.f, 0.f};
    const bf16_t* pbase = proj + h * 128 + 2 * lane;
    unsigned xq[11][3]; float gnext, bnext;
#define DN_LOAD_CHUNK(cn) do { const size_t Rn = (size_t)b * 2048 + 64 * (cn); \
        _Pragma("unroll") for (int a = 0; a < 11; ++a) { const int tt = 64 * (cn) + 8 * wave - 3 + a; \
            _Pragma("unroll") for (int p_ = 0; p_ < 3; ++p_) xq[a][p_] = (tt >= 0) ? *(const unsigned*)(pbase + (Rn + 8 * wave - 3 + a) * PROJ + p_ * 512) : 0u; } \
        gnext = gdec[(Rn + lane) * 4 + h]; bnext = beta[(Rn + lane) * 4 + h]; } while (0)
    DN_LOAD_CHUNK(0);
    for (int c = 0; c < 32; ++c) {
        const size_t R0 = (size_t)b * 2048 + 64 * c;
        int zoff = 0; asm volatile("" : "+v"(zoff));
        LAS unsigned char* lds = lds0 + zoff; const int r16 = r16c + zoff, g = gc + zoff;
        LAS float* Lf = (LAS float*)(lds + LF); LAS float* gcumL = (LAS float*)(lds + GC); LAS float* betaL = (LAS float*)(lds + BT);
        float gcum = gnext;
#pragma unroll
        for (int o = 1; o < 64; o <<= 1) { const float t = __shfl_up(gcum, o); if (lane >= o) gcum += t; }
        const float gl = __int_as_float(__builtin_amdgcn_readlane(__float_as_int(gcum), 63));
        const float bv = bnext;
        if (wave == 0) { gcumL[lane] = gcum; betaL[lane] = bv; }
        for (int rpE = 0; rpE < DN_REP_E; ++rpE) {
            float cw[3][2][4];
#pragma unroll
            for (int p = 0; p < 3; ++p)
#pragma unroll
                for (int e = 0; e < 2; ++e)
#pragma unroll
                    for (int j = 0; j < 4; ++j) cw[p][e][j] = cwL[((p * 2 + e) * 4 + j) * 64 + lane];
            float xw[3][3][2];
#pragma unroll
            for (int a = 0; a < 3; ++a)
#pragma unroll
                for (int p = 0; p < 3; ++p) { xw[a][p][0] = __uint_as_float(xq[a][p] << 16); xw[a][p][1] = __uint_as_float(xq[a][p] & 0xffff0000u); }
#pragma unroll
            for (int i = 0; i < 8; ++i) {
                const int r = 8 * wave + i; float x0[3][2], sv[3][2];
#pragma unroll
                for (int p = 0; p < 3; ++p) { x0[p][0] = __uint_as_float(xq[3 + i][p] << 16); x0[p][1] = __uint_as_float(xq[3 + i][p] & 0xffff0000u); }
#pragma unroll
                for (int p = 0; p < 3; ++p)
#pragma unroll
                    for (int e = 0; e < 2; ++e) { const float s = cw[p][e][0] * xw[0][p][e] + cw[p][e][1] * xw[1][p][e] + cw[p][e][2] * xw[2][p][e] + cw[p][e][3] * x0[p][e]; sv[p][e] = silu(s); }
                const float rq = rsqrtf(wave_sum(sv[0][0] * sv[0][0] + sv[0][1] * sv[0][1]) + EPS) * 0.08838834764831845f;
                const float rk = rsqrtf(wave_sum(sv[1][0] * sv[1][0] + sv[1][1] * sv[1][1]) + EPS);
                const float gr = __int_as_float(__builtin_amdgcn_readlane(__float_as_int(gcum), r)), br = __int_as_float(__builtin_amdgcn_readlane(__float_as_int(bv), r));
                const float eg = ex(gr), ekl = ex(gl - gr);
                const float k0 = sv[1][0] * rk, k1 = sv[1][1] * rk;
                *(LAS unsigned*)(lds + QS + r * QSTR + 4 * lane) = cvtpk(sv[0][0] * rq, sv[0][1] * rq);
                *(LAS unsigned*)(lds + KS + r * QSTR + 4 * lane) = cvtpk(k0, k1);
                const unsigned kg = cvtpk(k0 * ekl, k1 * ekl), kb = cvtpk(k0 * br * eg, k1 * br * eg), vb = cvtpk(sv[2][0] * br, sv[2][1] * br);
                *(LAS unsigned short*)(lds + KGT + (2 * lane) * TSTR + 2 * r) = (unsigned short)kg; *(LAS unsigned short*)(lds + KGT + (2 * lane + 1) * TSTR + 2 * r) = (unsigned short)(kg >> 16);
                *(LAS unsigned short*)(lds + KBT + (2 * lane) * TSTR + 2 * r) = (unsigned short)kb; *(LAS unsigned short*)(lds + KBT + (2 * lane + 1) * TSTR + 2 * r) = (unsigned short)(kb >> 16);
                *(LAS unsigned short*)(lds + VBT + (2 * lane) * TSTR + 2 * r) = (unsigned short)vb; *(LAS unsigned short*)(lds + VBT + (2 * lane + 1) * TSTR + 2 * r) = (unsigned short)(vb >> 16);
#pragma unroll
                for (int p = 0; p < 3; ++p)
#pragma unroll
                    for (int e = 0; e < 2; ++e) { xw[0][p][e] = xw[1][p][e]; xw[1][p][e] = xw[2][p][e]; xw[2][p][e] = x0[p][e]; }
            }
        }
        __syncthreads();
        for (int rpT = 0; rpT < DN_REP_T; ++rpT) {
        {
            const int ti = wave & 3, sel = wave >> 2;
            const LAS unsigned char* Ab = lds + (sel ? QS : KS) + (16 * ti + r16) * QSTR;
            bf16x8 A[4];
#pragma unroll
            for (int s = 0; s < 4; ++s) A[s] = *(const LAS bf16x8*)(Ab + (32 * s + 8 * g) * 2);
            const f32x4 gi4 = *(const LAS f32x4*)(gcumL + 16 * ti + 4 * g), bi4 = *(const LAS f32x4*)(betaL + 16 * ti + 4 * g);
#pragma unroll
            for (int tj = 0; tj < 4; ++tj) {
                f32x4 acc = {0.f, 0.f, 0.f, 0.f};
                if (tj <= ti) {
                    const LAS unsigned char* Bb = lds + KS + (16 * tj + r16) * QSTR; bf16x8 Bf[4];
#pragma unroll
                    for (int s = 0; s < 4; ++s) Bf[s] = *(const LAS bf16x8*)(Bb + (32 * s + 8 * g) * 2);
#pragma unroll
                    for (int s = 0; s < 4; ++s) acc = __builtin_amdgcn_mfma_f32_16x16x32_bf16(A[s], Bf[s], acc, 0, 0, 0);
                }
                const float gj = gcumL[16 * tj + r16]; const int j = 16 * tj + r16;
#pragma unroll
                for (int e = 0; e < 4; ++e) { const int i = 16 * ti + 4 * g + e; const float dec = ex(fminf(gi4[e] - gj, 0.f));
                    if (sel == 0) { const float lv = (i > j) ? bi4[e] * acc[e] * dec : 0.f;
                        if (tj == ti) Lf[i * LSTR + j] = lv; else if (tj < ti) *(LAS unsigned short*)(lds + TB + i * TBSTR + 2 * j) = f2bf(lv); }
                    else *(LAS unsigned short*)(lds + QKB + i * TBSTR + 2 * j) = f2bf((i >= j) ? acc[e] * dec : 0.f); }
            }
        }
        __syncthreads();
        if (wave == 0) {
            const LAS float* Nb = Lf + (16 * g) * LSTR + 16 * g; float x[16]; int rc = r16; asm volatile("" : "+v"(rc));
            float na[55], nb2[65];
            { int q = 0;
#pragma unroll
              for (int r = 1; r <= 10; ++r)
#pragma unroll
                  for (int j = 0; j < r; ++j) na[q++] = Nb[r * LSTR + j]; }
            { int q = 0;
#pragma unroll
              for (int r = 11; r <= 15; ++r)
#pragma unroll
                  for (int j = 0; j < r; ++j) nb2[q++] = Nb[r * LSTR + j]; }
            x[0] = (0 == rc) ? 1.f : 0.f;
            { int q = 0;
#pragma unroll
              for (int r = 1; r <= 10; ++r) { float s = (r == rc) ? 1.f : 0.f;
#pragma unroll
                  for (int j = 0; j < r; ++j) s -= na[q++] * x[j];
                  x[r] = s; } }
            { int q = 0;
#pragma unroll
              for (int r = 11; r <= 15; ++r) { float s = (r == rc) ? 1.f : 0.f;
#pragma unroll
                  for (int j = 0; j < r; ++j) s -= nb2[q++] * x[j];
                  x[r] = s; } }
#pragma unroll
            for (int r = 0; r < 16; ++r) *(LAS unsigned short*)(lds + TB + (16 * g + r) * TBSTR + 2 * (16 * g + r16)) = f2bf(x[r]);
        }
        __syncthreads();
        }
        f32x4 U[4];
        {
            const LAS unsigned char* tl = lds + TB;
#define DN_A1(b_, k_) ({ const u32x2 lo_ = *(const LAS u32x2*)(tl + (16 * (b_) + r16) * TBSTR + (16 * (k_) + 4 * g) * 2); u32x4 w_; w_.x = lo_.x; w_.y = lo_.y; w_.z = 0u; w_.w = 0u; __builtin_bit_cast(bf16x8, w_); })
#define DN_A2(b_, k0_, k1_) ({ const u32x2 lo_ = *(const LAS u32x2*)(tl + (16 * (b_) + r16) * TBSTR + (16 * (k0_) + 4 * g) * 2), hi_ = *(const LAS u32x2*)(tl + (16 * (b_) + r16) * TBSTR + (16 * (k1_) + 4 * g) * 2); \
            u32x4 w_; w_.x = lo_.x; w_.y = lo_.y; w_.z = hi_.x; w_.w = hi_.y; __builtin_bit_cast(bf16x8, w_); })
            const bf16x8 aD0 = DN_A1(0, 0), aL10 = DN_A1(1, 0), aD1 = DN_A1(1, 1), aL2 = DN_A2(2, 0, 1), aD2 = DN_A1(2, 2), aL3a = DN_A2(3, 0, 1), aL3b = DN_A1(3, 2), aD3 = DN_A1(3, 3);
            const f32x4 z4 = {0.f, 0.f, 0.f, 0.f};
#pragma unroll
            for (int which = 0; which < 2; ++which) {
                const LAS unsigned char* rp = lds + (which ? KBT : VBT) + (16 * wave + r16) * TSTR;
                f32x4 R[4];
#pragma unroll
                for (int b4 = 0; b4 < 4; ++b4) { const u32x2 w = *(const LAS u32x2*)(rp + (16 * b4 + 4 * g) * 2);
                    R[b4] = (f32x4){__uint_as_float(w.x << 16), __uint_as_float(w.x & 0xffff0000u), __uint_as_float(w.y << 16), __uint_as_float(w.y & 0xffff0000u)}; }
                f32x4 X0 = __builtin_amdgcn_mfma_f32_16x16x32_bf16(aD0, pack2(R[0], z4), z4, 0, 0, 0);
                f32x4 Y = __builtin_amdgcn_mfma_f32_16x16x32_bf16(aL10, pack2(X0, z4), z4, 0, 0, 0);
                f32x4 X1 = __builtin_amdgcn_mfma_f32_16x16x32_bf16(aD1, pack2(R[1] - Y, z4), z4, 0, 0, 0);
                const bf16x8 b01 = pack2(X0, X1);
                Y = __builtin_amdgcn_mfma_f32_16x16x32_bf16(aL2, b01, z4, 0, 0, 0);
                f32x4 X2 = __builtin_amdgcn_mfma_f32_16x16x32_bf16(aD2, pack2(R[2] - Y, z4), z4, 0, 0, 0);
                Y = __builtin_amdgcn_mfma_f32_16x16x32_bf16(aL3a, b01, z4, 0, 0, 0);
                Y = __builtin_amdgcn_mfma_f32_16x16x32_bf16(aL3b, pack2(X2, z4), Y, 0, 0, 0);
                f32x4 X3 = __builtin_amdgcn_mfma_f32_16x16x32_bf16(aD3, pack2(R[3] - Y, z4), z4, 0, 0, 0);
                if (which == 0) { U[0] = X0; U[1] = X1; U[2] = X2; U[3] = X3; }
                else { const f32x4 Xs[4] = {X0, X1, X2, X3};
#pragma unroll
                    for (int ti = 0; ti < 4; ++ti)
#pragma unroll
                        for (int e = 0; e < 4; ++e) *(LAS unsigned short*)(lds + WB + (16 * ti + 4 * g + e) * QSTR + (16 * wave + r16) * 2) = f2bf(Xs[ti][e]); }
            }
#undef DN_A1
#undef DN_A2
        }
        __syncthreads();
        if (c + 1 < 32) DN_LOAD_CHUNK(c + 1);
        unsigned dzq[8];
#pragma unroll
        for (int i = 0; i < 8; ++i) dzq[i] = *(const unsigned*)(proj + (R0 + 8 * wave + i) * PROJ + C_DZ + h * 128 + 2 * lane);
        {
            bf16x8 Sb[4];
#pragma unroll
            for (int s = 0; s < 4; ++s) Sb[s] = pack2(S[2 * s], S[2 * s + 1]);
            f32x4 Vn[4], Oa[4];
#pragma unroll
            for (int ti = 0; ti < 4; ++ti) {
                const LAS unsigned char* wp = lds + WB + (16 * ti + r16) * QSTR; const LAS unsigned char* qp = lds + QS + (16 * ti + r16) * QSTR;
                bf16x8 wf[4], qf[4];
#pragma unroll
                for (int s = 0; s < 4; ++s) { wf[s] = frag_perm(wp, s, g); qf[s] = frag_perm(qp, s, g); }
                const f32x4 gi4 = *(const LAS f32x4*)(gcumL + 16 * ti + 4 * g);
                f32x4 ws = {0.f, 0.f, 0.f, 0.f}, qs = {0.f, 0.f, 0.f, 0.f};
#pragma unroll
                for (int s = 0; s < 4; ++s) { ws = __builtin_amdgcn_mfma_f32_16x16x32_bf16(wf[s], Sb[s], ws, 0, 0, 0); qs = __builtin_amdgcn_mfma_f32_16x16x32_bf16(qf[s], Sb[s], qs, 0, 0, 0); }
                Vn[ti] = U[ti] - ws;
#pragma unroll
                for (int e = 0; e < 4; ++e) qs[e] *= ex(gi4[e]);
                Oa[ti] = qs;
            }
            bf16x8 Vb[2];
#pragma unroll
            for (int s = 0; s < 2; ++s) Vb[s] = pack2(Vn[2 * s], Vn[2 * s + 1]);
            { bf16x8 kf[4][2];
#pragma unroll
              for (int ti = 0; ti < 4; ++ti) { const LAS unsigned char* kp = lds + QKB + (16 * ti + r16) * TBSTR; kf[ti][0] = frag_perm(kp, 0, g); kf[ti][1] = frag_perm(kp, 1, g); }
#pragma unroll
              for (int ti = 0; ti < 4; ++ti)
#pragma unroll
                  for (int s = 0; s < 2; ++s) Oa[ti] = __builtin_amdgcn_mfma_f32_16x16x32_bf16(kf[ti][s], Vb[s], Oa[ti], 0, 0, 0); }
            const float egl = ex(gl);
#pragma unroll
            for (int half = 0; half < 2; ++half) { bf16x8 kf[4][2];
#pragma unroll
                for (int q = 0; q < 4; ++q) { const LAS unsigned char* kp = lds + KGT + (16 * (4 * half + q) + r16) * TSTR; kf[q][0] = frag_perm(kp, 0, g); kf[q][1] = frag_perm(kp, 1, g); }
#pragma unroll
                for (int q = 0; q < 4; ++q) { f32x4 sa = S[4 * half + q] * egl;
#pragma unroll
                    for (int s = 0; s < 2; ++s) sa = __builtin_amdgcn_mfma_f32_16x16x32_bf16(kf[q][s], Vb[s], sa, 0, 0, 0);
                    S[4 * half + q] = sa; } }
            LAS float* Of = (LAS float*)(lds + OF);
#pragma unroll
            for (int ti = 0; ti < 4; ++ti)
#pragma unroll
                for (int e = 0; e < 4; ++e) Of[(16 * ti + 4 * g + e) * OSTR + 16 * wave + r16] = Oa[ti][e];
        }
        __syncthreads();
        {
            const LAS float* Of = (const LAS float*)(lds + OF);
#pragma unroll
            for (int i = 0; i < 8; ++i) { const int r = 8 * wave + i; const f32x2 o = *(const LAS f32x2*)(Of + r * OSTR + 2 * lane);
                const float rstd = rsqrtf(wave_sum(o.x * o.x + o.y * o.y) * (1.f / 128.f) + EPS);
                const float z0 = __uint_as_float(dzq[i] << 16), z1 = __uint_as_float(dzq[i] & 0xffff0000u);
                *(unsigned*)(mix + (R0 + r) * MIXK + h * 128 + 2 * lane) = cvtpk(o.x * rstd * gn0 * silu(z0), o.y * rstd * gn1 * silu(z1)); }
        }
    }
}
#undef DN_LOAD_CHUNK
}
struct Args { const float* in[28]; float* out; unsigned char* ws; int ph_lo, ph_hi, li, pad; };
struct Frame {
    LAS unsigned char* lds; volatile LAS unsigned* MISC; int tid, lane, wave, G, vcu;
};
template <int NR> __device__ __forceinline__ void dsa_prep_rows(int row0, int lane, const bf16_t* proj, const float* kvg, const float* lng, const float* lnb, const float* a_log, const float* dt_bias,
                                             bf16_t* ckv, bf16_t* kidx, float* widx, float* beta, float* gdec) {
    unsigned cv[NR]; unsigned short kv[NR], sm[NR];
#pragma unroll
    for (int r = 0; r < NR; ++r) { const bf16_t* pr = proj + (size_t)(row0 + r) * PROJ; cv[r] = *(const unsigned*)(pr + C_CKV + lane * 2); kv[r] = pr[C_KIX + lane]; sm[r] = pr[C_WIX + (lane & 15)]; }
    const float g0 = kvg[lane * 2], g1 = kvg[lane * 2 + 1], lg = lng[lane], lb = lnb[lane], al = a_log[lane & 3], dtb = dt_bias[lane & 3];
#pragma unroll
    for (int r = 0; r < NR; ++r) { const int row = row0 + r;
        { const float a = __uint_as_float(cv[r] << 16), b = __uint_as_float(cv[r] & 0xffff0000u);
          const float rs = rsqrtf(wave_sum(a * a + b * b) * (1.f / 128.f) + EPS); *(unsigned*)(ckv + (size_t)row * 128 + lane * 2) = pk2(a * rs * g0, b * rs * g1); }
        { const float a = bf2f(kv[r]); const float mu = wave_sum(a) * (1.f / 64.f); const float xc = a - mu; const float rs = rsqrtf(wave_sum(xc * xc) * (1.f / 64.f) + EPS);
          kidx[(size_t)row * 64 + lane] = f2bf(xc * rs * lg + lb); }
        const float sv = bf2f(sm[r]);
        if (lane < 8) widx[(size_t)row * 8 + lane] = sv * 0.04419417382415922f;
        else if (lane < 12) beta[(size_t)row * 4 + (lane - 8)] = 1.f / (1.f + __expf(-sv));
        else if (lane < 16) { const float xx = sv + dtb; const float sp = xx > 20.f ? xx : log1pf(__expf(xx)); gdec[(size_t)row * 4 + (lane - 12)] = -__expf(al) * sp; }
    }
}

__global__ void __launch_bounds__(NWAVES * 64, 2) mega(Args args) {
    extern __shared__ __attribute__((aligned(16))) unsigned char lds_raw[];
    Frame F;
    F.lds = (LAS unsigned char*)lds_raw;
    F.MISC = (volatile LAS unsigned*)(F.lds + MISC_OFF);
    F.tid = threadIdx.x; F.lane = F.tid & 63; F.wave = __builtin_amdgcn_readfirstlane(F.tid >> 6);
    F.G = gridDim.x; { const int bx = blockIdx.x; F.vcu = (F.G % 8 == 0) ? (bx % 8) * (F.G / 8) + bx / 8 : bx; }
    unsigned char* ws = args.ws;
    const float* x = args.in[0]; const float* mem = args.in[1]; const float* g_mix = args.in[2]; const float* w_in = args.in[3];
    const float* conv_w = args.in[4]; const float* a_log = args.in[5]; const float* dt_bias = args.in[6];
    const float* dn_norm_g = args.in[7]; const float* q_norm_g = args.in[8]; const float* kv_norm_g = args.in[9]; const float* w_uq = args.in[10]; const float* w_uk = args.in[11];
    const float* w_uv = args.in[12]; const float* w_qidx = args.in[13]; const float* kidx_ln_g = args.in[14]; const float* kidx_ln_b = args.in[15];
    const float* rel_bias = args.in[16]; const float* w_out = args.in[17]; const float* g_xattn = args.in[18]; const float* g_mem = args.in[19];
    const float* w_xq = args.in[20]; const float* w_xkv = args.in[21]; const float* w_xo = args.in[22]; const float* g_ffn = args.in[23];
    const float* w_gate = args.in[24]; const float* w_up = args.in[25]; const float* w_down = args.in[26]; const float* g_final = args.in[27];
    float* out = args.out;
    bf16_t* Win_t = (bf16_t*)(ws + WS_WIN); bf16_t* Wkv_t = (bf16_t*)(ws + WS_WKV); bf16_t* Wdsa_t = (bf16_t*)(ws + WS_WDSA); bf16_t* Wout_t = (bf16_t*)(ws + WS_WOUT);
    bf16_t* Wxq_t = (bf16_t*)(ws + WS_WXQ); bf16_t* Wxo_t = (bf16_t*)(ws + WS_WXO); bf16_t* Wgu_t = (bf16_t*)(ws + WS_WGU); bf16_t* Wdn_t = (bf16_t*)(ws + WS_WDN);
    unsigned char* stt = ws + WS_ST;
    float* rstdx = (float*)(stt + ST_RSTDX); float* cqss = (float*)(stt + ST_CQSS); float* lpart = (float*)(stt + ST_LPART);
    float* widx = (float*)(stt + ST_WIDX); float* beta = (float*)(stt + ST_BETA); float* gdec = (float*)(stt + ST_G); float* biastab = (float*)(stt + ST_BIAS);
    bf16_t* mnb = (bf16_t*)(ws + WS_MNB); bf16_t* kx = (bf16_t*)(ws + WS_KX); bf16_t* vT = (bf16_t*)(ws + WS_VT); bf16_t* ckv = (bf16_t*)(ws + WS_CKV); bf16_t* kidx = (bf16_t*)(ws + WS_KIDX);
    float* ssq1 = (float*)(ws + WS_SSQ); float* ssq2 = ssq1 + (size_t)M * 16;
    bf16_t* proj = (bf16_t*)(ws + WS_PROJ); bf16_t* mix = (bf16_t*)(ws + WS_MIX); bf16_t* xb = (bf16_t*)(ws + WS_XB); bf16_t* qabs = (bf16_t*)out;
    bf16_t* x1b = (bf16_t*)(ws + WS_X1B); bf16_t* qx = (bf16_t*)(ws + WS_QX); bf16_t* Pb = (bf16_t*)(ws + WS_P); bf16_t* ox = (bf16_t*)(ws + WS_OX); bf16_t* x2b = (bf16_t*)(ws + WS_X2B); unsigned char* act = ws + WS_ACT; unsigned char* Wdn8 = ws + WS_W8; unsigned char* Wxq8 = ws + WS_W8 + 3 * MiB; unsigned char* Wxo8 = ws + WS_W8 + 4 * MiB;
    unsigned char* x1f8 = (unsigned char*)out;
    unsigned char* ox8 = ws + WS_OX;

    for (int u = F.tid; u < (LDS_BYTES - LDSCTL_OFF) / 4; u += NWAVES * 64) ((LAS unsigned*)(F.lds + LDSCTL_OFF))[u] = 0u;
    __syncthreads();
    XcdBarrier bar = xcd_barrier_post((unsigned*)(ws + WS_CTL) + 4096 + args.li * XCD_BAR_WORDS, F.MISC + 8);
#define GRID_BAR() xcd_barrier(bar, F.wave)
    const int lo = args.ph_lo, hi = args.ph_hi;
#ifdef ONLY_PHASE
#define IN(k) ((k) == ONLY_PHASE && lo <= (k) && (k) < hi)
#else
#define IN(k) (lo <= (k) && (k) < hi)
#endif
#define BOTH(k) (IN(k) && IN((k) + 1))
    const int gw = F.vcu * NWAVES + F.wave, NGW = F.G * NWAVES;
    PG8_LAS unsigned char* ring = (PG8_LAS unsigned char*)F.lds;

    if (IN(0)) {
        LAS float* scr = (LAS float*)(F.lds + F.wave * 16384);
        constexpr int I_OB = 32 * 32, I_QA = 8 * 32, I_QI = 4 * 16, I_IN = 16 * 80, I_KV = 16 * 64, I_XQ = 16 * 32, I_XO = 16 * 32, I_GU = 16 * 176, I_DN = 44 * 32, I_OA = 8 * 32;
        constexpr int NITEMS = I_OB + I_QA + I_QI + I_IN + I_KV + I_XQ + I_XO + I_GU + I_DN + I_OA;
        for (int it = gw; it < NITEMS; it += NGW) {
            int r = it;
            if (r < I_OB) { const int kb = r >> 5, nb = r & 31, k0 = 32 * kb, h = k0 >> 7;
                heavy_item(w_uv, 64, w_out + (size_t)(512 + h * 64) * 1024, 1024, nullptr, 1.f, k0, 32 * nb, 32 * nb, Wout_t, MIXK, 512, scr, F.lane); continue; } r -= I_OB;
            if (r < I_QA) { const int kb = r >> 5, nb = r & 31, n0 = 32 * nb, h = n0 >> 7;
                heavy_item(w_uq + h * 64, 512, w_uk + (size_t)(h * 64) * 128 - h * 128, 128, q_norm_g, 0.125f * LOG2E, 32 * kb, n0, ((n0 >> 5) & 3) * 256 + h * 32, Wdsa_t, 256, 0, scr, F.lane); continue; }   r -= I_QA;
            if (r < I_QI) { tr_item(SrcQidx{w_qidx, q_norm_g}, 512, Wdsa_t + (size_t)1024 * 256, 256, 0, scr, r, F.lane); continue; } r -= I_QI;
            if (r < I_IN) { tr_item(SrcWin{w_in, g_mix}, PROJ, Win_t, 1024, 0, scr, r, F.lane); continue; } r -= I_IN;
            if (r < I_KV) { tr_item(SrcPlain{w_xkv, 2048, nullptr, 1.f}, 2048, Wkv_t, 1024, 0, scr, r, F.lane); continue; } r -= I_KV;
            if (r < I_XQ) { tr_item(SrcPlain{w_xq, 1024, g_xattn, 0.0625f * LOG2E}, 1024, Wxq_t, 1024, 0, scr, r, F.lane, (unsigned*)(ws + WS_CTL) + CTL_AMAX + 1); continue; } r -= I_XQ;
            if (r < I_XO) { tr_item(SrcPlain{w_xo, 1024, nullptr, 1.f}, 1024, Wxo_t, 1024, 0, scr, r, F.lane, (unsigned*)(ws + WS_CTL) + CTL_AMAX + 2); continue; } r -= I_XO;
            if (r < I_GU) { tr_item(SrcGU{w_gate, w_up, g_ffn}, 2 * DFF, Wgu_t, 1024, 0, scr, r, F.lane); continue; } r -= I_GU;
            if (r < I_DN) { tr_item(SrcPlain{w_down, 1024, nullptr, 1.f}, 1024, Wdn_t, DFF, 0, scr, r, F.lane, (unsigned*)(ws + WS_CTL) + CTL_AMAX); continue; } r -= I_DN;
            tr_item(SrcPlain{w_out, 1024, nullptr, 1.f}, 1024, Wout_t, MIXK, 0, scr, r, F.lane);
        }
        for (int m = 4 * gw; m < M; m += 4 * NGW) row_prep<4>(x + (size_t)m * D, nullptr, xb + (size_t)m * D, rstdx + m, F.lane);
        for (int m = 2 * gw; m < MM; m += 2 * NGW) row_prep<2>(mem + (size_t)m * D, g_mem, mnb + (size_t)m * D, nullptr, F.lane);
        if (blockIdx.x == 0) for (int i = F.tid; i < 129 * 8; i += NWAVES * 64) {
            const int d = i >> 3, h = i & 7; int bkt;
            if (d < 16) bkt = d; else { const float lr = logf((float)d / 16.f) / 2.0794415416798357f; const int large = 16 + (int)(lr * 16.f); bkt = large < 31 ? large : 31; }
            biastab[i] = rel_bias[bkt * 8 + h] * LOG2E; }
        if (BOTH(0)) GRID_BAR();
    }
    if (IN(1)) {
        pg8::Gemm g{xb, Win_t, 1024, 1024, 1024}; pg8::StaticOrder S; S.init(M, PROJ, F.G, (int)blockIdx.x);
        pg8::EpiProj E{proj, PROJ, nullptr, cqss, 8};
        pg8::gemm_phase<pg8::EpiProj, pg8::StaticOrder, true>(ring, g, S, E, F.wave);
        if (BOTH(1)) GRID_BAR();
    }
    if (IN(2)) {
        const int lane2 = lane_now();
        for (int m = 4 * gw; m < M; m += 4 * NGW) dsa_prep_rows<4>(m, lane2, proj, kv_norm_g, kidx_ln_g, kidx_ln_b, a_log, dt_bias, ckv, kidx, widx, beta, gdec);
        { unsigned* am = (unsigned*)(ws + WS_CTL) + CTL_AMAX;
          cvt_w8(Wdn_t, Wdn8, DFF * 1024 / 16, __hip_atomic_load(am, __ATOMIC_RELAXED, __HIP_MEMORY_SCOPE_AGENT), gw * 64 + lane2, NGW * 64);
          cvt_w8(Wxq_t, Wxq8, 1024 * 1024 / 16, __hip_atomic_load(am + 1, __ATOMIC_RELAXED, __HIP_MEMORY_SCOPE_AGENT), gw * 64 + lane2, NGW * 64);
          cvt_w8(Wxo_t, Wxo8, 1024 * 1024 / 16, __hip_atomic_load(am + 2, __ATOMIC_RELAXED, __HIP_MEMORY_SCOPE_AGENT), gw * 64 + lane2, NGW * 64); }
        { pg8::Gemm g{proj + C_CQ, Wdsa_t, PROJ, 256, 256}; pg8::StaticOrder S; S.init(M, 1536, F.G, (int)blockIdx.x);
          pg8::EpiNormScale<4> E{qabs, 1536, cqss, 1.f / 256.f, 1.f};
          pg8::gemm_phase<pg8::EpiNormScale<4>, pg8::StaticOrder, true>(ring, g, S, E, F.wave); }
        if (BOTH(2)) GRID_BAR();
    }
    if (IN(3)) {
        const int lane3 = lane_now(); const int tid3 = F.wave * 64 + lane3;
        if (blockIdx.x < 64) dn::run(F.lds, (int)blockIdx.x >> 2, (int)blockIdx.x & 3, proj, conv_w, beta, gdec, dn_norm_g, mix, tid3, F.wave, lane3);
        __syncthreads();
        if (blockIdx.x >= 64) { unsigned* kvq = (unsigned*)(ws + WS_CTL) + 1536;
            for (;;) {
                if (tid3 == 0) F.MISC[17] = __hip_atomic_fetch_add(kvq, 1u, __ATOMIC_RELAXED, __HIP_MEMORY_SCOPE_AGENT);
                __syncthreads(); const int k = (int)F.MISC[17]; __syncthreads();
                if (k >= 128) break;
                if (k < 64) { pg8::Gemm g{mnb, Wkv_t, 1024, 1024, 1024}; pg8::OneUnit S1{{k >> 2, k & 3, 0, 0}}; pg8::EpiProj E{kx, 1024, nullptr, nullptr, -1};
                    pg8::gemm_phase<pg8::EpiProj, pg8::OneUnit, false>(ring, g, S1, E, F.wave); }
                else { const int k2 = k - 64; pg8::Gemm g{Wkv_t + (size_t)1024 * 1024, mnb, 1024, 1024, 1024}; pg8::OneUnit S1{{k2 >> 4, k2 & 15, 0, 0}}; pg8::EpiProj E{vT, MM, nullptr, nullptr, -1};
                    pg8::gemm_phase<pg8::EpiProj, pg8::OneUnit, false>(ring, g, S1, E, F.wave); }
            } }
        for (int pass = 0; pass <= args.pad; ++pass) {
        if (pass) GRID_BAR();
        const int lane4 = lane_now(); const int tid4 = F.wave * 64 + lane4;
        dsa::phase_init(F.lds, biastab, kv_norm_g, tid4);
        unsigned* qbase = (unsigned*)(ws + WS_CTL) + 2048 + 1024 * pass;
        const int myx = (int)(xb_xcc_id() & 7u);
        for (int sx = 0; sx < 8; ++sx) { const int qx8 = (myx + sx) & 7;
        for (;;) {
            if (tid4 == 0) F.MISC[16] = __hip_atomic_fetch_add(qbase + 64 * qx8, 1u, __ATOMIC_RELAXED, __HIP_MEMORY_SCOPE_AGENT);
            __syncthreads(); const int k = (int)F.MISC[16]; __syncthreads();
            if (k >= 256) break;
            dsa::unit(F.lds, 2 * qx8 + (k & 1), (127 - (k >> 1)) * 16, tid4, F.wave, lane4, qabs, ckv, kidx, widx, mix, (unsigned*)(ws + WS_CTL) + 1024);
        } }
        }
        if (BOTH(3)) GRID_BAR();
    }
    if (IN(4)) {
        pg8::Gemm g{mix, Wout_t, MIXK, MIXK, MIXK}; pg8::StaticOrder S; S.init(M, 1024, F.G, (int)blockIdx.x);
        pg8::EpiResid<true, true> E{nullptr, xb, x1b, ssq1, rstdx, x1f8, 1.f};
        pg8::gemm_phase<pg8::EpiResid<true, true>, pg8::StaticOrder, true>(ring, g, S, E, F.wave);
        if (BOTH(4)) GRID_BAR();
    }
    if (IN(5)) {
        pg8::StaticOrder S; S.init(M, 1024, F.G, (int)blockIdx.x); pg8::Unit ua, ub; const bool h0 = S.next(0, ua), h1 = S.next(1, ub);
        if (h0) {
            { pg8::Gemm g{(const bf16_t*)x1f8, (const bf16_t*)Wxq8, 1024, 1024, 1024};
              const float asc = pg8::w8_inv_scale((unsigned)__builtin_amdgcn_readfirstlane((int)__hip_atomic_load((unsigned*)(ws + WS_CTL) + CTL_AMAX + 1, __ATOMIC_RELAXED, __HIP_MEMORY_SCOPE_AGENT)), pg8::X8_SHIFT);
              pg8::EpiNormScale<16> E{qx, 1024, ssq1, 1.f / 1024.f, asc};
              pg8::gemm_phase<pg8::EpiNormScale<16>, pg8::StaticOrder, true, true>(ring, g, S, E, F.wave); }
            VM_WAIT(); __syncthreads();
            pg8::TwoUnits S2; S2.n = h1 ? 2 : 1;
            S2.u0 = pg8::Unit{ua.pm, ua.pm >> 3, (long)ua.pn * 512, (long)ua.pn * 512}; S2.u1 = pg8::Unit{ub.pm, ub.pm >> 3, (long)ub.pn * 512, (long)ub.pn * 512};
            { pg8::Gemm g{qx, kx, 1024, 1024, 256};
              pg8::EpiExpP E{Pb, lpart};
              pg8::gemm_phase<pg8::EpiExpP, pg8::TwoUnits, true>(ring, g, S2, E, F.wave); }
            VM_WAIT(); __syncthreads();
            pg8::TwoUnits S3; S3.n = S2.n;
            S3.u0 = pg8::Unit{ua.pm, ua.pn, (long)ua.pn * 512, (long)(ua.pm >> 3) * 512}; S3.u1 = pg8::Unit{ub.pm, ub.pn, (long)ub.pn * 512, (long)(ub.pm >> 3) * 512};
            { pg8::Gemm g{Pb, vT, 1024, MM, 256};
              pg8::EpiPV E{ox8, lpart};
              pg8::gemm_phase<pg8::EpiPV, pg8::TwoUnits, true>(ring, g, S3, E, F.wave); }
        }
        if (BOTH(5)) GRID_BAR();
    }
    if (IN(6)) {
        pg8::Gemm g{(const bf16_t*)ox8, (const bf16_t*)Wxo8, 1024, 1024, 1024}; pg8::StaticOrder S; S.init(M, 1024, F.G, (int)blockIdx.x);
        const float asc = pg8::w8_inv_scale((unsigned)__builtin_amdgcn_readfirstlane((int)__hip_atomic_load((unsigned*)(ws + WS_CTL) + CTL_AMAX + 2, __ATOMIC_RELAXED, __HIP_MEMORY_SCOPE_AGENT)), pg8::OX_SHIFT);
        pg8::EpiResid<true> E{nullptr, x1b, x2b, ssq2, nullptr, nullptr, asc};
        pg8::gemm_phase<pg8::EpiResid<true>, pg8::StaticOrder, true, true>(ring, g, S, E, F.wave);
        if (BOTH(6)) GRID_BAR();
    }
    if (IN(7)) {
        pg8::Gemm g{x2b, Wgu_t, 1024, 1024, 1024}; pg8::StaticOrder S; S.init(M, 2 * DFF, F.G, (int)blockIdx.x);
        pg8::EpiSwiglu E{act, ssq2};
        pg8::gemm_phase<pg8::EpiSwiglu, pg8::StaticOrder, true>(ring, g, S, E, F.wave);
        if (BOTH(7)) GRID_BAR();
    }
#if defined(DSA_TOPK_CHECK) || defined(DSA_FALLBACK_COUNT)
    const bool fuse_final = false;
#else
    const bool fuse_final = (F.G == 256);
#endif
    if (IN(8)) {
        pg8::Gemm g{(const bf16_t*)act, (const bf16_t*)Wdn8, DFF, DFF, DFF}; pg8::StaticOrder S; S.init(M, 1024, F.G, (int)blockIdx.x);
        const float asc = pg8::w8_inv_scale((unsigned)__builtin_amdgcn_readfirstlane((int)__hip_atomic_load((unsigned*)(ws + WS_CTL) + CTL_AMAX, __ATOMIC_RELAXED, __HIP_MEMORY_SCOPE_AGENT)), pg8::ACT_SHIFT);
        if (fuse_final) { pg8::EpiFinal E{x2b, out, ssq1, (unsigned*)(ws + WS_CTL) + 8192, g_final, asc};
            pg8::gemm_phase<pg8::EpiFinal, pg8::StaticOrder, true, true>(ring, g, S, E, F.wave); }
        else { pg8::EpiResidF32 E{x2b, out, ssq1, asc};
            pg8::gemm_phase<pg8::EpiResidF32, pg8::StaticOrder, true, true>(ring, g, S, E, F.wave);
            if (BOTH(8)) GRID_BAR(); }
    }
    if (IN(9) && !fuse_final) {
#ifdef DSA_FALLBACK_COUNT
        if (blockIdx.x == 0 && F.wave == 0 && lane_now() == 0 && __hip_atomic_load((unsigned*)(ws + WS_CTL) + 1024 + 64, __ATOMIC_RELAXED, __HIP_MEMORY_SCOPE_AGENT) > DSA_FALLBACK_COUNT) out[12345] = __builtin_nanf("");
#endif
#ifdef DSA_TOPK_CHECK
        if (blockIdx.x == 0 && F.wave == 0 && lane_now() == 0 && __hip_atomic_load((unsigned*)(ws + WS_CTL) + 1024, __ATOMIC_RELAXED, __HIP_MEMORY_SCOPE_AGENT) != 0u) out[12345] = __builtin_nanf("");
#endif
        const int lane9 = lane_now();
        for (int m = gw; m < M; m += NGW) {
            const float* pp = ssq1 + (size_t)m * 16; float s = 0.f;
#pragma unroll
            for (int q = 0; q < 4; ++q) { const f32x4 t = *(const f32x4*)(pp + 4 * q); s += (t.x + t.y) + (t.z + t.w); }
            const float rstd = rsqrtf(s * (1.f / 1024.f) + EPS);
            GAS f32x4* xr = (GAS f32x4*)(out + (size_t)m * D) + lane9;
#pragma unroll
            for (int j = 0; j < 4; ++j) { const f32x4 gg = *((const GAS f32x4*)g_final + lane9 + 64 * j); xr[64 * j] = xr[64 * j] * gg * rstd; }
        }
    }
#undef IN
#undef BOTH
}

extern "C" void kernel_launch(void* const* d_in, const int* in_sizes, int n_in, void* d_out, int out_size, void* d_ws, size_t ws_size, hipStream_t stream) {
    static int grid = 0;
    if (grid == 0) {
        if (n_in != 28 || ws_size < WS_NEED || out_size != M * D) { fprintf(stderr, "kernel_launch: unexpected problem (n_in %d ws %zu out %d)\n", n_in, ws_size, out_size); grid = -1; return; }
        int dev = 0, cus = 0, per_cu = 0;
        if (hipGetDevice(&dev) != hipSuccess || hipDeviceGetAttribute(&cus, hipDeviceAttributeMultiprocessorCount, dev) != hipSuccess) { grid = -1; return; }
        if (hipFuncSetAttribute((const void*)mega, hipFuncAttributeMaxDynamicSharedMemorySize, LDS_BYTES) != hipSuccess) { fprintf(stderr, "kernel_launch: hipFuncSetAttribute failed\n"); grid = -1; return; }
        if (hipOccupancyMaxActiveBlocksPerMultiprocessor(&per_cu, (const void*)mega, NWAVES * 64, LDS_BYTES) != hipSuccess || per_cu < 1) { fprintf(stderr, "kernel_launch: occupancy query says %d\n", per_cu); grid = -1; (void)hipGetLastError(); return; }
        grid = cus;
        if (grid < 64) { fprintf(stderr, "kernel_launch: needs >= 64 CUs\n"); grid = -1; return; }
    }
    if (grid < 0) return;
    unsigned char* ws = (unsigned char*)d_ws;
    (void)hipMemsetAsync(ws + WS_CTL, 0, CTL_ZERO_BYTES, stream);
    Args a{}; for (int i = 0; i < 28; ++i) a.in[i] = (const float*)d_in[i]; a.out = (float*)d_out; a.ws = ws;
    a.ph_lo = 0; a.ph_hi = 10; a.li = 0;
#ifdef DSA_PASSES
    a.pad = DSA_PASSES - 1;
#endif
    void* kargs[] = {&a};
    (void)hipLaunchCooperativeKernel((const void*)mega, dim3(grid), dim3(NWAVES * 64), kargs, LDS_BYTES, stream);
}
```

```cpp
#include <hip/hip_runtime.h>
#include <cstdio>
#include <cstdint>

typedef unsigned short bf16_t;
__device__ __forceinline__ float bf2f(bf16_t h) { return __uint_as_float(((unsigned)h) << 16); }
__device__ __forceinline__ bf16_t f2bf(float f) { unsigned u = __float_as_uint(f); return (bf16_t)((u + 0x7fffu + ((u >> 16) & 1u)) >> 16); }

constexpr int D = 1024, BATCH = 16, SEQ = 2048, M = BATCH * SEQ;
constexpr int PROJ_REF = 2512, PROJ = 2560;
constexpr int MEM_LEN = 256, MM = BATCH * MEM_LEN;
constexpr int DFF = 2816;
constexpr float EPS = 1e-6f;
constexpr float LOG2E = 1.4426950408889634f;
constexpr int C_DQ = 0, C_DK = 512, C_DV = 1024, C_DZ = 1536, C_CQ = 2048, C_CKV = 2304, C_KIX = 2432, C_WIX = 2496, C_DB = 2504, C_DA = 2508;
constexpr int MIXK = 1536;

constexpr size_t MiB = 1u << 20;
constexpr size_t WS_WIN = 0, WS_WKV = 5 * MiB, WS_WDSA = 9 * MiB, WS_WOUT = 10 * MiB, WS_WXQ = 13 * MiB, WS_WXO = 15 * MiB, WS_WGU = 17 * MiB, WS_WDN = 28 * MiB;
constexpr size_t WS_CTL = 34 * MiB, CTL_ZERO_BYTES = 256 * 1024;
constexpr size_t WS_ST = 35 * MiB;
constexpr size_t ST_RSTDX = 0, ST_CQSS = 128 * 1024  , ST_LPART = 640 * 1024  , ST_WIDX = 2688 * 1024  , ST_BETA = 3712 * 1024  , ST_G = 4224 * 1024  , ST_BIAS = 4736 * 1024;
constexpr size_t WS_MNB = 40 * MiB, WS_KX = 48 * MiB, WS_VT = 56 * MiB, WS_CKV = 64 * MiB, WS_KIDX = 72 * MiB;
constexpr size_t WS_SSQ = 76 * MiB;
constexpr size_t WS_PROJ = 80 * MiB;
constexpr size_t WS_XB = 240 * MiB;
constexpr size_t WS_QABS = 240 * MiB;
constexpr size_t WS_MIX = 336 * MiB;
constexpr size_t WS_X1B = 240 * MiB, WS_QX = 304 * MiB, WS_P = 368 * MiB, WS_OX = 432 * MiB, WS_X2B = 304 * MiB, WS_ACT = 80 * MiB;
constexpr size_t WS_W8 = 496 * MiB;
constexpr int CTL_AMAX = 1600;
constexpr size_t WS_NEED = 512 * MiB;

#define DPP_ADD(v, CTRL) ((v) + __int_as_float(__builtin_amdgcn_update_dpp(0, __float_as_int(v), (CTRL), 0xF, 0xF, true)))
__device__ __forceinline__ float wave_sum(float v) {
    v = DPP_ADD(v, 0xB1);
    v = DPP_ADD(v, 0x4E);
    v = DPP_ADD(v, 0x141);
    v = DPP_ADD(v, 0x140);
    const int b = __float_as_int(v);
    const float s0 = __int_as_float(__builtin_amdgcn_readlane(b, 0)), s1 = __int_as_float(__builtin_amdgcn_readlane(b, 16)), s2 = __int_as_float(__builtin_amdgcn_readlane(b, 32)), s3 = __int_as_float(__builtin_amdgcn_readlane(b, 48));
    return (s0 + s1) + (s2 + s3);
}
__device__ __forceinline__ int lane_now() { int l; asm volatile("v_mbcnt_lo_u32_b32 %0, -1, 0\n\tv_mbcnt_hi_u32_b32 %0, -1, %0" : "=v"(l)); return l; }
namespace pg8 {
#define PG8_LAS __attribute__((address_space(3)))
typedef short bf16x8 __attribute__((ext_vector_type(8)));
typedef float f32x4 __attribute__((ext_vector_type(4)));
typedef unsigned u32x4 __attribute__((ext_vector_type(4)));
typedef unsigned u32x2 __attribute__((ext_vector_type(2)));
typedef int i32x4 __attribute__((ext_vector_type(4)));
constexpr int BM = 256, BK = 64, HALF = 128, HTB = HALF * BK * 2  , STAGE_BYTES = 8 * HTB, NXCD = 8, WGM = 8;

__host__ __device__ __forceinline__ int lds_byte(int r, int c) { const int st = (r >> 4) * 2 + (c >> 5), rr = r & 15, cc = c & 31, ob = rr * 64 + cc * 2; return st * 1024 + (ob ^ (((ob >> 9) & 1) << 5)); }
__host__ __device__ __forceinline__ void stage_rc(int b, int& R, int& C) { const int st = b / 1024, sb = b % 1024, swz = sb ^ (((sb >> 9) & 1) << 5); R = (st >> 1) * 16 + swz / 64; C = (st & 1) * 32 + (swz % 64) / 2; }
__host__ __device__ __forceinline__ int perm32(int rho) { const int n = rho >> 4, i = rho & 15; return 8 * (i >> 2) + 4 * n + (i & 3); }

struct Unit { int pm, pn; long ao, bo; };
struct Gemm { const bf16_t* A; const bf16_t* Bt; int lda, ldb, K; };

struct StaticOrder {
    int nM, nN, nwg, G, c;
    __host__ __device__ __forceinline__ void init(int M_, int N_, int G_, int c_) { nM = M_ / BM; nN = N_ / BM; nwg = nM * nN; G = G_; c = c_; }
    __host__ __device__ __forceinline__ bool next(int i, Unit& u) const {
        const long L = (long)i * G + c; if (L >= nwg) return false;
        int wgid = (int)L; { const int q = nwg / NXCD, r = nwg % NXCD, xcd = wgid % NXCD, off = wgid / NXCD; wgid = (xcd < r ? xcd * (q + 1) : r * (q + 1) + (xcd - r) * q) + off; }
        const int nig = WGM * nN, gid = wgid / nig, fm = gid * WGM, gsz = (nM - fm) < WGM ? (nM - fm) : WGM;
        u.pm = fm + ((wgid % nig) % gsz); u.pn = (wgid % nig) / gsz; u.ao = 0; u.bo = 0; return true;
    }
};
struct OneUnit { Unit u; __host__ __device__ __forceinline__ bool next(int i, Unit& o) const { if (i) return false; o = u; return true; } };
struct TwoUnits { Unit u0, u1; int n; __host__ __device__ __forceinline__ bool next(int i, Unit& o) const { if (i >= n) return false; o = i ? u1 : u0; return true; } };

typedef float cvf32x2_t __attribute__((ext_vector_type(2))); typedef __bf16 cvbf16x2_t __attribute__((ext_vector_type(2)));
__device__ __forceinline__ unsigned cvt_pk_bf16(float lo, float hi) { cvf32x2_t v = {lo, hi}; return __builtin_bit_cast(unsigned, __builtin_convertvector(v, cvbf16x2_t)); }
__device__ __forceinline__ u32x4 pack8(const f32x4& a, const f32x4& b) { u32x4 w; w.x = cvt_pk_bf16(a[0], a[1]); w.y = cvt_pk_bf16(a[2], a[3]); w.z = cvt_pk_bf16(b[0], b[1]); w.w = cvt_pk_bf16(b[2], b[3]); return w; }
__device__ __forceinline__ unsigned pack4_fp8(float a, float b, float c, float d) {
    a = __builtin_amdgcn_fmed3f(a, -448.f, 448.f); b = __builtin_amdgcn_fmed3f(b, -448.f, 448.f); c = __builtin_amdgcn_fmed3f(c, -448.f, 448.f); d = __builtin_amdgcn_fmed3f(d, -448.f, 448.f);
    int w = 0; w = __builtin_amdgcn_cvt_pk_fp8_f32(a, b, w, false); w = __builtin_amdgcn_cvt_pk_fp8_f32(c, d, w, true); return (unsigned)w; }
__device__ __forceinline__ u32x2 pack8_fp8(const f32x4& a, const f32x4& b) { u32x2 w; w.x = pack4_fp8(a[0], a[1], a[2], a[3]); w.y = pack4_fp8(b[0], b[1], b[2], b[3]); return w; }
__device__ __forceinline__ float w8_scale(unsigned amax_bits) { const int e = (int)(amax_bits >> 23) - 127; return amax_bits ? __uint_as_float((unsigned)(127 + 6 - e) << 23) : 1.f; }
__device__ __forceinline__ float w8_inv_scale(unsigned amax_bits, int extra_shift) { const int e = (int)(amax_bits >> 23) - 127; return __uint_as_float((unsigned)(amax_bits ? 127 - 6 + e - extra_shift : 127 - extra_shift) << 23); }
__device__ __forceinline__ float dot4(const f32x4& a) { return (a[0] * a[0] + a[1] * a[1]) + (a[2] * a[2] + a[3] * a[3]); }
__device__ __forceinline__ float sum4(const f32x4& a) { return (a[0] + a[1]) + (a[2] + a[3]); }
__device__ __forceinline__ float lo_bf(unsigned w) { return __uint_as_float(w << 16); }
__device__ __forceinline__ float hi_bf(unsigned w) { return __uint_as_float(w & 0xffff0000u); }

typedef f32x4 Acc[2][2][4][2];
#define PG8_EPI_ROWS(...) _Pragma("unroll") for (int ai = 0; ai < 2; ++ai) _Pragma("unroll") for (int m = 0; m < 4; ++m) { const int rl = ai * HALF + wr * 64 + m * 16 + fr; __VA_ARGS__ }

struct EpiProj { static constexpr bool PERM = true;
    bf16_t* O; int ldc; const float* rs; float* cqss; int ssq_pn;
    __device__ __forceinline__ void operator()(const Acc& acc, const Unit& u, int wr, int wc, int fr, int fq) const {
        const int col0 = u.pn * BM + wc * 32 + 8 * fq; const bool doss = (u.pn == ssq_pn);
        PG8_EPI_ROWS( const int row = u.pm * BM + rl; const float r = rs ? rs[row] : 1.f; float ss = 0.f; bf16_t* rowp = O + (size_t)row * ldc + col0;
            _Pragma("unroll") for (int bj = 0; bj < 2; ++bj) { const f32x4 v0 = acc[ai][bj][m][0] * r, v1 = acc[ai][bj][m][1] * r; *(u32x4*)(rowp + bj * HALF) = pack8(v0, v1); ss += dot4(v0) + dot4(v1); }
            if (doss) { ss += __shfl_xor(ss, 16); ss += __shfl_xor(ss, 32); if (fq == 0) cqss[(size_t)row * 4 + wc] = ss; } )
    }
};
template <int NP> struct EpiNormScale { static constexpr bool PERM = true;
    bf16_t* O; int ldc; const float* part; float inv_dim; float ascale;
    __device__ __forceinline__ void operator()(const Acc& acc, const Unit& u, int wr, int wc, int fr, int fq) const {
        const int col0 = u.pn * BM + wc * 32 + 8 * fq;
        PG8_EPI_ROWS( const int row = u.pm * BM + rl; float s = 0.f;
            _Pragma("unroll") for (int q = 0; q < NP / 4; ++q) s += sum4(*(const f32x4*)(part + (size_t)row * NP + 4 * q));
            const float r = rsqrtf(s * inv_dim + EPS) * ascale; bf16_t* rowp = O + (size_t)row * ldc + col0;
            _Pragma("unroll") for (int bj = 0; bj < 2; ++bj) *(u32x4*)(rowp + bj * HALF) = pack8(acc[ai][bj][m][0] * r, acc[ai][bj][m][1] * r); )
    }
};
constexpr float X8_SCALE = 8.f; constexpr int X8_SHIFT = 3;
template <bool SRC16, bool X8 = false> struct EpiResid { static constexpr bool PERM = true;
    const float* src; const bf16_t* src16; bf16_t* xb; float* ssq; const float* rinv; unsigned char* x8; float ascale; int pad_;
    __device__ __forceinline__ void operator()(const Acc& acc, const Unit& u, int wr, int wc, int fr, int fq) const {
        const int col0 = u.pn * BM + wc * 32 + 8 * fq;
        PG8_EPI_ROWS( const size_t row = (size_t)u.pm * BM + rl; float ss = 0.f; const size_t off = row * 1024 + col0; const float rsc = (SRC16 && rinv) ? 1.f / rinv[row] : 1.f;
            _Pragma("unroll") for (int bj = 0; bj < 2; ++bj) { f32x4 s0, s1;
                if (SRC16) { const u32x4 w = *(const u32x4*)(src16 + off + bj * HALF); s0 = (f32x4){lo_bf(w.x), hi_bf(w.x), lo_bf(w.y), hi_bf(w.y)} * rsc; s1 = (f32x4){lo_bf(w.z), hi_bf(w.z), lo_bf(w.w), hi_bf(w.w)} * rsc; }
                else { s0 = *(const f32x4*)(src + off + bj * HALF); s1 = *(const f32x4*)(src + off + bj * HALF + 4); }
                const f32x4 v0 = s0 + acc[ai][bj][m][0] * ascale, v1 = s1 + acc[ai][bj][m][1] * ascale;
                *(u32x4*)(xb + off + bj * HALF) = pack8(v0, v1); ss += dot4(v0) + dot4(v1);
                if constexpr (X8) *(u32x2*)(x8 + off + bj * HALF) = pack8_fp8(v0 * X8_SCALE, v1 * X8_SCALE); }
            ss += __shfl_xor(ss, 16); ss += __shfl_xor(ss, 32); if (fq == 0) ssq[row * 16 + u.pn * 4 + wc] = ss; )
    }
};
struct EpiResidF32 { static constexpr bool PERM = true;
    const bf16_t* src16; float* dst; float* ssq; float ascale; int pad_;
    __device__ __forceinline__ void operator()(const Acc& acc, const Unit& u, int wr, int wc, int fr, int fq) const {
        const int col0 = u.pn * BM + wc * 32 + 8 * fq;
        PG8_EPI_ROWS( const size_t row = (size_t)u.pm * BM + rl; float ss = 0.f; const size_t off = row * 1024 + col0;
            _Pragma("unroll") for (int bj = 0; bj < 2; ++bj) { const u32x4 w = *(const u32x4*)(src16 + off + bj * HALF);
                const f32x4 v0 = (f32x4){lo_bf(w.x), hi_bf(w.x), lo_bf(w.y), hi_bf(w.y)} + acc[ai][bj][m][0] * ascale, v1 = (f32x4){lo_bf(w.z), hi_bf(w.z), lo_bf(w.w), hi_bf(w.w)} + acc[ai][bj][m][1] * ascale;
                *(f32x4*)(dst + off + bj * HALF) = v0; *(f32x4*)(dst + off + bj * HALF + 4) = v1; ss += dot4(v0) + dot4(v1); }
            ss += __shfl_xor(ss, 16); ss += __shfl_xor(ss, 32); if (fq == 0) ssq[row * 16 + u.pn * 4 + wc] = ss; )
    }
};
struct EpiFinal { static constexpr bool PERM = true;
    const bf16_t* src16; float* dst; float* part; unsigned* cnt; const float* gain; float ascale; int pad_;
    __device__ __forceinline__ void operator()(Acc& acc, const Unit& u, int wr, int wc, int fr, int fq) const {
        const int col0 = u.pn * BM + wc * 32 + 8 * fq; float asl = ascale; asm volatile("" : "+s"(asl));
        PG8_EPI_ROWS( const size_t row = (size_t)u.pm * BM + rl; float ss = 0.f; const size_t off = row * 1024 + col0;
            _Pragma("unroll") for (int bj = 0; bj < 2; ++bj) { const u32x4 w = *(const u32x4*)(src16 + off + bj * HALF); const f32x4 s0 = {lo_bf(w.x), hi_bf(w.x), lo_bf(w.y), hi_bf(w.y)}, s1 = {lo_bf(w.z), hi_bf(w.z), lo_bf(w.w), hi_bf(w.w)};
                acc[ai][bj][m][0] = acc[ai][bj][m][0] * asl + s0; acc[ai][bj][m][1] = acc[ai][bj][m][1] * asl + s1; ss += dot4(acc[ai][bj][m][0]) + dot4(acc[ai][bj][m][1]); }
            ss += __shfl_xor(ss, 16); ss += __shfl_xor(ss, 32);
            if (fq == 0) __hip_atomic_store(part + row * 16 + u.pn * 4 + wc, ss, __ATOMIC_RELAXED, __HIP_MEMORY_SCOPE_AGENT); )
        asm volatile("s_waitcnt vmcnt(0)" ::: "memory");
        unsigned* c = cnt + 64 * u.pm;
        if ((fr | fq) == 0) __hip_atomic_fetch_add(c, 1u, __ATOMIC_RELAXED, __HIP_MEMORY_SCOPE_AGENT);
        for (unsigned spins = 0; spins < (1u << 22); ++spins) { if ((unsigned)__builtin_amdgcn_readfirstlane(__hip_atomic_load(c, __ATOMIC_RELAXED, __HIP_MEMORY_SCOPE_AGENT)) >= 32u) break; __builtin_amdgcn_s_sleep(4); }
        __builtin_amdgcn_fence(__ATOMIC_ACQUIRE, "agent");
        f32x4 gv[2][2];
        _Pragma("unroll") for (int bj = 0; bj < 2; ++bj) { gv[bj][0] = *(const f32x4*)(gain + col0 + bj * HALF); gv[bj][1] = *(const f32x4*)(gain + col0 + bj * HALF + 4); }
        PG8_EPI_ROWS( const size_t row = (size_t)u.pm * BM + rl; float s = 0.f;
            _Pragma("unroll") for (int q = 0; q < 4; ++q) s += sum4(*(const f32x4*)(part + row * 16 + 4 * q));
            const float r = rsqrtf(s * (1.f / 1024.f) + EPS); const size_t off = row * 1024 + col0;
            _Pragma("unroll") for (int bj = 0; bj < 2; ++bj) { *(f32x4*)(dst + off + bj * HALF) = acc[ai][bj][m][0] * gv[bj][0] * r; *(f32x4*)(dst + off + bj * HALF + 4) = acc[ai][bj][m][1] * gv[bj][1] * r; } )
    }
};
struct EpiExpP { static constexpr bool PERM = true;
    bf16_t* Pb; float* lpart;
    __device__ __forceinline__ void operator()(const Acc& acc, const Unit& u, int wr, int wc, int fr, int fq) const {
        const int h = (int)(u.ao >> 9), rowbase = u.pm * BM, col0 = wc * 32 + 8 * fq; bf16_t* O = Pb + (size_t)rowbase * 1024 + h * 256;
        PG8_EPI_ROWS( float ss = 0.f; bf16_t* rowp = O + (size_t)rl * 1024 + col0;
            _Pragma("unroll") for (int bj = 0; bj < 2; ++bj) { f32x4 v0 = acc[ai][bj][m][0], v1 = acc[ai][bj][m][1];
                _Pragma("unroll") for (int e = 0; e < 4; ++e) { v0[e] = __builtin_amdgcn_exp2f(v0[e]); v1[e] = __builtin_amdgcn_exp2f(v1[e]); }
                const u32x4 w = pack8(v0, v1); *(u32x4*)(rowp + bj * HALF) = w;
                ss += (lo_bf(w.x) + hi_bf(w.x)) + (lo_bf(w.y) + hi_bf(w.y)) + (lo_bf(w.z) + hi_bf(w.z)) + (lo_bf(w.w) + hi_bf(w.w)); }
            ss += __shfl_xor(ss, 16); ss += __shfl_xor(ss, 32); if (fq == 0) lpart[(size_t)(rowbase + rl) * 16 + h * 4 + wc] = ss; )
    }
};
constexpr float OX_SCALE = 32.f; constexpr int OX_SHIFT = 5;
struct EpiPV { static constexpr bool PERM = true;
    unsigned char* Ob; const float* lpart;
    __device__ __forceinline__ void operator()(const Acc& acc, const Unit& u, int wr, int wc, int fr, int fq) const {
        const int h = u.pn, rowbase = u.pm * BM, col0 = wc * 32 + 8 * fq; unsigned char* O = Ob + (size_t)rowbase * 1024 + h * 256;
        PG8_EPI_ROWS( const float r = OX_SCALE / sum4(*(const f32x4*)(lpart + (size_t)(rowbase + rl) * 16 + h * 4)); unsigned char* rowp = O + (size_t)rl * 1024 + col0;
            _Pragma("unroll") for (int bj = 0; bj < 2; ++bj) *(u32x2*)(rowp + bj * HALF) = pack8_fp8(acc[ai][bj][m][0] * r, acc[ai][bj][m][1] * r); )
    }
};
constexpr float ACT_SCALE = 16.f; constexpr int ACT_SHIFT = 4;
struct EpiSwiglu { static constexpr bool PERM = true;
    unsigned char* act; const float* part;
    __device__ __forceinline__ void operator()(const Acc& acc, const Unit& u, int wr, int wc, int fr, int fq) const {
        const int col0 = u.pn * BM + wc * 32 + 8 * fq;
        PG8_EPI_ROWS( const size_t row = (size_t)u.pm * BM + rl; float s = 0.f;
            _Pragma("unroll") for (int q = 0; q < 4; ++q) s += sum4(*(const f32x4*)(part + row * 16 + 4 * q));
            const float r = rsqrtf(s * (1.f / 1024.f) + EPS); unsigned char* rowp = act + row * DFF + (col0 >> 1);
            _Pragma("unroll") for (int bj = 0; bj < 2; ++bj) { const f32x4 a = acc[ai][bj][m][0] * r, b = acc[ai][bj][m][1] * r;
                const float o0 = a[0] * __builtin_amdgcn_rcpf(1.f + __builtin_amdgcn_exp2f(-LOG2E * a[0])) * a[1], o1 = a[2] * __builtin_amdgcn_rcpf(1.f + __builtin_amdgcn_exp2f(-LOG2E * a[2])) * a[3];
                const float o2 = b[0] * __builtin_amdgcn_rcpf(1.f + __builtin_amdgcn_exp2f(-LOG2E * b[0])) * b[1], o3 = b[2] * __builtin_amdgcn_rcpf(1.f + __builtin_amdgcn_exp2f(-LOG2E * b[2])) * b[3];
                *(unsigned*)(rowp + bj * (HALF / 2)) = pack4_fp8(o0 * ACT_SCALE, o1 * ACT_SCALE, o2 * ACT_SCALE, o3 * ACT_SCALE); } )
    }
};

template <class Epi, class Sched, bool ALIGN_EPI, bool F8 = false>
__device__ __forceinline__ void gemm_phase(PG8_LAS unsigned char* lds, const Gemm g, const Sched& S, const Epi& E, int wave_id) {
    const int tid = wave_id * 64 + lane_now();
    const int wid = __builtin_amdgcn_readfirstlane(tid >> 6), lane = tid & 63, wr = wid >> 2, wc = wid & 3, fr = lane & 15, fq = lane >> 4;
    int Kop = g.K; asm volatile("" : "+s"(Kop));
    constexpr int ES = F8 ? 1 : 2;
    const int nt = Kop * ES / (BK * 2);
    unsigned voffA[2], voffB[2];
#pragma unroll
    for (int i = 0; i < 2; ++i) { int R, C; stage_rc(tid * 16 + i * 8192, R, C); const int Rb = Epi::PERM ? ((R & ~31) + perm32(R & 31)) : R;
        voffA[i] = (unsigned)(R * g.lda * ES + C * 2); voffB[i] = (unsigned)(Rb * g.ldb * ES + C * 2); }
    const size_t kstep = (size_t)(BK * 2);
    const size_t hstepA = (size_t)HALF * g.lda * ES, hstepB = (size_t)HALF * g.ldb * ES;
    const size_t tstepA = 2 * hstepA, tstepB = 2 * hstepB;
    const unsigned ldsw = (unsigned)wid * 1024u;
    const int aoff = lds_byte(wr * 64 + fr, fq * 8), boff = lds_byte(wc * 32 + fr, fq * 8);
#define PG8_SA(b, h) (((b) * 2 + (h)) * HTB)
#define PG8_SB(b, h) ((4 + (b) * 2 + (h)) * HTB)
#define PG8_STAGE(bufoff, gbase, voff, rs) do { _Pragma("unroll") for (int _i = 0; _i < 2; ++_i) { \
        if constexpr (F8) __builtin_amdgcn_raw_ptr_buffer_load_lds(rs, (PG8_LAS void*)(lds + (bufoff) + ldsw + _i * 8192), 16, (int)(voff)[_i], (int)(unsigned)(size_t)(gbase), 0, 0); \
        else __builtin_amdgcn_global_load_lds((const unsigned*)((const char*)(gbase) + (voff)[_i]), (PG8_LAS unsigned*)(lds + (bufoff) + ldsw + _i * 8192), 16, 0, 0); } } while (0)
#define PG8_LDA(dst, b, h) do { _Pragma("unroll") for (int m = 0; m < 4; ++m) _Pragma("unroll") for (int k = 0; k < 2; ++k) dst[m][k] = *(const PG8_LAS bf16x8*)(lds + PG8_SA(b, h) + aoff + m * 2048 + k * 1024); } while (0)
#define PG8_LDB(dst, b, h) do { _Pragma("unroll") for (int n = 0; n < 2; ++n) _Pragma("unroll") for (int k = 0; k < 2; ++k) dst[n][k] = *(const PG8_LAS bf16x8*)(lds + PG8_SB(b, h) + boff + n * 2048 + k * 1024); } while (0)
#define PG8_CAT8(x, y) __builtin_shufflevector(__builtin_bit_cast(i32x4, x), __builtin_bit_cast(i32x4, y), 0, 1, 2, 3, 4, 5, 6, 7)
#define PG8_MMA(ai, bj, At, Bt) do { __builtin_amdgcn_s_setprio(1); _Pragma("unroll") for (int m = 0; m < 4; ++m) _Pragma("unroll") for (int n = 0; n < 2; ++n) { \
        if constexpr (F8) acc[ai][bj][m][n] = __builtin_amdgcn_mfma_scale_f32_16x16x128_f8f6f4(PG8_CAT8(Bt[n][0], Bt[n][1]), PG8_CAT8(At[m][0], At[m][1]), acc[ai][bj][m][n], 0, 0, 0, 0, 0, 0); \
        else { _Pragma("unroll") for (int k = 0; k < 2; ++k) acc[ai][bj][m][n] = __builtin_amdgcn_mfma_f32_16x16x32_bf16(Bt[n][k], At[m][k], acc[ai][bj][m][n], 0, 0, 0); } } \
        __builtin_amdgcn_s_setprio(0); } while (0)
#define PG8_WAIT_V(n) asm volatile("s_waitcnt vmcnt(" #n ")" ::: "memory")
#define PG8_WAIT_L(n) asm volatile("s_waitcnt lgkmcnt(" #n ")" ::: "memory")
#define PG8_BAR __builtin_amdgcn_s_barrier()
#define PG8_SCHED __builtin_amdgcn_sched_barrier(0)
    Unit cur, nxt; int ui = 0;
    if (!S.next(0, cur)) return;
    Acc acc;
#pragma unroll
    for (int a = 0; a < 2; ++a)
#pragma unroll
        for (int b = 0; b < 2; ++b)
#pragma unroll
            for (int m = 0; m < 4; ++m)
#pragma unroll
                for (int n = 0; n < 2; ++n) acc[a][b][m][n] = (f32x4){0.f, 0.f, 0.f, 0.f};
    bf16x8 At[4][2], B0[2][2], B1[2][2];
    const __amdgpu_buffer_rsrc_t rsA = __builtin_amdgcn_make_buffer_rsrc((void*)g.A, 0, -1, 0x00020000), rsB = __builtin_amdgcn_make_buffer_rsrc((void*)g.Bt, 0, -1, 0x00020000);
    const char* const baseA = F8 ? (const char*)(size_t)0 : (const char*)g.A; const char* const baseB = F8 ? (const char*)(size_t)0 : (const char*)g.Bt;
    const char* cA = baseA + (size_t)cur.pm * tstepA + cur.ao; const char* cB = baseB + (size_t)cur.pn * tstepB + cur.bo;
    PG8_STAGE(PG8_SB(0, 0), cB, voffB, rsB); PG8_STAGE(PG8_SB(0, 1), cB + hstepB, voffB, rsB); PG8_STAGE(PG8_SA(0, 0), cA, voffA, rsA); PG8_STAGE(PG8_SA(0, 1), cA + hstepA, voffA, rsA);
    if (wr == 1) PG8_BAR;
    PG8_WAIT_V(2); PG8_BAR;
    PG8_STAGE(PG8_SB(1, 0), cB + kstep, voffB, rsB); PG8_STAGE(PG8_SA(1, 0), cA + kstep, voffA, rsA); PG8_STAGE(PG8_SB(1, 1), cB + hstepB + kstep, voffB, rsB);
    PG8_WAIT_V(6); PG8_BAR;
    for (;;) {
        const bool has_next = S.next(ui + 1, nxt);
        const char* nA = has_next ? baseA + (size_t)nxt.pm * tstepA + nxt.ao : cA; const char* nB = has_next ? baseB + (size_t)nxt.pn * tstepB + nxt.bo : cB;
        for (int t = 0; t < nt; t += 2) {
            const bool last = (t == nt - 2);
            const char* a1 = cA + (size_t)(t + 1) * kstep;
            const char* a2 = last ? nA : cA + (size_t)(t + 2) * kstep; const char* b2 = last ? nB : cB + (size_t)(t + 2) * kstep;
            const char* a3 = a2 + kstep; const char* b3 = b2 + kstep;
            PG8_LDB(B0, 0, 0); PG8_LDB(B1, 0, 1); PG8_SCHED; PG8_LDA(At, 0, 0); PG8_STAGE(PG8_SA(1, 1), a1 + hstepA, voffA, rsA);
            PG8_WAIT_V(8); PG8_WAIT_L(0); PG8_BAR; PG8_MMA(0, 0, At, B0); PG8_MMA(0, 1, At, B1); PG8_BAR; PG8_SCHED;
            PG8_LDA(At, 0, 1); PG8_STAGE(PG8_SB(0, 0), b2, voffB, rsB); PG8_STAGE(PG8_SB(0, 1), b2 + hstepB, voffB, rsB); PG8_STAGE(PG8_SA(0, 0), a2, voffA, rsA);
            PG8_WAIT_V(8); PG8_WAIT_L(0); PG8_BAR; PG8_MMA(1, 0, At, B0); PG8_MMA(1, 1, At, B1); PG8_BAR; PG8_SCHED;
            PG8_LDB(B0, 1, 0); PG8_LDB(B1, 1, 1); PG8_SCHED; PG8_LDA(At, 1, 0); PG8_STAGE(PG8_SA(0, 1), a2 + hstepA, voffA, rsA);
            PG8_WAIT_V(8); PG8_WAIT_L(0); PG8_BAR; PG8_MMA(0, 0, At, B0); PG8_MMA(0, 1, At, B1); PG8_BAR; PG8_SCHED;
            PG8_LDA(At, 1, 1); PG8_STAGE(PG8_SB(1, 0), b3, voffB, rsB); PG8_STAGE(PG8_SB(1, 1), b3 + hstepB, voffB, rsB); PG8_STAGE(PG8_SA(1, 0), a3, voffA, rsA);
            PG8_WAIT_V(8); PG8_WAIT_L(0); PG8_BAR; PG8_MMA(1, 0, At, B0); PG8_MMA(1, 1, At, B1); PG8_BAR; PG8_SCHED;
        }
        if constexpr (ALIGN_EPI) { if (wr == 0) PG8_BAR; }
        { int fr_e = fr, fq_e = fq;
          if constexpr (F8) { const int l_e = lane_now(); fr_e = l_e & 15; fq_e = l_e >> 4; }
          E(acc, cur, wr, wc, fr_e, fq_e); }
        if (!has_next) break;
#pragma unroll
        for (int a = 0; a < 2; ++a)
#pragma unroll
            for (int b = 0; b < 2; ++b)
#pragma unroll
                for (int m = 0; m < 4; ++m)
#pragma unroll
                    for (int n = 0; n < 2; ++n) acc[a][b][m][n] = (f32x4){0.f, 0.f, 0.f, 0.f};
        cur = nxt; cA = nA; cB = nB; ++ui;
        if constexpr (ALIGN_EPI) { if (wr == 1) PG8_BAR; }
    }
    PG8_WAIT_V(0);
    if constexpr (!ALIGN_EPI) { if (wr == 0) PG8_BAR; }
    PG8_BAR;
#undef PG8_SA
#undef PG8_SB
#undef PG8_STAGE
#undef PG8_LDA
#undef PG8_LDB
#undef PG8_MMA
#undef PG8_CAT8
#undef PG8_WAIT_V
#undef PG8_WAIT_L
#undef PG8_BAR
#undef PG8_SCHED
}
}
constexpr int NWAVES = 8;
constexpr int RING_BYTES = 131072;
constexpr int LDSCTL_OFF = RING_BYTES, MISC_OFF = LDSCTL_OFF + 320;
constexpr int LDS_BYTES = 147456;
#define GAS __attribute__((address_space(1)))
#define LAS __attribute__((address_space(3)))
typedef unsigned v4u __attribute__((ext_vector_type(4)));
typedef float f32x4 __attribute__((ext_vector_type(4)));
typedef GAS unsigned gu32;
#define RLX_AGENT __ATOMIC_RELAXED, __HIP_MEMORY_SCOPE_AGENT
#define LDS_WAIT() asm volatile("s_waitcnt lgkmcnt(0)" ::: "memory")
#define VM_WAIT() asm volatile("s_waitcnt vmcnt(0)" ::: "memory")
__device__ __forceinline__ unsigned pk2(float lo, float hi) { return (unsigned)f2bf(lo) | ((unsigned)f2bf(hi) << 16); }

#define XB_TMO      128
#define XB_XCNT(j)  (256  + 64 * (j))
#define XB_XSUB(j)  (1280 + 64 * (j))
#define XB_XGEN(j)  (2304 + 64 * (j))
#define XB_TOP      3328
#define XB_TOPGEN   3392
#define XCD_BAR_WORDS 3456
#define XB_SPIN_CAP (1u << 18)
__device__ __forceinline__ unsigned xb_ld(unsigned* p)              { return __hip_atomic_load(p, __ATOMIC_RELAXED, __HIP_MEMORY_SCOPE_AGENT); }
__device__ __forceinline__ unsigned xb_add(unsigned* p, unsigned v) { return __hip_atomic_fetch_add(p, v, __ATOMIC_RELAXED, __HIP_MEMORY_SCOPE_AGENT); }
__device__ __forceinline__ unsigned xb_xcc_id() { return (unsigned)__builtin_amdgcn_s_getreg((3 << 11) | 20) & 0xFu; }
#define XB_SPIN(cond, bar) do { unsigned _sp = 0; while (cond) { __builtin_amdgcn_s_sleep(1); \
    if ((++_sp & 255u) == 0u) { if (xb_ld(&(bar)[XB_TMO])) break; if (_sp > XB_SPIN_CAP) { atomicAdd(&(bar)[XB_TMO], 1u); break; } } } } while (0)
struct XcdBarrier { unsigned* bar; unsigned x; volatile LAS unsigned* st; };
__device__ __forceinline__ XcdBarrier xcd_barrier_post(unsigned* bar, volatile LAS unsigned* st) {
    XcdBarrier b; b.bar = bar; b.x = xb_xcc_id(); b.st = st;
    if (threadIdx.x == 0) (void)xb_add(&bar[XB_XCNT(b.x)], 1u);
    return b;
}
__device__ __forceinline__ void xcd_barrier_complete(unsigned* bar, unsigned x, unsigned& nloc, unsigned& nx) {
    const unsigned G = gridDim.x * gridDim.y * gridDim.z;
    unsigned sum, cnt, mine, sp = 0u;
    for (;;) {
        sum = 0u; cnt = 0u; mine = 0u;
#pragma unroll
        for (unsigned j = 0; j < 16; ++j) { const unsigned c = xb_ld(&bar[XB_XCNT(j)]); sum += c; cnt += (c > 0u) ? 1u : 0u; mine = (j == x) ? c : mine; }
        if (sum == G) break;
        __builtin_amdgcn_s_sleep(1);
        if ((++sp & 255u) == 0u) { if (xb_ld(&bar[XB_TMO])) break; if (sp > XB_SPIN_CAP) { atomicAdd(&bar[XB_TMO], 1u); break; } }
    }
    nloc = mine > 0u ? mine : 1u; nx = cnt > 0u ? cnt : 1u;
}
__device__ __forceinline__ void xcd_barrier(const XcdBarrier& b, int wave) {
    asm volatile("s_waitcnt vmcnt(0)" ::: "memory");
    __syncthreads();
    if (wave == 0 && lane_now() == 0) {
        unsigned* bar = b.bar;
        __builtin_amdgcn_s_waitcnt(0);
        unsigned nloc = b.st[0], nx = b.st[1];
        if (nloc == 0u) { xcd_barrier_complete(bar, b.x, nloc, nx); b.st[0] = nloc; b.st[1] = nx; }
        const unsigned old = xb_add(&bar[XB_XSUB(b.x)], 1u);
        const unsigned gen = old / nloc;
        if (old + 1u == (gen + 1u) * nloc) {
            __builtin_amdgcn_fence(__ATOMIC_RELEASE, "agent");
            asm volatile("s_waitcnt vmcnt(0)" ::: "memory");
            const unsigned og = xb_add(&bar[XB_TOP], 1u);
            const unsigned tg = og / nx;
            if (og + 1u == (tg + 1u) * nx) xb_add(&bar[XB_TOPGEN], 1u);
            else XB_SPIN(xb_ld(&bar[XB_TOPGEN]) == tg, bar);
            __builtin_amdgcn_fence(__ATOMIC_ACQUIRE, "agent");
            xb_add(&bar[XB_XGEN(b.x)], 1u);
            asm volatile("s_waitcnt vmcnt(0)" ::: "memory");
        } else {
            XB_SPIN(xb_ld(&bar[XB_XGEN(b.x)]) == gen, bar);
            __builtin_amdgcn_fence(__ATOMIC_ACQUIRE, "agent");
            asm volatile("s_waitcnt vmcnt(0)" ::: "memory");
        }
    }
    __syncthreads();
}

struct SrcWin { const float* w; const float* g;
    __device__ __forceinline__ float at(int k, int n) const {
        int src;
        if (n < 2048) src = n; else if (n < C_CKV) src = 2056 + (n - C_CQ); else if (n < C_KIX) src = 2312 + (n - C_CKV); else if (n < C_WIX) src = 2440 + (n - C_KIX);
        else if (n < C_DB) src = 2504 + (n - C_WIX); else if (n < C_DA) src = 2048 + (n - C_DB); else if (n < 2512) src = 2052 + (n - C_DA); else src = -1;
        return src >= 0 ? w[(size_t)k * PROJ_REF + src] * g[k] : 0.f; } };
struct SrcPlain { const float* w; int ld; const float* g; float cs;
    __device__ __forceinline__ float at(int k, int n) const { return w[(size_t)k * ld + n] * (g ? g[k] : 1.f) * cs; } };
struct SrcQidx { const float* w; const float* g;
    __device__ __forceinline__ float at(int k, int n) const { const int s = n >> 7, head = (n >> 4) & 7, r = n & 15; return w[(size_t)k * 512 + head * 64 + 16 * s + r] * g[k]; } };
struct SrcGU { const float* wg; const float* wu; const float* g;
    __device__ __forceinline__ float at(int k, int n) const { const size_t i = (size_t)k * DFF + (n >> 1); const float a = wg[i], b = wu[i]; return ((n & 1) ? b : a) * g[k]; } };
template <class Src> __device__ __forceinline__ void tr_item(const Src& S, int Nsz, bf16_t* WT, int ldo, int koff, LAS float* scr, int item, int lane, unsigned* amax = nullptr) {
    const int nblk = Nsz / 32, kb = item / nblk, nb = item % nblk, k0 = 64 * kb, n0 = 32 * nb;
    float t[32];
#pragma unroll
    for (int i = 0; i < 32; ++i) t[i] = S.at(k0 + 2 * i + (lane >> 5), n0 + (lane & 31));
    if (amax) { float mx = 0.f;
#pragma unroll
        for (int i = 0; i < 32; ++i) mx = fmaxf(mx, fabsf(t[i]));
#pragma unroll
        for (int o = 1; o < 64; o <<= 1) mx = fmaxf(mx, __shfl_xor(mx, o));
        if (lane == 0) (void)__hip_atomic_fetch_max(amax, __float_as_uint(mx), __ATOMIC_RELAXED, __HIP_MEMORY_SCOPE_AGENT); }
#pragma unroll
    for (int i = 0; i < 32; ++i) scr[(2 * i + (lane >> 5)) * 33 + (lane & 31)] = t[i];
    LDS_WAIT(); asm volatile("" ::: "memory");
    const int c = lane & 7;
#pragma unroll
    for (int j = 0; j < 4; ++j) { const int n = (lane >> 3) + 8 * j; const LAS float* s = scr + (8 * c) * 33 + n;
        v4u o; o.x = pk2(s[0 * 33], s[1 * 33]); o.y = pk2(s[2 * 33], s[3 * 33]); o.z = pk2(s[4 * 33], s[5 * 33]); o.w = pk2(s[6 * 33], s[7 * 33]);
        *(GAS v4u*)(WT + (size_t)(n0 + n) * ldo + koff + k0 + 8 * c) = o; }
    LDS_WAIT(); asm volatile("" ::: "memory");
}
__device__ __forceinline__ void heavy_item(const float* Ap, int lda, const float* Bp, int ldb, const float* cs, float cmul, int k0, int n0, int n0out, bf16_t* WT, int ldo, int koff, LAS float* scr, int lane) {
    LAS float* At = scr; LAS float* tt = scr + 2048;
#pragma unroll
    for (int i = 0; i < 8; ++i) { const int e = (i * 64 + lane) * 4, r = e >> 6, d = e & 63; *(LAS f32x4*)(At + e) = *(const GAS f32x4*)(Ap + (size_t)(k0 + r) * lda + d); }
    float bc[64];
#pragma unroll
    for (int d = 0; d < 64; ++d) bc[d] = Bp[(size_t)d * ldb + n0 + (lane & 31)];
    LDS_WAIT(); asm volatile("" ::: "memory");
#pragma unroll 2
    for (int i = 0; i < 16; ++i) { const int kk = 2 * i + (lane >> 5); const LAS f32x4* ar = (const LAS f32x4*)(At + kk * 64); float s0 = 0.f, s1 = 0.f;
#pragma unroll
        for (int q = 0; q < 16; q += 2) { const f32x4 a = ar[q], b2 = ar[q + 1]; s0 += a.x * bc[4 * q] + a.y * bc[4 * q + 1] + a.z * bc[4 * q + 2] + a.w * bc[4 * q + 3]; s1 += b2.x * bc[4 * q + 4] + b2.y * bc[4 * q + 5] + b2.z * bc[4 * q + 6] + b2.w * bc[4 * q + 7]; }
        tt[kk * 33 + (lane & 31)] = (s0 + s1) * (cs ? cs[k0 + kk] : 1.f) * cmul; }
    LDS_WAIT(); asm volatile("" ::: "memory");
    const int c = lane & 3;
#pragma unroll
    for (int j = 0; j < 2; ++j) { const int n = (lane >> 2) + 16 * j; const LAS float* s = tt + (8 * c) * 33 + n;
        v4u o; o.x = pk2(s[0 * 33], s[1 * 33]); o.y = pk2(s[2 * 33], s[3 * 33]); o.z = pk2(s[4 * 33], s[5 * 33]); o.w = pk2(s[6 * 33], s[7 * 33]);
        *(GAS v4u*)(WT + (size_t)(n0out + n) * ldo + koff + k0 + 8 * c) = o; }
    LDS_WAIT(); asm volatile("" ::: "memory");
}
template <int NR> __device__ __forceinline__ void row_prep(const float* xrow, const float* gain, bf16_t* orow, float* rstd_out, int lane) {
    f32x4 v[NR][4]; float s[NR];
#pragma unroll
    for (int r = 0; r < NR; ++r)
#pragma unroll
        for (int j = 0; j < 4; ++j) v[r][j] = *((const GAS f32x4*)(xrow + (size_t)r * 1024) + lane + 64 * j);
#pragma unroll
    for (int r = 0; r < NR; ++r) { float a = 0.f;
#pragma unroll
        for (int j = 0; j < 4; ++j) a += (v[r][j].x * v[r][j].x + v[r][j].y * v[r][j].y) + (v[r][j].z * v[r][j].z + v[r][j].w * v[r][j].w);
        s[r] = a; }
#pragma unroll
    for (int r = 0; r < NR; ++r) { const float rstd = rsqrtf(wave_sum(s[r]) * (1.f / 1024.f) + EPS);
        if (rstd_out && lane == 0) rstd_out[r] = rstd;
        GAS unsigned long long* o8 = (GAS unsigned long long*)(orow + (size_t)r * 1024) + lane;
#pragma unroll
        for (int j = 0; j < 4; ++j) { f32x4 a = v[r][j];
            if (gain) { const f32x4 gg = *((const GAS f32x4*)gain + lane + 64 * j); a = a * gg * rstd; } else a = a * rstd;
            o8[64 * j] = (unsigned long long)pk2(a.x, a.y) | ((unsigned long long)pk2(a.z, a.w) << 32); } }
}
__device__ __forceinline__ void cvt_w8(const bf16_t* src, unsigned char* dst, int n16, unsigned amax_bits, int gtid, int nthr) {
    const float sc = pg8::w8_scale(amax_bits);
    for (int i = gtid; i < n16; i += nthr) { const v4u a = *((const GAS v4u*)src + 2 * i), b = *((const GAS v4u*)src + 2 * i + 1); v4u o;
        o.x = pg8::pack4_fp8(pg8::lo_bf(a.x) * sc, pg8::hi_bf(a.x) * sc, pg8::lo_bf(a.y) * sc, pg8::hi_bf(a.y) * sc); o.y = pg8::pack4_fp8(pg8::lo_bf(a.z) * sc, pg8::hi_bf(a.z) * sc, pg8::lo_bf(a.w) * sc, pg8::hi_bf(a.w) * sc);
        o.z = pg8::pack4_fp8(pg8::lo_bf(b.x) * sc, pg8::hi_bf(b.x) * sc, pg8::lo_bf(b.y) * sc, pg8::hi_bf(b.y) * sc); o.w = pg8::pack4_fp8(pg8::lo_bf(b.z) * sc, pg8::hi_bf(b.z) * sc, pg8::lo_bf(b.w) * sc, pg8::hi_bf(b.w) * sc);
        *((GAS v4u*)dst + i) = o; }
}
namespace dsa {
typedef short bf16x8 __attribute__((ext_vector_type(8)));
typedef short s16x4 __attribute__((ext_vector_type(4)));
typedef float f32x16 __attribute__((ext_vector_type(16)));
typedef float f32x4 __attribute__((ext_vector_type(4)));
typedef unsigned u32x4 __attribute__((ext_vector_type(4)));
typedef unsigned short u16x4 __attribute__((ext_vector_type(4)));
constexpr int HIST_OFF = 145152;
constexpr int SC_OFF = 0, LIST_OFF = 132096, BIAS_OFF = 140288, W_OFF = 144416, NSEL_OFF = 144928, BMAX_OFF = 144992, CMAX_OFF = 145024;
__device__ __forceinline__ int xsw(int rr) { return rr < 8 ? 2 * rr : 2 * ((rr + 4) & 7) + 1; }
typedef float cvf32x2_t __attribute__((ext_vector_type(2))); typedef __bf16 cvbf16x2_t __attribute__((ext_vector_type(2)));
__device__ __forceinline__ unsigned cvtpk(float lo, float hi) { cvf32x2_t v = {lo, hi}; return __builtin_bit_cast(unsigned, __builtin_convertvector(v, cvbf16x2_t)); }
__device__ __forceinline__ int mbcnt64(unsigned long long m) { return (int)__builtin_amdgcn_mbcnt_hi((unsigned)(m >> 32), __builtin_amdgcn_mbcnt_lo((unsigned)m, 0u)); }

__device__ __forceinline__ void phase_init(LAS unsigned char* lds, const float* biastab, const float* kvg, int tid) {
    LAS float* bt = (LAS float*)(lds + BIAS_OFF);
    for (int i = tid; i < 129 * 8; i += 512) bt[i] = biastab[i];
    if (tid < 64) { float m = fmaxf(fabsf(kvg[tid]), fabsf(kvg[tid + 64]));
#pragma unroll
        for (int o = 1; o < 64; o <<= 1) m = fmaxf(m, __shfl_xor(m, o));
        if (tid == 0) *(LAS float*)(lds + CMAX_OFF) = m * 11.313708499f * 1.01f; }
    __syncthreads();
    if (tid < 8) { float m = -1e30f; for (int d = 0; d < 129; ++d) m = fmaxf(m, bt[d * 8 + tid]); ((LAS float*)(lds + BMAX_OFF))[tid] = m; }
    __syncthreads();
}

__device__ __forceinline__ void scores(LAS unsigned char* lds, int b, int q0, const bf16_t* qabs, const bf16_t* kidx, int wave, int lane) {
    const int hi = lane >> 5, c32 = lane & 31;
    const int a_ = c32 >> 3, hp = (c32 >> 2) & 1, r3 = c32 & 3;
    const int head = 4 * (a_ & 1) + r3, qt = 2 * hp + (a_ >> 1);
    bf16x8 A[4][4];
#pragma unroll
    for (int rt = 0; rt < 4; ++rt)
#pragma unroll
        for (int s = 0; s < 4; ++s) A[rt][s] = *(const bf16x8*)(qabs + (size_t)(b * 2048 + q0 + 4 * rt + qt) * 1536 + 1024 + s * 128 + head * 16 + 8 * hi);
    const int nkt = (q0 + 16 + 31) >> 5;
    LAS float* SC = (LAS float*)(lds + SC_OFF); const LAS float* Wl = (const LAS float*)(lds + W_OFF);
    bf16x8 Bn[4];
    { const bf16_t* kr = kidx + (size_t)(b * 2048 + (wave < nkt ? wave : 0) * 32 + c32) * 64 + 8 * hi;
#pragma unroll
      for (int s = 0; s < 4; ++s) Bn[s] = *(const bf16x8*)(kr + 16 * s); }
    __syncthreads();
    for (int kt = wave; kt < nkt; kt += 8) {
        bf16x8 B[4];
#pragma unroll
        for (int s = 0; s < 4; ++s) B[s] = Bn[s];
        if (kt + 8 < nkt) { const bf16_t* kr = kidx + (size_t)(b * 2048 + (kt + 8) * 32 + c32) * 64 + 8 * hi;
#pragma unroll
            for (int s = 0; s < 4; ++s) Bn[s] = *(const bf16x8*)(kr + 16 * s); }
        const int key = kt * 32 + c32;
        f32x16 acc[4];
#pragma unroll
        for (int rt = 0; rt < 4; ++rt) acc[rt] = (f32x16){0.f, 0.f, 0.f, 0.f, 0.f, 0.f, 0.f, 0.f, 0.f, 0.f, 0.f, 0.f, 0.f, 0.f, 0.f, 0.f};
#pragma unroll
        for (int s = 0; s < 4; ++s)
#pragma unroll
            for (int rt = 0; rt < 4; ++rt) acc[rt] = __builtin_amdgcn_mfma_f32_32x32x16_bf16(A[rt][s], B[s], acc[rt], 0, 0, 0);
        f32x4 wv[4][4];
#pragma unroll
        for (int rt = 0; rt < 4; ++rt) { const LAS f32x4* wp = (const LAS f32x4*)(Wl + (4 * rt + 2 * hi) * 8);
#pragma unroll
            for (int q = 0; q < 4; ++q) wv[rt][q] = wp[q]; }
#pragma unroll
        for (int rt = 0; rt < 4; ++rt) {
            const f32x4 w0 = wv[rt][0], w1 = wv[rt][1], w2 = wv[rt][2], w3 = wv[rt][3]; const f32x16 a = acc[rt];
            float s0 = w0.x * fmaxf(a[0], 0.f); s0 += w0.y * fmaxf(a[1], 0.f); s0 += w0.z * fmaxf(a[2], 0.f); s0 += w0.w * fmaxf(a[3], 0.f);
            s0 += w1.x * fmaxf(a[4], 0.f); s0 += w1.y * fmaxf(a[5], 0.f); s0 += w1.z * fmaxf(a[6], 0.f); s0 += w1.w * fmaxf(a[7], 0.f);
            float s1 = w2.x * fmaxf(a[8], 0.f); s1 += w2.y * fmaxf(a[9], 0.f); s1 += w2.z * fmaxf(a[10], 0.f); s1 += w2.w * fmaxf(a[11], 0.f);
            s1 += w3.x * fmaxf(a[12], 0.f); s1 += w3.y * fmaxf(a[13], 0.f); s1 += w3.z * fmaxf(a[14], 0.f); s1 += w3.w * fmaxf(a[15], 0.f);
            const int ql = 4 * rt + 2 * hi, t0 = q0 + ql;
            SC[ql * 2048 + key] = key <= t0 ? s0 : -INFINITY; SC[(ql + 1) * 2048 + key] = key <= t0 + 1 ? s1 : -INFINITY;
        }
    }
}
__device__ __forceinline__ void topk(LAS unsigned char* lds, int q0, int qq, int lane) {
    const int t = q0 + qq, n = t + 1;
    LAS unsigned short* list = (LAS unsigned short*)(lds + LIST_OFF) + qq * 256; LAS int* nsel = (LAS int*)(lds + NSEL_OFF);
    if (n <= 256) { for (int i = lane; i < 256; i += 64) list[i] = (unsigned short)(i < n ? i : t); if (lane == 0) nsel[qq] = n; return; }
    const int nk = ((q0 + 16 + 31) >> 5) * 32;
    const LAS float* SC = (const LAS float*)(lds + SC_OFF) + qq * 2048;
    unsigned u[32];
#pragma unroll
    for (int j = 0; j < 32; ++j) { const int key = lane + 64 * j; unsigned v = 0u; if (key < nk) { const unsigned bts = __float_as_uint(SC[key]); v = (bts & 0x80000000u) ? ~bts : (bts | 0x80000000u); } u[j] = v; }
    unsigned tau = 0u;
    for (int bit = 31; bit >= 0; --bit) {
        const unsigned cand = tau | (1u << bit); int cnt = 0;
#pragma unroll
        for (int j = 0; j < 32; ++j) cnt += __popcll(__ballot(u[j] >= cand));
        if (cnt >= 256) tau = cand;
        if (cnt == 256) break;
    }
    int cgt = 0;
#pragma unroll
    for (int j = 0; j < 32; ++j) cgt += __popcll(__ballot(u[j] > tau));
    const int r = 256 - cgt; int base = 0, eqb = 0;
#pragma unroll
    for (int j = 0; j < 32; ++j) {
        const bool gt = u[j] > tau, eq = u[j] == tau; const unsigned long long em = __ballot(eq);
        const bool sel = gt || (eq && (eqb + mbcnt64(em)) < r); const unsigned long long sm = __ballot(sel);
        if (sel) list[base + mbcnt64(sm)] = (unsigned short)(lane + 64 * j);
        base += __popcll(sm); eqb += __popcll(em);
    }
    if (lane == 0) nsel[qq] = 256;
}
__device__ __forceinline__ int wave_scan_incl(int x) {
    x += __builtin_amdgcn_update_dpp(0, x, 0x111, 0xF, 0xF, true);
    x += __builtin_amdgcn_update_dpp(0, x, 0x112, 0xF, 0xF, true);
    x += __builtin_amdgcn_update_dpp(0, x, 0x114, 0xF, 0xF, true);
    x += __builtin_amdgcn_update_dpp(0, x, 0x118, 0xF, 0xF, true);
    x += __builtin_amdgcn_update_dpp(0, x, 0x142, 0xA, 0xF, false);
    x += __builtin_amdgcn_update_dpp(0, x, 0x143, 0xC, 0xF, false);
    return x;
}
#define DPP_F32(v, CTRL) __int_as_float(__builtin_amdgcn_update_dpp(0, __float_as_int(v), (CTRL), 0xF, 0xF, true))
__device__ __forceinline__ float wave_max(float v) {
    v = fmaxf(v, DPP_F32(v, 0xB1)); v = fmaxf(v, DPP_F32(v, 0x4E)); v = fmaxf(v, DPP_F32(v, 0x141)); v = fmaxf(v, DPP_F32(v, 0x140));
    const int b = __float_as_int(v);
    return fmaxf(fmaxf(__int_as_float(__builtin_amdgcn_readlane(b, 0)), __int_as_float(__builtin_amdgcn_readlane(b, 16))), fmaxf(__int_as_float(__builtin_amdgcn_readlane(b, 32)), __int_as_float(__builtin_amdgcn_readlane(b, 48))));
}
__device__ __forceinline__ float wave_min(float v) {
    v = fminf(v, DPP_F32(v, 0xB1)); v = fminf(v, DPP_F32(v, 0x4E)); v = fminf(v, DPP_F32(v, 0x141)); v = fminf(v, DPP_F32(v, 0x140));
    const int b = __float_as_int(v);
    return fminf(fminf(__int_as_float(__builtin_amdgcn_readlane(b, 0)), __int_as_float(__builtin_amdgcn_readlane(b, 16))), fminf(__int_as_float(__builtin_amdgcn_readlane(b, 32)), __int_as_float(__builtin_amdgcn_readlane(b, 48))));
}
__device__ __forceinline__ void topk3(LAS unsigned char* lds, int q0, int qq, int wave, int lane, unsigned* dbg_flag_g = nullptr) {
    const int t = q0 + qq, n = t + 1;
    LAS unsigned short* list = (LAS unsigned short*)(lds + LIST_OFF) + qq * 256; LAS int* nsel = (LAS int*)(lds + NSEL_OFF);
    if (n <= 256) { for (int i = lane; i < 256; i += 64) list[i] = (unsigned short)(i < n ? i : t); if (lane == 0) nsel[qq] = n; return; }
    const int nk = ((q0 + 16 + 31) >> 5) * 32;
    LAS float* SC = (LAS float*)(lds + SC_OFF) + qq * 2048;
    LAS unsigned char* H = (LAS unsigned char*)SC;
    float v[32]; float hi = -INFINITY;
#pragma unroll
    for (int j = 0; j < 8; ++j) { f32x4 x = {-INFINITY, -INFINITY, -INFINITY, -INFINITY}; if (256 * j + 4 * lane < nk) x = *(const LAS f32x4*)(SC + 256 * j + 4 * lane);
#pragma unroll
        for (int e = 0; e < 4; ++e) { v[4 * j + e] = x[e]; hi = fmaxf(hi, x[e]); } }
    const float lo = wave_min(fminf(fminf(v[0], v[1]), fminf(v[2], v[3])));
    hi = wave_max(hi);
    const float sc = 8191.f / (hi - lo), off = __builtin_fmaf(-lo, sc, 0.25f);
    bool ok = (hi - lo) > 1e-30f && __builtin_fmaf(hi, sc, off) < 8191.9f && __builtin_fmaf(hi, sc, off) > 8190.f;
    unsigned B4 = 0u; int need2 = 0, ncand = 0;
    if (ok) {
        asm volatile("" ::: "memory");
        const u32x4 z4 = {0u, 0u, 0u, 0u};
#pragma unroll
        for (int j = 0; j < 8; ++j) *(LAS u32x4*)(H + 1024 * j + 16 * lane) = z4;
        asm volatile("" ::: "memory");
#pragma unroll
        for (int j = 0; j < 8; ++j) if (256 * j < nk) {
#pragma unroll
            for (int e = 0; e < 4; ++e) { const unsigned b = (unsigned)__builtin_fmaf(v[4 * j + e], sc, off); (void)__hip_atomic_fetch_add((LAS unsigned*)(H + (b & 0x1FFCu)), 1u, __ATOMIC_RELAXED, __HIP_MEMORY_SCOPE_WORKGROUP); } }
        asm volatile("" ::: "memory");
        const unsigned x4 = 4u * (unsigned)(lane & 31), hb = 128u * (unsigned)lane; int c[32];
#pragma unroll
        for (int k = 0; k < 32; ++k) c[k] = *(const LAS int*)(H + hb + (x4 ^ (4u * k)));
        __builtin_amdgcn_sched_barrier(0);
        int s = 0;
#pragma unroll
        for (int k = 0; k < 32; ++k) s += c[k];
        const int incl = wave_scan_incl(s), tot = __builtin_amdgcn_readlane(incl, 63), suf = tot - incl + s;
        const unsigned long long m = __ballot(suf >= 256); const int L = 63 - __builtin_clzll(m);
        const int aboveL = (L < 63) ? __builtin_amdgcn_readlane(suf, (L + 1) & 63) : 0; const int need1 = 256 - aboveL;
        const int cj = lane < 32 ? *(const LAS int*)(H + 128 * L + 4 * lane) : 0;
        const int incl2 = wave_scan_incl(cj), tot2 = __builtin_amdgcn_readlane(incl2, 63), suf2 = tot2 - incl2 + cj;
        const unsigned long long m2 = __ballot(lane < 32 && suf2 >= need1); const int J = 63 - __builtin_clzll(m2);
        const int above2 = (J < 31) ? __builtin_amdgcn_readlane(suf2, (J + 1) & 63) : 0; need2 = need1 - above2; ncand = __builtin_amdgcn_readlane(cj, J);
        B4 = (unsigned)(32 * L + J) * 4u;
        ok = (m != 0ull) && (m2 != 0ull) && (B4 > 0u) && (ncand <= 64);
    }
#ifdef DSA_FALLBACK_COUNT
    if (!ok && lane == 0) atomicAdd(dbg_flag_g + 64, 1u);
#endif
    if (!ok) {
        asm volatile("" ::: "memory");
#pragma unroll
        for (int j = 0; j < 8; ++j) if (256 * j + 4 * lane < nk) *(LAS f32x4*)(SC + 256 * j + 4 * lane) = (f32x4){v[4 * j], v[4 * j + 1], v[4 * j + 2], v[4 * j + 3]};
        asm volatile("" ::: "memory");
        topk(lds, q0, qq, lane); return; }
    LAS float* cv = (LAS float*)list; LAS unsigned short* ck = list + 128;
    int base = 0;
#pragma unroll
    for (int j = 0; j < 8; ++j) if (256 * j < nk) {
        bool isc[4];
#pragma unroll
        for (int e = 0; e < 4; ++e) { const unsigned b = (unsigned)__builtin_fmaf(v[4 * j + e], sc, off); isc[e] = (b & 0x1FFCu) == B4; }
        if (__ballot(isc[0] || isc[1] || isc[2] || isc[3])) {
#pragma unroll
            for (int e = 0; e < 4; ++e) { const unsigned long long cm = __ballot(isc[e]);
                if (isc[e]) { const int pos = base + mbcnt64(cm); cv[pos] = v[4 * j + e]; ck[pos] = (unsigned short)(256 * j + 4 * lane + e); } base += __popcll(cm); } } }
    const float myv = lane < ncand ? cv[lane] : -INFINITY; const int myk = lane < ncand ? (int)ck[lane] : 0x7fffffff; int rank = 0;
    for (int k = 0; k < ncand; ++k) { const float vk = __int_as_float(__builtin_amdgcn_readlane(__float_as_int(myv), k)); const int kk = __builtin_amdgcn_readlane(myk, k); rank += (vk > myv || (vk == myv && kk < myk)) ? 1 : 0; }
    const unsigned long long lm = __ballot(lane < ncand && rank == need2 - 1); const int ll = (int)__builtin_ctzll(lm);
    const float tauv = __int_as_float(__builtin_amdgcn_readlane(__float_as_int(myv), ll)); const int tauk = __builtin_amdgcn_readlane(myk, ll);
    int ngt = 0;
    LAS unsigned short* const dp = (LAS unsigned short*)(lds + HIST_OFF) + wave * 64 + lane;
#pragma unroll
    for (int j = 0; j < 8; ++j) if (256 * j < nk) {
        bool sel[4]; int c = 0;
#pragma unroll
        for (int e = 0; e < 4; ++e) { sel[e] = v[4 * j + e] > tauv; c += sel[e] ? 1 : 0; }
        const int incl3 = wave_scan_incl(c);
        LAS unsigned short* lp = list + ngt + (incl3 - c);
#pragma unroll
        for (int e = 0; e < 4; ++e) { LAS unsigned short* p = sel[e] ? lp : dp; *p = (unsigned short)(256 * j + 4 * lane + e); lp += sel[e] ? 1 : 0; }
        ngt += __builtin_amdgcn_readlane(incl3, 63); }
    const bool csel = lane < ncand && myv == tauv && myk <= tauk; const unsigned long long sm = __ballot(csel);
    if (csel) list[ngt + mbcnt64(sm)] = (unsigned short)myk;
    if (lane == 0) nsel[qq] = 256;
#ifdef DSA_S2_RESTORE
    asm volatile("" ::: "memory");
#pragma unroll
    for (int j = 0; j < 8; ++j) if (256 * j + 4 * lane < nk) *(LAS f32x4*)(SC + 256 * j + 4 * lane) = (f32x4){v[4 * j], v[4 * j + 1], v[4 * j + 2], v[4 * j + 3]};
    asm volatile("" ::: "memory");
#endif
}
__device__ __forceinline__ void attend2(LAS unsigned char* lds, int b, int q0, int wave, int lane, const bf16_t* qabs, const bf16_t* ckv, bf16_t* mix) {
    const int r16 = lane & 15, g = lane >> 4;
    LAS unsigned char* buf0 = lds + wave * 16384; LAS unsigned char* buf1 = buf0 + 8192;
    const LAS unsigned short* listw = (const LAS unsigned short*)(lds + LIST_OFF) + (2 * wave) * 256;
    const LAS float* biasT = (const LAS float*)(lds + BIAS_OFF);
    const int n0 = ((const LAS int*)(lds + NSEL_OFF))[2 * wave], n1 = ((const LAS int*)(lds + NSEL_OFF))[2 * wave + 1];
    const int ns0 = (n0 + 31) >> 5, total = ns0 + ((n1 + 31) >> 5);
    const float cmax = *(const LAS float*)(lds + CMAX_OFF), bmax = ((const LAS float*)(lds + BMAX_OFF))[r16 & 7];
    const int xr = xsw(r16);
    const int q4 = r16 >> 2, p4 = r16 & 3; const int rra = 4 * g + q4, rrb = 16 + 4 * g + q4; const int xa = xsw(rra & 15), xb = xsw(rrb & 15);
    int t = 0, n = 0; size_t row = 0; const LAS unsigned short* list = listw; bf16x8 QB[4]; float Mh = 0.f, lsum = 0.f; f32x4 O[8];
    u32x4 X[8], Y[8];
#define DSA_LOAD(ST, kk) do { if ((kk) < total) { const int sel_ = (kk) >= ns0 ? 1 : 0; const LAS unsigned short* lp_ = listw + sel_ * 256 + ((kk) - (sel_ ? ns0 : 0)) * 32; \
        _Pragma("unroll") for (int i_ = 0; i_ < 8; ++i_) { const int rr_ = 4 * i_ + g; const int idx_ = lp_[rr_]; ST[i_] = *(const u32x4*)(ckv + ((size_t)b * 2048 + idx_) * 128 + (r16 ^ xsw(rr_ & 15)) * 8); } } } while (0)
#define DSA_WRITE(ST, bufp) do { _Pragma("unroll") for (int i_ = 0; i_ < 8; ++i_) *(LAS u32x4*)((bufp) + (4 * i_ + g) * 256 + r16 * 16) = ST[i_]; } while (0)
#define DSA_INIT(qq_) do { t = q0 + (qq_); row = (size_t)b * 2048 + t; n = ((qq_) & 1) ? n1 : n0; list = listw + ((qq_) & 1) * 256; float qn2_ = 0.f; \
        _Pragma("unroll") for (int s_ = 0; s_ < 4; ++s_) { bf16x8 v_ = {0, 0, 0, 0, 0, 0, 0, 0}; if (r16 < 8) v_ = *(const bf16x8*)(qabs + row * 1536 + s_ * 256 + r16 * 32 + 8 * g); QB[s_] = v_; \
            _Pragma("unroll") for (int e_ = 0; e_ < 8; ++e_) { const float f_ = bf2f((bf16_t)v_[e_]); qn2_ += f_ * f_; } } \
        qn2_ += __shfl_xor(qn2_, 16); qn2_ += __shfl_xor(qn2_, 32); Mh = sqrtf(qn2_) * cmax + bmax; lsum = 0.f; \
        _Pragma("unroll") for (int dt_ = 0; dt_ < 8; ++dt_) O[dt_] = (f32x4){0.f, 0.f, 0.f, 0.f}; } while (0)
#define DSA_FINAL() do { float l_ = lsum; l_ += __shfl_xor(l_, 16); l_ += __shfl_xor(l_, 32); const float linv_ = 1.f / l_; \
        _Pragma("unroll") for (int e_ = 0; e_ < 4; ++e_) { const int hrow_ = (4 * g + e_) & 7; const float inv_ = __shfl(linv_, hrow_); \
            if (g < 2) { _Pragma("unroll") for (int dt_ = 0; dt_ < 8; ++dt_) mix[row * MIXK + 512 + hrow_ * 128 + 16 * dt_ + r16] = f2bf(O[dt_][e_] * inv_); } } } while (0)
#define DSA_COMPUTE(kk, buf) do { if ((kk) == ns0) { DSA_FINAL(); DSA_INIT(2 * wave + 1); } const int step = (kk) >= ns0 ? (kk) - ns0 : (kk); \
          \
        bf16x8 af_[2][4]; \
        _Pragma("unroll") for (int G = 0; G < 2; ++G) _Pragma("unroll") for (int s = 0; s < 4; ++s) af_[G][s] = *(const LAS bf16x8*)((buf) + (16 * G + r16) * 256 + (((4 * s + g) ^ xr) * 16)); \
        const int pb0_ = step * 32 + 4 * g; const u16x4 ida_ = *(const LAS u16x4*)(list + pb0_), idb_ = *(const LAS u16x4*)(list + pb0_ + 16); \
        s16x4 tlo_[8], thi_[8]; \
        _Pragma("unroll") for (int dt = 0; dt < 8; ++dt) { const int ch = 2 * dt + (p4 >> 1); \
            tlo_[dt] = __builtin_bit_cast(s16x4, __builtin_amdgcn_ds_read_tr16_b64_v4i16((LAS s16x4*)((buf) + rra * 256 + ((ch ^ xa) * 16) + 8 * (p4 & 1)))); \
            thi_[dt] = __builtin_bit_cast(s16x4, __builtin_amdgcn_ds_read_tr16_b64_v4i16((LAS s16x4*)((buf) + rrb * 256 + ((ch ^ xb) * 16) + 8 * (p4 & 1)))); } \
        float bz_[2][4]; \
        _Pragma("unroll") for (int e = 0; e < 4; ++e) { int d0_ = t - (int)ida_[e]; d0_ = d0_ < 128 ? d0_ : 128; d0_ = d0_ < 0 ? 0 : d0_; int d1_ = t - (int)idb_[e]; d1_ = d1_ < 128 ? d1_ : 128; d1_ = d1_ < 0 ? 0 : d1_; \
            bz_[0][e] = biasT[d0_ * 8 + (r16 & 7)]; bz_[1][e] = biasT[d1_ * 8 + (r16 & 7)]; } \
        f32x4 S_[2]; \
        _Pragma("unroll") for (int G = 0; G < 2; ++G) { f32x4 acc = {0.f, 0.f, 0.f, 0.f}; \
            _Pragma("unroll") for (int s = 0; s < 4; ++s) acc = __builtin_amdgcn_mfma_f32_16x16x32_bf16(af_[G][s], QB[s], acc, 0, 0, 0); \
            S_[G] = acc; } \
        float P_[2][4]; \
        _Pragma("unroll") for (int G = 0; G < 2; ++G) _Pragma("unroll") for (int e = 0; e < 4; ++e) { const float lg = S_[G][e] + bz_[G][e] - Mh; \
                const float pv = (pb0_ + 16 * G + e < n) ? __builtin_amdgcn_exp2f(lg) : 0.f; lsum += pv; P_[G][e] = pv; } \
        u32x4 pw; pw.x = cvtpk(P_[0][0], P_[0][1]); pw.y = cvtpk(P_[0][2], P_[0][3]); pw.z = cvtpk(P_[1][0], P_[1][1]); pw.w = cvtpk(P_[1][2], P_[1][3]); \
        const bf16x8 PA = __builtin_bit_cast(bf16x8, pw); \
        _Pragma("unroll") for (int dt = 0; dt < 8; ++dt) { const bf16x8 vb = {tlo_[dt][0], tlo_[dt][1], tlo_[dt][2], tlo_[dt][3], thi_[dt][0], thi_[dt][1], thi_[dt][2], thi_[dt][3]}; \
            O[dt] = __builtin_amdgcn_mfma_f32_16x16x32_bf16(PA, vb, O[dt], 0, 0, 0); } } while (0)
    DSA_LOAD(X, 0); DSA_LOAD(Y, 1);
    __syncthreads();
    DSA_INIT(2 * wave);
    DSA_WRITE(X, buf0); DSA_LOAD(X, 2);
    if (1 < total) { DSA_WRITE(Y, buf1); DSA_LOAD(Y, 3); }
    for (int k = 0; k < total; k += 2) {
        DSA_COMPUTE(k, buf0);
        if (k + 2 < total) { DSA_WRITE(X, buf0); DSA_LOAD(X, k + 4); }
        if (k + 1 < total) { DSA_COMPUTE(k + 1, buf1); if (k + 3 < total) { DSA_WRITE(Y, buf1); DSA_LOAD(Y, k + 5); } }
    }
    DSA_FINAL();
#undef DSA_LOAD
#undef DSA_WRITE
#undef DSA_INIT
#undef DSA_FINAL
#undef DSA_COMPUTE
}
__device__ __forceinline__ void unit(LAS unsigned char* lds, int b, int q0, int tid, int wave, int lane, const bf16_t* qabs, const bf16_t* ckv, const bf16_t* kidx, const float* widx, bf16_t* mix, unsigned* dbg_flag) {
    asm volatile("" : "+v"(tid));
    lane = tid & 63;
    if (tid < 128) ((LAS float*)(lds + W_OFF))[tid] = widx[(size_t)(b * 2048 + q0) * 8 + tid];
#ifndef DSA_REP_S1
#define DSA_REP_S1 1
#define DSA_REP_S2 1
#define DSA_REP_S3 1
#endif
    if (q0 + 16 > 256) { for (int rp = 0; rp < DSA_REP_S1; ++rp) { scores(lds, b, q0, qabs, kidx, wave, lane); __syncthreads(); } }
    else __syncthreads();
    asm volatile("" : "+v"(tid)); lane = tid & 63;
#ifdef DSA_TOPK_CHECK
    for (int e2 = 0; e2 < 2; ++e2) { const int qq = 2 * wave + e2;
        topk(lds, q0, qq, lane); const LAS unsigned short* lw = (const LAS unsigned short*)(lds + LIST_OFF) + qq * 256; const int ns = ((const LAS int*)(lds + NSEL_OFF))[qq];
        unsigned h1 = 0, h2 = 0; for (int i = lane; i < ns; i += 64) { const unsigned x = lw[i]; h1 += x; h2 += x * x; }
        topk3(lds, q0, qq, wave, lane); const int ns2 = ((const LAS int*)(lds + NSEL_OFF))[qq];
        unsigned g1 = 0, g2 = 0; for (int i = lane; i < ns2; i += 64) { const unsigned x = lw[i]; g1 += x; g2 += x * x; }
#pragma unroll
        for (int o = 1; o < 64; o <<= 1) { h1 += __shfl_xor(h1, o); h2 += __shfl_xor(h2, o); g1 += __shfl_xor(g1, o); g2 += __shfl_xor(g2, o); }
        if (lane == 0 && (h1 != g1 || h2 != g2 || ns != ns2)) atomicAdd(dbg_flag, 1u); }
#else
    for (int rp = 0; rp < DSA_REP_S2; ++rp) { topk3(lds, q0, 2 * wave, wave, lane, dbg_flag); topk3(lds, q0, 2 * wave + 1, wave, lane, dbg_flag); }
#endif
    asm volatile("" : "+v"(tid)); lane = tid & 63;
    for (int rp = 0; rp < DSA_REP_S3; ++rp) { attend2(lds, b, q0, wave, lane, qabs, ckv, mix); __syncthreads(); }
}
}
#ifndef DN_REP_E
#define DN_REP_E 1
#define DN_REP_T 1
#endif
namespace dn {
typedef short bf16x8 __attribute__((ext_vector_type(8)));
typedef short s16x4 __attribute__((ext_vector_type(4)));
typedef float f32x4 __attribute__((ext_vector_type(4)));
typedef float f32x2 __attribute__((ext_vector_type(2)));
typedef unsigned u32x4 __attribute__((ext_vector_type(4)));
typedef unsigned u32x2 __attribute__((ext_vector_type(2)));
constexpr int CWL = 132096;
constexpr int QS = 0, KS = 17408, WB = 17408, KGT = 34816, VBT = 52224, KBT = 69632, LF = 87040, TB = 103680, XF = 112896, OF = 87040, QKB = 120832, GC = 130048, BT = 130304;
constexpr int QSTR = 272, TSTR = 136, LSTR = 65, TBSTR = 144, OSTR = 132;
typedef float cvf32x2_t __attribute__((ext_vector_type(2))); typedef __bf16 cvbf16x2_t __attribute__((ext_vector_type(2)));
__device__ __forceinline__ unsigned cvtpk(float lo, float hi) { cvf32x2_t v = {lo, hi}; return __builtin_bit_cast(unsigned, __builtin_convertvector(v, cvbf16x2_t)); }
__device__ __forceinline__ bf16x8 pack2(const f32x4& a, const f32x4& b) { u32x4 w; w.x = cvtpk(a[0], a[1]); w.y = cvtpk(a[2], a[3]); w.z = cvtpk(b[0], b[1]); w.w = cvtpk(b[2], b[3]); return __builtin_bit_cast(bf16x8, w); }
__device__ __forceinline__ bf16x8 frag_perm(const LAS unsigned char* rowp, int s, int g) {
    const u32x2 lo = *(const LAS u32x2*)(rowp + (32 * s + 4 * g) * 2), hi = *(const LAS u32x2*)(rowp + (32 * s + 16 + 4 * g) * 2);
    u32x4 w; w.x = lo.x; w.y = lo.y; w.z = hi.x; w.w = hi.y; return __builtin_bit_cast(bf16x8, w); }
__device__ __forceinline__ bf16x8 frag_nat8(const LAS unsigned char* rowp, int s, int g) {
    const u32x2 lo = *(const LAS u32x2*)(rowp + (32 * s + 8 * g) * 2), hi = *(const LAS u32x2*)(rowp + (32 * s + 8 * g + 4) * 2);
    u32x4 w; w.x = lo.x; w.y = lo.y; w.z = hi.x; w.w = hi.y; return __builtin_bit_cast(bf16x8, w); }
__device__ __forceinline__ float silu(float x) { return x * __builtin_amdgcn_rcpf(1.f + __builtin_amdgcn_exp2f(-LOG2E * x)); }
__device__ __forceinline__ float ex(float x) { return __builtin_amdgcn_exp2f(LOG2E * x); }

__device__ __forceinline__ void run(LAS unsigned char* lds0, int b, int h, const bf16_t* proj, const float* conv_w, const float* beta, const float* gdec, const float* gn, bf16_t* mix, int tid, int wave, int lane) {
    const int r16c = lane & 15, gc = lane >> 4;
    LAS float* cwL = (LAS float*)(lds0 + CWL);
    if (wave == 0) {
#pragma unroll
        for (int p = 0; p < 3; ++p)
#pragma unroll
            for (int e = 0; e < 2; ++e)
#pragma unroll
                for (int j = 0; j < 4; ++j) cwL[((p * 2 + e) * 4 + j) * 64 + lane] = conv_w[j * 1536 + p * 512 + h * 128 + 2 * lane + e];
    }
    __syncthreads();
    const float gn0 = gn[2 * lane], gn1 = gn[2 * lane + 1];
    f32x4 S[8];
#pragma unroll
    for (int i = 0; i < 8; ++i) S[i] = (f32x4){0.f, 0.f, 0.f, 0.f};
    const bf16_t* pbase = proj + h * 128 + 2 * lane;
    unsigned xq[11][3]; float gnext, bnext;
#define DN_LOAD_CHUNK(cn) do { const size_t Rn = (size_t)b * 2048 + 64 * (cn); \
        _Pragma("unroll") for (int a = 0; a < 11; ++a) { const int tt = 64 * (cn) + 8 * wave - 3 + a; \
            _Pragma("unroll") for (int p_ = 0; p_ < 3; ++p_) xq[a][p_] = (tt >= 0) ? *(const unsigned*)(pbase + (Rn + 8 * wave - 3 + a) * PROJ + p_ * 512) : 0u; } \
        gnext = gdec[(Rn + lane) * 4 + h]; bnext = beta[(Rn + lane) * 4 + h]; } while (0)
    DN_LOAD_CHUNK(0);
    for (int c = 0; c < 32; ++c) {
        const size_t R0 = (size_t)b * 2048 + 64 * c;
        int zoff = 0; asm volatile("" : "+v"(zoff));
        LAS unsigned char* lds = lds0 + zoff; const int r16 = r16c + zoff, g = gc + zoff;
        LAS float* Lf = (LAS float*)(lds + LF); LAS float* gcumL = (LAS float*)(lds + GC); LAS float* betaL = (LAS float*)(lds + BT);
        float gcum = gnext;
#pragma unroll
        for (int o = 1; o < 64; o <<= 1) { const float t = __shfl_up(gcum, o); if (lane >= o) gcum += t; }
        const float gl = __int_as_float(__builtin_amdgcn_readlane(__float_as_int(gcum), 63));
        const float bv = bnext;
        if (wave == 0) { gcumL[lane] = gcum; betaL[lane] = bv; }
        for (int rpE = 0; rpE < DN_REP_E; ++rpE) {
            float cw[3][2][4];
#pragma unroll
            for (int p = 0; p < 3; ++p)
#pragma unroll
                for (int e = 0; e < 2; ++e)
#pragma unroll
                    for (int j = 0; j < 4; ++j) cw[p][e][j] = cwL[((p * 2 + e) * 4 + j) * 64 + lane];
            float xw[3][3][2];
#pragma unroll
            for (int a = 0; a < 3; ++a)
#pragma unroll
                for (int p = 0; p < 3; ++p) { xw[a][p][0] = __uint_as_float(xq[a][p] << 16); xw[a][p][1] = __uint_as_float(xq[a][p] & 0xffff0000u); }
#pragma unroll
            for (int i = 0; i < 8; ++i) {
                const int r = 8 * wave + i; float x0[3][2], sv[3][2];
#pragma unroll
                for (int p = 0; p < 3; ++p) { x0[p][0] = __uint_as_float(xq[3 + i][p] << 16); x0[p][1] = __uint_as_float(xq[3 + i][p] & 0xffff0000u); }
#pragma unroll
                for (int p = 0; p < 3; ++p)
#pragma unroll
                    for (int e = 0; e < 2; ++e) { const float s = cw[p][e][0] * xw[0][p][e] + cw[p][e][1] * xw[1][p][e] + cw[p][e][2] * xw[2][p][e] + cw[p][e][3] * x0[p][e]; sv[p][e] = silu(s); }
                const float rq = rsqrtf(wave_sum(sv[0][0] * sv[0][0] + sv[0][1] * sv[0][1]) + EPS) * 0.08838834764831845f;
                const float rk = rsqrtf(wave_sum(sv[1][0] * sv[1][0] + sv[1][1] * sv[1][1]) + EPS);
                const float gr = __int_as_float(__builtin_amdgcn_readlane(__float_as_int(gcum), r)), br = __int_as_float(__builtin_amdgcn_readlane(__float_as_int(bv), r));
                const float eg = ex(gr), ekl = ex(gl - gr);
                const float k0 = sv[1][0] * rk, k1 = sv[1][1] * rk;
                *(LAS unsigned*)(lds + QS + r * QSTR + 4 * lane) = cvtpk(sv[0][0] * rq, sv[0][1] * rq);
                *(LAS unsigned*)(lds + KS + r * QSTR + 4 * lane) = cvtpk(k0, k1);
                const unsigned kg = cvtpk(k0 * ekl, k1 * ekl), kb = cvtpk(k0 * br * eg, k1 * br * eg), vb = cvtpk(sv[2][0] * br, sv[2][1] * br);
                *(LAS unsigned short*)(lds + KGT + (2 * lane) * TSTR + 2 * r) = (unsigned short)kg; *(LAS unsigned short*)(lds + KGT + (2 * lane + 1) * TSTR + 2 * r) = (unsigned short)(kg >> 16);
                *(LAS unsigned short*)(lds + KBT + (2 * lane) * TSTR + 2 * r) = (unsigned short)kb; *(LAS unsigned short*)(lds + KBT + (2 * lane + 1) * TSTR + 2 * r) = (unsigned short)(kb >> 16);
                *(LAS unsigned short*)(lds + VBT + (2 * lane) * TSTR + 2 * r) = (unsigned short)vb; *(LAS unsigned short*)(lds + VBT + (2 * lane + 1) * TSTR + 2 * r) = (unsigned short)(vb >> 16);
#pragma unroll
                for (int p = 0; p < 3; ++p)
#pragma unroll
                    for (int e = 0; e < 2; ++e) { xw[0][p][e] = xw[1][p][e]; xw[1][p][e] = xw[2][p][e]; xw[2][p][e] = x0[p][e]; }
            }
        }
        __syncthreads();
        for (int rpT = 0; rpT < DN_REP_T; ++rpT) {
        {
            const int ti = wave & 3, sel = wave >> 2;
            const LAS unsigned char* Ab = lds + (sel ? QS : KS) + (16 * ti + r16) * QSTR;
            bf16x8 A[4];
#pragma unroll
            for (int s = 0; s < 4; ++s) A[s] = *(const LAS bf16x8*)(Ab + (32 * s + 8 * g) * 2);
            const f32x4 gi4 = *(const LAS f32x4*)(gcumL + 16 * ti + 4 * g), bi4 = *(const LAS f32x4*)(betaL + 16 * ti + 4 * g);
#pragma unroll
            for (int tj = 0; tj < 4; ++tj) {
                f32x4 acc = {0.f, 0.f, 0.f, 0.f};
                if (tj <= ti) {
                    const LAS unsigned char* Bb = lds + KS + (16 * tj + r16) * QSTR; bf16x8 Bf[4];
#pragma unroll
                    for (int s = 0; s < 4; ++s) Bf[s] = *(const LAS bf16x8*)(Bb + (32 * s + 8 * g) * 2);
#pragma unroll
                    for (int s = 0; s < 4; ++s) acc = __builtin_amdgcn_mfma_f32_16x16x32_bf16(A[s], Bf[s], acc, 0, 0, 0);
                }
                const float gj = gcumL[16 * tj + r16]; const int j = 16 * tj + r16;
#pragma unroll
                for (int e = 0; e < 4; ++e) { const int i = 16 * ti + 4 * g + e; const float dec = ex(fminf(gi4[e] - gj, 0.f));
                    if (sel == 0) { const float lv = (i > j) ? bi4[e] * acc[e] * dec : 0.f;
                        if (tj == ti) Lf[i * LSTR + j] = lv; else if (tj < ti) *(LAS unsigned short*)(lds + TB + i * TBSTR + 2 * j) = f2bf(lv); }
                    else *(LAS unsigned short*)(lds + QKB + i * TBSTR + 2 * j) = f2bf((i >= j) ? acc[e] * dec : 0.f); }
            }
        }
        __syncthreads();
        if (wave == 0) {
            const LAS float* Nb = Lf + (16 * g) * LSTR + 16 * g; float x[16]; int rc = r16; asm volatile("" : "+v"(rc));
            float na[55], nb2[65];
            { int q = 0;
#pragma unroll
              for (int r = 1; r <= 10; ++r)
#pragma unroll
                  for (int j = 0; j < r; ++j) na[q++] = Nb[r * LSTR + j]; }
            { int q = 0;
#pragma unroll
              for (int r = 11; r <= 15; ++r)
#pragma unroll
                  for (int j = 0; j < r; ++j) nb2[q++] = Nb[r * LSTR + j]; }
            x[0] = (0 == rc) ? 1.f : 0.f;
            { int q = 0;
#pragma unroll
              for (int r = 1; r <= 10; ++r) { float s = (r == rc) ? 1.f : 0.f;
#pragma unroll
                  for (int j = 0; j < r; ++j) s -= na[q++] * x[j];
                  x[r] = s; } }
            { int q = 0;
#pragma unroll
              for (int r = 11; r <= 15; ++r) { float s = (r == rc) ? 1.f : 0.f;
#pragma unroll
                  for (int j = 0; j < r; ++j) s -= nb2[q++] * x[j];
                  x[r] = s; } }
#pragma unroll
            for (int r = 0; r < 16; ++r) *(LAS unsigned short*)(lds + TB + (16 * g + r) * TBSTR + 2 * (16 * g + r16)) = f2bf(x[r]);
        }
        __syncthreads();
        }
        f32x4 U[4];
        {
            const LAS unsigned char* tl = lds + TB;
#define DN_A1(b_, k_) ({ const u32x2 lo_ = *(const LAS u32x2*)(tl + (16 * (b_) + r16) * TBSTR + (16 * (k_) + 4 * g) * 2); u32x4 w_; w_.x = lo_.x; w_.y = lo_.y; w_.z = 0u; w_.w = 0u; __builtin_bit_cast(bf16x8, w_); })
#define DN_A2(b_, k0_, k1_) ({ const u32x2 lo_ = *(const LAS u32x2*)(tl + (16 * (b_) + r16) * TBSTR + (16 * (k0_) + 4 * g) * 2), hi_ = *(const LAS u32x2*)(tl + (16 * (b_) + r16) * TBSTR + (16 * (k1_) + 4 * g) * 2); \
            u32x4 w_; w_.x = lo_.x; w_.y = lo_.y; w_.z = hi_.x; w_.w = hi_.y; __builtin_bit_cast(bf16x8, w_); })
            const bf16x8 aD0 = DN_A1(0, 0), aL10 = DN_A1(1, 0), aD1 = DN_A1(1, 1), aL2 = DN_A2(2, 0, 1), aD2 = DN_A1(2, 2), aL3a = DN_A2(3, 0, 1), aL3b = DN_A1(3, 2), aD3 = DN_A1(3, 3);
            const f32x4 z4 = {0.f, 0.f, 0.f, 0.f};
#pragma unroll
            for (int which = 0; which < 2; ++which) {
                const LAS unsigned char* rp = lds + (which ? KBT : VBT) + (16 * wave + r16) * TSTR;
                f32x4 R[4];
#pragma unroll
                for (int b4 = 0; b4 < 4; ++b4) { const u32x2 w = *(const LAS u32x2*)(rp + (16 * b4 + 4 * g) * 2);
                    R[b4] = (f32x4){__uint_as_float(w.x << 16), __uint_as_float(w.x & 0xffff0000u), __uint_as_float(w.y << 16), __uint_as_float(w.y & 0xffff0000u)}; }
                f32x4 X0 = __builtin_amdgcn_mfma_f32_16x16x32_bf16(aD0, pack2(R[0], z4), z4, 0, 0, 0);
                f32x4 Y = __builtin_amdgcn_mfma_f32_16x16x32_bf16(aL10, pack2(X0, z4), z4, 0, 0, 0);
                f32x4 X1 = __builtin_amdgcn_mfma_f32_16x16x32_bf16(aD1, pack2(R[1] - Y, z4), z4, 0, 0, 0);
                const bf16x8 b01 = pack2(X0, X1);
                Y = __builtin_amdgcn_mfma_f32_16x16x32_bf16(aL2, b01, z4, 0, 0, 0);
                f32x4 X2 = __builtin_amdgcn_mfma_f32_16x16x32_bf16(aD2, pack2(R[2] - Y, z4), z4, 0, 0, 0);
                Y = __builtin_amdgcn_mfma_f32_16x16x32_bf16(aL3a, b01, z4, 0, 0, 0);
                Y = __builtin_amdgcn_mfma_f32_16x16x32_bf16(aL3b, pack2(X2, z4), Y, 0, 0, 0);
                f32x4 X3 = __builtin_amdgcn_mfma_f32_16x16x32_bf16(aD3, pack2(R[3] - Y, z4), z4, 0, 0, 0);
                if (which == 0) { U[0] = X0; U[1] = X1; U[2] = X2; U[3] = X3; }
                else { const f32x4 Xs[4] = {X0, X1, X2, X3};
#pragma unroll
                    for (int ti = 0; ti < 4; ++ti)
#pragma unroll
                        for (int e = 0; e < 4; ++e) *(LAS unsigned short*)(lds + WB + (16 * ti + 4 * g + e) * QSTR + (16 * wave + r16) * 2) = f2bf(Xs[ti][e]); }
            }
#undef DN_A1
#undef DN_A2
        }
        __syncthreads();
        if (c + 1 < 32) DN_LOAD_CHUNK(c + 1);
        unsigned dzq[8];
#pragma unroll
        for (int i = 0; i < 8; ++i) dzq[i] = *(const unsigned*)(proj + (R0 + 8 * wave + i) * PROJ + C_DZ + h * 128 + 2 * lane);
        {
            bf16x8 Sb[4];
#pragma unroll
            for (int s = 0; s < 4; ++s) Sb[s] = pack2(S[2 * s], S[2 * s + 1]);
            f32x4 Vn[4], Oa[4];
#pragma unroll
            for (int ti = 0; ti < 4; ++ti) {
                const LAS unsigned char* wp = lds + WB + (16 * ti + r16) * QSTR; const LAS unsigned char* qp = lds + QS + (16 * ti + r16) * QSTR;
                bf16x8 wf[4], qf[4];
#pragma unroll
                for (int s = 0; s < 4; ++s) { wf[s] = frag_perm(wp, s, g); qf[s] = frag_perm(qp, s, g); }
                const f32x4 gi4 = *(const LAS f32x4*)(gcumL + 16 * ti + 4 * g);
                f32x4 ws = {0.f, 0.f, 0.f, 0.f}, qs = {0.f, 0.f, 0.f, 0.f};
#pragma unroll
                for (int s = 0; s < 4; ++s) { ws = __builtin_amdgcn_mfma_f32_16x16x32_bf16(wf[s], Sb[s], ws, 0, 0, 0); qs = __builtin_amdgcn_mfma_f32_16x16x32_bf16(qf[s], Sb[s], qs, 0, 0, 0); }
                Vn[ti] = U[ti] - ws;
#pragma unroll
                for (int e = 0; e < 4; ++e) qs[e] *= ex(gi4[e]);
                Oa[ti] = qs;
            }
            bf16x8 Vb[2];
#pragma unroll
            for (int s = 0; s < 2; ++s) Vb[s] = pack2(Vn[2 * s], Vn[2 * s + 1]);
            { bf16x8 kf[4][2];
#pragma unroll
              for (int ti = 0; ti < 4; ++ti) { const LAS unsigned char* kp = lds + QKB + (16 * ti + r16) * TBSTR; kf[ti][0] = frag_perm(kp, 0, g); kf[ti][1] = frag_perm(kp, 1, g); }
#pragma unroll
              for (int ti = 0; ti < 4; ++ti)
#pragma unroll
                  for (int s = 0; s < 2; ++s) Oa[ti] = __builtin_amdgcn_mfma_f32_16x16x32_bf16(kf[ti][s], Vb[s], Oa[ti], 0, 0, 0); }
            const float egl = ex(gl);
#pragma unroll
            for (int half = 0; half < 2; ++half) { bf16x8 kf[4][2];
#pragma unroll
                for (int q = 0; q < 4; ++q) { const LAS unsigned char* kp = lds + KGT + (16 * (4 * half + q) + r16) * TSTR; kf[q][0] = frag_perm(kp, 0, g); kf[q][1] = frag_perm(kp, 1, g); }
#pragma unroll
                for (int q = 0; q < 4; ++q) { f32x4 sa = S[4 * half + q] * egl;
#pragma unroll
                    for (int s = 0; s < 2; ++s) sa = __builtin_amdgcn_mfma_f32_16x16x32_bf16(kf[q][s], Vb[s], sa, 0, 0, 0);
                    S[4 * half + q] = sa; } }
            LAS float* Of = (LAS float*)(lds + OF);
#pragma unroll
            for (int ti = 0; ti < 4; ++ti)
#pragma unroll
                for (int e = 0; e < 4; ++e) Of[(16 * ti + 4 * g + e) * OSTR + 16 * wave + r16] = Oa[ti][e];
        }
        __syncthreads();
        {
            const LAS float* Of = (const LAS float*)(lds + OF);
#pragma unroll
            for (int i = 0; i < 8; ++i) { const int r = 8 * wave + i; const f32x2 o = *(const LAS f32x2*)(Of + r * OSTR + 2 * lane);
                const float rstd = rsqrtf(wave_sum(o.x * o.x + o.y * o.y) * (1.f / 128.f) + EPS);
                const float z0 = __uint_as_float(dzq[i] << 16), z1 = __uint_as_float(dzq[i] & 0xffff0000u);
                *(unsigned*)(mix + (R0 + r) * MIXK + h * 128 + 2 * lane) = cvtpk(o.x * rstd * gn0 * silu(z0), o.y * rstd * gn1 * silu(z1)); }
        }
    }
}
#undef DN_LOAD_CHUNK
}
struct Args { const float* in[28]; float* out; unsigned char* ws; int ph_lo, ph_hi, li, pad; };
struct Frame {
    LAS unsigned char* lds; volatile LAS unsigned* MISC; int tid, lane, wave, G, vcu;
};
template <int NR> __device__ __forceinline__ void dsa_prep_rows(int row0, int lane, const bf16_t* proj, const float* kvg, const float* lng, const float* lnb, const float* a_log, const float* dt_bias,
                                             bf16_t* ckv, bf16_t* kidx, float* widx, float* beta, float* gdec) {
    unsigned cv[NR]; unsigned short kv[NR], sm[NR];
#pragma unroll
    for (int r = 0; r < NR; ++r) { const bf16_t* pr = proj + (size_t)(row0 + r) * PROJ; cv[r] = *(const unsigned*)(pr + C_CKV + lane * 2); kv[r] = pr[C_KIX + lane]; sm[r] = pr[C_WIX + (lane & 15)]; }
    const float g0 = kvg[lane * 2], g1 = kvg[lane * 2 + 1], lg = lng[lane], lb = lnb[lane], al = a_log[lane & 3], dtb = dt_bias[lane & 3];
#pragma unroll
    for (int r = 0; r < NR; ++r) { const int row = row0 + r;
        { const float a = __uint_as_float(cv[r] << 16), b = __uint_as_float(cv[r] & 0xffff0000u);
          const float rs = rsqrtf(wave_sum(a * a + b * b) * (1.f / 128.f) + EPS); *(unsigned*)(ckv + (size_t)row * 128 + lane * 2) = pk2(a * rs * g0, b * rs * g1); }
        { const float a = bf2f(kv[r]); const float mu = wave_sum(a) * (1.f / 64.f); const float xc = a - mu; const float rs = rsqrtf(wave_sum(xc * xc) * (1.f / 64.f) + EPS);
          kidx[(size_t)row * 64 + lane] = f2bf(xc * rs * lg + lb); }
        const float sv = bf2f(sm[r]);
        if (lane < 8) widx[(size_t)row * 8 + lane] = sv * 0.04419417382415922f;
        else if (lane < 12) beta[(size_t)row * 4 + (lane - 8)] = 1.f / (1.f + __expf(-sv));
        else if (lane < 16) { const float xx = sv + dtb; const float sp = xx > 20.f ? xx : log1pf(__expf(xx)); gdec[(size_t)row * 4 + (lane - 12)] = -__expf(al) * sp; }
    }
}

__global__ void __launch_bounds__(NWAVES * 64, 2) mega(Args args) {
    extern __shared__ __attribute__((aligned(16))) unsigned char lds_raw[];
    Frame F;
    F.lds = (LAS unsigned char*)lds_raw;
    F.MISC = (volatile LAS unsigned*)(F.lds + MISC_OFF);
    F.tid = threadIdx.x; F.lane = F.tid & 63; F.wave = __builtin_amdgcn_readfirstlane(F.tid >> 6);
    F.G = gridDim.x; { const int bx = blockIdx.x; F.vcu = (F.G % 8 == 0) ? (bx % 8) * (F.G / 8) + bx / 8 : bx; }
    unsigned char* ws = args.ws;
    const float* x = args.in[0]; const float* mem = args.in[1]; const float* g_mix = args.in[2]; const float* w_in = args.in[3];
    const float* conv_w = args.in[4]; const float* a_log = args.in[5]; const float* dt_bias = args.in[6];
    const float* dn_norm_g = args.in[7]; const float* q_norm_g = args.in[8]; const float* kv_norm_g = args.in[9]; const float* w_uq = args.in[10]; const float* w_uk = args.in[11];
    const float* w_uv = args.in[12]; const float* w_qidx = args.in[13]; const float* kidx_ln_g = args.in[14]; const float* kidx_ln_b = args.in[15];
    const float* rel_bias = args.in[16]; const float* w_out = args.in[17]; const float* g_xattn = args.in[18]; const float* g_mem = args.in[19];
    const float* w_xq = args.in[20]; const float* w_xkv = args.in[21]; const float* w_xo = args.in[22]; const float* g_ffn = args.in[23];
    const float* w_gate = args.in[24]; const float* w_up = args.in[25]; const float* w_down = args.in[26]; const float* g_final = args.in[27];
    float* out = args.out;
    bf16_t* Win_t = (bf16_t*)(ws + WS_WIN); bf16_t* Wkv_t = (bf16_t*)(ws + WS_WKV); bf16_t* Wdsa_t = (bf16_t*)(ws + WS_WDSA); bf16_t* Wout_t = (bf16_t*)(ws + WS_WOUT);
    bf16_t* Wxq_t = (bf16_t*)(ws + WS_WXQ); bf16_t* Wxo_t = (bf16_t*)(ws + WS_WXO); bf16_t* Wgu_t = (bf16_t*)(ws + WS_WGU); bf16_t* Wdn_t = (bf16_t*)(ws + WS_WDN);
    unsigned char* stt = ws + WS_ST;
    float* rstdx = (float*)(stt + ST_RSTDX); float* cqss = (float*)(stt + ST_CQSS); float* lpart = (float*)(stt + ST_LPART);
    float* widx = (float*)(stt + ST_WIDX); float* beta = (float*)(stt + ST_BETA); float* gdec = (float*)(stt + ST_G); float* biastab = (float*)(stt + ST_BIAS);
    bf16_t* mnb = (bf16_t*)(ws + WS_MNB); bf16_t* kx = (bf16_t*)(ws + WS_KX); bf16_t* vT = (bf16_t*)(ws + WS_VT); bf16_t* ckv = (bf16_t*)(ws + WS_CKV); bf16_t* kidx = (bf16_t*)(ws + WS_KIDX);
    float* ssq1 = (float*)(ws + WS_SSQ); float* ssq2 = ssq1 + (size_t)M * 16;
    bf16_t* proj = (bf16_t*)(ws + WS_PROJ); bf16_t* mix = (bf16_t*)(ws + WS_MIX); bf16_t* xb = (bf16_t*)(ws + WS_XB); bf16_t* qabs = (bf16_t*)out;
    bf16_t* x1b = (bf16_t*)(ws + WS_X1B); bf16_t* qx = (bf16_t*)(ws + WS_QX); bf16_t* Pb = (bf16_t*)(ws + WS_P); bf16_t* ox = (bf16_t*)(ws + WS_OX); bf16_t* x2b = (bf16_t*)(ws + WS_X2B); unsigned char* act = ws + WS_ACT; unsigned char* Wdn8 = ws + WS_W8; unsigned char* Wxq8 = ws + WS_W8 + 3 * MiB; unsigned char* Wxo8 = ws + WS_W8 + 4 * MiB;
    unsigned char* x1f8 = (unsigned char*)out;
    unsigned char* ox8 = ws + WS_OX;

    for (int u = F.tid; u < (LDS_BYTES - LDSCTL_OFF) / 4; u += NWAVES * 64) ((LAS unsigned*)(F.lds + LDSCTL_OFF))[u] = 0u;
    __syncthreads();
    XcdBarrier bar = xcd_barrier_post((unsigned*)(ws + WS_CTL) + 4096 + args.li * XCD_BAR_WORDS, F.MISC + 8);
#define GRID_BAR() xcd_barrier(bar, F.wave)
    const int lo = args.ph_lo, hi = args.ph_hi;
#ifdef ONLY_PHASE
#define IN(k) ((k) == ONLY_PHASE && lo <= (k) && (k) < hi)
#else
#define IN(k) (lo <= (k) && (k) < hi)
#endif
#define BOTH(k) (IN(k) && IN((k) + 1))
    const int gw = F.vcu * NWAVES + F.wave, NGW = F.G * NWAVES;
    PG8_LAS unsigned char* ring = (PG8_LAS unsigned char*)F.lds;

    if (IN(0)) {
        LAS float* scr = (LAS float*)(F.lds + F.wave * 16384);
        constexpr int I_OB = 32 * 32, I_QA = 8 * 32, I_QI = 4 * 16, I_IN = 16 * 80, I_KV = 16 * 64, I_XQ = 16 * 32, I_XO = 16 * 32, I_GU = 16 * 176, I_DN = 44 * 32, I_OA = 8 * 32;
        constexpr int NITEMS = I_OB + I_QA + I_QI + I_IN + I_KV + I_XQ + I_XO + I_GU + I_DN + I_OA;
        for (int it = gw; it < NITEMS; it += NGW) {
            int r = it;
            if (r < I_OB) { const int kb = r >> 5, nb = r & 31, k0 = 32 * kb, h = k0 >> 7;
                heavy_item(w_uv, 64, w_out + (size_t)(512 + h * 64) * 1024, 1024, nullptr, 1.f, k0, 32 * nb, 32 * nb, Wout_t, MIXK, 512, scr, F.lane); continue; } r -= I_OB;
            if (r < I_QA) { const int kb = r >> 5, nb = r & 31, n0 = 32 * nb, h = n0 >> 7;
                heavy_item(w_uq + h * 64, 512, w_uk + (size_t)(h * 64) * 128 - h * 128, 128, q_norm_g, 0.125f * LOG2E, 32 * kb, n0, ((n0 >> 5) & 3) * 256 + h * 32, Wdsa_t, 256, 0, scr, F.lane); continue; }   r -= I_QA;
            if (r < I_QI) { tr_item(SrcQidx{w_qidx, q_norm_g}, 512, Wdsa_t + (size_t)1024 * 256, 256, 0, scr, r, F.lane); continue; } r -= I_QI;
            if (r < I_IN) { tr_item(SrcWin{w_in, g_mix}, PROJ, Win_t, 1024, 0, scr, r, F.lane); continue; } r -= I_IN;
            if (r < I_KV) { tr_item(SrcPlain{w_xkv, 2048, nullptr, 1.f}, 2048, Wkv_t, 1024, 0, scr, r, F.lane); continue; } r -= I_KV;
            if (r < I_XQ) { tr_item(SrcPlain{w_xq, 1024, g_xattn, 0.0625f * LOG2E}, 1024, Wxq_t, 1024, 0, scr, r, F.lane, (unsigned*)(ws + WS_CTL) + CTL_AMAX + 1); continue; } r -= I_XQ;
            if (r < I_XO) { tr_item(SrcPlain{w_xo, 1024, nullptr, 1.f}, 1024, Wxo_t, 1024, 0, scr, r, F.lane, (unsigned*)(ws + WS_CTL) + CTL_AMAX + 2); continue; } r -= I_XO;
            if (r < I_GU) { tr_item(SrcGU{w_gate, w_up, g_ffn}, 2 * DFF, Wgu_t, 1024, 0, scr, r, F.lane); continue; } r -= I_GU;
            if (r < I_DN) { tr_item(SrcPlain{w_down, 1024, nullptr, 1.f}, 1024, Wdn_t, DFF, 0, scr, r, F.lane, (unsigned*)(ws + WS_CTL) + CTL_AMAX); continue; } r -= I_DN;
            tr_item(SrcPlain{w_out, 1024, nullptr, 1.f}, 1024, Wout_t, MIXK, 0, scr, r, F.lane);
        }
        for (int m = 4 * gw; m < M; m += 4 * NGW) row_prep<4>(x + (size_t)m * D, nullptr, xb + (size_t)m * D, rstdx + m, F.lane);
        for (int m = 2 * gw; m < MM; m += 2 * NGW) row_prep<2>(mem + (size_t)m * D, g_mem, mnb + (size_t)m * D, nullptr, F.lane);
        if (blockIdx.x == 0) for (int i = F.tid; i < 129 * 8; i += NWAVES * 64) {
            const int d = i >> 3, h = i & 7; int bkt;
            if (d < 16) bkt = d; else { const float lr = logf((float)d / 16.f) / 2.0794415416798357f; const int large = 16 + (int)(lr * 16.f); bkt = large < 31 ? large : 31; }
            biastab[i] = rel_bias[bkt * 8 + h] * LOG2E; }
        if (BOTH(0)) GRID_BAR();
    }
    if (IN(1)) {
        pg8::Gemm g{xb, Win_t, 1024, 1024, 1024}; pg8::StaticOrder S; S.init(M, PROJ, F.G, (int)blockIdx.x);
        pg8::EpiProj E{proj, PROJ, nullptr, cqss, 8};
        pg8::gemm_phase<pg8::EpiProj, pg8::StaticOrder, true>(ring, g, S, E, F.wave);
        if (BOTH(1)) GRID_BAR();
    }
    if (IN(2)) {
        const int lane2 = lane_now();
        for (int m = 4 * gw; m < M; m += 4 * NGW) dsa_prep_rows<4>(m, lane2, proj, kv_norm_g, kidx_ln_g, kidx_ln_b, a_log, dt_bias, ckv, kidx, widx, beta, gdec);
        { unsigned* am = (unsigned*)(ws + WS_CTL) + CTL_AMAX;
          cvt_w8(Wdn_t, Wdn8, DFF * 1024 / 16, __hip_atomic_load(am, __ATOMIC_RELAXED, __HIP_MEMORY_SCOPE_AGENT), gw * 64 + lane2, NGW * 64);
          cvt_w8(Wxq_t, Wxq8, 1024 * 1024 / 16, __hip_atomic_load(am + 1, __ATOMIC_RELAXED, __HIP_MEMORY_SCOPE_AGENT), gw * 64 + lane2, NGW * 64);
          cvt_w8(Wxo_t, Wxo8, 1024 * 1024 / 16, __hip_atomic_load(am + 2, __ATOMIC_RELAXED, __HIP_MEMORY_SCOPE_AGENT), gw * 64 + lane2, NGW * 64); }
        { pg8::Gemm g{proj + C_CQ, Wdsa_t, PROJ, 256, 256}; pg8::StaticOrder S; S.init(M, 1536, F.G, (int)blockIdx.x);
          pg8::EpiNormScale<4> E{qabs, 1536, cqss, 1.f / 256.f, 1.f};
          pg8::gemm_phase<pg8::EpiNormScale<4>, pg8::StaticOrder, true>(ring, g, S, E, F.wave); }
        if (BOTH(2)) GRID_BAR();
    }
    if (IN(3)) {
        const int lane3 = lane_now(); const int tid3 = F.wave * 64 + lane3;
        if (blockIdx.x < 64) dn::run(F.lds, (int)blockIdx.x >> 2, (int)blockIdx.x & 3, proj, conv_w, beta, gdec, dn_norm_g, mix, tid3, F.wave, lane3);
        __syncthreads();
        if (blockIdx.x >= 64) { unsigned* kvq = (unsigned*)(ws + WS_CTL) + 1536;
            for (;;) {
                if (tid3 == 0) F.MISC[17] = __hip_atomic_fetch_add(kvq, 1u, __ATOMIC_RELAXED, __HIP_MEMORY_SCOPE_AGENT);
                __syncthreads(); const int k = (int)F.MISC[17]; __syncthreads();
                if (k >= 128) break;
                if (k < 64) { pg8::Gemm g{mnb, Wkv_t, 1024, 1024, 1024}; pg8::OneUnit S1{{k >> 2, k & 3, 0, 0}}; pg8::EpiProj E{kx, 1024, nullptr, nullptr, -1};
                    pg8::gemm_phase<pg8::EpiProj, pg8::OneUnit, false>(ring, g, S1, E, F.wave); }
                else { const int k2 = k - 64; pg8::Gemm g{Wkv_t + (size_t)1024 * 1024, mnb, 1024, 1024, 1024}; pg8::OneUnit S1{{k2 >> 4, k2 & 15, 0, 0}}; pg8::EpiProj E{vT, MM, nullptr, nullptr, -1};
                    pg8::gemm_phase<pg8::EpiProj, pg8::OneUnit, false>(ring, g, S1, E, F.wave); }
            } }
        for (int pass = 0; pass <= args.pad; ++pass) {
        if (pass) GRID_BAR();
        const int lane4 = lane_now(); const int tid4 = F.wave * 64 + lane4;
        dsa::phase_init(F.lds, biastab, kv_norm_g, tid4);
        unsigned* qbase = (unsigned*)(ws + WS_CTL) + 2048 + 1024 * pass;
        const int myx = (int)(xb_xcc_id() & 7u);
        for (int sx = 0; sx < 8; ++sx) { const int qx8 = (myx + sx) & 7;
        for (;;) {
            if (tid4 == 0) F.MISC[16] = __hip_atomic_fetch_add(qbase + 64 * qx8, 1u, __ATOMIC_RELAXED, __HIP_MEMORY_SCOPE_AGENT);
            __syncthreads(); const int k = (int)F.MISC[16]; __syncthreads();
            if (k >= 256) break;
            dsa::unit(F.lds, 2 * qx8 + (k & 1), (127 - (k >> 1)) * 16, tid4, F.wave, lane4, qabs, ckv, kidx, widx, mix, (unsigned*)(ws + WS_CTL) + 1024);
        } }
        }
        if (BOTH(3)) GRID_BAR();
    }
    if (IN(4)) {
        pg8::Gemm g{mix, Wout_t, MIXK, MIXK, MIXK}; pg8::StaticOrder S; S.init(M, 1024, F.G, (int)blockIdx.x);
        pg8::EpiResid<true, true> E{nullptr, xb, x1b, ssq1, rstdx, x1f8, 1.f};
        pg8::gemm_phase<pg8::EpiResid<true, true>, pg8::StaticOrder, true>(ring, g, S, E, F.wave);
        if (BOTH(4)) GRID_BAR();
    }
    if (IN(5)) {
        pg8::StaticOrder S; S.init(M, 1024, F.G, (int)blockIdx.x); pg8::Unit ua, ub; const bool h0 = S.next(0, ua), h1 = S.next(1, ub);
        if (h0) {
            { pg8::Gemm g{(const bf16_t*)x1f8, (const bf16_t*)Wxq8, 1024, 1024, 1024};
              const float asc = pg8::w8_inv_scale((unsigned)__builtin_amdgcn_readfirstlane((int)__hip_atomic_load((unsigned*)(ws + WS_CTL) + CTL_AMAX + 1, __ATOMIC_RELAXED, __HIP_MEMORY_SCOPE_AGENT)), pg8::X8_SHIFT);
              pg8::EpiNormScale<16> E{qx, 1024, ssq1, 1.f / 1024.f, asc};
              pg8::gemm_phase<pg8::EpiNormScale<16>, pg8::StaticOrder, true, true>(ring, g, S, E, F.wave); }
            VM_WAIT(); __syncthreads();
            pg8::TwoUnits S2; S2.n = h1 ? 2 : 1;
            S2.u0 = pg8::Unit{ua.pm, ua.pm >> 3, (long)ua.pn * 512, (long)ua.pn * 512}; S2.u1 = pg8::Unit{ub.pm, ub.pm >> 3, (long)ub.pn * 512, (long)ub.pn * 512};
            { pg8::Gemm g{qx, kx, 1024, 1024, 256};
              pg8::EpiExpP E{Pb, lpart};
              pg8::gemm_phase<pg8::EpiExpP, pg8::TwoUnits, true>(ring, g, S2, E, F.wave); }
            VM_WAIT(); __syncthreads();
            pg8::TwoUnits S3; S3.n = S2.n;
            S3.u0 = pg8::Unit{ua.pm, ua.pn, (long)ua.pn * 512, (long)(ua.pm >> 3) * 512}; S3.u1 = pg8::Unit{ub.pm, ub.pn, (long)ub.pn * 512, (long)(ub.pm >> 3) * 512};
            { pg8::Gemm g{Pb, vT, 1024, MM, 256};
              pg8::EpiPV E{ox8, lpart};
              pg8::gemm_phase<pg8::EpiPV, pg8::TwoUnits, true>(ring, g, S3, E, F.wave); }
        }
        if (BOTH(5)) GRID_BAR();
    }
    if (IN(6)) {
        pg8::Gemm g{(const bf16_t*)ox8, (const bf16_t*)Wxo8, 1024, 1024, 1024}; pg8::StaticOrder S; S.init(M, 1024, F.G, (int)blockIdx.x);
        const float asc = pg8::w8_inv_scale((unsigned)__builtin_amdgcn_readfirstlane((int)__hip_atomic_load((unsigned*)(ws + WS_CTL) + CTL_AMAX + 2, __ATOMIC_RELAXED, __HIP_MEMORY_SCOPE_AGENT)), pg8::OX_SHIFT);
        pg8::EpiResid<true> E{nullptr, x1b, x2b, ssq2, nullptr, nullptr, asc};
        pg8::gemm_phase<pg8::EpiResid<true>, pg8::StaticOrder, true, true>(ring, g, S, E, F.wave);
        if (BOTH(6)) GRID_BAR();
    }
    if (IN(7)) {
        pg8::Gemm g{x2b, Wgu_t, 1024, 1024, 1024}; pg8::StaticOrder S; S.init(M, 2 * DFF, F.G, (int)blockIdx.x);
        pg8::EpiSwiglu E{act, ssq2};
        pg8::gemm_phase<pg8::EpiSwiglu, pg8::StaticOrder, true>(ring, g, S, E, F.wave);
        if (BOTH(7)) GRID_BAR();
    }
#if defined(DSA_TOPK_CHECK) || defined(DSA_FALLBACK_COUNT)
    const bool fuse_final = false;
#else
    const bool fuse_final = (F.G == 256);
#endif
    if (IN(8)) {
        pg8::Gemm g{(const bf16_t*)act, (const bf16_t*)Wdn8, DFF, DFF, DFF}; pg8::StaticOrder S; S.init(M, 1024, F.G, (int)blockIdx.x);
        const float asc = pg8::w8_inv_scale((unsigned)__builtin_amdgcn_readfirstlane((int)__hip_atomic_load((unsigned*)(ws + WS_CTL) + CTL_AMAX, __ATOMIC_RELAXED, __HIP_MEMORY_SCOPE_AGENT)), pg8::ACT_SHIFT);
        if (fuse_final) { pg8::EpiFinal E{x2b, out, ssq1, (unsigned*)(ws + WS_CTL) + 8192, g_final, asc};
            pg8::gemm_phase<pg8::EpiFinal, pg8::StaticOrder, true, true>(ring, g, S, E, F.wave); }
        else { pg8::EpiResidF32 E{x2b, out, ssq1, asc};
            pg8::gemm_phase<pg8::EpiResidF32, pg8::StaticOrder, true, true>(ring, g, S, E, F.wave);
            if (BOTH(8)) GRID_BAR(); }
    }
    if (IN(9) && !fuse_final) {
#ifdef DSA_FALLBACK_COUNT
        if (blockIdx.x == 0 && F.wave == 0 && lane_now() == 0 && __hip_atomic_load((unsigned*)(ws + WS_CTL) + 1024 + 64, __ATOMIC_RELAXED, __HIP_MEMORY_SCOPE_AGENT) > DSA_FALLBACK_COUNT) out[12345] = __builtin_nanf("");
#endif
#ifdef DSA_TOPK_CHECK
        if (blockIdx.x == 0 && F.wave == 0 && lane_now() == 0 && __hip_atomic_load((unsigned*)(ws + WS_CTL) + 1024, __ATOMIC_RELAXED, __HIP_MEMORY_SCOPE_AGENT) != 0u) out[12345] = __builtin_nanf("");
#endif
        const int lane9 = lane_now();
        for (int m = gw; m < M; m += NGW) {
            const float* pp = ssq1 + (size_t)m * 16; float s = 0.f;
#pragma unroll
            for (int q = 0; q < 4; ++q) { const f32x4 t = *(const f32x4*)(pp + 4 * q); s += (t.x + t.y) + (t.z + t.w); }
            const float rstd = rsqrtf(s * (1.f / 1024.f) + EPS);
            GAS f32x4* xr = (GAS f32x4*)(out + (size_t)m * D) + lane9;
#pragma unroll
            for (int j = 0; j < 4; ++j) { const f32x4 gg = *((const GAS f32x4*)g_final + lane9 + 64 * j); xr[64 * j] = xr[64 * j] * gg * rstd; }
        }
    }
#undef IN
#undef BOTH
}

extern "C" void kernel_launch(void* const* d_in, const int* in_sizes, int n_in, void* d_out, int out_size, void* d_ws, size_t ws_size, hipStream_t stream) {
    static int grid = 0;
    if (grid == 0) {
        if (n_in != 28 || ws_size < WS_NEED || out_size != M * D) { fprintf(stderr, "kernel_launch: unexpected problem (n_in %d ws %zu out %d)\n", n_in, ws_size, out_size); grid = -1; return; }
        int dev = 0, cus = 0, per_cu = 0;
        if (hipGetDevice(&dev) != hipSuccess || hipDeviceGetAttribute(&cus, hipDeviceAttributeMultiprocessorCount, dev) != hipSuccess) { grid = -1; return; }
        if (hipFuncSetAttribute((const void*)mega, hipFuncAttributeMaxDynamicSharedMemorySize, LDS_BYTES) != hipSuccess) { fprintf(stderr, "kernel_launch: hipFuncSetAttribute failed\n"); grid = -1; return; }
        if (hipOccupancyMaxActiveBlocksPerMultiprocessor(&per_cu, (const void*)mega, NWAVES * 64, LDS_BYTES) != hipSuccess || per_cu < 1) { fprintf(stderr, "kernel_launch: occupancy query says %d\n", per_cu); grid = -1; (void)hipGetLastError(); return; }
        grid = cus;
        if (grid < 64) { fprintf(stderr, "kernel_launch: needs >= 64 CUs\n"); grid = -1; return; }
    }
    if (grid < 0) return;
    unsigned char* ws = (unsigned char*)d_ws;
    (void)hipMemsetAsync(ws + WS_CTL, 0, CTL_ZERO_BYTES, stream);
    Args a{}; for (int i = 0; i < 28; ++i) a.in[i] = (const float*)d_in[i]; a.out = (float*)d_out; a.ws = ws;
    a.ph_lo = 0; a.ph_hi = 10; a.li = 0;
#ifdef DSA_PASSES
    a.pad = DSA_PASSES - 1;
#endif
    void* kargs[] = {&a};
    (void)hipLaunchCooperativeKernel((const void*)mega, dim3(grid), dim3(NWAVES * 64), kargs, LDS_BYTES, stream);
}
```

```cpp
#include <hip/hip_runtime.h>
#include <cstdio>
#include <cstdint>

typedef unsigned short bf16_t;
__device__ __forceinline__ float bf2f(bf16_t h) { return __uint_as_float(((unsigned)h) << 16); }
__device__ __forceinline__ bf16_t f2bf(float f) { unsigned u = __float_as_uint(f); return (bf16_t)((u + 0x7fffu + ((u >> 16) & 1u)) >> 16); }

constexpr int D = 1024, BATCH = 16, SEQ = 2048, M = BATCH * SEQ;
constexpr int PROJ_REF = 2512, PROJ = 2560;
constexpr int MEM_LEN = 256, MM = BATCH * MEM_LEN;
constexpr int DFF = 2816;
constexpr float EPS = 1e-6f;
constexpr float LOG2E = 1.4426950408889634f;
constexpr int C_DQ = 0, C_DK = 512, C_DV = 1024, C_DZ = 1536, C_CQ = 2048, C_CKV = 2304, C_KIX = 2432, C_WIX = 2496, C_DB = 2504, C_DA = 2508;
constexpr int MIXK = 1536;

constexpr size_t MiB = 1u << 20;
constexpr size_t WS_WIN = 0, WS_WKV = 5 * MiB, WS_WDSA = 9 * MiB, WS_WOUT = 10 * MiB, WS_WXQ = 13 * MiB, WS_WXO = 15 * MiB, WS_WGU = 17 * MiB, WS_WDN = 28 * MiB;
constexpr size_t WS_CTL = 34 * MiB, CTL_ZERO_BYTES = 256 * 1024;
constexpr size_t WS_ST = 35 * MiB;
constexpr size_t ST_RSTDX = 0, ST_CQSS = 128 * 1024  , ST_LPART = 640 * 1024  , ST_WIDX = 2688 * 1024  , ST_BETA = 3712 * 1024  , ST_G = 4224 * 1024  , ST_BIAS = 4736 * 1024;
constexpr size_t WS_MNB = 40 * MiB, WS_KX = 48 * MiB, WS_VT = 56 * MiB, WS_CKV = 64 * MiB, WS_KIDX = 72 * MiB;
constexpr size_t WS_SSQ = 76 * MiB;
constexpr size_t WS_PROJ = 80 * MiB;
constexpr size_t WS_XB = 240 * MiB;
constexpr size_t WS_QABS = 240 * MiB;
constexpr size_t WS_MIX = 336 * MiB;
constexpr size_t WS_X1B = 240 * MiB, WS_QX = 304 * MiB, WS_P = 368 * MiB, WS_OX = 432 * MiB, WS_X2B = 304 * MiB, WS_ACT = 80 * MiB;
constexpr size_t WS_W8 = 496 * MiB;
constexpr int CTL_AMAX = 1600;
constexpr size_t WS_NEED = 512 * MiB;

#define DPP_ADD(v, CTRL) ((v) + __int_as_float(__builtin_amdgcn_update_dpp(0, __float_as_int(v), (CTRL), 0xF, 0xF, true)))
__device__ __forceinline__ float wave_sum(float v) {
    v = DPP_ADD(v, 0xB1);
    v = DPP_ADD(v, 0x4E);
    v = DPP_ADD(v, 0x141);
    v = DPP_ADD(v, 0x140);
    const int b = __float_as_int(v);
    const float s0 = __int_as_float(__builtin_amdgcn_readlane(b, 0)), s1 = __int_as_float(__builtin_amdgcn_readlane(b, 16)), s2 = __int_as_float(__builtin_amdgcn_readlane(b, 32)), s3 = __int_as_float(__builtin_amdgcn_readlane(b, 48));
    return (s0 + s1) + (s2 + s3);
}
__device__ __forceinline__ int lane_now() { int l; asm volatile("v_mbcnt_lo_u32_b32 %0, -1, 0\n\tv_mbcnt_hi_u32_b32 %0, -1, %0" : "=v"(l)); return l; }
namespace pg8 {
#define PG8_LAS __attribute__((address_space(3)))
typedef short bf16x8 __attribute__((ext_vector_type(8)));
typedef float f32x4 __attribute__((ext_vector_type(4)));
typedef unsigned u32x4 __attribute__((ext_vector_type(4)));
typedef unsigned u32x2 __attribute__((ext_vector_type(2)));
typedef int i32x4 __attribute__((ext_vector_type(4)));
constexpr int BM = 256, BK = 64, HALF = 128, HTB = HALF * BK * 2  , STAGE_BYTES = 8 * HTB, NXCD = 8, WGM = 8;

__host__ __device__ __forceinline__ int lds_byte(int r, int c) { const int st = (r >> 4) * 2 + (c >> 5), rr = r & 15, cc = c & 31, ob = rr * 64 + cc * 2; return st * 1024 + (ob ^ (((ob >> 9) & 1) << 5)); }
__host__ __device__ __forceinline__ void stage_rc(int b, int& R, int& C) { const int st = b / 1024, sb = b % 1024, swz = sb ^ (((sb >> 9) & 1) << 5); R = (st >> 1) * 16 + swz / 64; C = (st & 1) * 32 + (swz % 64) / 2; }
__host__ __device__ __forceinline__ int perm32(int rho) { const int n = rho >> 4, i = rho & 15; return 8 * (i >> 2) + 4 * n + (i & 3); }

struct Unit { int pm, pn; long ao, bo; };
struct Gemm { const bf16_t* A; const bf16_t* Bt; int lda, ldb, K; };

struct StaticOrder {
    int nM, nN, nwg, G, c;
    __host__ __device__ __forceinline__ void init(int M_, int N_, int G_, int c_) { nM = M_ / BM; nN = N_ / BM; nwg = nM * nN; G = G_; c = c_; }
    __host__ __device__ __forceinline__ bool next(int i, Unit& u) const {
        const long L = (long)i * G + c; if (L >= nwg) return false;
        int wgid = (int)L; { const int q = nwg / NXCD, r = nwg % NXCD, xcd = wgid % NXCD, off = wgid / NXCD; wgid = (xcd < r ? xcd * (q + 1) : r * (q + 1) + (xcd - r) * q) + off; }
        const int nig = WGM * nN, gid = wgid / nig, fm = gid * WGM, gsz = (nM - fm) < WGM ? (nM - fm) : WGM;
        u.pm = fm + ((wgid % nig) % gsz); u.pn = (wgid % nig) / gsz; u.ao = 0; u.bo = 0; return true;
    }
};
struct OneUnit { Unit u; __host__ __device__ __forceinline__ bool next(int i, Unit& o) const { if (i) return false; o = u; return true; } };
struct TwoUnits { Unit u0, u1; int n; __host__ __device__ __forceinline__ bool next(int i, Unit& o) const { if (i >= n) return false; o = i ? u1 : u0; return true; } };

typedef float cvf32x2_t __attribute__((ext_vector_type(2))); typedef __bf16 cvbf16x2_t __attribute__((ext_vector_type(2)));
__device__ __forceinline__ unsigned cvt_pk_bf16(float lo, float hi) { cvf32x2_t v = {lo, hi}; return __builtin_bit_cast(unsigned, __builtin_convertvector(v, cvbf16x2_t)); }
__device__ __forceinline__ u32x4 pack8(const f32x4& a, const f32x4& b) { u32x4 w; w.x = cvt_pk_bf16(a[0], a[1]); w.y = cvt_pk_bf16(a[2], a[3]); w.z = cvt_pk_bf16(b[0], b[1]); w.w = cvt_pk_bf16(b[2], b[3]); return w; }
__device__ __forceinline__ unsigned pack4_fp8(float a, float b, float c, float d) {
    a = __builtin_amdgcn_fmed3f(a, -448.f, 448.f); b = __builtin_amdgcn_fmed3f(b, -448.f, 448.f); c = __builtin_amdgcn_fmed3f(c, -448.f, 448.f); d = __builtin_amdgcn_fmed3f(d, -448.f, 448.f);
    int w = 0; w = __builtin_amdgcn_cvt_pk_fp8_f32(a, b, w, false); w = __builtin_amdgcn_cvt_pk_fp8_f32(c, d, w, true); return (unsigned)w; }
__device__ __forceinline__ u32x2 pack8_fp8(const f32x4& a, const f32x4& b) { u32x2 w; w.x = pack4_fp8(a[0], a[1], a[2], a[3]); w.y = pack4_fp8(b[0], b[1], b[2], b[3]); return w; }
__device__ __forceinline__ float w8_scale(unsigned amax_bits) { const int e = (int)(amax_bits >> 23) - 127; return amax_bits ? __uint_as_float((unsigned)(127 + 6 - e) << 23) : 1.f; }
__device__ __forceinline__ float w8_inv_scale(unsigned amax_bits, int extra_shift) { const int e = (int)(amax_bits >> 23) - 127; return __uint_as_float((unsigned)(amax_bits ? 127 - 6 + e - extra_shift : 127 - extra_shift) << 23); }
__device__ __forceinline__ float dot4(const f32x4& a) { return (a[0] * a[0] + a[1] * a[1]) + (a[2] * a[2] + a[3] * a[3]); }
__device__ __forceinline__ float sum4(const f32x4& a) { return (a[0] + a[1]) + (a[2] + a[3]); }
__device__ __forceinline__ float lo_bf(unsigned w) { return __uint_as_float(w << 16); }
__device__ __forceinline__ float hi_bf(unsigned w) { return __uint_as_float(w & 0xffff0000u); }

typedef f32x4 Acc[2][2][4][2];
#define PG8_EPI_ROWS(...) _Pragma("unroll") for (int ai = 0; ai < 2; ++ai) _Pragma("unroll") for (int m = 0; m < 4; ++m) { const int rl = ai * HALF + wr * 64 + m * 16 + fr; __VA_ARGS__ }

struct EpiProj { static constexpr bool PERM = true;
    bf16_t* O; int ldc; const float* rs; float* cqss; int ssq_pn;
    __device__ __forceinline__ void operator()(const Acc& acc, const Unit& u, int wr, int wc, int fr, int fq) const {
        const int col0 = u.pn * BM + wc * 32 + 8 * fq; const bool doss = (u.pn == ssq_pn);
        PG8_EPI_ROWS( const int row = u.pm * BM + rl; const float r = rs ? rs[row] : 1.f; float ss = 0.f; bf16_t* rowp = O + (size_t)row * ldc + col0;
            _Pragma("unroll") for (int bj = 0; bj < 2; ++bj) { const f32x4 v0 = acc[ai][bj][m][0] * r, v1 = acc[ai][bj][m][1] * r; *(u32x4*)(rowp + bj * HALF) = pack8(v0, v1); ss += dot4(v0) + dot4(v1); }
            if (doss) { ss += __shfl_xor(ss, 16); ss += __shfl_xor(ss, 32); if (fq == 0) cqss[(size_t)row * 4 + wc] = ss; } )
    }
};
constexpr float KV8_SCALE = 8.f; constexpr int KV8_SHIFT = 3;
struct EpiProj8 { static constexpr bool PERM = true;
    unsigned char* O; int ldc; float scale;
    __device__ __forceinline__ void operator()(const Acc& acc, const Unit& u, int wr, int wc, int fr, int fq) const {
        const int col0 = u.pn * BM + wc * 32 + 8 * fq;
        PG8_EPI_ROWS( const int row = u.pm * BM + rl; unsigned char* rowp = O + (size_t)row * ldc + col0;
            _Pragma("unroll") for (int bj = 0; bj < 2; ++bj) *(u32x2*)(rowp + bj * HALF) = pack8_fp8(acc[ai][bj][m][0] * scale, acc[ai][bj][m][1] * scale); )
    }
};
constexpr float QX8_SCALE = 64.f; constexpr int QX8_SHIFT = 6;
template <int NP, bool F8OUT = false> struct EpiNormScale { static constexpr bool PERM = true;
    bf16_t* O; int ldc; const float* part; float inv_dim; float ascale;
    __device__ __forceinline__ void operator()(const Acc& acc, const Unit& u, int wr, int wc, int fr, int fq) const {
        const int col0 = u.pn * BM + wc * 32 + 8 * fq;
        PG8_EPI_ROWS( const int row = u.pm * BM + rl; float s = 0.f;
            _Pragma("unroll") for (int q = 0; q < NP / 4; ++q) s += sum4(*(const f32x4*)(part + (size_t)row * NP + 4 * q));
            const float r = rsqrtf(s * inv_dim + EPS) * ascale;
            if constexpr (F8OUT) { unsigned char* rowp = (unsigned char*)O + (size_t)row * ldc + col0;
                _Pragma("unroll") for (int bj = 0; bj < 2; ++bj) *(u32x2*)(rowp + bj * HALF) = pack8_fp8(acc[ai][bj][m][0] * r, acc[ai][bj][m][1] * r); }
            else { bf16_t* rowp = O + (size_t)row * ldc + col0;
                _Pragma("unroll") for (int bj = 0; bj < 2; ++bj) *(u32x4*)(rowp + bj * HALF) = pack8(acc[ai][bj][m][0] * r, acc[ai][bj][m][1] * r); } )
    }
};
constexpr float X8_SCALE = 8.f; constexpr int X8_SHIFT = 3;
template <bool SRC16, bool X8 = false> struct EpiResid { static constexpr bool PERM = true;
    const float* src; const bf16_t* src16; bf16_t* xb; float* ssq; const float* rinv; unsigned char* x8; float ascale; int pad_;
    __device__ __forceinline__ void operator()(const Acc& acc, const Unit& u, int wr, int wc, int fr, int fq) const {
        const int col0 = u.pn * BM + wc * 32 + 8 * fq;
        PG8_EPI_ROWS( const size_t row = (size_t)u.pm * BM + rl; float ss = 0.f; const size_t off = row * 1024 + col0; const float rsc = (SRC16 && rinv) ? 1.f / rinv[row] : 1.f;
            _Pragma("unroll") for (int bj = 0; bj < 2; ++bj) { f32x4 s0, s1;
                if (SRC16) { const u32x4 w = *(const u32x4*)(src16 + off + bj * HALF); s0 = (f32x4){lo_bf(w.x), hi_bf(w.x), lo_bf(w.y), hi_bf(w.y)} * rsc; s1 = (f32x4){lo_bf(w.z), hi_bf(w.z), lo_bf(w.w), hi_bf(w.w)} * rsc; }
                else { s0 = *(const f32x4*)(src + off + bj * HALF); s1 = *(const f32x4*)(src + off + bj * HALF + 4); }
                const f32x4 v0 = s0 + acc[ai][bj][m][0] * ascale, v1 = s1 + acc[ai][bj][m][1] * ascale;
                *(u32x4*)(xb + off + bj * HALF) = pack8(v0, v1); ss += dot4(v0) + dot4(v1);
                if constexpr (X8) *(u32x2*)(x8 + off + bj * HALF) = pack8_fp8(v0 * X8_SCALE, v1 * X8_SCALE); }
            ss += __shfl_xor(ss, 16); ss += __shfl_xor(ss, 32); if (fq == 0) ssq[row * 16 + u.pn * 4 + wc] = ss; )
    }
};
struct EpiResidF32 { static constexpr bool PERM = true;
    const bf16_t* src16; float* dst; float* ssq; float ascale; int pad_;
    __device__ __forceinline__ void operator()(const Acc& acc, const Unit& u, int wr, int wc, int fr, int fq) const {
        const int col0 = u.pn * BM + wc * 32 + 8 * fq;
        PG8_EPI_ROWS( const size_t row = (size_t)u.pm * BM + rl; float ss = 0.f; const size_t off = row * 1024 + col0;
            _Pragma("unroll") for (int bj = 0; bj < 2; ++bj) { const u32x4 w = *(const u32x4*)(src16 + off + bj * HALF);
                const f32x4 v0 = (f32x4){lo_bf(w.x), hi_bf(w.x), lo_bf(w.y), hi_bf(w.y)} + acc[ai][bj][m][0] * ascale, v1 = (f32x4){lo_bf(w.z), hi_bf(w.z), lo_bf(w.w), hi_bf(w.w)} + acc[ai][bj][m][1] * ascale;
                *(f32x4*)(dst + off + bj * HALF) = v0; *(f32x4*)(dst + off + bj * HALF + 4) = v1; ss += dot4(v0) + dot4(v1); }
            ss += __shfl_xor(ss, 16); ss += __shfl_xor(ss, 32); if (fq == 0) ssq[row * 16 + u.pn * 4 + wc] = ss; )
    }
};
struct EpiFinal { static constexpr bool PERM = true;
    const bf16_t* src16; float* dst; float* part; unsigned* cnt; const float* gain; float ascale; int pad_;
    __device__ __forceinline__ void operator()(Acc& acc, const Unit& u, int wr, int wc, int fr, int fq) const {
        const int col0 = u.pn * BM + wc * 32 + 8 * fq; float asl = ascale; asm volatile("" : "+s"(asl));
        PG8_EPI_ROWS( const size_t row = (size_t)u.pm * BM + rl; float ss = 0.f; const size_t off = row * 1024 + col0;
            _Pragma("unroll") for (int bj = 0; bj < 2; ++bj) { const u32x4 w = *(const u32x4*)(src16 + off + bj * HALF); const f32x4 s0 = {lo_bf(w.x), hi_bf(w.x), lo_bf(w.y), hi_bf(w.y)}, s1 = {lo_bf(w.z), hi_bf(w.z), lo_bf(w.w), hi_bf(w.w)};
                acc[ai][bj][m][0] = acc[ai][bj][m][0] * asl + s0; acc[ai][bj][m][1] = acc[ai][bj][m][1] * asl + s1; ss += dot4(acc[ai][bj][m][0]) + dot4(acc[ai][bj][m][1]); }
            ss += __shfl_xor(ss, 16); ss += __shfl_xor(ss, 32);
            if (fq == 0) __hip_atomic_store(part + row * 16 + u.pn * 4 + wc, ss, __ATOMIC_RELAXED, __HIP_MEMORY_SCOPE_AGENT); )
        asm volatile("s_waitcnt vmcnt(0)" ::: "memory");
        unsigned* c = cnt + 64 * u.pm;
        if ((fr | fq) == 0) __hip_atomic_fetch_add(c, 1u, __ATOMIC_RELAXED, __HIP_MEMORY_SCOPE_AGENT);
        for (unsigned spins = 0; spins < (1u << 22); ++spins) { if ((unsigned)__builtin_amdgcn_readfirstlane(__hip_atomic_load(c, __ATOMIC_RELAXED, __HIP_MEMORY_SCOPE_AGENT)) >= 32u) break; __builtin_amdgcn_s_sleep(4); }
        __builtin_amdgcn_fence(__ATOMIC_ACQUIRE, "agent");
        f32x4 gv[2][2];
        _Pragma("unroll") for (int bj = 0; bj < 2; ++bj) { gv[bj][0] = *(const f32x4*)(gain + col0 + bj * HALF); gv[bj][1] = *(const f32x4*)(gain + col0 + bj * HALF + 4); }
        PG8_EPI_ROWS( const size_t row = (size_t)u.pm * BM + rl; float s = 0.f;
            _Pragma("unroll") for (int q = 0; q < 4; ++q) s += sum4(*(const f32x4*)(part + row * 16 + 4 * q));
            const float r = rsqrtf(s * (1.f / 1024.f) + EPS); const size_t off = row * 1024 + col0;
            _Pragma("unroll") for (int bj = 0; bj < 2; ++bj) { *(f32x4*)(dst + off + bj * HALF) = acc[ai][bj][m][0] * gv[bj][0] * r; *(f32x4*)(dst + off + bj * HALF + 4) = acc[ai][bj][m][1] * gv[bj][1] * r; } )
    }
};
struct EpiExpP { static constexpr bool PERM = true;
    unsigned char* Pb; float* lpart; float ascale; int pad_;
    __device__ __forceinline__ void operator()(const Acc& acc, const Unit& u, int wr, int wc, int fr, int fq) const {
        const int h = (int)(u.ao >> 8), rowbase = u.pm * BM, col0 = wc * 32 + 8 * fq; unsigned char* O = Pb + (size_t)rowbase * 1024 + h * 256;
        PG8_EPI_ROWS( float ss = 0.f; unsigned char* rowp = O + (size_t)rl * 1024 + col0;
            _Pragma("unroll") for (int bj = 0; bj < 2; ++bj) { f32x4 v0 = acc[ai][bj][m][0] * ascale, v1 = acc[ai][bj][m][1] * ascale;
                _Pragma("unroll") for (int e = 0; e < 4; ++e) { v0[e] = __builtin_amdgcn_exp2f(v0[e]); v1[e] = __builtin_amdgcn_exp2f(v1[e]); }
                const u32x2 w = pack8_fp8(v0, v1); *(u32x2*)(rowp + bj * HALF) = w;
                ss += (__builtin_amdgcn_cvt_f32_fp8((int)w.x, 0) + __builtin_amdgcn_cvt_f32_fp8((int)w.x, 1)) + (__builtin_amdgcn_cvt_f32_fp8((int)w.x, 2) + __builtin_amdgcn_cvt_f32_fp8((int)w.x, 3))
                    + (__builtin_amdgcn_cvt_f32_fp8((int)w.y, 0) + __builtin_amdgcn_cvt_f32_fp8((int)w.y, 1)) + (__builtin_amdgcn_cvt_f32_fp8((int)w.y, 2) + __builtin_amdgcn_cvt_f32_fp8((int)w.y, 3)); }
            ss += __shfl_xor(ss, 16); ss += __shfl_xor(ss, 32); if (fq == 0) lpart[(size_t)(rowbase + rl) * 16 + h * 4 + wc] = ss; )
    }
};
constexpr float OX_SCALE = 32.f; constexpr int OX_SHIFT = 5;
struct EpiPV { static constexpr bool PERM = true;
    unsigned char* Ob; const float* lpart; float ascale; int pad_;
    __device__ __forceinline__ void operator()(const Acc& acc, const Unit& u, int wr, int wc, int fr, int fq) const {
        const int h = u.pn, rowbase = u.pm * BM, col0 = wc * 32 + 8 * fq; unsigned char* O = Ob + (size_t)rowbase * 1024 + h * 256;
        PG8_EPI_ROWS( const float r = ascale / sum4(*(const f32x4*)(lpart + (size_t)(rowbase + rl) * 16 + h * 4)); unsigned char* rowp = O + (size_t)rl * 1024 + col0;
            _Pragma("unroll") for (int bj = 0; bj < 2; ++bj) *(u32x2*)(rowp + bj * HALF) = pack8_fp8(acc[ai][bj][m][0] * r, acc[ai][bj][m][1] * r); )
    }
};
constexpr float ACT_SCALE = 16.f; constexpr int ACT_SHIFT = 4;
struct EpiSwiglu { static constexpr bool PERM = true;
    unsigned char* act; const float* part;
    __device__ __forceinline__ void operator()(const Acc& acc, const Unit& u, int wr, int wc, int fr, int fq) const {
        const int col0 = u.pn * BM + wc * 32 + 8 * fq;
        PG8_EPI_ROWS( const size_t row = (size_t)u.pm * BM + rl; float s = 0.f;
            _Pragma("unroll") for (int q = 0; q < 4; ++q) s += sum4(*(const f32x4*)(part + row * 16 + 4 * q));
            const float r = rsqrtf(s * (1.f / 1024.f) + EPS); unsigned char* rowp = act + row * DFF + (col0 >> 1);
            _Pragma("unroll") for (int bj = 0; bj < 2; ++bj) { const f32x4 a = acc[ai][bj][m][0] * r, b = acc[ai][bj][m][1] * r;
                const float o0 = a[0] * __builtin_amdgcn_rcpf(1.f + __builtin_amdgcn_exp2f(-LOG2E * a[0])) * a[1], o1 = a[2] * __builtin_amdgcn_rcpf(1.f + __builtin_amdgcn_exp2f(-LOG2E * a[2])) * a[3];
                const float o2 = b[0] * __builtin_amdgcn_rcpf(1.f + __builtin_amdgcn_exp2f(-LOG2E * b[0])) * b[1], o3 = b[2] * __builtin_amdgcn_rcpf(1.f + __builtin_amdgcn_exp2f(-LOG2E * b[2])) * b[3];
                *(unsigned*)(rowp + bj * (HALF / 2)) = pack4_fp8(o0 * ACT_SCALE, o1 * ACT_SCALE, o2 * ACT_SCALE, o3 * ACT_SCALE); } )
    }
};

template <class Epi, class Sched, bool ALIGN_EPI, bool F8 = false>
__device__ __forceinline__ void gemm_phase(PG8_LAS unsigned char* lds, const Gemm g, const Sched& S, const Epi& E, int wave_id) {
    const int tid = wave_id * 64 + lane_now();
    const int wid = __builtin_amdgcn_readfirstlane(tid >> 6), lane = tid & 63, wr = wid >> 2, wc = wid & 3, fr = lane & 15, fq = lane >> 4;
    int Kop = g.K; asm volatile("" : "+s"(Kop));
    constexpr int ES = F8 ? 1 : 2;
    const int nt = Kop * ES / (BK * 2);
    unsigned voffA[2], voffB[2];
#pragma unroll
    for (int i = 0; i < 2; ++i) { int R, C; stage_rc(tid * 16 + i * 8192, R, C); const int Rb = Epi::PERM ? ((R & ~31) + perm32(R & 31)) : R;
        voffA[i] = (unsigned)(R * g.lda * ES + C * 2); voffB[i] = (unsigned)(Rb * g.ldb * ES + C * 2); }
    const size_t kstep = (size_t)(BK * 2);
    const size_t hstepA = (size_t)HALF * g.lda * ES, hstepB = (size_t)HALF * g.ldb * ES;
    const size_t tstepA = 2 * hstepA, tstepB = 2 * hstepB;
    const unsigned ldsw = (unsigned)wid * 1024u;
    const int aoff = lds_byte(wr * 64 + fr, fq * 8), boff = lds_byte(wc * 32 + fr, fq * 8);
#define PG8_SA(b, h) (((b) * 2 + (h)) * HTB)
#define PG8_SB(b, h) ((4 + (b) * 2 + (h)) * HTB)
#define PG8_STAGE(bufoff, gbase, voff, rs) do { _Pragma("unroll") for (int _i = 0; _i < 2; ++_i) { \
        if constexpr (F8) __builtin_amdgcn_raw_ptr_buffer_load_lds(rs, (PG8_LAS void*)(lds + (bufoff) + ldsw + _i * 8192), 16, (int)(voff)[_i], (int)(unsigned)(size_t)(gbase), 0, 0); \
        else __builtin_amdgcn_global_load_lds((const unsigned*)((const char*)(gbase) + (voff)[_i]), (PG8_LAS unsigned*)(lds + (bufoff) + ldsw + _i * 8192), 16, 0, 0); } } while (0)
#define PG8_LDA(dst, b, h) do { _Pragma("unroll") for (int m = 0; m < 4; ++m) _Pragma("unroll") for (int k = 0; k < 2; ++k) dst[m][k] = *(const PG8_LAS bf16x8*)(lds + PG8_SA(b, h) + aoff + m * 2048 + k * 1024); } while (0)
#define PG8_LDB(dst, b, h) do { _Pragma("unroll") for (int n = 0; n < 2; ++n) _Pragma("unroll") for (int k = 0; k < 2; ++k) dst[n][k] = *(const PG8_LAS bf16x8*)(lds + PG8_SB(b, h) + boff + n * 2048 + k * 1024); } while (0)
#define PG8_CAT8(x, y) __builtin_shufflevector(__builtin_bit_cast(i32x4, x), __builtin_bit_cast(i32x4, y), 0, 1, 2, 3, 4, 5, 6, 7)
#define PG8_MMA(ai, bj, At, Bt) do { __builtin_amdgcn_s_setprio(1); _Pragma("unroll") for (int m = 0; m < 4; ++m) _Pragma("unroll") for (int n = 0; n < 2; ++n) { \
        if constexpr (F8) acc[ai][bj][m][n] = __builtin_amdgcn_mfma_scale_f32_16x16x128_f8f6f4(PG8_CAT8(Bt[n][0], Bt[n][1]), PG8_CAT8(At[m][0], At[m][1]), acc[ai][bj][m][n], 0, 0, 0, 0, 0, 0); \
        else { _Pragma("unroll") for (int k = 0; k < 2; ++k) acc[ai][bj][m][n] = __builtin_amdgcn_mfma_f32_16x16x32_bf16(Bt[n][k], At[m][k], acc[ai][bj][m][n], 0, 0, 0); } } \
        __builtin_amdgcn_s_setprio(0); } while (0)
#define PG8_WAIT_V(n) asm volatile("s_waitcnt vmcnt(" #n ")" ::: "memory")
#define PG8_WAIT_L(n) asm volatile("s_waitcnt lgkmcnt(" #n ")" ::: "memory")
#define PG8_BAR __builtin_amdgcn_s_barrier()
#define PG8_SCHED __builtin_amdgcn_sched_barrier(0)
    Unit cur, nxt; int ui = 0;
    if (!S.next(0, cur)) return;
    Acc acc;
#pragma unroll
    for (int a = 0; a < 2; ++a)
#pragma unroll
        for (int b = 0; b < 2; ++b)
#pragma unroll
            for (int m = 0; m < 4; ++m)
#pragma unroll
                for (int n = 0; n < 2; ++n) acc[a][b][m][n] = (f32x4){0.f, 0.f, 0.f, 0.f};
    bf16x8 At[4][2], B0[2][2], B1[2][2];
    const __amdgpu_buffer_rsrc_t rsA = __builtin_amdgcn_make_buffer_rsrc((void*)g.A, 0, -1, 0x00020000), rsB = __builtin_amdgcn_make_buffer_rsrc((void*)g.Bt, 0, -1, 0x00020000);
    const char* const baseA = F8 ? (const char*)(size_t)0 : (const char*)g.A; const char* const baseB = F8 ? (const char*)(size_t)0 : (const char*)g.Bt;
    const char* cA = baseA + (size_t)cur.pm * tstepA + cur.ao; const char* cB = baseB + (size_t)cur.pn * tstepB + cur.bo;
    PG8_STAGE(PG8_SB(0, 0), cB, voffB, rsB); PG8_STAGE(PG8_SB(0, 1), cB + hstepB, voffB, rsB); PG8_STAGE(PG8_SA(0, 0), cA, voffA, rsA); PG8_STAGE(PG8_SA(0, 1), cA + hstepA, voffA, rsA);
    if (wr == 1) PG8_BAR;
    PG8_WAIT_V(2); PG8_BAR;
    PG8_STAGE(PG8_SB(1, 0), cB + kstep, voffB, rsB); PG8_STAGE(PG8_SA(1, 0), cA + kstep, voffA, rsA); PG8_STAGE(PG8_SB(1, 1), cB + hstepB + kstep, voffB, rsB);
    PG8_WAIT_V(6); PG8_BAR;
    for (;;) {
        const bool has_next = S.next(ui + 1, nxt);
        const char* nA = has_next ? baseA + (size_t)nxt.pm * tstepA + nxt.ao : cA; const char* nB = has_next ? baseB + (size_t)nxt.pn * tstepB + nxt.bo : cB;
        for (int t = 0; t < nt; t += 2) {
            const bool last = (t == nt - 2);
            const char* a1 = cA + (size_t)(t + 1) * kstep;
            const char* a2 = last ? nA : cA + (size_t)(t + 2) * kstep; const char* b2 = last ? nB : cB + (size_t)(t + 2) * kstep;
            const char* a3 = a2 + kstep; const char* b3 = b2 + kstep;
            PG8_LDB(B0, 0, 0); PG8_LDB(B1, 0, 1); PG8_SCHED; PG8_LDA(At, 0, 0); PG8_STAGE(PG8_SA(1, 1), a1 + hstepA, voffA, rsA);
            PG8_WAIT_V(8); PG8_WAIT_L(0); PG8_BAR; PG8_MMA(0, 0, At, B0); PG8_MMA(0, 1, At, B1); PG8_BAR; PG8_SCHED;
            PG8_LDA(At, 0, 1); PG8_STAGE(PG8_SB(0, 0), b2, voffB, rsB); PG8_STAGE(PG8_SB(0, 1), b2 + hstepB, voffB, rsB); PG8_STAGE(PG8_SA(0, 0), a2, voffA, rsA);
            PG8_WAIT_V(8); PG8_WAIT_L(0); PG8_BAR; PG8_MMA(1, 0, At, B0); PG8_MMA(1, 1, At, B1); PG8_BAR; PG8_SCHED;
            PG8_LDB(B0, 1, 0); PG8_LDB(B1, 1, 1); PG8_SCHED; PG8_LDA(At, 1, 0); PG8_STAGE(PG8_SA(0, 1), a2 + hstepA, voffA, rsA);
            PG8_WAIT_V(8); PG8_WAIT_L(0); PG8_BAR; PG8_MMA(0, 0, At, B0); PG8_MMA(0, 1, At, B1); PG8_BAR; PG8_SCHED;
            PG8_LDA(At, 1, 1); PG8_STAGE(PG8_SB(1, 0), b3, voffB, rsB); PG8_STAGE(PG8_SB(1, 1), b3 + hstepB, voffB, rsB); PG8_STAGE(PG8_SA(1, 0), a3, voffA, rsA);
            PG8_WAIT_V(8); PG8_WAIT_L(0); PG8_BAR; PG8_MMA(1, 0, At, B0); PG8_MMA(1, 1, At, B1); PG8_BAR; PG8_SCHED;
        }
        if constexpr (ALIGN_EPI) { if (wr == 0) PG8_BAR; }
        { int fr_e = fr, fq_e = fq;
          if constexpr (F8) { const int l_e = lane_now(); fr_e = l_e & 15; fq_e = l_e >> 4; }
          E(acc, cur, wr, wc, fr_e, fq_e); }
        if (!has_next) break;
#pragma unroll
        for (int a = 0; a < 2; ++a)
#pragma unroll
            for (int b = 0; b < 2; ++b)
#pragma unroll
                for (int m = 0; m < 4; ++m)
#pragma unroll
                    for (int n = 0; n < 2; ++n) acc[a][b][m][n] = (f32x4){0.f, 0.f, 0.f, 0.f};
        cur = nxt; cA = nA; cB = nB; ++ui;
        if constexpr (ALIGN_EPI) { if (wr == 1) PG8_BAR; }
    }
    PG8_WAIT_V(0);
    if constexpr (!ALIGN_EPI) { if (wr == 0) PG8_BAR; }
    PG8_BAR;
#undef PG8_SA
#undef PG8_SB
#undef PG8_STAGE
#undef PG8_LDA
#undef PG8_LDB
#undef PG8_MMA
#undef PG8_CAT8
#undef PG8_WAIT_V
#undef PG8_WAIT_L
#undef PG8_BAR
#undef PG8_SCHED
}
}
constexpr int NWAVES = 8;
constexpr int RING_BYTES = 131072;
constexpr int LDSCTL_OFF = RING_BYTES, MISC_OFF = LDSCTL_OFF + 320;
constexpr int LDS_BYTES = 147456;
#define GAS __attribute__((address_space(1)))
#define LAS __attribute__((address_space(3)))
typedef unsigned v4u __attribute__((ext_vector_type(4)));
typedef float f32x4 __attribute__((ext_vector_type(4)));
typedef GAS unsigned gu32;
#define RLX_AGENT __ATOMIC_RELAXED, __HIP_MEMORY_SCOPE_AGENT
#define LDS_WAIT() asm volatile("s_waitcnt lgkmcnt(0)" ::: "memory")
#define VM_WAIT() asm volatile("s_waitcnt vmcnt(0)" ::: "memory")
__device__ __forceinline__ unsigned pk2(float lo, float hi) { return (unsigned)f2bf(lo) | ((unsigned)f2bf(hi) << 16); }

#define XB_TMO      128
#define XB_XCNT(j)  (256  + 64 * (j))
#define XB_XSUB(j)  (1280 + 64 * (j))
#define XB_XGEN(j)  (2304 + 64 * (j))
#define XB_TOP      3328
#define XB_TOPGEN   3392
#define XCD_BAR_WORDS 3456
#define XB_SPIN_CAP (1u << 18)
__device__ __forceinline__ unsigned xb_ld(unsigned* p)              { return __hip_atomic_load(p, __ATOMIC_RELAXED, __HIP_MEMORY_SCOPE_AGENT); }
__device__ __forceinline__ unsigned xb_add(unsigned* p, unsigned v) { return __hip_atomic_fetch_add(p, v, __ATOMIC_RELAXED, __HIP_MEMORY_SCOPE_AGENT); }
__device__ __forceinline__ unsigned xb_xcc_id() { return (unsigned)__builtin_amdgcn_s_getreg((3 << 11) | 20) & 0xFu; }
#define XB_SPIN(cond, bar) do { unsigned _sp = 0; while (cond) { __builtin_amdgcn_s_sleep(1); \
    if ((++_sp & 255u) == 0u) { if (xb_ld(&(bar)[XB_TMO])) break; if (_sp > XB_SPIN_CAP) { atomicAdd(&(bar)[XB_TMO], 1u); break; } } } } while (0)
struct XcdBarrier { unsigned* bar; unsigned x; volatile LAS unsigned* st; };
__device__ __forceinline__ XcdBarrier xcd_barrier_post(unsigned* bar, volatile LAS unsigned* st) {
    XcdBarrier b; b.bar = bar; b.x = xb_xcc_id(); b.st = st;
    if (threadIdx.x == 0) (void)xb_add(&bar[XB_XCNT(b.x)], 1u);
    return b;
}
__device__ __forceinline__ void xcd_barrier_complete(unsigned* bar, unsigned x, unsigned& nloc, unsigned& nx) {
    const unsigned G = gridDim.x * gridDim.y * gridDim.z;
    unsigned sum, cnt, mine, sp = 0u;
    for (;;) {
        sum = 0u; cnt = 0u; mine = 0u;
#pragma unroll
        for (unsigned j = 0; j < 16; ++j) { const unsigned c = xb_ld(&bar[XB_XCNT(j)]); sum += c; cnt += (c > 0u) ? 1u : 0u; mine = (j == x) ? c : mine; }
        if (sum == G) break;
        __builtin_amdgcn_s_sleep(1);
        if ((++sp & 255u) == 0u) { if (xb_ld(&bar[XB_TMO])) break; if (sp > XB_SPIN_CAP) { atomicAdd(&bar[XB_TMO], 1u); break; } }
    }
    nloc = mine > 0u ? mine : 1u; nx = cnt > 0u ? cnt : 1u;
}
__device__ __forceinline__ void xcd_barrier(const XcdBarrier& b, int wave) {
    asm volatile("s_waitcnt vmcnt(0)" ::: "memory");
    __syncthreads();
    if (wave == 0 && lane_now() == 0) {
        unsigned* bar = b.bar;
        __builtin_amdgcn_s_waitcnt(0);
        unsigned nloc = b.st[0], nx = b.st[1];
        if (nloc == 0u) { xcd_barrier_complete(bar, b.x, nloc, nx); b.st[0] = nloc; b.st[1] = nx; }
        const unsigned old = xb_add(&bar[XB_XSUB(b.x)], 1u);
        const unsigned gen = old / nloc;
        if (old + 1u == (gen + 1u) * nloc) {
            __builtin_amdgcn_fence(__ATOMIC_RELEASE, "agent");
            asm volatile("s_waitcnt vmcnt(0)" ::: "memory");
            const unsigned og = xb_add(&bar[XB_TOP], 1u);
            const unsigned tg = og / nx;
            if (og + 1u == (tg + 1u) * nx) xb_add(&bar[XB_TOPGEN], 1u);
            else XB_SPIN(xb_ld(&bar[XB_TOPGEN]) == tg, bar);
            __builtin_amdgcn_fence(__ATOMIC_ACQUIRE, "agent");
            xb_add(&bar[XB_XGEN(b.x)], 1u);
            asm volatile("s_waitcnt vmcnt(0)" ::: "memory");
        } else {
            XB_SPIN(xb_ld(&bar[XB_XGEN(b.x)]) == gen, bar);
            __builtin_amdgcn_fence(__ATOMIC_ACQUIRE, "agent");
            asm volatile("s_waitcnt vmcnt(0)" ::: "memory");
        }
    }
    __syncthreads();
}

struct SrcWin { const float* w; const float* g;
    __device__ __forceinline__ float at(int k, int n) const {
        int src;
        if (n < 2048) src = n; else if (n < C_CKV) src = 2056 + (n - C_CQ); else if (n < C_KIX) src = 2312 + (n - C_CKV); else if (n < C_WIX) src = 2440 + (n - C_KIX);
        else if (n < C_DB) src = 2504 + (n - C_WIX); else if (n < C_DA) src = 2048 + (n - C_DB); else if (n < 2512) src = 2052 + (n - C_DA); else src = -1;
        return src >= 0 ? w[(size_t)k * PROJ_REF + src] * g[k] : 0.f; } };
struct SrcPlain { const float* w; int ld; const float* g; float cs;
    __device__ __forceinline__ float at(int k, int n) const { return w[(size_t)k * ld + n] * (g ? g[k] : 1.f) * cs; } };
struct SrcQidx { const float* w; const float* g;
    __device__ __forceinline__ float at(int k, int n) const { const int s = n >> 7, head = (n >> 4) & 7, r = n & 15; return w[(size_t)k * 512 + head * 64 + 16 * s + r] * g[k]; } };
struct SrcGU { const float* wg; const float* wu; const float* g;
    __device__ __forceinline__ float at(int k, int n) const { const size_t i = (size_t)k * DFF + (n >> 1); const float a = wg[i], b = wu[i]; return ((n & 1) ? b : a) * g[k]; } };
template <class Src> __device__ __forceinline__ void tr_item(const Src& S, int Nsz, bf16_t* WT, int ldo, int koff, LAS float* scr, int item, int lane, unsigned* amax = nullptr) {
    const int nblk = Nsz / 32, kb = item / nblk, nb = item % nblk, k0 = 64 * kb, n0 = 32 * nb;
    float t[32];
#pragma unroll
    for (int i = 0; i < 32; ++i) t[i] = S.at(k0 + 2 * i + (lane >> 5), n0 + (lane & 31));
    if (amax) { float mx = 0.f;
#pragma unroll
        for (int i = 0; i < 32; ++i) mx = fmaxf(mx, fabsf(t[i]));
#pragma unroll
        for (int o = 1; o < 64; o <<= 1) mx = fmaxf(mx, __shfl_xor(mx, o));
        if (lane == 0) (void)__hip_atomic_fetch_max(amax, __float_as_uint(mx), __ATOMIC_RELAXED, __HIP_MEMORY_SCOPE_AGENT); }
#pragma unroll
    for (int i = 0; i < 32; ++i) scr[(2 * i + (lane >> 5)) * 33 + (lane & 31)] = t[i];
    LDS_WAIT(); asm volatile("" ::: "memory");
    const int c = lane & 7;
#pragma unroll
    for (int j = 0; j < 4; ++j) { const int n = (lane >> 3) + 8 * j; const LAS float* s = scr + (8 * c) * 33 + n;
        v4u o; o.x = pk2(s[0 * 33], s[1 * 33]); o.y = pk2(s[2 * 33], s[3 * 33]); o.z = pk2(s[4 * 33], s[5 * 33]); o.w = pk2(s[6 * 33], s[7 * 33]);
        *(GAS v4u*)(WT + (size_t)(n0 + n) * ldo + koff + k0 + 8 * c) = o; }
    LDS_WAIT(); asm volatile("" ::: "memory");
}
__device__ __forceinline__ void heavy_item(const float* Ap, int lda, const float* Bp, int ldb, const float* cs, float cmul, int k0, int n0, int n0out, bf16_t* WT, int ldo, int koff, LAS float* scr, int lane) {
    LAS float* At = scr; LAS float* tt = scr + 2048;
#pragma unroll
    for (int i = 0; i < 8; ++i) { const int e = (i * 64 + lane) * 4, r = e >> 6, d = e & 63; *(LAS f32x4*)(At + e) = *(const GAS f32x4*)(Ap + (size_t)(k0 + r) * lda + d); }
    float bc[64];
#pragma unroll
    for (int d = 0; d < 64; ++d) bc[d] = Bp[(size_t)d * ldb + n0 + (lane & 31)];
    LDS_WAIT(); asm volatile("" ::: "memory");
#pragma unroll 2
    for (int i = 0; i < 16; ++i) { const int kk = 2 * i + (lane >> 5); const LAS f32x4* ar = (const LAS f32x4*)(At + kk * 64); float s0 = 0.f, s1 = 0.f;
#pragma unroll
        for (int q = 0; q < 16; q += 2) { const f32x4 a = ar[q], b2 = ar[q + 1]; s0 += a.x * bc[4 * q] + a.y * bc[4 * q + 1] + a.z * bc[4 * q + 2] + a.w * bc[4 * q + 3]; s1 += b2.x * bc[4 * q + 4] + b2.y * bc[4 * q + 5] + b2.z * bc[4 * q + 6] + b2.w * bc[4 * q + 7]; }
        tt[kk * 33 + (lane & 31)] = (s0 + s1) * (cs ? cs[k0 + kk] : 1.f) * cmul; }
    LDS_WAIT(); asm volatile("" ::: "memory");
    const int c = lane & 3;
#pragma unroll
    for (int j = 0; j < 2; ++j) { const int n = (lane >> 2) + 16 * j; const LAS float* s = tt + (8 * c) * 33 + n;
        v4u o; o.x = pk2(s[0 * 33], s[1 * 33]); o.y = pk2(s[2 * 33], s[3 * 33]); o.z = pk2(s[4 * 33], s[5 * 33]); o.w = pk2(s[6 * 33], s[7 * 33]);
        *(GAS v4u*)(WT + (size_t)(n0out + n) * ldo + koff + k0 + 8 * c) = o; }
    LDS_WAIT(); asm volatile("" ::: "memory");
}
template <int NR> __device__ __forceinline__ void row_prep(const float* xrow, const float* gain, bf16_t* orow, float* rstd_out, int lane) {
    f32x4 v[NR][4]; float s[NR];
#pragma unroll
    for (int r = 0; r < NR; ++r)
#pragma unroll
        for (int j = 0; j < 4; ++j) v[r][j] = *((const GAS f32x4*)(xrow + (size_t)r * 1024) + lane + 64 * j);
#pragma unroll
    for (int r = 0; r < NR; ++r) { float a = 0.f;
#pragma unroll
        for (int j = 0; j < 4; ++j) a += (v[r][j].x * v[r][j].x + v[r][j].y * v[r][j].y) + (v[r][j].z * v[r][j].z + v[r][j].w * v[r][j].w);
        s[r] = a; }
#pragma unroll
    for (int r = 0; r < NR; ++r) { const float rstd = rsqrtf(wave_sum(s[r]) * (1.f / 1024.f) + EPS);
        if (rstd_out && lane == 0) rstd_out[r] = rstd;
        GAS unsigned long long* o8 = (GAS unsigned long long*)(orow + (size_t)r * 1024) + lane;
#pragma unroll
        for (int j = 0; j < 4; ++j) { f32x4 a = v[r][j];
            if (gain) { const f32x4 gg = *((const GAS f32x4*)gain + lane + 64 * j); a = a * gg * rstd; } else a = a * rstd;
            o8[64 * j] = (unsigned long long)pk2(a.x, a.y) | ((unsigned long long)pk2(a.z, a.w) << 32); } }
}
__device__ __forceinline__ void cvt_w8(const bf16_t* src, unsigned char* dst, int n16, unsigned amax_bits, int gtid, int nthr) {
    const float sc = pg8::w8_scale(amax_bits);
    for (int i = gtid; i < n16; i += nthr) { const v4u a = *((const GAS v4u*)src + 2 * i), b = *((const GAS v4u*)src + 2 * i + 1); v4u o;
        o.x = pg8::pack4_fp8(pg8::lo_bf(a.x) * sc, pg8::hi_bf(a.x) * sc, pg8::lo_bf(a.y) * sc, pg8::hi_bf(a.y) * sc); o.y = pg8::pack4_fp8(pg8::lo_bf(a.z) * sc, pg8::hi_bf(a.z) * sc, pg8::lo_bf(a.w) * sc, pg8::hi_bf(a.w) * sc);
        o.z = pg8::pack4_fp8(pg8::lo_bf(b.x) * sc, pg8::hi_bf(b.x) * sc, pg8::lo_bf(b.y) * sc, pg8::hi_bf(b.y) * sc); o.w = pg8::pack4_fp8(pg8::lo_bf(b.z) * sc, pg8::hi_bf(b.z) * sc, pg8::lo_bf(b.w) * sc, pg8::hi_bf(b.w) * sc);
        *((GAS v4u*)dst + i) = o; }
}
namespace dsa {
typedef short bf16x8 __attribute__((ext_vector_type(8)));
typedef short s16x4 __attribute__((ext_vector_type(4)));
typedef float f32x16 __attribute__((ext_vector_type(16)));
typedef float f32x4 __attribute__((ext_vector_type(4)));
typedef unsigned u32x4 __attribute__((ext_vector_type(4)));
typedef unsigned short u16x4 __attribute__((ext_vector_type(4)));
constexpr int HIST_OFF = 145152;
constexpr int SC_OFF = 0, LIST_OFF = 132096, BIAS_OFF = 140288, W_OFF = 144416, NSEL_OFF = 144928, BMAX_OFF = 144992, CMAX_OFF = 145024;
__device__ __forceinline__ int xsw(int rr) { return rr < 8 ? 2 * rr : 2 * ((rr + 4) & 7) + 1; }
typedef float cvf32x2_t __attribute__((ext_vector_type(2))); typedef __bf16 cvbf16x2_t __attribute__((ext_vector_type(2)));
__device__ __forceinline__ unsigned cvtpk(float lo, float hi) { cvf32x2_t v = {lo, hi}; return __builtin_bit_cast(unsigned, __builtin_convertvector(v, cvbf16x2_t)); }
__device__ __forceinline__ int mbcnt64(unsigned long long m) { return (int)__builtin_amdgcn_mbcnt_hi((unsigned)(m >> 32), __builtin_amdgcn_mbcnt_lo((unsigned)m, 0u)); }

__device__ __forceinline__ void phase_init(LAS unsigned char* lds, const float* biastab, const float* kvg, int tid) {
    LAS float* bt = (LAS float*)(lds + BIAS_OFF);
    for (int i = tid; i < 129 * 8; i += 512) bt[i] = biastab[i];
    if (tid < 64) { float m = fmaxf(fabsf(kvg[tid]), fabsf(kvg[tid + 64]));
#pragma unroll
        for (int o = 1; o < 64; o <<= 1) m = fmaxf(m, __shfl_xor(m, o));
        if (tid == 0) *(LAS float*)(lds + CMAX_OFF) = m * 11.313708499f * 1.01f; }
    __syncthreads();
    if (tid < 8) { float m = -1e30f; for (int d = 0; d < 129; ++d) m = fmaxf(m, bt[d * 8 + tid]); ((LAS float*)(lds + BMAX_OFF))[tid] = m; }
    __syncthreads();
}

__device__ __forceinline__ void scores(LAS unsigned char* lds, int b, int q0, const bf16_t* qabs, const bf16_t* kidx, int wave, int lane) {
    const int hi = lane >> 5, c32 = lane & 31;
    const int a_ = c32 >> 3, hp = (c32 >> 2) & 1, r3 = c32 & 3;
    const int head = 4 * (a_ & 1) + r3, qt = 2 * hp + (a_ >> 1);
    bf16x8 A[4][4];
#pragma unroll
    for (int rt = 0; rt < 4; ++rt)
#pragma unroll
        for (int s = 0; s < 4; ++s) A[rt][s] = *(const bf16x8*)(qabs + (size_t)(b * 2048 + q0 + 4 * rt + qt) * 1536 + 1024 + s * 128 + head * 16 + 8 * hi);
    const int nkt = (q0 + 16 + 31) >> 5;
    LAS float* SC = (LAS float*)(lds + SC_OFF); const LAS float* Wl = (const LAS float*)(lds + W_OFF);
    bf16x8 Bn[4];
    { const bf16_t* kr = kidx + (size_t)(b * 2048 + (wave < nkt ? wave : 0) * 32 + c32) * 64 + 8 * hi;
#pragma unroll
      for (int s = 0; s < 4; ++s) Bn[s] = *(const bf16x8*)(kr + 16 * s); }
    __syncthreads();
    for (int kt = wave; kt < nkt; kt += 8) {
        bf16x8 B[4];
#pragma unroll
        for (int s = 0; s < 4; ++s) B[s] = Bn[s];
        if (kt + 8 < nkt) { const bf16_t* kr = kidx + (size_t)(b * 2048 + (kt + 8) * 32 + c32) * 64 + 8 * hi;
#pragma unroll
            for (int s = 0; s < 4; ++s) Bn[s] = *(const bf16x8*)(kr + 16 * s); }
        const int key = kt * 32 + c32;
        f32x16 acc[4];
#pragma unroll
        for (int rt = 0; rt < 4; ++rt) acc[rt] = (f32x16){0.f, 0.f, 0.f, 0.f, 0.f, 0.f, 0.f, 0.f, 0.f, 0.f, 0.f, 0.f, 0.f, 0.f, 0.f, 0.f};
#pragma unroll
        for (int s = 0; s < 4; ++s)
#pragma unroll
            for (int rt = 0; rt < 4; ++rt) acc[rt] = __builtin_amdgcn_mfma_f32_32x32x16_bf16(A[rt][s], B[s], acc[rt], 0, 0, 0);
        f32x4 wv[4][4];
#pragma unroll
        for (int rt = 0; rt < 4; ++rt) { const LAS f32x4* wp = (const LAS f32x4*)(Wl + (4 * rt + 2 * hi) * 8);
#pragma unroll
            for (int q = 0; q < 4; ++q) wv[rt][q] = wp[q]; }
#pragma unroll
        for (int rt = 0; rt < 4; ++rt) {
            const f32x4 w0 = wv[rt][0], w1 = wv[rt][1], w2 = wv[rt][2], w3 = wv[rt][3]; const f32x16 a = acc[rt];
            float s0 = w0.x * fmaxf(a[0], 0.f); s0 += w0.y * fmaxf(a[1], 0.f); s0 += w0.z * fmaxf(a[2], 0.f); s0 += w0.w * fmaxf(a[3], 0.f);
            s0 += w1.x * fmaxf(a[4], 0.f); s0 += w1.y * fmaxf(a[5], 0.f); s0 += w1.z * fmaxf(a[6], 0.f); s0 += w1.w * fmaxf(a[7], 0.f);
            float s1 = w2.x * fmaxf(a[8], 0.f); s1 += w2.y * fmaxf(a[9], 0.f); s1 += w2.z * fmaxf(a[10], 0.f); s1 += w2.w * fmaxf(a[11], 0.f);
            s1 += w3.x * fmaxf(a[12], 0.f); s1 += w3.y * fmaxf(a[13], 0.f); s1 += w3.z * fmaxf(a[14], 0.f); s1 += w3.w * fmaxf(a[15], 0.f);
            const int ql = 4 * rt + 2 * hi, t0 = q0 + ql;
            SC[ql * 2048 + key] = key <= t0 ? s0 : -INFINITY; SC[(ql + 1) * 2048 + key] = key <= t0 + 1 ? s1 : -INFINITY;
        }
    }
}
__device__ __forceinline__ void topk(LAS unsigned char* lds, int q0, int qq, int lane) {
    const int t = q0 + qq, n = t + 1;
    LAS unsigned short* list = (LAS unsigned short*)(lds + LIST_OFF) + qq * 256; LAS int* nsel = (LAS int*)(lds + NSEL_OFF);
    if (n <= 256) { for (int i = lane; i < 256; i += 64) list[i] = (unsigned short)(i < n ? i : t); if (lane == 0) nsel[qq] = n; return; }
    const int nk = ((q0 + 16 + 31) >> 5) * 32;
    const LAS float* SC = (const LAS float*)(lds + SC_OFF) + qq * 2048;
    unsigned u[32];
#pragma unroll
    for (int j = 0; j < 32; ++j) { const int key = lane + 64 * j; unsigned v = 0u; if (key < nk) { const unsigned bts = __float_as_uint(SC[key]); v = (bts & 0x80000000u) ? ~bts : (bts | 0x80000000u); } u[j] = v; }
    unsigned tau = 0u;
    for (int bit = 31; bit >= 0; --bit) {
        const unsigned cand = tau | (1u << bit); int cnt = 0;
#pragma unroll
        for (int j = 0; j < 32; ++j) cnt += __popcll(__ballot(u[j] >= cand));
        if (cnt >= 256) tau = cand;
        if (cnt == 256) break;
    }
    int cgt = 0;
#pragma unroll
    for (int j = 0; j < 32; ++j) cgt += __popcll(__ballot(u[j] > tau));
    const int r = 256 - cgt; int base = 0, eqb = 0;
#pragma unroll
    for (int j = 0; j < 32; ++j) {
        const bool gt = u[j] > tau, eq = u[j] == tau; const unsigned long long em = __ballot(eq);
        const bool sel = gt || (eq && (eqb + mbcnt64(em)) < r); const unsigned long long sm = __ballot(sel);
        if (sel) list[base + mbcnt64(sm)] = (unsigned short)(lane + 64 * j);
        base += __popcll(sm); eqb += __popcll(em);
    }
    if (lane == 0) nsel[qq] = 256;
}
__device__ __forceinline__ int wave_scan_incl(int x) {
    x += __builtin_amdgcn_update_dpp(0, x, 0x111, 0xF, 0xF, true);
    x += __builtin_amdgcn_update_dpp(0, x, 0x112, 0xF, 0xF, true);
    x += __builtin_amdgcn_update_dpp(0, x, 0x114, 0xF, 0xF, true);
    x += __builtin_amdgcn_update_dpp(0, x, 0x118, 0xF, 0xF, true);
    x += __builtin_amdgcn_update_dpp(0, x, 0x142, 0xA, 0xF, false);
    x += __builtin_amdgcn_update_dpp(0, x, 0x143, 0xC, 0xF, false);
    return x;
}
#define DPP_F32(v, CTRL) __int_as_float(__builtin_amdgcn_update_dpp(0, __float_as_int(v), (CTRL), 0xF, 0xF, true))
__device__ __forceinline__ float wave_max(float v) {
    v = fmaxf(v, DPP_F32(v, 0xB1)); v = fmaxf(v, DPP_F32(v, 0x4E)); v = fmaxf(v, DPP_F32(v, 0x141)); v = fmaxf(v, DPP_F32(v, 0x140));
    const int b = __float_as_int(v);
    return fmaxf(fmaxf(__int_as_float(__builtin_amdgcn_readlane(b, 0)), __int_as_float(__builtin_amdgcn_readlane(b, 16))), fmaxf(__int_as_float(__builtin_amdgcn_readlane(b, 32)), __int_as_float(__builtin_amdgcn_readlane(b, 48))));
}
__device__ __forceinline__ float wave_min(float v) {
    v = fminf(v, DPP_F32(v, 0xB1)); v = fminf(v, DPP_F32(v, 0x4E)); v = fminf(v, DPP_F32(v, 0x141)); v = fminf(v, DPP_F32(v, 0x140));
    const int b = __float_as_int(v);
    return fminf(fminf(__int_as_float(__builtin_amdgcn_readlane(b, 0)), __int_as_float(__builtin_amdgcn_readlane(b, 16))), fminf(__int_as_float(__builtin_amdgcn_readlane(b, 32)), __int_as_float(__builtin_amdgcn_readlane(b, 48))));
}
__device__ __forceinline__ void topk3(LAS unsigned char* lds, int q0, int qq, int wave, int lane, unsigned* dbg_flag_g = nullptr) {
    const int t = q0 + qq, n = t + 1;
    LAS unsigned short* list = (LAS unsigned short*)(lds + LIST_OFF) + qq * 256; LAS int* nsel = (LAS int*)(lds + NSEL_OFF);
    if (n <= 256) { for (int i = lane; i < 256; i += 64) list[i] = (unsigned short)(i < n ? i : t); if (lane == 0) nsel[qq] = n; return; }
    const int nk = ((q0 + 16 + 31) >> 5) * 32;
    LAS float* SC = (LAS float*)(lds + SC_OFF) + qq * 2048;
    LAS unsigned char* H = (LAS unsigned char*)SC;
    float v[32]; float hi = -INFINITY;
#pragma unroll
    for (int j = 0; j < 8; ++j) { f32x4 x = {-INFINITY, -INFINITY, -INFINITY, -INFINITY}; if (256 * j + 4 * lane < nk) x = *(const LAS f32x4*)(SC + 256 * j + 4 * lane);
#pragma unroll
        for (int e = 0; e < 4; ++e) { v[4 * j + e] = x[e]; hi = fmaxf(hi, x[e]); } }
    const float lo = wave_min(fminf(fminf(v[0], v[1]), fminf(v[2], v[3])));
    hi = wave_max(hi);
    const float sc = 8191.f / (hi - lo), off = __builtin_fmaf(-lo, sc, 0.25f);
    bool ok = (hi - lo) > 1e-30f && __builtin_fmaf(hi, sc, off) < 8191.9f && __builtin_fmaf(hi, sc, off) > 8190.f;
    unsigned B4 = 0u; int need2 = 0, ncand = 0;
    if (ok) {
        asm volatile("" ::: "memory");
        const u32x4 z4 = {0u, 0u, 0u, 0u};
#pragma unroll
        for (int j = 0; j < 8; ++j) *(LAS u32x4*)(H + 1024 * j + 16 * lane) = z4;
        asm volatile("" ::: "memory");
#pragma unroll
        for (int j = 0; j < 8; ++j) if (256 * j < nk) {
#pragma unroll
            for (int e = 0; e < 4; ++e) { const unsigned b = (unsigned)__builtin_fmaf(v[4 * j + e], sc, off); (void)__hip_atomic_fetch_add((LAS unsigned*)(H + (b & 0x1FFCu)), 1u, __ATOMIC_RELAXED, __HIP_MEMORY_SCOPE_WORKGROUP); } }
        asm volatile("" ::: "memory");
        const unsigned x4 = 4u * (unsigned)(lane & 31), hb = 128u * (unsigned)lane; int c[32];
#pragma unroll
        for (int k = 0; k < 32; ++k) c[k] = *(const LAS int*)(H + hb + (x4 ^ (4u * k)));
        __builtin_amdgcn_sched_barrier(0);
        int s = 0;
#pragma unroll
        for (int k = 0; k < 32; ++k) s += c[k];
        const int incl = wave_scan_incl(s), tot = __builtin_amdgcn_readlane(incl, 63), suf = tot - incl + s;
        const unsigned long long m = __ballot(suf >= 256); const int L = 63 - __builtin_clzll(m);
        const int aboveL = (L < 63) ? __builtin_amdgcn_readlane(suf, (L + 1) & 63) : 0; const int need1 = 256 - aboveL;
        const int cj = lane < 32 ? *(const LAS int*)(H + 128 * L + 4 * lane) : 0;
        const int incl2 = wave_scan_incl(cj), tot2 = __builtin_amdgcn_readlane(incl2, 63), suf2 = tot2 - incl2 + cj;
        const unsigned long long m2 = __ballot(lane < 32 && suf2 >= need1); const int J = 63 - __builtin_clzll(m2);
        const int above2 = (J < 31) ? __builtin_amdgcn_readlane(suf2, (J + 1) & 63) : 0; need2 = need1 - above2; ncand = __builtin_amdgcn_readlane(cj, J);
        B4 = (unsigned)(32 * L + J) * 4u;
        ok = (m != 0ull) && (m2 != 0ull) && (B4 > 0u) && (ncand <= 64);
    }
#ifdef DSA_FALLBACK_COUNT
    if (!ok && lane == 0) atomicAdd(dbg_flag_g + 64, 1u);
#endif
    if (!ok) {
        asm volatile("" ::: "memory");
#pragma unroll
        for (int j = 0; j < 8; ++j) if (256 * j + 4 * lane < nk) *(LAS f32x4*)(SC + 256 * j + 4 * lane) = (f32x4){v[4 * j], v[4 * j + 1], v[4 * j + 2], v[4 * j + 3]};
        asm volatile("" ::: "memory");
        topk(lds, q0, qq, lane); return; }
    LAS float* cv = (LAS float*)list; LAS unsigned short* ck = list + 128;
    int base = 0;
#pragma unroll
    for (int j = 0; j < 8; ++j) if (256 * j < nk) {
        bool isc[4];
#pragma unroll
        for (int e = 0; e < 4; ++e) { const unsigned b = (unsigned)__builtin_fmaf(v[4 * j + e], sc, off); isc[e] = (b & 0x1FFCu) == B4; }
        if (__ballot(isc[0] || isc[1] || isc[2] || isc[3])) {
#pragma unroll
            for (int e = 0; e < 4; ++e) { const unsigned long long cm = __ballot(isc[e]);
                if (isc[e]) { const int pos = base + mbcnt64(cm); cv[pos] = v[4 * j + e]; ck[pos] = (unsigned short)(256 * j + 4 * lane + e); } base += __popcll(cm); } } }
    const float myv = lane < ncand ? cv[lane] : -INFINITY; const int myk = lane < ncand ? (int)ck[lane] : 0x7fffffff; int rank = 0;
    for (int k = 0; k < ncand; ++k) { const float vk = __int_as_float(__builtin_amdgcn_readlane(__float_as_int(myv), k)); const int kk = __builtin_amdgcn_readlane(myk, k); rank += (vk > myv || (vk == myv && kk < myk)) ? 1 : 0; }
    const unsigned long long lm = __ballot(lane < ncand && rank == need2 - 1); const int ll = (int)__builtin_ctzll(lm);
    const float tauv = __int_as_float(__builtin_amdgcn_readlane(__float_as_int(myv), ll)); const int tauk = __builtin_amdgcn_readlane(myk, ll);
    int ngt = 0;
    LAS unsigned short* const dp = (LAS unsigned short*)(lds + HIST_OFF) + wave * 64 + lane;
#pragma unroll
    for (int j = 0; j < 8; ++j) if (256 * j < nk) {
        bool sel[4]; int c = 0;
#pragma unroll
        for (int e = 0; e < 4; ++e) { sel[e] = v[4 * j + e] > tauv; c += sel[e] ? 1 : 0; }
        const int incl3 = wave_scan_incl(c);
        LAS unsigned short* lp = list + ngt + (incl3 - c);
#pragma unroll
        for (int e = 0; e < 4; ++e) { LAS unsigned short* p = sel[e] ? lp : dp; *p = (unsigned short)(256 * j + 4 * lane + e); lp += sel[e] ? 1 : 0; }
        ngt += __builtin_amdgcn_readlane(incl3, 63); }
    const bool csel = lane < ncand && myv == tauv && myk <= tauk; const unsigned long long sm = __ballot(csel);
    if (csel) list[ngt + mbcnt64(sm)] = (unsigned short)myk;
    if (lane == 0) nsel[qq] = 256;
#ifdef DSA_S2_RESTORE
    asm volatile("" ::: "memory");
#pragma unroll
    for (int j = 0; j < 8; ++j) if (256 * j + 4 * lane < nk) *(LAS f32x4*)(SC + 256 * j + 4 * lane) = (f32x4){v[4 * j], v[4 * j + 1], v[4 * j + 2], v[4 * j + 3]};
    asm volatile("" ::: "memory");
#endif
}
__device__ __forceinline__ void attend2(LAS unsigned char* lds, int b, int q0, int wave, int lane, const bf16_t* qabs, const bf16_t* ckv, bf16_t* mix) {
    const int r16 = lane & 15, g = lane >> 4;
    LAS unsigned char* buf0 = lds + wave * 16384; LAS unsigned char* buf1 = buf0 + 8192;
    const LAS unsigned short* listw = (const LAS unsigned short*)(lds + LIST_OFF) + (2 * wave) * 256;
    const LAS float* biasT = (const LAS float*)(lds + BIAS_OFF);
    const int n0 = ((const LAS int*)(lds + NSEL_OFF))[2 * wave], n1 = ((const LAS int*)(lds + NSEL_OFF))[2 * wave + 1];
    const int ns0 = (n0 + 31) >> 5, total = ns0 + ((n1 + 31) >> 5);
    const float cmax = *(const LAS float*)(lds + CMAX_OFF), bmax = ((const LAS float*)(lds + BMAX_OFF))[r16 & 7];
    const int xr = xsw(r16);
    const int q4 = r16 >> 2, p4 = r16 & 3; const int rra = 4 * g + q4, rrb = 16 + 4 * g + q4; const int xa = xsw(rra & 15), xb = xsw(rrb & 15);
    int t = 0, n = 0; size_t row = 0; const LAS unsigned short* list = listw; bf16x8 QB[4]; float Mh = 0.f, lsum = 0.f; f32x4 O[8];
    u32x4 X[8], Y[8];
#define DSA_LOAD(ST, kk) do { if ((kk) < total) { const int sel_ = (kk) >= ns0 ? 1 : 0; const LAS unsigned short* lp_ = listw + sel_ * 256 + ((kk) - (sel_ ? ns0 : 0)) * 32; \
        _Pragma("unroll") for (int i_ = 0; i_ < 8; ++i_) { const int rr_ = 4 * i_ + g; const int idx_ = lp_[rr_]; ST[i_] = *(const u32x4*)(ckv + ((size_t)b * 2048 + idx_) * 128 + (r16 ^ xsw(rr_ & 15)) * 8); } } } while (0)
#define DSA_WRITE(ST, bufp) do { _Pragma("unroll") for (int i_ = 0; i_ < 8; ++i_) *(LAS u32x4*)((bufp) + (4 * i_ + g) * 256 + r16 * 16) = ST[i_]; } while (0)
#define DSA_INIT(qq_) do { t = q0 + (qq_); row = (size_t)b * 2048 + t; n = ((qq_) & 1) ? n1 : n0; list = listw + ((qq_) & 1) * 256; float qn2_ = 0.f; \
        _Pragma("unroll") for (int s_ = 0; s_ < 4; ++s_) { bf16x8 v_ = {0, 0, 0, 0, 0, 0, 0, 0}; if (r16 < 8) v_ = *(const bf16x8*)(qabs + row * 1536 + s_ * 256 + r16 * 32 + 8 * g); QB[s_] = v_; \
            _Pragma("unroll") for (int e_ = 0; e_ < 8; ++e_) { const float f_ = bf2f((bf16_t)v_[e_]); qn2_ += f_ * f_; } } \
        qn2_ += __shfl_xor(qn2_, 16); qn2_ += __shfl_xor(qn2_, 32); Mh = sqrtf(qn2_) * cmax + bmax; lsum = 0.f; \
        _Pragma("unroll") for (int dt_ = 0; dt_ < 8; ++dt_) O[dt_] = (f32x4){0.f, 0.f, 0.f, 0.f}; } while (0)
#define DSA_FINAL() do { float l_ = lsum; l_ += __shfl_xor(l_, 16); l_ += __shfl_xor(l_, 32); const float linv_ = 1.f / l_; \
        _Pragma("unroll") for (int e_ = 0; e_ < 4; ++e_) { const int hrow_ = (4 * g + e_) & 7; const float inv_ = __shfl(linv_, hrow_); \
            if (g < 2) { _Pragma("unroll") for (int dt_ = 0; dt_ < 8; ++dt_) mix[row * MIXK + 512 + hrow_ * 128 + 16 * dt_ + r16] = f2bf(O[dt_][e_] * inv_); } } } while (0)
#define DSA_COMPUTE(kk, buf) do { if ((kk) == ns0) { DSA_FINAL(); DSA_INIT(2 * wave + 1); } const int step = (kk) >= ns0 ? (kk) - ns0 : (kk); \
          \
        bf16x8 af_[2][4]; \
        _Pragma("unroll") for (int G = 0; G < 2; ++G) _Pragma("unroll") for (int s = 0; s < 4; ++s) af_[G][s] = *(const LAS bf16x8*)((buf) + (16 * G + r16) * 256 + (((4 * s + g) ^ xr) * 16)); \
        const int pb0_ = step * 32 + 4 * g; const u16x4 ida_ = *(const LAS u16x4*)(list + pb0_), idb_ = *(const LAS u16x4*)(list + pb0_ + 16); \
        s16x4 tlo_[8], thi_[8]; \
        _Pragma("unroll") for (int dt = 0; dt < 8; ++dt) { const int ch = 2 * dt + (p4 >> 1); \
            tlo_[dt] = __builtin_bit_cast(s16x4, __builtin_amdgcn_ds_read_tr16_b64_v4i16((LAS s16x4*)((buf) + rra * 256 + ((ch ^ xa) * 16) + 8 * (p4 & 1)))); \
            thi_[dt] = __builtin_bit_cast(s16x4, __builtin_amdgcn_ds_read_tr16_b64_v4i16((LAS s16x4*)((buf) + rrb * 256 + ((ch ^ xb) * 16) + 8 * (p4 & 1)))); } \
        float bz_[2][4]; \
        _Pragma("unroll") for (int e = 0; e < 4; ++e) { int d0_ = t - (int)ida_[e]; d0_ = d0_ < 128 ? d0_ : 128; d0_ = d0_ < 0 ? 0 : d0_; int d1_ = t - (int)idb_[e]; d1_ = d1_ < 128 ? d1_ : 128; d1_ = d1_ < 0 ? 0 : d1_; \
            bz_[0][e] = biasT[d0_ * 8 + (r16 & 7)]; bz_[1][e] = biasT[d1_ * 8 + (r16 & 7)]; } \
        f32x4 S_[2]; \
        _Pragma("unroll") for (int G = 0; G < 2; ++G) { f32x4 acc = {0.f, 0.f, 0.f, 0.f}; \
            _Pragma("unroll") for (int s = 0; s < 4; ++s) acc = __builtin_amdgcn_mfma_f32_16x16x32_bf16(af_[G][s], QB[s], acc, 0, 0, 0); \
            S_[G] = acc; } \
        float P_[2][4]; \
        _Pragma("unroll") for (int G = 0; G < 2; ++G) _Pragma("unroll") for (int e = 0; e < 4; ++e) { const float lg = S_[G][e] + bz_[G][e] - Mh; \
                const float pv = (pb0_ + 16 * G + e < n) ? __builtin_amdgcn_exp2f(lg) : 0.f; lsum += pv; P_[G][e] = pv; } \
        u32x4 pw; pw.x = cvtpk(P_[0][0], P_[0][1]); pw.y = cvtpk(P_[0][2], P_[0][3]); pw.z = cvtpk(P_[1][0], P_[1][1]); pw.w = cvtpk(P_[1][2], P_[1][3]); \
        const bf16x8 PA = __builtin_bit_cast(bf16x8, pw); \
        _Pragma("unroll") for (int dt = 0; dt < 8; ++dt) { const bf16x8 vb = {tlo_[dt][0], tlo_[dt][1], tlo_[dt][2], tlo_[dt][3], thi_[dt][0], thi_[dt][1], thi_[dt][2], thi_[dt][3]}; \
            O[dt] = __builtin_amdgcn_mfma_f32_16x16x32_bf16(PA, vb, O[dt], 0, 0, 0); } } while (0)
    DSA_LOAD(X, 0); DSA_LOAD(Y, 1);
    __syncthreads();
    DSA_INIT(2 * wave);
    DSA_WRITE(X, buf0); DSA_LOAD(X, 2);
    if (1 < total) { DSA_WRITE(Y, buf1); DSA_LOAD(Y, 3); }
    for (int k = 0; k < total; k += 2) {
        DSA_COMPUTE(k, buf0);
        if (k + 2 < total) { DSA_WRITE(X, buf0); DSA_LOAD(X, k + 4); }
        if (k + 1 < total) { DSA_COMPUTE(k + 1, buf1); if (k + 3 < total) { DSA_WRITE(Y, buf1); DSA_LOAD(Y, k + 5); } }
    }
    DSA_FINAL();
#undef DSA_LOAD
#undef DSA_WRITE
#undef DSA_INIT
#undef DSA_FINAL
#undef DSA_COMPUTE
}
__device__ __forceinline__ void unit(LAS unsigned char* lds, int b, int q0, int tid, int wave, int lane, const bf16_t* qabs, const bf16_t* ckv, const bf16_t* kidx, const float* widx, bf16_t* mix, unsigned* dbg_flag) {
    asm volatile("" : "+v"(tid));
    lane = tid & 63;
    if (tid < 128) ((LAS float*)(lds + W_OFF))[tid] = widx[(size_t)(b * 2048 + q0) * 8 + tid];
#ifndef DSA_REP_S1
#define DSA_REP_S1 1
#define DSA_REP_S2 1
#define DSA_REP_S3 1
#endif
    if (q0 + 16 > 256) { for (int rp = 0; rp < DSA_REP_S1; ++rp) { scores(lds, b, q0, qabs, kidx, wave, lane); __syncthreads(); } }
    else __syncthreads();
    asm volatile("" : "+v"(tid)); lane = tid & 63;
#ifdef DSA_TOPK_CHECK
    for (int e2 = 0; e2 < 2; ++e2) { const int qq = 2 * wave + e2;
        topk(lds, q0, qq, lane); const LAS unsigned short* lw = (const LAS unsigned short*)(lds + LIST_OFF) + qq * 256; const int ns = ((const LAS int*)(lds + NSEL_OFF))[qq];
        unsigned h1 = 0, h2 = 0; for (int i = lane; i < ns; i += 64) { const unsigned x = lw[i]; h1 += x; h2 += x * x; }
        topk3(lds, q0, qq, wave, lane); const int ns2 = ((const LAS int*)(lds + NSEL_OFF))[qq];
        unsigned g1 = 0, g2 = 0; for (int i = lane; i < ns2; i += 64) { const unsigned x = lw[i]; g1 += x; g2 += x * x; }
#pragma unroll
        for (int o = 1; o < 64; o <<= 1) { h1 += __shfl_xor(h1, o); h2 += __shfl_xor(h2, o); g1 += __shfl_xor(g1, o); g2 += __shfl_xor(g2, o); }
        if (lane == 0 && (h1 != g1 || h2 != g2 || ns != ns2)) atomicAdd(dbg_flag, 1u); }
#else
    for (int rp = 0; rp < DSA_REP_S2; ++rp) { topk3(lds, q0, 2 * wave, wave, lane, dbg_flag); topk3(lds, q0, 2 * wave + 1, wave, lane, dbg_flag); }
#endif
    asm volatile("" : "+v"(tid)); lane = tid & 63;
    for (int rp = 0; rp < DSA_REP_S3; ++rp) { attend2(lds, b, q0, wave, lane, qabs, ckv, mix); __syncthreads(); }
}
}
#ifndef DN_REP_E
#define DN_REP_E 1
#define DN_REP_T 1
#endif
namespace dn {
typedef short bf16x8 __attribute__((ext_vector_type(8)));
typedef short s16x4 __attribute__((ext_vector_type(4)));
typedef float f32x4 __attribute__((ext_vector_type(4)));
typedef float f32x2 __attribute__((ext_vector_type(2)));
typedef unsigned u32x4 __attribute__((ext_vector_type(4)));
typedef unsigned u32x2 __attribute__((ext_vector_type(2)));
constexpr int CWL = 132096;
constexpr int QS = 0, KS = 17408, WB = 17408, KGT = 34816, VBT = 52224, KBT = 69632, LF = 87040, TB = 103680, XF = 112896, OF = 87040, QKB = 120832, GC = 130048, BT = 130304;
constexpr int QSTR = 272, TSTR = 136, LSTR = 65, TBSTR = 144, OSTR = 132;
typedef float cvf32x2_t __attribute__((ext_vector_type(2))); typedef __bf16 cvbf16x2_t __attribute__((ext_vector_type(2)));
__device__ __forceinline__ unsigned cvtpk(float lo, float hi) { cvf32x2_t v = {lo, hi}; return __builtin_bit_cast(unsigned, __builtin_convertvector(v, cvbf16x2_t)); }
__device__ __forceinline__ bf16x8 pack2(const f32x4& a, const f32x4& b) { u32x4 w; w.x = cvtpk(a[0], a[1]); w.y = cvtpk(a[2], a[3]); w.z = cvtpk(b[0], b[1]); w.w = cvtpk(b[2], b[3]); return __builtin_bit_cast(bf16x8, w); }
__device__ __forceinline__ bf16x8 frag_perm(const LAS unsigned char* rowp, int s, int g) {
    const u32x2 lo = *(const LAS u32x2*)(rowp + (32 * s + 4 * g) * 2), hi = *(const LAS u32x2*)(rowp + (32 * s + 16 + 4 * g) * 2);
    u32x4 w; w.x = lo.x; w.y = lo.y; w.z = hi.x; w.w = hi.y; return __builtin_bit_cast(bf16x8, w); }
__device__ __forceinline__ bf16x8 frag_nat8(const LAS unsigned char* rowp, int s, int g) {
    const u32x2 lo = *(const LAS u32x2*)(rowp + (32 * s + 8 * g) * 2), hi = *(const LAS u32x2*)(rowp + (32 * s + 8 * g + 4) * 2);
    u32x4 w; w.x = lo.x; w.y = lo.y; w.z = hi.x; w.w = hi.y; return __builtin_bit_cast(bf16x8, w); }
__device__ __forceinline__ float silu(float x) { return x * __builtin_amdgcn_rcpf(1.f + __builtin_amdgcn_exp2f(-LOG2E * x)); }
__device__ __forceinline__ float ex(float x) { return __builtin_amdgcn_exp2f(LOG2E * x); }

__device__ __forceinline__ void run(LAS unsigned char* lds0, int b, int h, const bf16_t* proj, const float* conv_w, const float* beta, const float* gdec, const float* gn, bf16_t* mix, int tid, int wave, int lane) {
    const int r16c = lane & 15, gc = lane >> 4;
    LAS float* cwL = (LAS float*)(lds0 + CWL);
    if (wave == 0) {
#pragma unroll
        for (int p = 0; p < 3; ++p)
#pragma unroll
            for (int e = 0; e < 2; ++e)
#pragma unroll
                for (int j = 0; j < 4; ++j) cwL[((p * 2 + e) * 4 + j) * 64 + lane] = conv_w[j * 1536 + p * 512 + h * 128 + 2 * lane + e];
    }
    __syncthreads();
    const float gn0 = gn[2 * lane], gn1 = gn[2 * lane + 1];
    f32x4 S[8];
#pragma unroll
    for (int i = 0; i < 8; ++i) S[i] = (f32x4){0.f, 0.f, 0.f, 0.f};
    const bf16_t* pbase = proj + h * 128 + 2 * lane;
    unsigned xq[11][3]; float gnext, bnext;
#define DN_LOAD_CHUNK(cn) do { const size_t Rn = (size_t)b * 2048 + 64 * (cn); \
        _Pragma("unroll") for (int a = 0; a < 11; ++a) { const int tt = 64 * (cn) + 8 * wave - 3 + a; \
            _Pragma("unroll") for (int p_ = 0; p_ < 3; ++p_) xq[a][p_] = (tt >= 0) ? *(const unsigned*)(pbase + (Rn + 8 * wave - 3 + a) * PROJ + p_ * 512) : 0u; } \
        gnext = gdec[(Rn + lane) * 4 + h]; bnext = beta[(Rn + lane) * 4 + h]; } while (0)
    DN_LOAD_CHUNK(0);
    for (int c = 0; c < 32; ++c) {
        const size_t R0 = (size_t)b * 2048 + 64 * c;
        int zoff = 0; asm volatile("" : "+v"(zoff));
        LAS unsigned char* lds = lds0 + zoff; const int r16 = r16c + zoff, g = gc + zoff;
        LAS float* Lf = (LAS float*)(lds + LF); LAS float* gcumL = (LAS float*)(lds + GC); LAS float* betaL = (LAS float*)(lds + BT);
        float gcum = gnext;
#pragma unroll
        for (int o = 1; o < 64; o <<= 1) { const float t = __shfl_up(gcum, o); if (lane >= o) gcum += t; }
        const float gl = __int_as_float(__builtin_amdgcn_readlane(__float_as_int(gcum), 63));
        const float bv = bnext;
        if (wave == 0) { gcumL[lane] = gcum; betaL[lane] = bv; }
        for (int rpE = 0; rpE < DN_REP_E; ++rpE) {
            float cw[3][2][4];
#pragma unroll
            for (int p = 0; p < 3; ++p)
#pragma unroll
                for (int e = 0; e < 2; ++e)
#pragma unroll
                    for (int j = 0; j < 4; ++j) cw[p][e][j] = cwL[((p * 2 + e) * 4 + j) * 64 + lane];
            float xw[3][3][2];
#pragma unroll
            for (int a = 0; a < 3; ++a)
#pragma unroll
                for (int p = 0; p < 3; ++p) { xw[a][p][0] = __uint_as_float(xq[a][p] << 16); xw[a][p][1] = __uint_as_float(xq[a][p] & 0xffff0000u); }
#pragma unroll
            for (int i = 0; i < 8; ++i) {
                const int r = 8 * wave + i; float x0[3][2], sv[3][2];
#pragma unroll
                for (int p = 0; p < 3; ++p) { x0[p][0] = __uint_as_float(xq[3 + i][p] << 16); x0[p][1] = __uint_as_float(xq[3 + i][p] & 0xffff0000u); }
#pragma unroll
                for (int p = 0; p < 3; ++p)
#pragma unroll
                    for (int e = 0; e < 2; ++e) { const float s = cw[p][e][0] * xw[0][p][e] + cw[p][e][1] * xw[1][p][e] + cw[p][e][2] * xw[2][p][e] + cw[p][e][3] * x0[p][e]; sv[p][e] = silu(s); }
                const float rq = rsqrtf(wave_sum(sv[0][0] * sv[0][0] + sv[0][1] * sv[0][1]) + EPS) * 0.08838834764831845f;
                const float rk = rsqrtf(wave_sum(sv[1][0] * sv[1][0] + sv[1][1] * sv[1][1]) + EPS);
                const float gr = __int_as_float(__builtin_amdgcn_readlane(__float_as_int(gcum), r)), br = __int_as_float(__builtin_amdgcn_readlane(__float_as_int(bv), r));
                const float eg = ex(gr), ekl = ex(gl - gr);
                const float k0 = sv[1][0] * rk, k1 = sv[1][1] * rk;
                *(LAS unsigned*)(lds + QS + r * QSTR + 4 * lane) = cvtpk(sv[0][0] * rq, sv[0][1] * rq);
                *(LAS unsigned*)(lds + KS + r * QSTR + 4 * lane) = cvtpk(k0, k1);
                const unsigned kg = cvtpk(k0 * ekl, k1 * ekl), kb = cvtpk(k0 * br * eg, k1 * br * eg), vb = cvtpk(sv[2][0] * br, sv[2][1] * br);
                *(LAS unsigned short*)(lds + KGT + (2 * lane) * TSTR + 2 * r) = (unsigned short)kg; *(LAS unsigned short*)(lds + KGT + (2 * lane + 1) * TSTR + 2 * r) = (unsigned short)(kg >> 16);
                *(LAS unsigned short*)(lds + KBT + (2 * lane) * TSTR + 2 * r) = (unsigned short)kb; *(LAS unsigned short*)(lds + KBT + (2 * lane + 1) * TSTR + 2 * r) = (unsigned short)(kb >> 16);
                *(LAS unsigned short*)(lds + VBT + (2 * lane) * TSTR + 2 * r) = (unsigned short)vb; *(LAS unsigned short*)(lds + VBT + (2 * lane + 1) * TSTR + 2 * r) = (unsigned short)(vb >> 16);
#pragma unroll
                for (int p = 0; p < 3; ++p)
#pragma unroll
                    for (int e = 0; e < 2; ++e) { xw[0][p][e] = xw[1][p][e]; xw[1][p][e] = xw[2][p][e]; xw[2][p][e] = x0[p][e]; }
            }
        }
        __syncthreads();
        for (int rpT = 0; rpT < DN_REP_T; ++rpT) {
        {
            const int ti = wave & 3, sel = wave >> 2;
            const LAS unsigned char* Ab = lds + (sel ? QS : KS) + (16 * ti + r16) * QSTR;
            bf16x8 A[4];
#pragma unroll
            for (int s = 0; s < 4; ++s) A[s] = *(const LAS bf16x8*)(Ab + (32 * s + 8 * g) * 2);
            const f32x4 gi4 = *(const LAS f32x4*)(gcumL + 16 * ti + 4 * g), bi4 = *(const LAS f32x4*)(betaL + 16 * ti + 4 * g);
#pragma unroll
            for (int tj = 0; tj < 4; ++tj) {
                f32x4 acc = {0.f, 0.f, 0.f, 0.f};
                if (tj <= ti) {
                    const LAS unsigned char* Bb = lds + KS + (16 * tj + r16) * QSTR; bf16x8 Bf[4];
#pragma unroll
                    for (int s = 0; s < 4; ++s) Bf[s] = *(const LAS bf16x8*)(Bb + (32 * s + 8 * g) * 2);
#pragma unroll
                    for (int s = 0; s < 4; ++s) acc = __builtin_amdgcn_mfma_f32_16x16x32_bf16(A[s], Bf[s], acc, 0, 0, 0);
                }
                const float gj = gcumL[16 * tj + r16]; const int j = 16 * tj + r16;
#pragma unroll
                for (int e = 0; e < 4; ++e) { const int i = 16 * ti + 4 * g + e; const float dec = ex(fminf(gi4[e] - gj, 0.f));
                    if (sel == 0) { const float lv = (i > j) ? bi4[e] * acc[e] * dec : 0.f;
                        if (tj == ti) Lf[i * LSTR + j] = lv; else if (tj < ti) *(LAS unsigned short*)(lds + TB + i * TBSTR + 2 * j) = f2bf(lv); }
                    else *(LAS unsigned short*)(lds + QKB + i * TBSTR + 2 * j) = f2bf((i >= j) ? acc[e] * dec : 0.f); }
            }
        }
        __syncthreads();
        if (wave == 0) {
            const LAS float* Nb = Lf + (16 * g) * LSTR + 16 * g; float x[16]; int rc = r16; asm volatile("" : "+v"(rc));
            float na[55], nb2[65];
            { int q = 0;
#pragma unroll
              for (int r = 1; r <= 10; ++r)
#pragma unroll
                  for (int j = 0; j < r; ++j) na[q++] = Nb[r * LSTR + j]; }
            { int q = 0;
#pragma unroll
              for (int r = 11; r <= 15; ++r)
#pragma unroll
                  for (int j = 0; j < r; ++j) nb2[q++] = Nb[r * LSTR + j]; }
            x[0] = (0 == rc) ? 1.f : 0.f;
            { int q = 0;
#pragma unroll
              for (int r = 1; r <= 10; ++r) { float s = (r == rc) ? 1.f : 0.f;
#pragma unroll
                  for (int j = 0; j < r; ++j) s -= na[q++] * x[j];
                  x[r] = s; } }
            { int q = 0;
#pragma unroll
              for (int r = 11; r <= 15; ++r) { float s = (r == rc) ? 1.f : 0.f;
#pragma unroll
                  for (int j = 0; j < r; ++j) s -= nb2[q++] * x[j];
                  x[r] = s; } }
#pragma unroll
            for (int r = 0; r < 16; ++r) *(LAS unsigned short*)(lds + TB + (16 * g + r) * TBSTR + 2 * (16 * g + r16)) = f2bf(x[r]);
        }
        __syncthreads();
        }
        f32x4 U[4];
        {
            const LAS unsigned char* tl = lds + TB;
#define DN_A1(b_, k_) ({ const u32x2 lo_ = *(const LAS u32x2*)(tl + (16 * (b_) + r16) * TBSTR + (16 * (k_) + 4 * g) * 2); u32x4 w_; w_.x = lo_.x; w_.y = lo_.y; w_.z = 0u; w_.w = 0u; __builtin_bit_cast(bf16x8, w_); })
#define DN_A2(b_, k0_, k1_) ({ const u32x2 lo_ = *(const LAS u32x2*)(tl + (16 * (b_) + r16) * TBSTR + (16 * (k0_) + 4 * g) * 2), hi_ = *(const LAS u32x2*)(tl + (16 * (b_) + r16) * TBSTR + (16 * (k1_) + 4 * g) * 2); \
            u32x4 w_; w_.x = lo_.x; w_.y = lo_.y; w_.z = hi_.x; w_.w = hi_.y; __builtin_bit_cast(bf16x8, w_); })
            const bf16x8 aD0 = DN_A1(0, 0), aL10 = DN_A1(1, 0), aD1 = DN_A1(1, 1), aL2 = DN_A2(2, 0, 1), aD2 = DN_A1(2, 2), aL3a = DN_A2(3, 0, 1), aL3b = DN_A1(3, 2), aD3 = DN_A1(3, 3);
            const f32x4 z4 = {0.f, 0.f, 0.f, 0.f};
#pragma unroll
            for (int which = 0; which < 2; ++which) {
                const LAS unsigned char* rp = lds + (which ? KBT : VBT) + (16 * wave + r16) * TSTR;
                f32x4 R[4];
#pragma unroll
                for (int b4 = 0; b4 < 4; ++b4) { const u32x2 w = *(const LAS u32x2*)(rp + (16 * b4 + 4 * g) * 2);
                    R[b4] = (f32x4){__uint_as_float(w.x << 16), __uint_as_float(w.x & 0xffff0000u), __uint_as_float(w.y << 16), __uint_as_float(w.y & 0xffff0000u)}; }
                f32x4 X0 = __builtin_amdgcn_mfma_f32_16x16x32_bf16(aD0, pack2(R[0], z4), z4, 0, 0, 0);
                f32x4 Y = __builtin_amdgcn_mfma_f32_16x16x32_bf16(aL10, pack2(X0, z4), z4, 0, 0, 0);
                f32x4 X1 = __builtin_amdgcn_mfma_f32_16x16x32_bf16(aD1, pack2(R[1] - Y, z4), z4, 0, 0, 0);
                const bf16x8 b01 = pack2(X0, X1);
                Y = __builtin_amdgcn_mfma_f32_16x16x32_bf16(aL2, b01, z4, 0, 0, 0);
                f32x4 X2 = __builtin_amdgcn_mfma_f32_16x16x32_bf16(aD2, pack2(R[2] - Y, z4), z4, 0, 0, 0);
                Y = __builtin_amdgcn_mfma_f32_16x16x32_bf16(aL3a, b01, z4, 0, 0, 0);
                Y = __builtin_amdgcn_mfma_f32_16x16x32_bf16(aL3b, pack2(X2, z4), Y, 0, 0, 0);
                f32x4 X3 = __builtin_amdgcn_mfma_f32_16x16x32_bf16(aD3, pack2(R[3] - Y, z4), z4, 0, 0, 0);
                if (which == 0) { U[0] = X0; U[1] = X1; U[2] = X2; U[3] = X3; }
                else { const f32x4 Xs[4] = {X0, X1, X2, X3};
#pragma unroll
                    for (int ti = 0; ti < 4; ++ti)
#pragma unroll
                        for (int e = 0; e < 4; ++e) *(LAS unsigned short*)(lds + WB + (16 * ti + 4 * g + e) * QSTR + (16 * wave + r16) * 2) = f2bf(Xs[ti][e]); }
            }
#undef DN_A1
#undef DN_A2
        }
        __syncthreads();
        if (c + 1 < 32) DN_LOAD_CHUNK(c + 1);
        unsigned dzq[8];
#pragma unroll
        for (int i = 0; i < 8; ++i) dzq[i] = *(const unsigned*)(proj + (R0 + 8 * wave + i) * PROJ + C_DZ + h * 128 + 2 * lane);
        {
            bf16x8 Sb[4];
#pragma unroll
            for (int s = 0; s < 4; ++s) Sb[s] = pack2(S[2 * s], S[2 * s + 1]);
            f32x4 Vn[4], Oa[4];
#pragma unroll
            for (int ti = 0; ti < 4; ++ti) {
                const LAS unsigned char* wp = lds + WB + (16 * ti + r16) * QSTR; const LAS unsigned char* qp = lds + QS + (16 * ti + r16) * QSTR;
                bf16x8 wf[4], qf[4];
#pragma unroll
                for (int s = 0; s < 4; ++s) { wf[s] = frag_perm(wp, s, g); qf[s] = frag_perm(qp, s, g); }
                const f32x4 gi4 = *(const LAS f32x4*)(gcumL + 16 * ti + 4 * g);
                f32x4 ws = {0.f, 0.f, 0.f, 0.f}, qs = {0.f, 0.f, 0.f, 0.f};
#pragma unroll
                for (int s = 0; s < 4; ++s) { ws = __builtin_amdgcn_mfma_f32_16x16x32_bf16(wf[s], Sb[s], ws, 0, 0, 0); qs = __builtin_amdgcn_mfma_f32_16x16x32_bf16(qf[s], Sb[s], qs, 0, 0, 0); }
                Vn[ti] = U[ti] - ws;
#pragma unroll
                for (int e = 0; e < 4; ++e) qs[e] *= ex(gi4[e]);
                Oa[ti] = qs;
            }
            bf16x8 Vb[2];
#pragma unroll
            for (int s = 0; s < 2; ++s) Vb[s] = pack2(Vn[2 * s], Vn[2 * s + 1]);
            { bf16x8 kf[4][2];
#pragma unroll
              for (int ti = 0; ti < 4; ++ti) { const LAS unsigned char* kp = lds + QKB + (16 * ti + r16) * TBSTR; kf[ti][0] = frag_perm(kp, 0, g); kf[ti][1] = frag_perm(kp, 1, g); }
#pragma unroll
              for (int ti = 0; ti < 4; ++ti)
#pragma unroll
                  for (int s = 0; s < 2; ++s) Oa[ti] = __builtin_amdgcn_mfma_f32_16x16x32_bf16(kf[ti][s], Vb[s], Oa[ti], 0, 0, 0); }
            const float egl = ex(gl);
#pragma unroll
            for (int half = 0; half < 2; ++half) { bf16x8 kf[4][2];
#pragma unroll
                for (int q = 0; q < 4; ++q) { const LAS unsigned char* kp = lds + KGT + (16 * (4 * half + q) + r16) * TSTR; kf[q][0] = frag_perm(kp, 0, g); kf[q][1] = frag_perm(kp, 1, g); }
#pragma unroll
                for (int q = 0; q < 4; ++q) { f32x4 sa = S[4 * half + q] * egl;
#pragma unroll
                    for (int s = 0; s < 2; ++s) sa = __builtin_amdgcn_mfma_f32_16x16x32_bf16(kf[q][s], Vb[s], sa, 0, 0, 0);
                    S[4 * half + q] = sa; } }
            LAS float* Of = (LAS float*)(lds + OF);
#pragma unroll
            for (int ti = 0; ti < 4; ++ti)
#pragma unroll
                for (int e = 0; e < 4; ++e) Of[(16 * ti + 4 * g + e) * OSTR + 16 * wave + r16] = Oa[ti][e];
        }
        __syncthreads();
        {
            const LAS float* Of = (const LAS float*)(lds + OF);
#pragma unroll
            for (int i = 0; i < 8; ++i) { const int r = 8 * wave + i; const f32x2 o = *(const LAS f32x2*)(Of + r * OSTR + 2 * lane);
                const float rstd = rsqrtf(wave_sum(o.x * o.x + o.y * o.y) * (1.f / 128.f) + EPS);
                const float z0 = __uint_as_float(dzq[i] << 16), z1 = __uint_as_float(dzq[i] & 0xffff0000u);
                *(unsigned*)(mix + (R0 + r) * MIXK + h * 128 + 2 * lane) = cvtpk(o.x * rstd * gn0 * silu(z0), o.y * rstd * gn1 * silu(z1)); }
        }
    }
}
#undef DN_LOAD_CHUNK
}
struct Args { const float* in[28]; float* out; unsigned char* ws; int ph_lo, ph_hi, li, pad; };
struct Frame {
    LAS unsigned char* lds; volatile LAS unsigned* MISC; int tid, lane, wave, G, vcu;
};
template <int NR> __device__ __forceinline__ void dsa_prep_rows(int row0, int lane, const bf16_t* proj, const float* kvg, const float* lng, const float* lnb, const float* a_log, const float* dt_bias,
                                             bf16_t* ckv, bf16_t* kidx, float* widx, float* beta, float* gdec) {
    unsigned cv[NR]; unsigned short kv[NR], sm[NR];
#pragma unroll
    for (int r = 0; r < NR; ++r) { const bf16_t* pr = proj + (size_t)(row0 + r) * PROJ; cv[r] = *(const unsigned*)(pr + C_CKV + lane * 2); kv[r] = pr[C_KIX + lane]; sm[r] = pr[C_WIX + (lane & 15)]; }
    const float g0 = kvg[lane * 2], g1 = kvg[lane * 2 + 1], lg = lng[lane], lb = lnb[lane], al = a_log[lane & 3], dtb = dt_bias[lane & 3];
#pragma unroll
    for (int r = 0; r < NR; ++r) { const int row = row0 + r;
        { const float a = __uint_as_float(cv[r] << 16), b = __uint_as_float(cv[r] & 0xffff0000u);
          const float rs = rsqrtf(wave_sum(a * a + b * b) * (1.f / 128.f) + EPS); *(unsigned*)(ckv + (size_t)row * 128 + lane * 2) = pk2(a * rs * g0, b * rs * g1); }
        { const float a = bf2f(kv[r]); const float mu = wave_sum(a) * (1.f / 64.f); const float xc = a - mu; const float rs = rsqrtf(wave_sum(xc * xc) * (1.f / 64.f) + EPS);
          kidx[(size_t)row * 64 + lane] = f2bf(xc * rs * lg + lb); }
        const float sv = bf2f(sm[r]);
        if (lane < 8) widx[(size_t)row * 8 + lane] = sv * 0.04419417382415922f;
        else if (lane < 12) beta[(size_t)row * 4 + (lane - 8)] = 1.f / (1.f + __expf(-sv));
        else if (lane < 16) { const float xx = sv + dtb; const float sp = xx > 20.f ? xx : log1pf(__expf(xx)); gdec[(size_t)row * 4 + (lane - 12)] = -__expf(al) * sp; }
    }
}

__global__ void __launch_bounds__(NWAVES * 64, 2) mega(Args args) {
    extern __shared__ __attribute__((aligned(16))) unsigned char lds_raw[];
    Frame F;
    F.lds = (LAS unsigned char*)lds_raw;
    F.MISC = (volatile LAS unsigned*)(F.lds + MISC_OFF);
    F.tid = threadIdx.x; F.lane = F.tid & 63; F.wave = __builtin_amdgcn_readfirstlane(F.tid >> 6);
    F.G = gridDim.x; { const int bx = blockIdx.x; F.vcu = (F.G % 8 == 0) ? (bx % 8) * (F.G / 8) + bx / 8 : bx; }
    unsigned char* ws = args.ws;
    const float* x = args.in[0]; const float* mem = args.in[1]; const float* g_mix = args.in[2]; const float* w_in = args.in[3];
    const float* conv_w = args.in[4]; const float* a_log = args.in[5]; const float* dt_bias = args.in[6];
    const float* dn_norm_g = args.in[7]; const float* q_norm_g = args.in[8]; const float* kv_norm_g = args.in[9]; const float* w_uq = args.in[10]; const float* w_uk = args.in[11];
    const float* w_uv = args.in[12]; const float* w_qidx = args.in[13]; const float* kidx_ln_g = args.in[14]; const float* kidx_ln_b = args.in[15];
    const float* rel_bias = args.in[16]; const float* w_out = args.in[17]; const float* g_xattn = args.in[18]; const float* g_mem = args.in[19];
    const float* w_xq = args.in[20]; const float* w_xkv = args.in[21]; const float* w_xo = args.in[22]; const float* g_ffn = args.in[23];
    const float* w_gate = args.in[24]; const float* w_up = args.in[25]; const float* w_down = args.in[26]; const float* g_final = args.in[27];
    float* out = args.out;
    bf16_t* Win_t = (bf16_t*)(ws + WS_WIN); bf16_t* Wkv_t = (bf16_t*)(ws + WS_WKV); bf16_t* Wdsa_t = (bf16_t*)(ws + WS_WDSA); bf16_t* Wout_t = (bf16_t*)(ws + WS_WOUT);
    bf16_t* Wxq_t = (bf16_t*)(ws + WS_WXQ); bf16_t* Wxo_t = (bf16_t*)(ws + WS_WXO); bf16_t* Wgu_t = (bf16_t*)(ws + WS_WGU); bf16_t* Wdn_t = (bf16_t*)(ws + WS_WDN);
    unsigned char* stt = ws + WS_ST;
    float* rstdx = (float*)(stt + ST_RSTDX); float* cqss = (float*)(stt + ST_CQSS); float* lpart = (float*)(stt + ST_LPART);
    float* widx = (float*)(stt + ST_WIDX); float* beta = (float*)(stt + ST_BETA); float* gdec = (float*)(stt + ST_G); float* biastab = (float*)(stt + ST_BIAS);
    bf16_t* mnb = (bf16_t*)(ws + WS_MNB); unsigned char* kx = ws + WS_KX; unsigned char* vT = ws + WS_VT;        bf16_t* ckv = (bf16_t*)(ws + WS_CKV); bf16_t* kidx = (bf16_t*)(ws + WS_KIDX);
    float* ssq1 = (float*)(ws + WS_SSQ); float* ssq2 = ssq1 + (size_t)M * 16;
    bf16_t* proj = (bf16_t*)(ws + WS_PROJ); bf16_t* mix = (bf16_t*)(ws + WS_MIX); bf16_t* xb = (bf16_t*)(ws + WS_XB); bf16_t* qabs = (bf16_t*)out;
    bf16_t* x1b = (bf16_t*)(ws + WS_X1B); bf16_t* qx = (bf16_t*)(ws + WS_QX); bf16_t* Pb = (bf16_t*)(ws + WS_P); bf16_t* ox = (bf16_t*)(ws + WS_OX); bf16_t* x2b = (bf16_t*)(ws + WS_X2B); unsigned char* act = ws + WS_ACT; unsigned char* Wdn8 = ws + WS_W8; unsigned char* Wxq8 = ws + WS_W8 + 3 * MiB; unsigned char* Wxo8 = ws + WS_W8 + 4 * MiB;
    unsigned char* x1f8 = (unsigned char*)out;
    unsigned char* ox8 = ws + WS_OX;

    for (int u = F.tid; u < (LDS_BYTES - LDSCTL_OFF) / 4; u += NWAVES * 64) ((LAS unsigned*)(F.lds + LDSCTL_OFF))[u] = 0u;
    __syncthreads();
    XcdBarrier bar = xcd_barrier_post((unsigned*)(ws + WS_CTL) + 4096 + args.li * XCD_BAR_WORDS, F.MISC + 8);
#define GRID_BAR() xcd_barrier(bar, F.wave)
    const int lo = args.ph_lo, hi = args.ph_hi;
#ifdef ONLY_PHASE
#define IN(k) ((k) == ONLY_PHASE && lo <= (k) && (k) < hi)
#else
#define IN(k) (lo <= (k) && (k) < hi)
#endif
#define BOTH(k) (IN(k) && IN((k) + 1))
    const int gw = F.vcu * NWAVES + F.wave, NGW = F.G * NWAVES;
    PG8_LAS unsigned char* ring = (PG8_LAS unsigned char*)F.lds;

    if (IN(0)) {
        LAS float* scr = (LAS float*)(F.lds + F.wave * 16384);
        constexpr int I_OB = 32 * 32, I_QA = 8 * 32, I_QI = 4 * 16, I_IN = 16 * 80, I_KV = 16 * 64, I_XQ = 16 * 32, I_XO = 16 * 32, I_GU = 16 * 176, I_DN = 44 * 32, I_OA = 8 * 32;
        constexpr int NITEMS = I_OB + I_QA + I_QI + I_IN + I_KV + I_XQ + I_XO + I_GU + I_DN + I_OA;
        for (int it = gw; it < NITEMS; it += NGW) {
            int r = it;
            if (r < I_OB) { const int kb = r >> 5, nb = r & 31, k0 = 32 * kb, h = k0 >> 7;
                heavy_item(w_uv, 64, w_out + (size_t)(512 + h * 64) * 1024, 1024, nullptr, 1.f, k0, 32 * nb, 32 * nb, Wout_t, MIXK, 512, scr, F.lane); continue; } r -= I_OB;
            if (r < I_QA) { const int kb = r >> 5, nb = r & 31, n0 = 32 * nb, h = n0 >> 7;
                heavy_item(w_uq + h * 64, 512, w_uk + (size_t)(h * 64) * 128 - h * 128, 128, q_norm_g, 0.125f * LOG2E, 32 * kb, n0, ((n0 >> 5) & 3) * 256 + h * 32, Wdsa_t, 256, 0, scr, F.lane); continue; }   r -= I_QA;
            if (r < I_QI) { tr_item(SrcQidx{w_qidx, q_norm_g}, 512, Wdsa_t + (size_t)1024 * 256, 256, 0, scr, r, F.lane); continue; } r -= I_QI;
            if (r < I_IN) { tr_item(SrcWin{w_in, g_mix}, PROJ, Win_t, 1024, 0, scr, r, F.lane); continue; } r -= I_IN;
            if (r < I_KV) { tr_item(SrcPlain{w_xkv, 2048, nullptr, 1.f}, 2048, Wkv_t, 1024, 0, scr, r, F.lane); continue; } r -= I_KV;
            if (r < I_XQ) { tr_item(SrcPlain{w_xq, 1024, g_xattn, 0.0625f * LOG2E}, 1024, Wxq_t, 1024, 0, scr, r, F.lane, (unsigned*)(ws + WS_CTL) + CTL_AMAX + 1); continue; } r -= I_XQ;
            if (r < I_XO) { tr_item(SrcPlain{w_xo, 1024, nullptr, 1.f}, 1024, Wxo_t, 1024, 0, scr, r, F.lane, (unsigned*)(ws + WS_CTL) + CTL_AMAX + 2); continue; } r -= I_XO;
            if (r < I_GU) { tr_item(SrcGU{w_gate, w_up, g_ffn}, 2 * DFF, Wgu_t, 1024, 0, scr, r, F.lane); continue; } r -= I_GU;
            if (r < I_DN) { tr_item(SrcPlain{w_down, 1024, nullptr, 1.f}, 1024, Wdn_t, DFF, 0, scr, r, F.lane, (unsigned*)(ws + WS_CTL) + CTL_AMAX); continue; } r -= I_DN;
            tr_item(SrcPlain{w_out, 1024, nullptr, 1.f}, 1024, Wout_t, MIXK, 0, scr, r, F.lane);
        }
        for (int m = 4 * gw; m < M; m += 4 * NGW) row_prep<4>(x + (size_t)m * D, nullptr, xb + (size_t)m * D, rstdx + m, F.lane);
        for (int m = 2 * gw; m < MM; m += 2 * NGW) row_prep<2>(mem + (size_t)m * D, g_mem, mnb + (size_t)m * D, nullptr, F.lane);
        if (blockIdx.x == 0) for (int i = F.tid; i < 129 * 8; i += NWAVES * 64) {
            const int d = i >> 3, h = i & 7; int bkt;
            if (d < 16) bkt = d; else { const float lr = logf((float)d / 16.f) / 2.0794415416798357f; const int large = 16 + (int)(lr * 16.f); bkt = large < 31 ? large : 31; }
            biastab[i] = rel_bias[bkt * 8 + h] * LOG2E; }
        if (BOTH(0)) GRID_BAR();
    }
    if (IN(1)) {
        pg8::Gemm g{xb, Win_t, 1024, 1024, 1024}; pg8::StaticOrder S; S.init(M, PROJ, F.G, (int)blockIdx.x);
        pg8::EpiProj E{proj, PROJ, nullptr, cqss, 8};
        pg8::gemm_phase<pg8::EpiProj, pg8::StaticOrder, true>(ring, g, S, E, F.wave);
        if (BOTH(1)) GRID_BAR();
    }
    if (IN(2)) {
        const int lane2 = lane_now();
        for (int m = 4 * gw; m < M; m += 4 * NGW) dsa_prep_rows<4>(m, lane2, proj, kv_norm_g, kidx_ln_g, kidx_ln_b, a_log, dt_bias, ckv, kidx, widx, beta, gdec);
        { unsigned* am = (unsigned*)(ws + WS_CTL) + CTL_AMAX;
          cvt_w8(Wdn_t, Wdn8, DFF * 1024 / 16, __hip_atomic_load(am, __ATOMIC_RELAXED, __HIP_MEMORY_SCOPE_AGENT), gw * 64 + lane2, NGW * 64);
          cvt_w8(Wxq_t, Wxq8, 1024 * 1024 / 16, __hip_atomic_load(am + 1, __ATOMIC_RELAXED, __HIP_MEMORY_SCOPE_AGENT), gw * 64 + lane2, NGW * 64);
          cvt_w8(Wxo_t, Wxo8, 1024 * 1024 / 16, __hip_atomic_load(am + 2, __ATOMIC_RELAXED, __HIP_MEMORY_SCOPE_AGENT), gw * 64 + lane2, NGW * 64); }
        { pg8::Gemm g{proj + C_CQ, Wdsa_t, PROJ, 256, 256}; pg8::StaticOrder S; S.init(M, 1536, F.G, (int)blockIdx.x);
          pg8::EpiNormScale<4> E{qabs, 1536, cqss, 1.f / 256.f, 1.f};
          pg8::gemm_phase<pg8::EpiNormScale<4>, pg8::StaticOrder, true>(ring, g, S, E, F.wave); }
        if (BOTH(2)) GRID_BAR();
    }
    if (IN(3)) {
        const int lane3 = lane_now(); const int tid3 = F.wave * 64 + lane3;
        if (blockIdx.x < 64) dn::run(F.lds, (int)blockIdx.x >> 2, (int)blockIdx.x & 3, proj, conv_w, beta, gdec, dn_norm_g, mix, tid3, F.wave, lane3);
        __syncthreads();
        if (blockIdx.x >= 64) { unsigned* kvq = (unsigned*)(ws + WS_CTL) + 1536;
            for (;;) {
                if (tid3 == 0) F.MISC[17] = __hip_atomic_fetch_add(kvq, 1u, __ATOMIC_RELAXED, __HIP_MEMORY_SCOPE_AGENT);
                __syncthreads(); const int k = (int)F.MISC[17]; __syncthreads();
                if (k >= 128) break;
                if (k < 64) { pg8::Gemm g{mnb, Wkv_t, 1024, 1024, 1024}; pg8::OneUnit S1{{k >> 2, k & 3, 0, 0}}; pg8::EpiProj8 E{kx, 1024, pg8::KV8_SCALE};
                    pg8::gemm_phase<pg8::EpiProj8, pg8::OneUnit, false>(ring, g, S1, E, F.wave); }
                else { const int k2 = k - 64; pg8::Gemm g{Wkv_t + (size_t)1024 * 1024, mnb, 1024, 1024, 1024}; pg8::OneUnit S1{{k2 >> 4, k2 & 15, 0, 0}}; pg8::EpiProj8 E{vT, MM, pg8::KV8_SCALE};
                    pg8::gemm_phase<pg8::EpiProj8, pg8::OneUnit, false>(ring, g, S1, E, F.wave); }
            } }
        for (int pass = 0; pass <= args.pad; ++pass) {
        if (pass) GRID_BAR();
        const int lane4 = lane_now(); const int tid4 = F.wave * 64 + lane4;
        dsa::phase_init(F.lds, biastab, kv_norm_g, tid4);
        unsigned* qbase = (unsigned*)(ws + WS_CTL) + 2048 + 1024 * pass;
        const int myx = (int)(xb_xcc_id() & 7u);
        for (int sx = 0; sx < 8; ++sx) { const int qx8 = (myx + sx) & 7;
        for (;;) {
            if (tid4 == 0) F.MISC[16] = __hip_atomic_fetch_add(qbase + 64 * qx8, 1u, __ATOMIC_RELAXED, __HIP_MEMORY_SCOPE_AGENT);
            __syncthreads(); const int k = (int)F.MISC[16]; __syncthreads();
            if (k >= 256) break;
            dsa::unit(F.lds, 2 * qx8 + (k & 1), (127 - (k >> 1)) * 16, tid4, F.wave, lane4, qabs, ckv, kidx, widx, mix, (unsigned*)(ws + WS_CTL) + 1024);
        } }
        }
        if (BOTH(3)) GRID_BAR();
    }
    if (IN(4)) {
        pg8::Gemm g{mix, Wout_t, MIXK, MIXK, MIXK}; pg8::StaticOrder S; S.init(M, 1024, F.G, (int)blockIdx.x);
        pg8::EpiResid<true, true> E{nullptr, xb, x1b, ssq1, rstdx, x1f8, 1.f};
        pg8::gemm_phase<pg8::EpiResid<true, true>, pg8::StaticOrder, true>(ring, g, S, E, F.wave);
        if (BOTH(4)) GRID_BAR();
    }
    if (IN(5)) {
        pg8::StaticOrder S; S.init(M, 1024, F.G, (int)blockIdx.x); pg8::Unit ua, ub; const bool h0 = S.next(0, ua), h1 = S.next(1, ub);
        if (h0) {
            { pg8::Gemm g{(const bf16_t*)x1f8, (const bf16_t*)Wxq8, 1024, 1024, 1024};
              const float asc = pg8::w8_inv_scale((unsigned)__builtin_amdgcn_readfirstlane((int)__hip_atomic_load((unsigned*)(ws + WS_CTL) + CTL_AMAX + 1, __ATOMIC_RELAXED, __HIP_MEMORY_SCOPE_AGENT)), pg8::X8_SHIFT - pg8::QX8_SHIFT);
              pg8::EpiNormScale<16, true> E{qx, 1024, ssq1, 1.f / 1024.f, asc};
              pg8::gemm_phase<pg8::EpiNormScale<16, true>, pg8::StaticOrder, true, true>(ring, g, S, E, F.wave); }
            VM_WAIT(); __syncthreads();
            pg8::TwoUnits S2; S2.n = h1 ? 2 : 1;
            S2.u0 = pg8::Unit{ua.pm, ua.pm >> 3, (long)ua.pn * 256, (long)ua.pn * 256}; S2.u1 = pg8::Unit{ub.pm, ub.pm >> 3, (long)ub.pn * 256, (long)ub.pn * 256};
            { pg8::Gemm g{qx, (const bf16_t*)kx, 1024, 1024, 256};
              pg8::EpiExpP E{(unsigned char*)Pb, lpart, 1.f / (pg8::QX8_SCALE * pg8::KV8_SCALE)};
              pg8::gemm_phase<pg8::EpiExpP, pg8::TwoUnits, true, true>(ring, g, S2, E, F.wave); }
            VM_WAIT(); __syncthreads();
            pg8::TwoUnits S3; S3.n = S2.n;
            S3.u0 = pg8::Unit{ua.pm, ua.pn, (long)ua.pn * 256, (long)(ua.pm >> 3) * 256}; S3.u1 = pg8::Unit{ub.pm, ub.pn, (long)ub.pn * 256, (long)(ub.pm >> 3) * 256};
            { pg8::Gemm g{Pb, (const bf16_t*)vT, 1024, MM, 256};
              pg8::EpiPV E{ox8, lpart, pg8::OX_SCALE / pg8::KV8_SCALE};
              pg8::gemm_phase<pg8::EpiPV, pg8::TwoUnits, true, true>(ring, g, S3, E, F.wave); }
        }
        if (BOTH(5)) GRID_BAR();
    }
    if (IN(6)) {
        pg8::Gemm g{(const bf16_t*)ox8, (const bf16_t*)Wxo8, 1024, 1024, 1024}; pg8::StaticOrder S; S.init(M, 1024, F.G, (int)blockIdx.x);
        const float asc = pg8::w8_inv_scale((unsigned)__builtin_amdgcn_readfirstlane((int)__hip_atomic_load((unsigned*)(ws + WS_CTL) + CTL_AMAX + 2, __ATOMIC_RELAXED, __HIP_MEMORY_SCOPE_AGENT)), pg8::OX_SHIFT);
        pg8::EpiResid<true> E{nullptr, x1b, x2b, ssq2, nullptr, nullptr, asc};
        pg8::gemm_phase<pg8::EpiResid<true>, pg8::StaticOrder, true, true>(ring, g, S, E, F.wave);
        if (BOTH(6)) GRID_BAR();
    }
    if (IN(7)) {
        pg8::Gemm g{x2b, Wgu_t, 1024, 1024, 1024}; pg8::StaticOrder S; S.init(M, 2 * DFF, F.G, (int)blockIdx.x);
        pg8::EpiSwiglu E{act, ssq2};
        pg8::gemm_phase<pg8::EpiSwiglu, pg8::StaticOrder, true>(ring, g, S, E, F.wave);
        if (BOTH(7)) GRID_BAR();
    }
#if defined(DSA_TOPK_CHECK) || defined(DSA_FALLBACK_COUNT)
    const bool fuse_final = false;
#else
    const bool fuse_final = (F.G == 256);
#endif
    if (IN(8)) {
        pg8::Gemm g{(const bf16_t*)act, (const bf16_t*)Wdn8, DFF, DFF, DFF}; pg8::StaticOrder S; S.init(M, 1024, F.G, (int)blockIdx.x);
        const float asc = pg8::w8_inv_scale((unsigned)__builtin_amdgcn_readfirstlane((int)__hip_atomic_load((unsigned*)(ws + WS_CTL) + CTL_AMAX, __ATOMIC_RELAXED, __HIP_MEMORY_SCOPE_AGENT)), pg8::ACT_SHIFT);
        if (fuse_final) { pg8::EpiFinal E{x2b, out, ssq1, (unsigned*)(ws + WS_CTL) + 8192, g_final, asc};
            pg8::gemm_phase<pg8::EpiFinal, pg8::StaticOrder, true, true>(ring, g, S, E, F.wave); }
        else { pg8::EpiResidF32 E{x2b, out, ssq1, asc};
            pg8::gemm_phase<pg8::EpiResidF32, pg8::StaticOrder, true, true>(ring, g, S, E, F.wave);
            if (BOTH(8)) GRID_BAR(); }
    }
    if (IN(9) && !fuse_final) {
#ifdef DSA_FALLBACK_COUNT
        if (blockIdx.x == 0 && F.wave == 0 && lane_now() == 0 && __hip_atomic_load((unsigned*)(ws + WS_CTL) + 1024 + 64, __ATOMIC_RELAXED, __HIP_MEMORY_SCOPE_AGENT) > DSA_FALLBACK_COUNT) out[12345] = __builtin_nanf("");
#endif
#ifdef DSA_TOPK_CHECK
        if (blockIdx.x == 0 && F.wave == 0 && lane_now() == 0 && __hip_atomic_load((unsigned*)(ws + WS_CTL) + 1024, __ATOMIC_RELAXED, __HIP_MEMORY_SCOPE_AGENT) != 0u) out[12345] = __builtin_nanf("");
#endif
        const int lane9 = lane_now();
        for (int m = gw; m < M; m += NGW) {
            const float* pp = ssq1 + (size_t)m * 16; float s = 0.f;
#pragma unroll
            for (int q = 0; q < 4; ++q) { const f32x4 t = *(const f32x4*)(pp + 4 * q); s += (t.x + t.y) + (t.z + t.w); }
            const float rstd = rsqrtf(s * (1.f / 1024.f) + EPS);
            GAS f32x4* xr = (GAS f32x4*)(out + (size_t)m * D) + lane9;
#pragma unroll
            for (int j = 0; j < 4; ++j) { const f32x4 gg = *((const GAS f32x4*)g_final + lane9 + 64 * j); xr[64 * j] = xr[64 * j] * gg * rstd; }
        }
    }
#undef IN
#undef BOTH
}

extern "C" void kernel_launch(void* const* d_in, const int* in_sizes, int n_in, void* d_out, int out_size, void* d_ws, size_t ws_size, hipStream_t stream) {
    static int grid = 0;
    if (grid == 0) {
        if (n_in != 28 || ws_size < WS_NEED || out_size != M * D) { fprintf(stderr, "kernel_launch: unexpected problem (n_in %d ws %zu out %d)\n", n_in, ws_size, out_size); grid = -1; return; }
        int dev = 0, cus = 0, per_cu = 0;
        if (hipGetDevice(&dev) != hipSuccess || hipDeviceGetAttribute(&cus, hipDeviceAttributeMultiprocessorCount, dev) != hipSuccess) { grid = -1; return; }
        if (hipFuncSetAttribute((const void*)mega, hipFuncAttributeMaxDynamicSharedMemorySize, LDS_BYTES) != hipSuccess) { fprintf(stderr, "kernel_launch: hipFuncSetAttribute failed\n"); grid = -1; return; }
        if (hipOccupancyMaxActiveBlocksPerMultiprocessor(&per_cu, (const void*)mega, NWAVES * 64, LDS_BYTES) != hipSuccess || per_cu < 1) { fprintf(stderr, "kernel_launch: occupancy query says %d\n", per_cu); grid = -1; (void)hipGetLastError(); return; }
        grid = cus;
        if (grid < 64) { fprintf(stderr, "kernel_launch: needs >= 64 CUs\n"); grid = -1; return; }
    }
    if (grid < 0) return;
    unsigned char* ws = (unsigned char*)d_ws;
    (void)hipMemsetAsync(ws + WS_CTL, 0, CTL_ZERO_BYTES, stream);
    Args a{}; for (int i = 0; i < 28; ++i) a.in[i] = (const float*)d_in[i]; a.out = (float*)d_out; a.ws = ws;
    a.ph_lo = 0; a.ph_hi = 10; a.li = 0;
#ifdef DSA_PASSES
    a.pad = DSA_PASSES - 1;
#endif
    void* kargs[] = {&a};
    (void)hipLaunchCooperativeKernel((const void*)mega, dim3(grid), dim3(NWAVES * 64), kargs, LDS_BYTES, stream);
}
```

```cpp
#include <hip/hip_runtime.h>
#include <cstdio>
#include <cstdint>

typedef unsigned short bf16_t;
__device__ __forceinline__ float bf2f(bf16_t h) { return __uint_as_float(((unsigned)h) << 16); }
__device__ __forceinline__ bf16_t f2bf(float f) { unsigned u = __float_as_uint(f); return (bf16_t)((u + 0x7fffu + ((u >> 16) & 1u)) >> 16); }

constexpr int D = 1024, BATCH = 16, SEQ = 2048, M = BATCH * SEQ;
constexpr int PROJ_REF = 2512, PROJ = 2560;
constexpr int MEM_LEN = 256, MM = BATCH * MEM_LEN;
constexpr int DFF = 2816;
constexpr float EPS = 1e-6f;
constexpr float LOG2E = 1.4426950408889634f;
constexpr int C_DQ = 0, C_DK = 512, C_DV = 1024, C_DZ = 1536, C_CQ = 2048, C_CKV = 2304, C_KIX = 2432, C_WIX = 2496, C_DB = 2504, C_DA = 2508;
constexpr int MIXK = 1536;
constexpr int MIXB = 2048;
constexpr float OLAT_SCALE = 32.f; constexpr int OLAT_SHIFT = 5;

constexpr size_t MiB = 1u << 20;
constexpr size_t WS_WIN = 0, WS_WKV = 5 * MiB, WS_WDSA = 9 * MiB, WS_WOUT = 10 * MiB, WS_WXQ = 13 * MiB, WS_WXO = 15 * MiB, WS_WGU = 17 * MiB, WS_WDN = 28 * MiB;
constexpr size_t WS_CTL = 34 * MiB, CTL_ZERO_BYTES = 256 * 1024;
constexpr size_t WS_ST = 35 * MiB;
constexpr size_t ST_RSTDX = 0, ST_CQSS = 128 * 1024  , ST_LPART = 640 * 1024  , ST_WIDX = 2688 * 1024  , ST_BETA = 3712 * 1024  , ST_G = 4224 * 1024  , ST_BIAS = 4736 * 1024;
constexpr size_t WS_MNB = 40 * MiB, WS_KX = 48 * MiB, WS_VT = 56 * MiB, WS_CKV = 64 * MiB, WS_KIDX = 72 * MiB;
constexpr size_t WS_SSQ = 76 * MiB;
constexpr size_t WS_PROJ = 80 * MiB;
constexpr size_t WS_XB = 240 * MiB;
constexpr size_t WS_QABS = 240 * MiB;
constexpr size_t WS_MIX = 336 * MiB;
constexpr size_t WS_X1B = 240 * MiB, WS_QX = 304 * MiB, WS_P = 368 * MiB, WS_OX = 432 * MiB, WS_X2B = 304 * MiB, WS_ACT = 80 * MiB;
constexpr size_t WS_W8 = 496 * MiB;
constexpr int CTL_AMAX = 1600;
constexpr size_t WS_NEED = 512 * MiB;

#define DPP_ADD(v, CTRL) ((v) + __int_as_float(__builtin_amdgcn_update_dpp(0, __float_as_int(v), (CTRL), 0xF, 0xF, true)))
__device__ __forceinline__ float wave_sum(float v) {
    v = DPP_ADD(v, 0xB1);
    v = DPP_ADD(v, 0x4E);
    v = DPP_ADD(v, 0x141);
    v = DPP_ADD(v, 0x140);
    const int b = __float_as_int(v);
    const float s0 = __int_as_float(__builtin_amdgcn_readlane(b, 0)), s1 = __int_as_float(__builtin_amdgcn_readlane(b, 16)), s2 = __int_as_float(__builtin_amdgcn_readlane(b, 32)), s3 = __int_as_float(__builtin_amdgcn_readlane(b, 48));
    return (s0 + s1) + (s2 + s3);
}
__device__ __forceinline__ int lane_now() { int l; asm volatile("v_mbcnt_lo_u32_b32 %0, -1, 0\n\tv_mbcnt_hi_u32_b32 %0, -1, %0" : "=v"(l)); return l; }
namespace pg8 {
#define PG8_LAS __attribute__((address_space(3)))
typedef short bf16x8 __attribute__((ext_vector_type(8)));
typedef float f32x4 __attribute__((ext_vector_type(4)));
typedef unsigned u32x4 __attribute__((ext_vector_type(4)));
typedef unsigned u32x2 __attribute__((ext_vector_type(2)));
typedef int i32x4 __attribute__((ext_vector_type(4)));
constexpr int BM = 256, BK = 64, HALF = 128, HTB = HALF * BK * 2  , STAGE_BYTES = 8 * HTB, NXCD = 8, WGM = 8;

__host__ __device__ __forceinline__ int lds_byte(int r, int c) { const int st = (r >> 4) * 2 + (c >> 5), rr = r & 15, cc = c & 31, ob = rr * 64 + cc * 2; return st * 1024 + (ob ^ (((ob >> 9) & 1) << 5)); }
__host__ __device__ __forceinline__ void stage_rc(int b, int& R, int& C) { const int st = b / 1024, sb = b % 1024, swz = sb ^ (((sb >> 9) & 1) << 5); R = (st >> 1) * 16 + swz / 64; C = (st & 1) * 32 + (swz % 64) / 2; }
__host__ __device__ __forceinline__ int perm32(int rho) { const int n = rho >> 4, i = rho & 15; return 8 * (i >> 2) + 4 * n + (i & 3); }

struct Unit { int pm, pn; long ao, bo; };
struct Gemm { const bf16_t* A; const bf16_t* Bt; int lda, ldb, K; };

struct StaticOrder {
    int nM, nN, nwg, G, c;
    __host__ __device__ __forceinline__ void init(int M_, int N_, int G_, int c_) { nM = M_ / BM; nN = N_ / BM; nwg = nM * nN; G = G_; c = c_; }
    __host__ __device__ __forceinline__ bool next(int i, Unit& u) const {
        const long L = (long)i * G + c; if (L >= nwg) return false;
        int wgid = (int)L; { const int q = nwg / NXCD, r = nwg % NXCD, xcd = wgid % NXCD, off = wgid / NXCD; wgid = (xcd < r ? xcd * (q + 1) : r * (q + 1) + (xcd - r) * q) + off; }
        const int nig = WGM * nN, gid = wgid / nig, fm = gid * WGM, gsz = (nM - fm) < WGM ? (nM - fm) : WGM;
        u.pm = fm + ((wgid % nig) % gsz); u.pn = (wgid % nig) / gsz; u.ao = 0; u.bo = 0; return true;
    }
};
struct OneUnit { Unit u; __host__ __device__ __forceinline__ bool next(int i, Unit& o) const { if (i) return false; o = u; return true; } };
struct TwoUnits { Unit u0, u1; int n; __host__ __device__ __forceinline__ bool next(int i, Unit& o) const { if (i >= n) return false; o = i ? u1 : u0; return true; } };

typedef float cvf32x2_t __attribute__((ext_vector_type(2))); typedef __bf16 cvbf16x2_t __attribute__((ext_vector_type(2)));
__device__ __forceinline__ unsigned cvt_pk_bf16(float lo, float hi) { cvf32x2_t v = {lo, hi}; return __builtin_bit_cast(unsigned, __builtin_convertvector(v, cvbf16x2_t)); }
__device__ __forceinline__ u32x4 pack8(const f32x4& a, const f32x4& b) { u32x4 w; w.x = cvt_pk_bf16(a[0], a[1]); w.y = cvt_pk_bf16(a[2], a[3]); w.z = cvt_pk_bf16(b[0], b[1]); w.w = cvt_pk_bf16(b[2], b[3]); return w; }
__device__ __forceinline__ unsigned pack4_fp8(float a, float b, float c, float d) {
    a = __builtin_amdgcn_fmed3f(a, -448.f, 448.f); b = __builtin_amdgcn_fmed3f(b, -448.f, 448.f); c = __builtin_amdgcn_fmed3f(c, -448.f, 448.f); d = __builtin_amdgcn_fmed3f(d, -448.f, 448.f);
    int w = 0; w = __builtin_amdgcn_cvt_pk_fp8_f32(a, b, w, false); w = __builtin_amdgcn_cvt_pk_fp8_f32(c, d, w, true); return (unsigned)w; }
__device__ __forceinline__ u32x2 pack8_fp8(const f32x4& a, const f32x4& b) { u32x2 w; w.x = pack4_fp8(a[0], a[1], a[2], a[3]); w.y = pack4_fp8(b[0], b[1], b[2], b[3]); return w; }
__device__ __forceinline__ float w8_scale(unsigned amax_bits) { const int e = (int)(amax_bits >> 23) - 127; return amax_bits ? __uint_as_float((unsigned)(127 + 6 - e) << 23) : 1.f; }
__device__ __forceinline__ float w8_inv_scale(unsigned amax_bits, int extra_shift) { const int e = (int)(amax_bits >> 23) - 127; return __uint_as_float((unsigned)(amax_bits ? 127 - 6 + e - extra_shift : 127 - extra_shift) << 23); }
__device__ __forceinline__ float dot4(const f32x4& a) { return (a[0] * a[0] + a[1] * a[1]) + (a[2] * a[2] + a[3] * a[3]); }
__device__ __forceinline__ float sum4(const f32x4& a) { return (a[0] + a[1]) + (a[2] + a[3]); }
__device__ __forceinline__ float lo_bf(unsigned w) { return __uint_as_float(w << 16); }
__device__ __forceinline__ float hi_bf(unsigned w) { return __uint_as_float(w & 0xffff0000u); }

typedef f32x4 Acc[2][2][4][2];
#define PG8_EPI_ROWS(...) _Pragma("unroll") for (int ai = 0; ai < 2; ++ai) _Pragma("unroll") for (int m = 0; m < 4; ++m) { const int rl = ai * HALF + wr * 64 + m * 16 + fr; __VA_ARGS__ }

struct EpiProj { static constexpr bool PERM = true;
    bf16_t* O; int ldc; const float* rs; float* cqss; int ssq_pn;
    __device__ __forceinline__ void operator()(const Acc& acc, const Unit& u, int wr, int wc, int fr, int fq) const {
        const int col0 = u.pn * BM + wc * 32 + 8 * fq; const bool doss = (u.pn == ssq_pn);
        PG8_EPI_ROWS( const int row = u.pm * BM + rl; const float r = rs ? rs[row] : 1.f; float ss = 0.f; bf16_t* rowp = O + (size_t)row * ldc + col0;
            _Pragma("unroll") for (int bj = 0; bj < 2; ++bj) { const f32x4 v0 = acc[ai][bj][m][0] * r, v1 = acc[ai][bj][m][1] * r; *(u32x4*)(rowp + bj * HALF) = pack8(v0, v1); ss += dot4(v0) + dot4(v1); }
            if (doss) { ss += __shfl_xor(ss, 16); ss += __shfl_xor(ss, 32); if (fq == 0) cqss[(size_t)row * 4 + wc] = ss; } )
    }
};
constexpr float KV8_SCALE = 8.f; constexpr int KV8_SHIFT = 3;
struct EpiProj8 { static constexpr bool PERM = true;
    unsigned char* O; int ldc; float scale;
    __device__ __forceinline__ void operator()(const Acc& acc, const Unit& u, int wr, int wc, int fr, int fq) const {
        const int col0 = u.pn * BM + wc * 32 + 8 * fq;
        PG8_EPI_ROWS( const int row = u.pm * BM + rl; unsigned char* rowp = O + (size_t)row * ldc + col0;
            _Pragma("unroll") for (int bj = 0; bj < 2; ++bj) *(u32x2*)(rowp + bj * HALF) = pack8_fp8(acc[ai][bj][m][0] * scale, acc[ai][bj][m][1] * scale); )
    }
};
constexpr float QX8_SCALE = 64.f; constexpr int QX8_SHIFT = 6;
template <int NP, bool F8OUT = false> struct EpiNormScale { static constexpr bool PERM = true;
    bf16_t* O; int ldc; const float* part; float inv_dim; float ascale;
    __device__ __forceinline__ void operator()(const Acc& acc, const Unit& u, int wr, int wc, int fr, int fq) const {
        const int col0 = u.pn * BM + wc * 32 + 8 * fq;
        PG8_EPI_ROWS( const int row = u.pm * BM + rl; float s = 0.f;
            _Pragma("unroll") for (int q = 0; q < NP / 4; ++q) s += sum4(*(const f32x4*)(part + (size_t)row * NP + 4 * q));
            const float r = rsqrtf(s * inv_dim + EPS) * ascale;
            if constexpr (F8OUT) { unsigned char* rowp = (unsigned char*)O + (size_t)row * ldc + col0;
                _Pragma("unroll") for (int bj = 0; bj < 2; ++bj) *(u32x2*)(rowp + bj * HALF) = pack8_fp8(acc[ai][bj][m][0] * r, acc[ai][bj][m][1] * r); }
            else { bf16_t* rowp = O + (size_t)row * ldc + col0;
                _Pragma("unroll") for (int bj = 0; bj < 2; ++bj) *(u32x4*)(rowp + bj * HALF) = pack8(acc[ai][bj][m][0] * r, acc[ai][bj][m][1] * r); } )
    }
};
constexpr float X8_SCALE = 8.f; constexpr int X8_SHIFT = 3;
template <bool SRC16, bool X8 = false> struct EpiResid { static constexpr bool PERM = true;
    const float* src; const bf16_t* src16; bf16_t* xb; float* ssq; const float* rinv; unsigned char* x8; float ascale; int pad_;
    __device__ __forceinline__ void operator()(const Acc& acc, const Unit& u, int wr, int wc, int fr, int fq) const {
        const int col0 = u.pn * BM + wc * 32 + 8 * fq;
        PG8_EPI_ROWS( const size_t row = (size_t)u.pm * BM + rl; float ss = 0.f; const size_t off = row * 1024 + col0; const float rsc = (SRC16 && rinv) ? 1.f / rinv[row] : 1.f;
            _Pragma("unroll") for (int bj = 0; bj < 2; ++bj) { f32x4 s0, s1;
                if (SRC16) { const u32x4 w = *(const u32x4*)(src16 + off + bj * HALF); s0 = (f32x4){lo_bf(w.x), hi_bf(w.x), lo_bf(w.y), hi_bf(w.y)} * rsc; s1 = (f32x4){lo_bf(w.z), hi_bf(w.z), lo_bf(w.w), hi_bf(w.w)} * rsc; }
                else { s0 = *(const f32x4*)(src + off + bj * HALF); s1 = *(const f32x4*)(src + off + bj * HALF + 4); }
                const f32x4 v0 = s0 + acc[ai][bj][m][0] * ascale, v1 = s1 + acc[ai][bj][m][1] * ascale;
                *(u32x4*)(xb + off + bj * HALF) = pack8(v0, v1); ss += dot4(v0) + dot4(v1);
                if constexpr (X8) *(u32x2*)(x8 + off + bj * HALF) = pack8_fp8(v0 * X8_SCALE, v1 * X8_SCALE); }
            ss += __shfl_xor(ss, 16); ss += __shfl_xor(ss, 32); if (fq == 0) ssq[row * 16 + u.pn * 4 + wc] = ss; )
    }
};
struct EpiResidF32 { static constexpr bool PERM = true;
    const bf16_t* src16; float* dst; float* ssq; float ascale; int pad_;
    __device__ __forceinline__ void operator()(const Acc& acc, const Unit& u, int wr, int wc, int fr, int fq) const {
        const int col0 = u.pn * BM + wc * 32 + 8 * fq;
        PG8_EPI_ROWS( const size_t row = (size_t)u.pm * BM + rl; float ss = 0.f; const size_t off = row * 1024 + col0;
            _Pragma("unroll") for (int bj = 0; bj < 2; ++bj) { const u32x4 w = *(const u32x4*)(src16 + off + bj * HALF);
                const f32x4 v0 = (f32x4){lo_bf(w.x), hi_bf(w.x), lo_bf(w.y), hi_bf(w.y)} + acc[ai][bj][m][0] * ascale, v1 = (f32x4){lo_bf(w.z), hi_bf(w.z), lo_bf(w.w), hi_bf(w.w)} + acc[ai][bj][m][1] * ascale;
                *(f32x4*)(dst + off + bj * HALF) = v0; *(f32x4*)(dst + off + bj * HALF + 4) = v1; ss += dot4(v0) + dot4(v1); }
            ss += __shfl_xor(ss, 16); ss += __shfl_xor(ss, 32); if (fq == 0) ssq[row * 16 + u.pn * 4 + wc] = ss; )
    }
};
struct EpiFinal { static constexpr bool PERM = true;
    const bf16_t* src16; float* dst; float* part; unsigned* cnt; const float* gain; float ascale; int pad_;
    __device__ __forceinline__ void operator()(Acc& acc, const Unit& u, int wr, int wc, int fr, int fq) const {
        const int col0 = u.pn * BM + wc * 32 + 8 * fq; float asl = ascale; asm volatile("" : "+s"(asl));
        PG8_EPI_ROWS( const size_t row = (size_t)u.pm * BM + rl; float ss = 0.f; const size_t off = row * 1024 + col0;
            _Pragma("unroll") for (int bj = 0; bj < 2; ++bj) { const u32x4 w = *(const u32x4*)(src16 + off + bj * HALF); const f32x4 s0 = {lo_bf(w.x), hi_bf(w.x), lo_bf(w.y), hi_bf(w.y)}, s1 = {lo_bf(w.z), hi_bf(w.z), lo_bf(w.w), hi_bf(w.w)};
                acc[ai][bj][m][0] = acc[ai][bj][m][0] * asl + s0; acc[ai][bj][m][1] = acc[ai][bj][m][1] * asl + s1; ss += dot4(acc[ai][bj][m][0]) + dot4(acc[ai][bj][m][1]); }
            ss += __shfl_xor(ss, 16); ss += __shfl_xor(ss, 32);
            if (fq == 0) __hip_atomic_store(part + row * 16 + u.pn * 4 + wc, ss, __ATOMIC_RELAXED, __HIP_MEMORY_SCOPE_AGENT); )
        asm volatile("s_waitcnt vmcnt(0)" ::: "memory");
        unsigned* c = cnt + 64 * u.pm;
        if ((fr | fq) == 0) __hip_atomic_fetch_add(c, 1u, __ATOMIC_RELAXED, __HIP_MEMORY_SCOPE_AGENT);
        for (unsigned spins = 0; spins < (1u << 22); ++spins) { if ((unsigned)__builtin_amdgcn_readfirstlane(__hip_atomic_load(c, __ATOMIC_RELAXED, __HIP_MEMORY_SCOPE_AGENT)) >= 32u) break; __builtin_amdgcn_s_sleep(4); }
        __builtin_amdgcn_fence(__ATOMIC_ACQUIRE, "agent");
        f32x4 gv[2][2];
        _Pragma("unroll") for (int bj = 0; bj < 2; ++bj) { gv[bj][0] = *(const f32x4*)(gain + col0 + bj * HALF); gv[bj][1] = *(const f32x4*)(gain + col0 + bj * HALF + 4); }
        PG8_EPI_ROWS( const size_t row = (size_t)u.pm * BM + rl; float s = 0.f;
            _Pragma("unroll") for (int q = 0; q < 4; ++q) s += sum4(*(const f32x4*)(part + row * 16 + 4 * q));
            const float r = rsqrtf(s * (1.f / 1024.f) + EPS); const size_t off = row * 1024 + col0;
            _Pragma("unroll") for (int bj = 0; bj < 2; ++bj) { *(f32x4*)(dst + off + bj * HALF) = acc[ai][bj][m][0] * gv[bj][0] * r; *(f32x4*)(dst + off + bj * HALF + 4) = acc[ai][bj][m][1] * gv[bj][1] * r; } )
    }
};
struct EpiExpP { static constexpr bool PERM = true;
    unsigned char* Pb; float* lpart; float ascale; int pad_;
    __device__ __forceinline__ void operator()(const Acc& acc, const Unit& u, int wr, int wc, int fr, int fq) const {
        const int h = (int)(u.ao >> 8), rowbase = u.pm * BM, col0 = wc * 32 + 8 * fq; unsigned char* O = Pb + (size_t)rowbase * 1024 + h * 256;
        PG8_EPI_ROWS( float ss = 0.f; unsigned char* rowp = O + (size_t)rl * 1024 + col0;
            _Pragma("unroll") for (int bj = 0; bj < 2; ++bj) { f32x4 v0 = acc[ai][bj][m][0] * ascale, v1 = acc[ai][bj][m][1] * ascale;
                _Pragma("unroll") for (int e = 0; e < 4; ++e) { v0[e] = __builtin_amdgcn_exp2f(v0[e]); v1[e] = __builtin_amdgcn_exp2f(v1[e]); }
                const u32x2 w = pack8_fp8(v0, v1); *(u32x2*)(rowp + bj * HALF) = w;
                ss += (__builtin_amdgcn_cvt_f32_fp8((int)w.x, 0) + __builtin_amdgcn_cvt_f32_fp8((int)w.x, 1)) + (__builtin_amdgcn_cvt_f32_fp8((int)w.x, 2) + __builtin_amdgcn_cvt_f32_fp8((int)w.x, 3))
                    + (__builtin_amdgcn_cvt_f32_fp8((int)w.y, 0) + __builtin_amdgcn_cvt_f32_fp8((int)w.y, 1)) + (__builtin_amdgcn_cvt_f32_fp8((int)w.y, 2) + __builtin_amdgcn_cvt_f32_fp8((int)w.y, 3)); }
            ss += __shfl_xor(ss, 16); ss += __shfl_xor(ss, 32); if (fq == 0) lpart[(size_t)(rowbase + rl) * 16 + h * 4 + wc] = ss; )
    }
};
constexpr float OX_SCALE = 32.f; constexpr int OX_SHIFT = 5;
struct EpiPV { static constexpr bool PERM = true;
    unsigned char* Ob; const float* lpart; float ascale; int pad_;
    __device__ __forceinline__ void operator()(const Acc& acc, const Unit& u, int wr, int wc, int fr, int fq) const {
        const int h = u.pn, rowbase = u.pm * BM, col0 = wc * 32 + 8 * fq; unsigned char* O = Ob + (size_t)rowbase * 1024 + h * 256;
        PG8_EPI_ROWS( const float r = ascale / sum4(*(const f32x4*)(lpart + (size_t)(rowbase + rl) * 16 + h * 4)); unsigned char* rowp = O + (size_t)rl * 1024 + col0;
            _Pragma("unroll") for (int bj = 0; bj < 2; ++bj) *(u32x2*)(rowp + bj * HALF) = pack8_fp8(acc[ai][bj][m][0] * r, acc[ai][bj][m][1] * r); )
    }
};
constexpr float ACT_SCALE = 16.f; constexpr int ACT_SHIFT = 4;
struct EpiSwiglu { static constexpr bool PERM = true;
    unsigned char* act; const float* part;
    __device__ __forceinline__ void operator()(const Acc& acc, const Unit& u, int wr, int wc, int fr, int fq) const {
        const int col0 = u.pn * BM + wc * 32 + 8 * fq;
        PG8_EPI_ROWS( const size_t row = (size_t)u.pm * BM + rl; float s = 0.f;
            _Pragma("unroll") for (int q = 0; q < 4; ++q) s += sum4(*(const f32x4*)(part + row * 16 + 4 * q));
            const float r = rsqrtf(s * (1.f / 1024.f) + EPS); unsigned char* rowp = act + row * DFF + (col0 >> 1);
            _Pragma("unroll") for (int bj = 0; bj < 2; ++bj) { const f32x4 a = acc[ai][bj][m][0] * r, b = acc[ai][bj][m][1] * r;
                const float o0 = a[0] * __builtin_amdgcn_rcpf(1.f + __builtin_amdgcn_exp2f(-LOG2E * a[0])) * a[1], o1 = a[2] * __builtin_amdgcn_rcpf(1.f + __builtin_amdgcn_exp2f(-LOG2E * a[2])) * a[3];
                const float o2 = b[0] * __builtin_amdgcn_rcpf(1.f + __builtin_amdgcn_exp2f(-LOG2E * b[0])) * b[1], o3 = b[2] * __builtin_amdgcn_rcpf(1.f + __builtin_amdgcn_exp2f(-LOG2E * b[2])) * b[3];
                *(unsigned*)(rowp + bj * (HALF / 2)) = pack4_fp8(o0 * ACT_SCALE, o1 * ACT_SCALE, o2 * ACT_SCALE, o3 * ACT_SCALE); } )
    }
};

template <class Epi, class Sched, bool ALIGN_EPI, int MODE = 0>
__device__ __forceinline__ void gemm_phase(PG8_LAS unsigned char* lds, const Gemm g, const Sched& S, const Epi& E, int wave_id, int tsplit = 0) {
    constexpr bool F8 = (MODE != 0);
    const int tid = wave_id * 64 + lane_now();
    const int wid = __builtin_amdgcn_readfirstlane(tid >> 6), lane = tid & 63, wr = wid >> 2, wc = wid & 3, fr = lane & 15, fq = lane >> 4;
    int Kop = g.K; asm volatile("" : "+s"(Kop));
    constexpr int ES = F8 ? 1 : 2;
    const int nt = Kop * ES / (BK * 2);
    unsigned voffA[2], voffB[2];
#pragma unroll
    for (int i = 0; i < 2; ++i) { int R, C; stage_rc(tid * 16 + i * 8192, R, C); const int Rb = Epi::PERM ? ((R & ~31) + perm32(R & 31)) : R;
        voffA[i] = (unsigned)(R * g.lda * ES + C * 2); voffB[i] = (unsigned)(Rb * g.ldb * ES + C * 2); }
    const size_t kstep = (size_t)(BK * 2);
    const size_t hstepA = (size_t)HALF * g.lda * ES, hstepB = (size_t)HALF * g.ldb * ES;
    const size_t tstepA = 2 * hstepA, tstepB = 2 * hstepB;
    const unsigned ldsw = (unsigned)wid * 1024u;
    const int aoff = lds_byte(wr * 64 + fr, fq * 8), boff = lds_byte(wc * 32 + fr, fq * 8);
#define PG8_SA(b, h) (((b) * 2 + (h)) * HTB)
#define PG8_SB(b, h) ((4 + (b) * 2 + (h)) * HTB)
#define PG8_STAGE(bufoff, gbase, voff, rs) do { _Pragma("unroll") for (int _i = 0; _i < 2; ++_i) { \
        if constexpr (F8) __builtin_amdgcn_raw_ptr_buffer_load_lds(rs, (PG8_LAS void*)(lds + (bufoff) + ldsw + _i * 8192), 16, (int)(voff)[_i], (int)(unsigned)(size_t)(gbase), 0, 0); \
        else __builtin_amdgcn_global_load_lds((const unsigned*)((const char*)(gbase) + (voff)[_i]), (PG8_LAS unsigned*)(lds + (bufoff) + ldsw + _i * 8192), 16, 0, 0); } } while (0)
#define PG8_LDA(dst, b, h) do { _Pragma("unroll") for (int m = 0; m < 4; ++m) _Pragma("unroll") for (int k = 0; k < 2; ++k) dst[m][k] = *(const PG8_LAS bf16x8*)(lds + PG8_SA(b, h) + aoff + m * 2048 + k * 1024); } while (0)
#define PG8_LDB(dst, b, h) do { _Pragma("unroll") for (int n = 0; n < 2; ++n) _Pragma("unroll") for (int k = 0; k < 2; ++k) dst[n][k] = *(const PG8_LAS bf16x8*)(lds + PG8_SB(b, h) + boff + n * 2048 + k * 1024); } while (0)
#define PG8_CAT8(x, y) __builtin_shufflevector(__builtin_bit_cast(i32x4, x), __builtin_bit_cast(i32x4, y), 0, 1, 2, 3, 4, 5, 6, 7)
#define PG8_MMA(ai, bj, At, Bt) do { __builtin_amdgcn_s_setprio(1); _Pragma("unroll") for (int m = 0; m < 4; ++m) _Pragma("unroll") for (int n = 0; n < 2; ++n) { \
        if constexpr (f8now) acc[ai][bj][m][n] = __builtin_amdgcn_mfma_scale_f32_16x16x128_f8f6f4(PG8_CAT8(Bt[n][0], Bt[n][1]), PG8_CAT8(At[m][0], At[m][1]), acc[ai][bj][m][n], 0, 0, 0, 0, 0, 0); \
        else { _Pragma("unroll") for (int k = 0; k < 2; ++k) acc[ai][bj][m][n] = __builtin_amdgcn_mfma_f32_16x16x32_bf16(Bt[n][k], At[m][k], acc[ai][bj][m][n], 0, 0, 0); } } \
        __builtin_amdgcn_s_setprio(0); } while (0)
#define PG8_WAIT_V(n) asm volatile("s_waitcnt vmcnt(" #n ")" ::: "memory")
#define PG8_WAIT_L(n) asm volatile("s_waitcnt lgkmcnt(" #n ")" ::: "memory")
#define PG8_BAR __builtin_amdgcn_s_barrier()
#define PG8_SCHED __builtin_amdgcn_sched_barrier(0)
    Unit cur, nxt; int ui = 0;
    if (!S.next(0, cur)) return;
    Acc acc;
#pragma unroll
    for (int a = 0; a < 2; ++a)
#pragma unroll
        for (int b = 0; b < 2; ++b)
#pragma unroll
            for (int m = 0; m < 4; ++m)
#pragma unroll
                for (int n = 0; n < 2; ++n) acc[a][b][m][n] = (f32x4){0.f, 0.f, 0.f, 0.f};
    bf16x8 At[4][2], B0[2][2], B1[2][2];
    const __amdgpu_buffer_rsrc_t rsA = __builtin_amdgcn_make_buffer_rsrc((void*)g.A, 0, -1, 0x00020000), rsB = __builtin_amdgcn_make_buffer_rsrc((void*)g.Bt, 0, -1, 0x00020000);
    const char* const baseA = F8 ? (const char*)(size_t)0 : (const char*)g.A; const char* const baseB = F8 ? (const char*)(size_t)0 : (const char*)g.Bt;
    const char* cA = baseA + (size_t)cur.pm * tstepA + cur.ao; const char* cB = baseB + (size_t)cur.pn * tstepB + cur.bo;
    PG8_STAGE(PG8_SB(0, 0), cB, voffB, rsB); PG8_STAGE(PG8_SB(0, 1), cB + hstepB, voffB, rsB); PG8_STAGE(PG8_SA(0, 0), cA, voffA, rsA); PG8_STAGE(PG8_SA(0, 1), cA + hstepA, voffA, rsA);
    if (wr == 1) PG8_BAR;
    PG8_WAIT_V(2); PG8_BAR;
    PG8_STAGE(PG8_SB(1, 0), cB + kstep, voffB, rsB); PG8_STAGE(PG8_SA(1, 0), cA + kstep, voffA, rsA); PG8_STAGE(PG8_SB(1, 1), cB + hstepB + kstep, voffB, rsB);
    PG8_WAIT_V(6); PG8_BAR;
    for (;;) {
        const bool has_next = S.next(ui + 1, nxt);
        const char* nA = has_next ? baseA + (size_t)nxt.pm * tstepA + nxt.ao : cA; const char* nB = has_next ? baseB + (size_t)nxt.pn * tstepB + nxt.bo : cB;
#define PG8_KLOOP(T0, T1, F8NOW) for (int t = (T0); t < (T1); t += 2) { \
            const bool last = (t == nt - 2); constexpr bool f8now = (F8NOW); \
            const char* a1 = cA + (size_t)(t + 1) * kstep; \
            const char* a2 = last ? nA : cA + (size_t)(t + 2) * kstep; const char* b2 = last ? nB : cB + (size_t)(t + 2) * kstep; \
            const char* a3 = a2 + kstep; const char* b3 = b2 + kstep; \
              \
            PG8_LDB(B0, 0, 0); PG8_LDB(B1, 0, 1); PG8_SCHED; PG8_LDA(At, 0, 0); PG8_STAGE(PG8_SA(1, 1), a1 + hstepA, voffA, rsA); \
            PG8_WAIT_V(8); PG8_WAIT_L(0); PG8_BAR; PG8_MMA(0, 0, At, B0); PG8_MMA(0, 1, At, B1); PG8_BAR; PG8_SCHED; \
              \
            PG8_LDA(At, 0, 1); PG8_STAGE(PG8_SB(0, 0), b2, voffB, rsB); PG8_STAGE(PG8_SB(0, 1), b2 + hstepB, voffB, rsB); PG8_STAGE(PG8_SA(0, 0), a2, voffA, rsA); \
            PG8_WAIT_V(8); PG8_WAIT_L(0); PG8_BAR; PG8_MMA(1, 0, At, B0); PG8_MMA(1, 1, At, B1); PG8_BAR; PG8_SCHED; \
              \
            PG8_LDB(B0, 1, 0); PG8_LDB(B1, 1, 1); PG8_SCHED; PG8_LDA(At, 1, 0); PG8_STAGE(PG8_SA(0, 1), a2 + hstepA, voffA, rsA); \
            PG8_WAIT_V(8); PG8_WAIT_L(0); PG8_BAR; PG8_MMA(0, 0, At, B0); PG8_MMA(0, 1, At, B1); PG8_BAR; PG8_SCHED; \
              \
            PG8_LDA(At, 1, 1); PG8_STAGE(PG8_SB(1, 0), b3, voffB, rsB); PG8_STAGE(PG8_SB(1, 1), b3 + hstepB, voffB, rsB); PG8_STAGE(PG8_SA(1, 0), a3, voffA, rsA); \
            PG8_WAIT_V(8); PG8_WAIT_L(0); PG8_BAR; PG8_MMA(1, 0, At, B0); PG8_MMA(1, 1, At, B1); PG8_BAR; PG8_SCHED; \
        }
        if constexpr (MODE == 2) { PG8_KLOOP(0, tsplit, false) PG8_KLOOP(tsplit, nt, true) }
        else { PG8_KLOOP(0, nt, (MODE == 1)) }
        if constexpr (ALIGN_EPI) { if (wr == 0) PG8_BAR; }
        { int fr_e = fr, fq_e = fq;
          if constexpr (F8) { const int l_e = lane_now(); fr_e = l_e & 15; fq_e = l_e >> 4; }
          E(acc, cur, wr, wc, fr_e, fq_e); }
        if (!has_next) break;
#pragma unroll
        for (int a = 0; a < 2; ++a)
#pragma unroll
            for (int b = 0; b < 2; ++b)
#pragma unroll
                for (int m = 0; m < 4; ++m)
#pragma unroll
                    for (int n = 0; n < 2; ++n) acc[a][b][m][n] = (f32x4){0.f, 0.f, 0.f, 0.f};
        cur = nxt; cA = nA; cB = nB; ++ui;
        if constexpr (ALIGN_EPI) { if (wr == 1) PG8_BAR; }
    }
    PG8_WAIT_V(0);
    if constexpr (!ALIGN_EPI) { if (wr == 0) PG8_BAR; }
    PG8_BAR;
#undef PG8_SA
#undef PG8_SB
#undef PG8_STAGE
#undef PG8_LDA
#undef PG8_LDB
#undef PG8_MMA
#undef PG8_KLOOP
#undef PG8_CAT8
#undef PG8_WAIT_V
#undef PG8_WAIT_L
#undef PG8_BAR
#undef PG8_SCHED
}
}
constexpr int NWAVES = 8;
constexpr int RING_BYTES = 131072;
constexpr int LDSCTL_OFF = RING_BYTES, MISC_OFF = LDSCTL_OFF + 320;
constexpr int LDS_BYTES = 147456;
#define GAS __attribute__((address_space(1)))
#define LAS __attribute__((address_space(3)))
typedef unsigned v4u __attribute__((ext_vector_type(4)));
typedef float f32x4 __attribute__((ext_vector_type(4)));
typedef GAS unsigned gu32;
#define RLX_AGENT __ATOMIC_RELAXED, __HIP_MEMORY_SCOPE_AGENT
#define LDS_WAIT() asm volatile("s_waitcnt lgkmcnt(0)" ::: "memory")
#define VM_WAIT() asm volatile("s_waitcnt vmcnt(0)" ::: "memory")
__device__ __forceinline__ unsigned pk2(float lo, float hi) { return (unsigned)f2bf(lo) | ((unsigned)f2bf(hi) << 16); }

#define XB_TMO      128
#define XB_XCNT(j)  (256  + 64 * (j))
#define XB_XSUB(j)  (1280 + 64 * (j))
#define XB_XGEN(j)  (2304 + 64 * (j))
#define XB_TOP      3328
#define XB_TOPGEN   3392
#define XCD_BAR_WORDS 3456
#define XB_SPIN_CAP (1u << 18)
__device__ __forceinline__ unsigned xb_ld(unsigned* p)              { return __hip_atomic_load(p, __ATOMIC_RELAXED, __HIP_MEMORY_SCOPE_AGENT); }
__device__ __forceinline__ unsigned xb_add(unsigned* p, unsigned v) { return __hip_atomic_fetch_add(p, v, __ATOMIC_RELAXED, __HIP_MEMORY_SCOPE_AGENT); }
__device__ __forceinline__ unsigned xb_xcc_id() { return (unsigned)__builtin_amdgcn_s_getreg((3 << 11) | 20) & 0xFu; }
#define XB_SPIN(cond, bar) do { unsigned _sp = 0; while (cond) { __builtin_amdgcn_s_sleep(1); \
    if ((++_sp & 255u) == 0u) { if (xb_ld(&(bar)[XB_TMO])) break; if (_sp > XB_SPIN_CAP) { atomicAdd(&(bar)[XB_TMO], 1u); break; } } } } while (0)
struct XcdBarrier { unsigned* bar; unsigned x; volatile LAS unsigned* st; };
__device__ __forceinline__ XcdBarrier xcd_barrier_post(unsigned* bar, volatile LAS unsigned* st) {
    XcdBarrier b; b.bar = bar; b.x = xb_xcc_id(); b.st = st;
    if (threadIdx.x == 0) (void)xb_add(&bar[XB_XCNT(b.x)], 1u);
    return b;
}
__device__ __forceinline__ void xcd_barrier_complete(unsigned* bar, unsigned x, unsigned& nloc, unsigned& nx) {
    const unsigned G = gridDim.x * gridDim.y * gridDim.z;
    unsigned sum, cnt, mine, sp = 0u;
    for (;;) {
        sum = 0u; cnt = 0u; mine = 0u;
#pragma unroll
        for (unsigned j = 0; j < 16; ++j) { const unsigned c = xb_ld(&bar[XB_XCNT(j)]); sum += c; cnt += (c > 0u) ? 1u : 0u; mine = (j == x) ? c : mine; }
        if (sum == G) break;
        __builtin_amdgcn_s_sleep(1);
        if ((++sp & 255u) == 0u) { if (xb_ld(&bar[XB_TMO])) break; if (sp > XB_SPIN_CAP) { atomicAdd(&bar[XB_TMO], 1u); break; } }
    }
    nloc = mine > 0u ? mine : 1u; nx = cnt > 0u ? cnt : 1u;
}
__device__ __forceinline__ void xcd_barrier(const XcdBarrier& b, int wave) {
    asm volatile("s_waitcnt vmcnt(0)" ::: "memory");
    __syncthreads();
    if (wave == 0 && lane_now() == 0) {
        unsigned* bar = b.bar;
        __builtin_amdgcn_s_waitcnt(0);
        unsigned nloc = b.st[0], nx = b.st[1];
        if (nloc == 0u) { xcd_barrier_complete(bar, b.x, nloc, nx); b.st[0] = nloc; b.st[1] = nx; }
        const unsigned old = xb_add(&bar[XB_XSUB(b.x)], 1u);
        const unsigned gen = old / nloc;
        if (old + 1u == (gen + 1u) * nloc) {
            __builtin_amdgcn_fence(__ATOMIC_RELEASE, "agent");
            asm volatile("s_waitcnt vmcnt(0)" ::: "memory");
            const unsigned og = xb_add(&bar[XB_TOP], 1u);
            const unsigned tg = og / nx;
            if (og + 1u == (tg + 1u) * nx) xb_add(&bar[XB_TOPGEN], 1u);
            else XB_SPIN(xb_ld(&bar[XB_TOPGEN]) == tg, bar);
            __builtin_amdgcn_fence(__ATOMIC_ACQUIRE, "agent");
            xb_add(&bar[XB_XGEN(b.x)], 1u);
            asm volatile("s_waitcnt vmcnt(0)" ::: "memory");
        } else {
            XB_SPIN(xb_ld(&bar[XB_XGEN(b.x)]) == gen, bar);
            __builtin_amdgcn_fence(__ATOMIC_ACQUIRE, "agent");
            asm volatile("s_waitcnt vmcnt(0)" ::: "memory");
        }
    }
    __syncthreads();
}

struct SrcWin { const float* w; const float* g;
    __device__ __forceinline__ float at(int k, int n) const {
        int src;
        if (n < 2048) src = n; else if (n < C_CKV) src = 2056 + (n - C_CQ); else if (n < C_KIX) src = 2312 + (n - C_CKV); else if (n < C_WIX) src = 2440 + (n - C_KIX);
        else if (n < C_DB) src = 2504 + (n - C_WIX); else if (n < C_DA) src = 2048 + (n - C_DB); else if (n < 2512) src = 2052 + (n - C_DA); else src = -1;
        return src >= 0 ? w[(size_t)k * PROJ_REF + src] * g[k] : 0.f; } };
struct SrcPlain { const float* w; int ld; const float* g; float cs;
    __device__ __forceinline__ float at(int k, int n) const { return w[(size_t)k * ld + n] * (g ? g[k] : 1.f) * cs; } };
struct SrcQidx { const float* w; const float* g;
    __device__ __forceinline__ float at(int k, int n) const { const int s = n >> 7, head = (n >> 4) & 7, r = n & 15; return w[(size_t)k * 512 + head * 64 + 16 * s + r] * g[k]; } };
struct SrcGU { const float* wg; const float* wu; const float* g;
    __device__ __forceinline__ float at(int k, int n) const { const size_t i = (size_t)k * DFF + (n >> 1); const float a = wg[i], b = wu[i]; return ((n & 1) ? b : a) * g[k]; } };
template <class Src> __device__ __forceinline__ void tr_item(const Src& S, int Nsz, bf16_t* WT, int ldo, int koff, LAS float* scr, int item, int lane, unsigned* amax = nullptr) {
    const int nblk = Nsz / 32, kb = item / nblk, nb = item % nblk, k0 = 64 * kb, n0 = 32 * nb;
    float t[32];
#pragma unroll
    for (int i = 0; i < 32; ++i) t[i] = S.at(k0 + 2 * i + (lane >> 5), n0 + (lane & 31));
    if (amax) { float mx = 0.f;
#pragma unroll
        for (int i = 0; i < 32; ++i) mx = fmaxf(mx, fabsf(t[i]));
#pragma unroll
        for (int o = 1; o < 64; o <<= 1) mx = fmaxf(mx, __shfl_xor(mx, o));
        if (lane == 0) (void)__hip_atomic_fetch_max(amax, __float_as_uint(mx), __ATOMIC_RELAXED, __HIP_MEMORY_SCOPE_AGENT); }
#pragma unroll
    for (int i = 0; i < 32; ++i) scr[(2 * i + (lane >> 5)) * 33 + (lane & 31)] = t[i];
    LDS_WAIT(); asm volatile("" ::: "memory");
    const int c = lane & 7;
#pragma unroll
    for (int j = 0; j < 4; ++j) { const int n = (lane >> 3) + 8 * j; const LAS float* s = scr + (8 * c) * 33 + n;
        v4u o; o.x = pk2(s[0 * 33], s[1 * 33]); o.y = pk2(s[2 * 33], s[3 * 33]); o.z = pk2(s[4 * 33], s[5 * 33]); o.w = pk2(s[6 * 33], s[7 * 33]);
        *(GAS v4u*)(WT + (size_t)(n0 + n) * ldo + koff + k0 + 8 * c) = o; }
    LDS_WAIT(); asm volatile("" ::: "memory");
}
__device__ __forceinline__ void heavy_item(const float* Ap, int lda, const float* Bp, int ldb, const float* cs, float cmul, int k0, int n0, int n0out, bf16_t* WT, int ldo, int koff, LAS float* scr, int lane, unsigned* amax = nullptr) {
    LAS float* At = scr; LAS float* tt = scr + 2048;
#pragma unroll
    for (int i = 0; i < 8; ++i) { const int e = (i * 64 + lane) * 4, r = e >> 6, d = e & 63; *(LAS f32x4*)(At + e) = *(const GAS f32x4*)(Ap + (size_t)(k0 + r) * lda + d); }
    float bc[64];
#pragma unroll
    for (int d = 0; d < 64; ++d) bc[d] = Bp[(size_t)d * ldb + n0 + (lane & 31)];
    LDS_WAIT(); asm volatile("" ::: "memory");
    float hmx = 0.f;
#pragma unroll 2
    for (int i = 0; i < 16; ++i) { const int kk = 2 * i + (lane >> 5); const LAS f32x4* ar = (const LAS f32x4*)(At + kk * 64); float s0 = 0.f, s1 = 0.f;
#pragma unroll
        for (int q = 0; q < 16; q += 2) { const f32x4 a = ar[q], b2 = ar[q + 1]; s0 += a.x * bc[4 * q] + a.y * bc[4 * q + 1] + a.z * bc[4 * q + 2] + a.w * bc[4 * q + 3]; s1 += b2.x * bc[4 * q + 4] + b2.y * bc[4 * q + 5] + b2.z * bc[4 * q + 6] + b2.w * bc[4 * q + 7]; }
        const float tv = (s0 + s1) * (cs ? cs[k0 + kk] : 1.f) * cmul; tt[kk * 33 + (lane & 31)] = tv; hmx = fmaxf(hmx, fabsf(tv)); }
    if (amax) {
#pragma unroll
        for (int o = 1; o < 64; o <<= 1) hmx = fmaxf(hmx, __shfl_xor(hmx, o));
        if (lane == 0) (void)__hip_atomic_fetch_max(amax, __float_as_uint(hmx), __ATOMIC_RELAXED, __HIP_MEMORY_SCOPE_AGENT); }
    LDS_WAIT(); asm volatile("" ::: "memory");
    const int c = lane & 3;
#pragma unroll
    for (int j = 0; j < 2; ++j) { const int n = (lane >> 2) + 16 * j; const LAS float* s = tt + (8 * c) * 33 + n;
        v4u o; o.x = pk2(s[0 * 33], s[1 * 33]); o.y = pk2(s[2 * 33], s[3 * 33]); o.z = pk2(s[4 * 33], s[5 * 33]); o.w = pk2(s[6 * 33], s[7 * 33]);
        *(GAS v4u*)(WT + (size_t)(n0out + n) * ldo + koff + k0 + 8 * c) = o; }
    LDS_WAIT(); asm volatile("" ::: "memory");
}
template <int NR> __device__ __forceinline__ void row_prep(const float* xrow, const float* gain, bf16_t* orow, float* rstd_out, int lane) {
    f32x4 v[NR][4]; float s[NR];
#pragma unroll
    for (int r = 0; r < NR; ++r)
#pragma unroll
        for (int j = 0; j < 4; ++j) v[r][j] = *((const GAS f32x4*)(xrow + (size_t)r * 1024) + lane + 64 * j);
#pragma unroll
    for (int r = 0; r < NR; ++r) { float a = 0.f;
#pragma unroll
        for (int j = 0; j < 4; ++j) a += (v[r][j].x * v[r][j].x + v[r][j].y * v[r][j].y) + (v[r][j].z * v[r][j].z + v[r][j].w * v[r][j].w);
        s[r] = a; }
#pragma unroll
    for (int r = 0; r < NR; ++r) { const float rstd = rsqrtf(wave_sum(s[r]) * (1.f / 1024.f) + EPS);
        if (rstd_out && lane == 0) rstd_out[r] = rstd;
        GAS unsigned long long* o8 = (GAS unsigned long long*)(orow + (size_t)r * 1024) + lane;
#pragma unroll
        for (int j = 0; j < 4; ++j) { f32x4 a = v[r][j];
            if (gain) { const f32x4 gg = *((const GAS f32x4*)gain + lane + 64 * j); a = a * gg * rstd; } else a = a * rstd;
            o8[64 * j] = (unsigned long long)pk2(a.x, a.y) | ((unsigned long long)pk2(a.z, a.w) << 32); } }
}
__device__ __forceinline__ void cvt_w8(const bf16_t* src, unsigned char* dst, int n16, unsigned amax_bits, int gtid, int nthr) {
    const float sc = pg8::w8_scale(amax_bits);
    for (int i = gtid; i < n16; i += nthr) { const v4u a = *((const GAS v4u*)src + 2 * i), b = *((const GAS v4u*)src + 2 * i + 1); v4u o;
        o.x = pg8::pack4_fp8(pg8::lo_bf(a.x) * sc, pg8::hi_bf(a.x) * sc, pg8::lo_bf(a.y) * sc, pg8::hi_bf(a.y) * sc); o.y = pg8::pack4_fp8(pg8::lo_bf(a.z) * sc, pg8::hi_bf(a.z) * sc, pg8::lo_bf(a.w) * sc, pg8::hi_bf(a.w) * sc);
        o.z = pg8::pack4_fp8(pg8::lo_bf(b.x) * sc, pg8::hi_bf(b.x) * sc, pg8::lo_bf(b.y) * sc, pg8::hi_bf(b.y) * sc); o.w = pg8::pack4_fp8(pg8::lo_bf(b.z) * sc, pg8::hi_bf(b.z) * sc, pg8::lo_bf(b.w) * sc, pg8::hi_bf(b.w) * sc);
        *((GAS v4u*)dst + i) = o; }
}
__device__ __forceinline__ void cvt_wout8(const bf16_t* src, unsigned char* dst, unsigned amax_bits, int gtid, int nthr) {
    const float sW = pg8::w8_scale(amax_bits), S = sW * OLAT_SCALE;
    for (int i = gtid; i < 1024 * 96; i += nthr) { const int n = i / 96, c = i - n * 96;
        const v4u a = *((const GAS v4u*)(src + (size_t)n * MIXK + 16 * c)), b = *((const GAS v4u*)(src + (size_t)n * MIXK + 16 * c) + 1);
        if (c < 32) { v4u o, o2;
            o.x = pg8::cvt_pk_bf16(pg8::lo_bf(a.x) * S, pg8::hi_bf(a.x) * S); o.y = pg8::cvt_pk_bf16(pg8::lo_bf(a.y) * S, pg8::hi_bf(a.y) * S); o.z = pg8::cvt_pk_bf16(pg8::lo_bf(a.z) * S, pg8::hi_bf(a.z) * S); o.w = pg8::cvt_pk_bf16(pg8::lo_bf(a.w) * S, pg8::hi_bf(a.w) * S);
            o2.x = pg8::cvt_pk_bf16(pg8::lo_bf(b.x) * S, pg8::hi_bf(b.x) * S); o2.y = pg8::cvt_pk_bf16(pg8::lo_bf(b.y) * S, pg8::hi_bf(b.y) * S); o2.z = pg8::cvt_pk_bf16(pg8::lo_bf(b.z) * S, pg8::hi_bf(b.z) * S); o2.w = pg8::cvt_pk_bf16(pg8::lo_bf(b.w) * S, pg8::hi_bf(b.w) * S);
            GAS v4u* d = (GAS v4u*)(dst + (size_t)n * MIXB + 32 * c); d[0] = o; d[1] = o2; }
        else { v4u o;
            o.x = pg8::pack4_fp8(pg8::lo_bf(a.x) * sW, pg8::hi_bf(a.x) * sW, pg8::lo_bf(a.y) * sW, pg8::hi_bf(a.y) * sW); o.y = pg8::pack4_fp8(pg8::lo_bf(a.z) * sW, pg8::hi_bf(a.z) * sW, pg8::lo_bf(a.w) * sW, pg8::hi_bf(a.w) * sW);
            o.z = pg8::pack4_fp8(pg8::lo_bf(b.x) * sW, pg8::hi_bf(b.x) * sW, pg8::lo_bf(b.y) * sW, pg8::hi_bf(b.y) * sW); o.w = pg8::pack4_fp8(pg8::lo_bf(b.z) * sW, pg8::hi_bf(b.z) * sW, pg8::lo_bf(b.w) * sW, pg8::hi_bf(b.w) * sW);
            *(GAS v4u*)(dst + (size_t)n * MIXB + 1024 + 16 * (c - 32)) = o; } }
}
namespace dsa {
typedef short bf16x8 __attribute__((ext_vector_type(8)));
typedef short s16x4 __attribute__((ext_vector_type(4)));
typedef float f32x16 __attribute__((ext_vector_type(16)));
typedef float f32x4 __attribute__((ext_vector_type(4)));
typedef unsigned u32x4 __attribute__((ext_vector_type(4)));
typedef unsigned short u16x4 __attribute__((ext_vector_type(4)));
constexpr int HIST_OFF = 145152;
constexpr int SC_OFF = 0, LIST_OFF = 132096, BIAS_OFF = 140288, W_OFF = 144416, NSEL_OFF = 144928, BMAX_OFF = 144992, CMAX_OFF = 145024;
__device__ __forceinline__ int xsw(int rr) { return rr < 8 ? 2 * rr : 2 * ((rr + 4) & 7) + 1; }
typedef float cvf32x2_t __attribute__((ext_vector_type(2))); typedef __bf16 cvbf16x2_t __attribute__((ext_vector_type(2)));
__device__ __forceinline__ unsigned cvtpk(float lo, float hi) { cvf32x2_t v = {lo, hi}; return __builtin_bit_cast(unsigned, __builtin_convertvector(v, cvbf16x2_t)); }
__device__ __forceinline__ int mbcnt64(unsigned long long m) { return (int)__builtin_amdgcn_mbcnt_hi((unsigned)(m >> 32), __builtin_amdgcn_mbcnt_lo((unsigned)m, 0u)); }

__device__ __forceinline__ void phase_init(LAS unsigned char* lds, const float* biastab, const float* kvg, int tid) {
    LAS float* bt = (LAS float*)(lds + BIAS_OFF);
    for (int i = tid; i < 129 * 8; i += 512) bt[i] = biastab[i];
    if (tid < 64) { float m = fmaxf(fabsf(kvg[tid]), fabsf(kvg[tid + 64]));
#pragma unroll
        for (int o = 1; o < 64; o <<= 1) m = fmaxf(m, __shfl_xor(m, o));
        if (tid == 0) *(LAS float*)(lds + CMAX_OFF) = m * 11.313708499f * 1.01f; }
    __syncthreads();
    if (tid < 8) { float m = -1e30f; for (int d = 0; d < 129; ++d) m = fmaxf(m, bt[d * 8 + tid]); ((LAS float*)(lds + BMAX_OFF))[tid] = m; }
    __syncthreads();
}

__device__ __forceinline__ void scores(LAS unsigned char* lds, int b, int q0, const bf16_t* qabs, const bf16_t* kidx, int wave, int lane) {
    const int hi = lane >> 5, c32 = lane & 31;
    const int a_ = c32 >> 3, hp = (c32 >> 2) & 1, r3 = c32 & 3;
    const int head = 4 * (a_ & 1) + r3, qt = 2 * hp + (a_ >> 1);
    bf16x8 A[4][4];
#pragma unroll
    for (int rt = 0; rt < 4; ++rt)
#pragma unroll
        for (int s = 0; s < 4; ++s) A[rt][s] = *(const bf16x8*)(qabs + (size_t)(b * 2048 + q0 + 4 * rt + qt) * 1536 + 1024 + s * 128 + head * 16 + 8 * hi);
    const int nkt = (q0 + 16 + 31) >> 5;
    LAS float* SC = (LAS float*)(lds + SC_OFF); const LAS float* Wl = (const LAS float*)(lds + W_OFF);
    bf16x8 Bn[4];
    { const bf16_t* kr = kidx + (size_t)(b * 2048 + (wave < nkt ? wave : 0) * 32 + c32) * 64 + 8 * hi;
#pragma unroll
      for (int s = 0; s < 4; ++s) Bn[s] = *(const bf16x8*)(kr + 16 * s); }
    __syncthreads();
    for (int kt = wave; kt < nkt; kt += 8) {
        bf16x8 B[4];
#pragma unroll
        for (int s = 0; s < 4; ++s) B[s] = Bn[s];
        if (kt + 8 < nkt) { const bf16_t* kr = kidx + (size_t)(b * 2048 + (kt + 8) * 32 + c32) * 64 + 8 * hi;
#pragma unroll
            for (int s = 0; s < 4; ++s) Bn[s] = *(const bf16x8*)(kr + 16 * s); }
        const int key = kt * 32 + c32;
        f32x16 acc[4];
#pragma unroll
        for (int rt = 0; rt < 4; ++rt) acc[rt] = (f32x16){0.f, 0.f, 0.f, 0.f, 0.f, 0.f, 0.f, 0.f, 0.f, 0.f, 0.f, 0.f, 0.f, 0.f, 0.f, 0.f};
#pragma unroll
        for (int s = 0; s < 4; ++s)
#pragma unroll
            for (int rt = 0; rt < 4; ++rt) acc[rt] = __builtin_amdgcn_mfma_f32_32x32x16_bf16(A[rt][s], B[s], acc[rt], 0, 0, 0);
        f32x4 wv[4][4];
#pragma unroll
        for (int rt = 0; rt < 4; ++rt) { const LAS f32x4* wp = (const LAS f32x4*)(Wl + (4 * rt + 2 * hi) * 8);
#pragma unroll
            for (int q = 0; q < 4; ++q) wv[rt][q] = wp[q]; }
#pragma unroll
        for (int rt = 0; rt < 4; ++rt) {
            const f32x4 w0 = wv[rt][0], w1 = wv[rt][1], w2 = wv[rt][2], w3 = wv[rt][3]; const f32x16 a = acc[rt];
            float s0 = w0.x * fmaxf(a[0], 0.f); s0 += w0.y * fmaxf(a[1], 0.f); s0 += w0.z * fmaxf(a[2], 0.f); s0 += w0.w * fmaxf(a[3], 0.f);
            s0 += w1.x * fmaxf(a[4], 0.f); s0 += w1.y * fmaxf(a[5], 0.f); s0 += w1.z * fmaxf(a[6], 0.f); s0 += w1.w * fmaxf(a[7], 0.f);
            float s1 = w2.x * fmaxf(a[8], 0.f); s1 += w2.y * fmaxf(a[9], 0.f); s1 += w2.z * fmaxf(a[10], 0.f); s1 += w2.w * fmaxf(a[11], 0.f);
            s1 += w3.x * fmaxf(a[12], 0.f); s1 += w3.y * fmaxf(a[13], 0.f); s1 += w3.z * fmaxf(a[14], 0.f); s1 += w3.w * fmaxf(a[15], 0.f);
            const int ql = 4 * rt + 2 * hi, t0 = q0 + ql;
            SC[ql * 2048 + key] = key <= t0 ? s0 : -INFINITY; SC[(ql + 1) * 2048 + key] = key <= t0 + 1 ? s1 : -INFINITY;
        }
    }
}
__device__ __forceinline__ void topk(LAS unsigned char* lds, int q0, int qq, int lane) {
    const int t = q0 + qq, n = t + 1;
    LAS unsigned short* list = (LAS unsigned short*)(lds + LIST_OFF) + qq * 256; LAS int* nsel = (LAS int*)(lds + NSEL_OFF);
    if (n <= 256) { for (int i = lane; i < 256; i += 64) list[i] = (unsigned short)(i < n ? i : t); if (lane == 0) nsel[qq] = n; return; }
    const int nk = ((q0 + 16 + 31) >> 5) * 32;
    const LAS float* SC = (const LAS float*)(lds + SC_OFF) + qq * 2048;
    unsigned u[32];
#pragma unroll
    for (int j = 0; j < 32; ++j) { const int key = lane + 64 * j; unsigned v = 0u; if (key < nk) { const unsigned bts = __float_as_uint(SC[key]); v = (bts & 0x80000000u) ? ~bts : (bts | 0x80000000u); } u[j] = v; }
    unsigned tau = 0u;
    for (int bit = 31; bit >= 0; --bit) {
        const unsigned cand = tau | (1u << bit); int cnt = 0;
#pragma unroll
        for (int j = 0; j < 32; ++j) cnt += __popcll(__ballot(u[j] >= cand));
        if (cnt >= 256) tau = cand;
        if (cnt == 256) break;
    }
    int cgt = 0;
#pragma unroll
    for (int j = 0; j < 32; ++j) cgt += __popcll(__ballot(u[j] > tau));
    const int r = 256 - cgt; int base = 0, eqb = 0;
#pragma unroll
    for (int j = 0; j < 32; ++j) {
        const bool gt = u[j] > tau, eq = u[j] == tau; const unsigned long long em = __ballot(eq);
        const bool sel = gt || (eq && (eqb + mbcnt64(em)) < r); const unsigned long long sm = __ballot(sel);
        if (sel) list[base + mbcnt64(sm)] = (unsigned short)(lane + 64 * j);
        base += __popcll(sm); eqb += __popcll(em);
    }
    if (lane == 0) nsel[qq] = 256;
}
__device__ __forceinline__ int wave_scan_incl(int x) {
    x += __builtin_amdgcn_update_dpp(0, x, 0x111, 0xF, 0xF, true);
    x += __builtin_amdgcn_update_dpp(0, x, 0x112, 0xF, 0xF, true);
    x += __builtin_amdgcn_update_dpp(0, x, 0x114, 0xF, 0xF, true);
    x += __builtin_amdgcn_update_dpp(0, x, 0x118, 0xF, 0xF, true);
    x += __builtin_amdgcn_update_dpp(0, x, 0x142, 0xA, 0xF, false);
    x += __builtin_amdgcn_update_dpp(0, x, 0x143, 0xC, 0xF, false);
    return x;
}
#define DPP_F32(v, CTRL) __int_as_float(__builtin_amdgcn_update_dpp(0, __float_as_int(v), (CTRL), 0xF, 0xF, true))
__device__ __forceinline__ float wave_max(float v) {
    v = fmaxf(v, DPP_F32(v, 0xB1)); v = fmaxf(v, DPP_F32(v, 0x4E)); v = fmaxf(v, DPP_F32(v, 0x141)); v = fmaxf(v, DPP_F32(v, 0x140));
    const int b = __float_as_int(v);
    return fmaxf(fmaxf(__int_as_float(__builtin_amdgcn_readlane(b, 0)), __int_as_float(__builtin_amdgcn_readlane(b, 16))), fmaxf(__int_as_float(__builtin_amdgcn_readlane(b, 32)), __int_as_float(__builtin_amdgcn_readlane(b, 48))));
}
__device__ __forceinline__ float wave_min(float v) {
    v = fminf(v, DPP_F32(v, 0xB1)); v = fminf(v, DPP_F32(v, 0x4E)); v = fminf(v, DPP_F32(v, 0x141)); v = fminf(v, DPP_F32(v, 0x140));
    const int b = __float_as_int(v);
    return fminf(fminf(__int_as_float(__builtin_amdgcn_readlane(b, 0)), __int_as_float(__builtin_amdgcn_readlane(b, 16))), fminf(__int_as_float(__builtin_amdgcn_readlane(b, 32)), __int_as_float(__builtin_amdgcn_readlane(b, 48))));
}
__device__ __forceinline__ void topk3(LAS unsigned char* lds, int q0, int qq, int wave, int lane, unsigned* dbg_flag_g = nullptr) {
    const int t = q0 + qq, n = t + 1;
    LAS unsigned short* list = (LAS unsigned short*)(lds + LIST_OFF) + qq * 256; LAS int* nsel = (LAS int*)(lds + NSEL_OFF);
    if (n <= 256) { for (int i = lane; i < 256; i += 64) list[i] = (unsigned short)(i < n ? i : t); if (lane == 0) nsel[qq] = n; return; }
    const int nk = ((q0 + 16 + 31) >> 5) * 32;
    LAS float* SC = (LAS float*)(lds + SC_OFF) + qq * 2048;
    LAS unsigned char* H = (LAS unsigned char*)SC;
    float v[32]; float hi = -INFINITY;
#pragma unroll
    for (int j = 0; j < 8; ++j) { f32x4 x = {-INFINITY, -INFINITY, -INFINITY, -INFINITY}; if (256 * j + 4 * lane < nk) x = *(const LAS f32x4*)(SC + 256 * j + 4 * lane);
#pragma unroll
        for (int e = 0; e < 4; ++e) { v[4 * j + e] = x[e]; hi = fmaxf(hi, x[e]); } }
    const float lo = wave_min(fminf(fminf(v[0], v[1]), fminf(v[2], v[3])));
    hi = wave_max(hi);
    const float sc = 8191.f / (hi - lo), off = __builtin_fmaf(-lo, sc, 0.25f);
    bool ok = (hi - lo) > 1e-30f && __builtin_fmaf(hi, sc, off) < 8191.9f && __builtin_fmaf(hi, sc, off) > 8190.f;
    unsigned B4 = 0u; int need2 = 0, ncand = 0;
    if (ok) {
        asm volatile("" ::: "memory");
        const u32x4 z4 = {0u, 0u, 0u, 0u};
#pragma unroll
        for (int j = 0; j < 8; ++j) *(LAS u32x4*)(H + 1024 * j + 16 * lane) = z4;
        asm volatile("" ::: "memory");
#pragma unroll
        for (int j = 0; j < 8; ++j) if (256 * j < nk) {
#pragma unroll
            for (int e = 0; e < 4; ++e) { const unsigned b = (unsigned)__builtin_fmaf(v[4 * j + e], sc, off); (void)__hip_atomic_fetch_add((LAS unsigned*)(H + (b & 0x1FFCu)), 1u, __ATOMIC_RELAXED, __HIP_MEMORY_SCOPE_WORKGROUP); } }
        asm volatile("" ::: "memory");
        const unsigned x4 = 4u * (unsigned)(lane & 31), hb = 128u * (unsigned)lane; int c[32];
#pragma unroll
        for (int k = 0; k < 32; ++k) c[k] = *(const LAS int*)(H + hb + (x4 ^ (4u * k)));
        __builtin_amdgcn_sched_barrier(0);
        int s = 0;
#pragma unroll
        for (int k = 0; k < 32; ++k) s += c[k];
        const int incl = wave_scan_incl(s), tot = __builtin_amdgcn_readlane(incl, 63), suf = tot - incl + s;
        const unsigned long long m = __ballot(suf >= 256); const int L = 63 - __builtin_clzll(m);
        const int aboveL = (L < 63) ? __builtin_amdgcn_readlane(suf, (L + 1) & 63) : 0; const int need1 = 256 - aboveL;
        const int cj = lane < 32 ? *(const LAS int*)(H + 128 * L + 4 * lane) : 0;
        const int incl2 = wave_scan_incl(cj), tot2 = __builtin_amdgcn_readlane(incl2, 63), suf2 = tot2 - incl2 + cj;
        const unsigned long long m2 = __ballot(lane < 32 && suf2 >= need1); const int J = 63 - __builtin_clzll(m2);
        const int above2 = (J < 31) ? __builtin_amdgcn_readlane(suf2, (J + 1) & 63) : 0; need2 = need1 - above2; ncand = __builtin_amdgcn_readlane(cj, J);
        B4 = (unsigned)(32 * L + J) * 4u;
        ok = (m != 0ull) && (m2 != 0ull) && (B4 > 0u) && (ncand <= 64);
    }
#ifdef DSA_FALLBACK_COUNT
    if (!ok && lane == 0) atomicAdd(dbg_flag_g + 64, 1u);
#endif
    if (!ok) {
        asm volatile("" ::: "memory");
#pragma unroll
        for (int j = 0; j < 8; ++j) if (256 * j + 4 * lane < nk) *(LAS f32x4*)(SC + 256 * j + 4 * lane) = (f32x4){v[4 * j], v[4 * j + 1], v[4 * j + 2], v[4 * j + 3]};
        asm volatile("" ::: "memory");
        topk(lds, q0, qq, lane); return; }
    LAS float* cv = (LAS float*)list; LAS unsigned short* ck = list + 128;
    int base = 0;
#pragma unroll
    for (int j = 0; j < 8; ++j) if (256 * j < nk) {
        bool isc[4];
#pragma unroll
        for (int e = 0; e < 4; ++e) { const unsigned b = (unsigned)__builtin_fmaf(v[4 * j + e], sc, off); isc[e] = (b & 0x1FFCu) == B4; }
        if (__ballot(isc[0] || isc[1] || isc[2] || isc[3])) {
#pragma unroll
            for (int e = 0; e < 4; ++e) { const unsigned long long cm = __ballot(isc[e]);
                if (isc[e]) { const int pos = base + mbcnt64(cm); cv[pos] = v[4 * j + e]; ck[pos] = (unsigned short)(256 * j + 4 * lane + e); } base += __popcll(cm); } } }
    const float myv = lane < ncand ? cv[lane] : -INFINITY; const int myk = lane < ncand ? (int)ck[lane] : 0x7fffffff; int rank = 0;
    for (int k = 0; k < ncand; ++k) { const float vk = __int_as_float(__builtin_amdgcn_readlane(__float_as_int(myv), k)); const int kk = __builtin_amdgcn_readlane(myk, k); rank += (vk > myv || (vk == myv && kk < myk)) ? 1 : 0; }
    const unsigned long long lm = __ballot(lane < ncand && rank == need2 - 1); const int ll = (int)__builtin_ctzll(lm);
    const float tauv = __int_as_float(__builtin_amdgcn_readlane(__float_as_int(myv), ll)); const int tauk = __builtin_amdgcn_readlane(myk, ll);
    int ngt = 0;
    LAS unsigned short* const dp = (LAS unsigned short*)(lds + HIST_OFF) + wave * 64 + lane;
#pragma unroll
    for (int j = 0; j < 8; ++j) if (256 * j < nk) {
        bool sel[4]; int c = 0;
#pragma unroll
        for (int e = 0; e < 4; ++e) { sel[e] = v[4 * j + e] > tauv; c += sel[e] ? 1 : 0; }
        const int incl3 = wave_scan_incl(c);
        LAS unsigned short* lp = list + ngt + (incl3 - c);
#pragma unroll
        for (int e = 0; e < 4; ++e) { LAS unsigned short* p = sel[e] ? lp : dp; *p = (unsigned short)(256 * j + 4 * lane + e); lp += sel[e] ? 1 : 0; }
        ngt += __builtin_amdgcn_readlane(incl3, 63); }
    const bool csel = lane < ncand && myv == tauv && myk <= tauk; const unsigned long long sm = __ballot(csel);
    if (csel) list[ngt + mbcnt64(sm)] = (unsigned short)myk;
    if (lane == 0) nsel[qq] = 256;
#ifdef DSA_S2_RESTORE
    asm volatile("" ::: "memory");
#pragma unroll
    for (int j = 0; j < 8; ++j) if (256 * j + 4 * lane < nk) *(LAS f32x4*)(SC + 256 * j + 4 * lane) = (f32x4){v[4 * j], v[4 * j + 1], v[4 * j + 2], v[4 * j + 3]};
    asm volatile("" ::: "memory");
#endif
}
__device__ __forceinline__ void attend2(LAS unsigned char* lds, int b, int q0, int wave, int lane, const bf16_t* qabs, const bf16_t* ckv, unsigned char* mix) {
    const int r16 = lane & 15, g = lane >> 4;
    LAS unsigned char* buf0 = lds + wave * 16384; LAS unsigned char* buf1 = buf0 + 8192;
    const LAS unsigned short* listw = (const LAS unsigned short*)(lds + LIST_OFF) + (2 * wave) * 256;
    const LAS float* biasT = (const LAS float*)(lds + BIAS_OFF);
    const int n0 = ((const LAS int*)(lds + NSEL_OFF))[2 * wave], n1 = ((const LAS int*)(lds + NSEL_OFF))[2 * wave + 1];
    const int ns0 = (n0 + 31) >> 5, total = ns0 + ((n1 + 31) >> 5);
    const float cmax = *(const LAS float*)(lds + CMAX_OFF), bmax = ((const LAS float*)(lds + BMAX_OFF))[r16 & 7];
    const int xr = xsw(r16);
    const int q4 = r16 >> 2, p4 = r16 & 3; const int rra = 4 * g + q4, rrb = 16 + 4 * g + q4; const int xa = xsw(rra & 15), xb = xsw(rrb & 15);
    int t = 0, n = 0; size_t row = 0; const LAS unsigned short* list = listw; bf16x8 QB[4]; float Mh = 0.f, lsum = 0.f; f32x4 O[8];
    u32x4 X[8], Y[8];
#define DSA_LOAD(ST, kk) do { if ((kk) < total) { const int sel_ = (kk) >= ns0 ? 1 : 0; const LAS unsigned short* lp_ = listw + sel_ * 256 + ((kk) - (sel_ ? ns0 : 0)) * 32; \
        _Pragma("unroll") for (int i_ = 0; i_ < 8; ++i_) { const int rr_ = 4 * i_ + g; const int idx_ = lp_[rr_]; ST[i_] = *(const u32x4*)(ckv + ((size_t)b * 2048 + idx_) * 128 + (r16 ^ xsw(rr_ & 15)) * 8); } } } while (0)
#define DSA_WRITE(ST, bufp) do { _Pragma("unroll") for (int i_ = 0; i_ < 8; ++i_) *(LAS u32x4*)((bufp) + (4 * i_ + g) * 256 + r16 * 16) = ST[i_]; } while (0)
#define DSA_INIT(qq_) do { t = q0 + (qq_); row = (size_t)b * 2048 + t; n = ((qq_) & 1) ? n1 : n0; list = listw + ((qq_) & 1) * 256; float qn2_ = 0.f; \
        _Pragma("unroll") for (int s_ = 0; s_ < 4; ++s_) { bf16x8 v_ = {0, 0, 0, 0, 0, 0, 0, 0}; if (r16 < 8) v_ = *(const bf16x8*)(qabs + row * 1536 + s_ * 256 + r16 * 32 + 8 * g); QB[s_] = v_; \
            _Pragma("unroll") for (int e_ = 0; e_ < 8; ++e_) { const float f_ = bf2f((bf16_t)v_[e_]); qn2_ += f_ * f_; } } \
        qn2_ += __shfl_xor(qn2_, 16); qn2_ += __shfl_xor(qn2_, 32); Mh = sqrtf(qn2_) * cmax + bmax; lsum = 0.f; \
        _Pragma("unroll") for (int dt_ = 0; dt_ < 8; ++dt_) O[dt_] = (f32x4){0.f, 0.f, 0.f, 0.f}; } while (0)
#define DSA_FINAL() do { float l_ = lsum; l_ += __shfl_xor(l_, 16); l_ += __shfl_xor(l_, 32); const float linv_ = OLAT_SCALE / l_; \
        _Pragma("unroll") for (int e_ = 0; e_ < 4; ++e_) { const int hrow_ = (4 * g + e_) & 7; const float inv_ = __shfl(linv_, hrow_); \
            if (g < 2) { _Pragma("unroll") for (int dt_ = 0; dt_ < 8; ++dt_) { const float ov_ = __builtin_amdgcn_fmed3f(O[dt_][e_] * inv_, -448.f, 448.f); \
                mix[row * MIXB + 1024 + hrow_ * 128 + 16 * dt_ + r16] = (unsigned char)__builtin_amdgcn_cvt_pk_fp8_f32(ov_, ov_, 0, false); } } } } while (0)
#define DSA_COMPUTE(kk, buf) do { if ((kk) == ns0) { DSA_FINAL(); DSA_INIT(2 * wave + 1); } const int step = (kk) >= ns0 ? (kk) - ns0 : (kk); \
          \
        bf16x8 af_[2][4]; \
        _Pragma("unroll") for (int G = 0; G < 2; ++G) _Pragma("unroll") for (int s = 0; s < 4; ++s) af_[G][s] = *(const LAS bf16x8*)((buf) + (16 * G + r16) * 256 + (((4 * s + g) ^ xr) * 16)); \
        const int pb0_ = step * 32 + 4 * g; const u16x4 ida_ = *(const LAS u16x4*)(list + pb0_), idb_ = *(const LAS u16x4*)(list + pb0_ + 16); \
        s16x4 tlo_[8], thi_[8]; \
        _Pragma("unroll") for (int dt = 0; dt < 8; ++dt) { const int ch = 2 * dt + (p4 >> 1); \
            tlo_[dt] = __builtin_bit_cast(s16x4, __builtin_amdgcn_ds_read_tr16_b64_v4i16((LAS s16x4*)((buf) + rra * 256 + ((ch ^ xa) * 16) + 8 * (p4 & 1)))); \
            thi_[dt] = __builtin_bit_cast(s16x4, __builtin_amdgcn_ds_read_tr16_b64_v4i16((LAS s16x4*)((buf) + rrb * 256 + ((ch ^ xb) * 16) + 8 * (p4 & 1)))); } \
        float bz_[2][4]; \
        _Pragma("unroll") for (int e = 0; e < 4; ++e) { int d0_ = t - (int)ida_[e]; d0_ = d0_ < 128 ? d0_ : 128; d0_ = d0_ < 0 ? 0 : d0_; int d1_ = t - (int)idb_[e]; d1_ = d1_ < 128 ? d1_ : 128; d1_ = d1_ < 0 ? 0 : d1_; \
            bz_[0][e] = biasT[d0_ * 8 + (r16 & 7)]; bz_[1][e] = biasT[d1_ * 8 + (r16 & 7)]; } \
        f32x4 S_[2]; \
        _Pragma("unroll") for (int G = 0; G < 2; ++G) { f32x4 acc = {0.f, 0.f, 0.f, 0.f}; \
            _Pragma("unroll") for (int s = 0; s < 4; ++s) acc = __builtin_amdgcn_mfma_f32_16x16x32_bf16(af_[G][s], QB[s], acc, 0, 0, 0); \
            S_[G] = acc; } \
        float P_[2][4]; \
        _Pragma("unroll") for (int G = 0; G < 2; ++G) _Pragma("unroll") for (int e = 0; e < 4; ++e) { const float lg = S_[G][e] + bz_[G][e] - Mh; \
                const float pv = (pb0_ + 16 * G + e < n) ? __builtin_amdgcn_exp2f(lg) : 0.f; lsum += pv; P_[G][e] = pv; } \
        u32x4 pw; pw.x = cvtpk(P_[0][0], P_[0][1]); pw.y = cvtpk(P_[0][2], P_[0][3]); pw.z = cvtpk(P_[1][0], P_[1][1]); pw.w = cvtpk(P_[1][2], P_[1][3]); \
        const bf16x8 PA = __builtin_bit_cast(bf16x8, pw); \
        _Pragma("unroll") for (int dt = 0; dt < 8; ++dt) { const bf16x8 vb = {tlo_[dt][0], tlo_[dt][1], tlo_[dt][2], tlo_[dt][3], thi_[dt][0], thi_[dt][1], thi_[dt][2], thi_[dt][3]}; \
            O[dt] = __builtin_amdgcn_mfma_f32_16x16x32_bf16(PA, vb, O[dt], 0, 0, 0); } } while (0)
    DSA_LOAD(X, 0); DSA_LOAD(Y, 1);
    __syncthreads();
    DSA_INIT(2 * wave);
    DSA_WRITE(X, buf0); DSA_LOAD(X, 2);
    if (1 < total) { DSA_WRITE(Y, buf1); DSA_LOAD(Y, 3); }
    for (int k = 0; k < total; k += 2) {
        DSA_COMPUTE(k, buf0);
        if (k + 2 < total) { DSA_WRITE(X, buf0); DSA_LOAD(X, k + 4); }
        if (k + 1 < total) { DSA_COMPUTE(k + 1, buf1); if (k + 3 < total) { DSA_WRITE(Y, buf1); DSA_LOAD(Y, k + 5); } }
    }
    DSA_FINAL();
#undef DSA_LOAD
#undef DSA_WRITE
#undef DSA_INIT
#undef DSA_FINAL
#undef DSA_COMPUTE
}
__device__ __forceinline__ void unit(LAS unsigned char* lds, int b, int q0, int tid, int wave, int lane, const bf16_t* qabs, const bf16_t* ckv, const bf16_t* kidx, const float* widx, unsigned char* mix, unsigned* dbg_flag) {
    asm volatile("" : "+v"(tid));
    lane = tid & 63;
    if (tid < 128) ((LAS float*)(lds + W_OFF))[tid] = widx[(size_t)(b * 2048 + q0) * 8 + tid];
#ifndef DSA_REP_S1
#define DSA_REP_S1 1
#define DSA_REP_S2 1
#define DSA_REP_S3 1
#endif
    if (q0 + 16 > 256) { for (int rp = 0; rp < DSA_REP_S1; ++rp) { scores(lds, b, q0, qabs, kidx, wave, lane); __syncthreads(); } }
    else __syncthreads();
    asm volatile("" : "+v"(tid)); lane = tid & 63;
#ifdef DSA_TOPK_CHECK
    for (int e2 = 0; e2 < 2; ++e2) { const int qq = 2 * wave + e2;
        topk(lds, q0, qq, lane); const LAS unsigned short* lw = (const LAS unsigned short*)(lds + LIST_OFF) + qq * 256; const int ns = ((const LAS int*)(lds + NSEL_OFF))[qq];
        unsigned h1 = 0, h2 = 0; for (int i = lane; i < ns; i += 64) { const unsigned x = lw[i]; h1 += x; h2 += x * x; }
        topk3(lds, q0, qq, wave, lane); const int ns2 = ((const LAS int*)(lds + NSEL_OFF))[qq];
        unsigned g1 = 0, g2 = 0; for (int i = lane; i < ns2; i += 64) { const unsigned x = lw[i]; g1 += x; g2 += x * x; }
#pragma unroll
        for (int o = 1; o < 64; o <<= 1) { h1 += __shfl_xor(h1, o); h2 += __shfl_xor(h2, o); g1 += __shfl_xor(g1, o); g2 += __shfl_xor(g2, o); }
        if (lane == 0 && (h1 != g1 || h2 != g2 || ns != ns2)) atomicAdd(dbg_flag, 1u); }
#else
    for (int rp = 0; rp < DSA_REP_S2; ++rp) { topk3(lds, q0, 2 * wave, wave, lane, dbg_flag); topk3(lds, q0, 2 * wave + 1, wave, lane, dbg_flag); }
#endif
    asm volatile("" : "+v"(tid)); lane = tid & 63;
    for (int rp = 0; rp < DSA_REP_S3; ++rp) { attend2(lds, b, q0, wave, lane, qabs, ckv, mix); __syncthreads(); }
}
}
#ifndef DN_REP_E
#define DN_REP_E 1
#define DN_REP_T 1
#endif
namespace dn {
typedef short bf16x8 __attribute__((ext_vector_type(8)));
typedef short s16x4 __attribute__((ext_vector_type(4)));
typedef float f32x4 __attribute__((ext_vector_type(4)));
typedef float f32x2 __attribute__((ext_vector_type(2)));
typedef unsigned u32x4 __attribute__((ext_vector_type(4)));
typedef unsigned u32x2 __attribute__((ext_vector_type(2)));
constexpr int CWL = 132096;
constexpr int QS = 0, KS = 17408, WB = 17408, KGT = 34816, VBT = 52224, KBT = 69632, LF = 87040, TB = 103680, XF = 112896, OF = 87040, QKB = 120832, GC = 130048, BT = 130304;
constexpr int QSTR = 272, TSTR = 136, LSTR = 65, TBSTR = 144, OSTR = 132;
typedef float cvf32x2_t __attribute__((ext_vector_type(2))); typedef __bf16 cvbf16x2_t __attribute__((ext_vector_type(2)));
__device__ __forceinline__ unsigned cvtpk(float lo, float hi) { cvf32x2_t v = {lo, hi}; return __builtin_bit_cast(unsigned, __builtin_convertvector(v, cvbf16x2_t)); }
__device__ __forceinline__ bf16x8 pack2(const f32x4& a, const f32x4& b) { u32x4 w; w.x = cvtpk(a[0], a[1]); w.y = cvtpk(a[2], a[3]); w.z = cvtpk(b[0], b[1]); w.w = cvtpk(b[2], b[3]); return __builtin_bit_cast(bf16x8, w); }
__device__ __forceinline__ bf16x8 frag_perm(const LAS unsigned char* rowp, int s, int g) {
    const u32x2 lo = *(const LAS u32x2*)(rowp + (32 * s + 4 * g) * 2), hi = *(const LAS u32x2*)(rowp + (32 * s + 16 + 4 * g) * 2);
    u32x4 w; w.x = lo.x; w.y = lo.y; w.z = hi.x; w.w = hi.y; return __builtin_bit_cast(bf16x8, w); }
__device__ __forceinline__ bf16x8 frag_nat8(const LAS unsigned char* rowp, int s, int g) {
    const u32x2 lo = *(const LAS u32x2*)(rowp + (32 * s + 8 * g) * 2), hi = *(const LAS u32x2*)(rowp + (32 * s + 8 * g + 4) * 2);
    u32x4 w; w.x = lo.x; w.y = lo.y; w.z = hi.x; w.w = hi.y; return __builtin_bit_cast(bf16x8, w); }
__device__ __forceinline__ float silu(float x) { return x * __builtin_amdgcn_rcpf(1.f + __builtin_amdgcn_exp2f(-LOG2E * x)); }
__device__ __forceinline__ float ex(float x) { return __builtin_amdgcn_exp2f(LOG2E * x); }

__device__ __forceinline__ void run(LAS unsigned char* lds0, int b, int h, const bf16_t* proj, const float* conv_w, const float* beta, const float* gdec, const float* gn, unsigned char* mix, int tid, int wave, int lane) {
    const int r16c = lane & 15, gc = lane >> 4;
    LAS float* cwL = (LAS float*)(lds0 + CWL);
    if (wave == 0) {
#pragma unroll
        for (int p = 0; p < 3; ++p)
#pragma unroll
            for (int e = 0; e < 2; ++e)
#pragma unroll
                for (int j = 0; j < 4; ++j) cwL[((p * 2 + e) * 4 + j) * 64 + lane] = conv_w[j * 1536 + p * 512 + h * 128 + 2 * lane + e];
    }
    __syncthreads();
    const float gn0 = gn[2 * lane], gn1 = gn[2 * lane + 1];
    f32x4 S[8];
#pragma unroll
    for (int i = 0; i < 8; ++i) S[i] = (f32x4){0.f, 0.f, 0.f, 0.f};
    const bf16_t* pbase = proj + h * 128 + 2 * lane;
    unsigned xq[11][3]; float gnext, bnext;
#define DN_LOAD_CHUNK(cn) do { const size_t Rn = (size_t)b * 2048 + 64 * (cn); \
        _Pragma("unroll") for (int a = 0; a < 11; ++a) { const int tt = 64 * (cn) + 8 * wave - 3 + a; \
            _Pragma("unroll") for (int p_ = 0; p_ < 3; ++p_) xq[a][p_] = (tt >= 0) ? *(const unsigned*)(pbase + (Rn + 8 * wave - 3 + a) * PROJ + p_ * 512) : 0u; } \
        gnext = gdec[(Rn + lane) * 4 + h]; bnext = beta[(Rn + lane) * 4 + h]; } while (0)
    DN_LOAD_CHUNK(0);
    for (int c = 0; c < 32; ++c) {
        const size_t R0 = (size_t)b * 2048 + 64 * c;
        int zoff = 0; asm volatile("" : "+v"(zoff));
        LAS unsigned char* lds = lds0 + zoff; const int r16 = r16c + zoff, g = gc + zoff;
        LAS float* Lf = (LAS float*)(lds + LF); LAS float* gcumL = (LAS float*)(lds + GC); LAS float* betaL = (LAS float*)(lds + BT);
        float gcum = gnext;
#pragma unroll
        for (int o = 1; o < 64; o <<= 1) { const float t = __shfl_up(gcum, o); if (lane >= o) gcum += t; }
        const float gl = __int_as_float(__builtin_amdgcn_readlane(__float_as_int(gcum), 63));
        const float bv = bnext;
        if (wave == 0) { gcumL[lane] = gcum; betaL[lane] = bv; }
        for (int rpE = 0; rpE < DN_REP_E; ++rpE) {
            float cw[3][2][4];
#pragma unroll
            for (int p = 0; p < 3; ++p)
#pragma unroll
                for (int e = 0; e < 2; ++e)
#pragma unroll
                    for (int j = 0; j < 4; ++j) cw[p][e][j] = cwL[((p * 2 + e) * 4 + j) * 64 + lane];
            float xw[3][3][2];
#pragma unroll
            for (int a = 0; a < 3; ++a)
#pragma unroll
                for (int p = 0; p < 3; ++p) { xw[a][p][0] = __uint_as_float(xq[a][p] << 16); xw[a][p][1] = __uint_as_float(xq[a][p] & 0xffff0000u); }
#pragma unroll
            for (int i = 0; i < 8; ++i) {
                const int r = 8 * wave + i; float x0[3][2], sv[3][2];
#pragma unroll
                for (int p = 0; p < 3; ++p) { x0[p][0] = __uint_as_float(xq[3 + i][p] << 16); x0[p][1] = __uint_as_float(xq[3 + i][p] & 0xffff0000u); }
#pragma unroll
                for (int p = 0; p < 3; ++p)
#pragma unroll
                    for (int e = 0; e < 2; ++e) { const float s = cw[p][e][0] * xw[0][p][e] + cw[p][e][1] * xw[1][p][e] + cw[p][e][2] * xw[2][p][e] + cw[p][e][3] * x0[p][e]; sv[p][e] = silu(s); }
                const float rq = rsqrtf(wave_sum(sv[0][0] * sv[0][0] + sv[0][1] * sv[0][1]) + EPS) * 0.08838834764831845f;
                const float rk = rsqrtf(wave_sum(sv[1][0] * sv[1][0] + sv[1][1] * sv[1][1]) + EPS);
                const float gr = __int_as_float(__builtin_amdgcn_readlane(__float_as_int(gcum), r)), br = __int_as_float(__builtin_amdgcn_readlane(__float_as_int(bv), r));
                const float eg = ex(gr), ekl = ex(gl - gr);
                const float k0 = sv[1][0] * rk, k1 = sv[1][1] * rk;
                *(LAS unsigned*)(lds + QS + r * QSTR + 4 * lane) = cvtpk(sv[0][0] * rq, sv[0][1] * rq);
                *(LAS unsigned*)(lds + KS + r * QSTR + 4 * lane) = cvtpk(k0, k1);
                const unsigned kg = cvtpk(k0 * ekl, k1 * ekl), kb = cvtpk(k0 * br * eg, k1 * br * eg), vb = cvtpk(sv[2][0] * br, sv[2][1] * br);
                *(LAS unsigned short*)(lds + KGT + (2 * lane) * TSTR + 2 * r) = (unsigned short)kg; *(LAS unsigned short*)(lds + KGT + (2 * lane + 1) * TSTR + 2 * r) = (unsigned short)(kg >> 16);
                *(LAS unsigned short*)(lds + KBT + (2 * lane) * TSTR + 2 * r) = (unsigned short)kb; *(LAS unsigned short*)(lds + KBT + (2 * lane + 1) * TSTR + 2 * r) = (unsigned short)(kb >> 16);
                *(LAS unsigned short*)(lds + VBT + (2 * lane) * TSTR + 2 * r) = (unsigned short)vb; *(LAS unsigned short*)(lds + VBT + (2 * lane + 1) * TSTR + 2 * r) = (unsigned short)(vb >> 16);
#pragma unroll
                for (int p = 0; p < 3; ++p)
#pragma unroll
                    for (int e = 0; e < 2; ++e) { xw[0][p][e] = xw[1][p][e]; xw[1][p][e] = xw[2][p][e]; xw[2][p][e] = x0[p][e]; }
            }
        }
        __syncthreads();
        for (int rpT = 0; rpT < DN_REP_T; ++rpT) {
        {
            const int ti = wave & 3, sel = wave >> 2;
            const LAS unsigned char* Ab = lds + (sel ? QS : KS) + (16 * ti + r16) * QSTR;
            bf16x8 A[4];
#pragma unroll
            for (int s = 0; s < 4; ++s) A[s] = *(const LAS bf16x8*)(Ab + (32 * s + 8 * g) * 2);
            const f32x4 gi4 = *(const LAS f32x4*)(gcumL + 16 * ti + 4 * g), bi4 = *(const LAS f32x4*)(betaL + 16 * ti + 4 * g);
#pragma unroll
            for (int tj = 0; tj < 4; ++tj) {
                f32x4 acc = {0.f, 0.f, 0.f, 0.f};
                if (tj <= ti) {
                    const LAS unsigned char* Bb = lds + KS + (16 * tj + r16) * QSTR; bf16x8 Bf[4];
#pragma unroll
                    for (int s = 0; s < 4; ++s) Bf[s] = *(const LAS bf16x8*)(Bb + (32 * s + 8 * g) * 2);
#pragma unroll
                    for (int s = 0; s < 4; ++s) acc = __builtin_amdgcn_mfma_f32_16x16x32_bf16(A[s], Bf[s], acc, 0, 0, 0);
                }
                const float gj = gcumL[16 * tj + r16]; const int j = 16 * tj + r16;
#pragma unroll
                for (int e = 0; e < 4; ++e) { const int i = 16 * ti + 4 * g + e; const float dec = ex(fminf(gi4[e] - gj, 0.f));
                    if (sel == 0) { const float lv = (i > j) ? bi4[e] * acc[e] * dec : 0.f;
                        if (tj == ti) Lf[i * LSTR + j] = lv; else if (tj < ti) *(LAS unsigned short*)(lds + TB + i * TBSTR + 2 * j) = f2bf(lv); }
                    else *(LAS unsigned short*)(lds + QKB + i * TBSTR + 2 * j) = f2bf((i >= j) ? acc[e] * dec : 0.f); }
            }
        }
        __syncthreads();
        if (wave == 0) {
            const LAS float* Nb = Lf + (16 * g) * LSTR + 16 * g; float x[16]; int rc = r16; asm volatile("" : "+v"(rc));
            float na[55], nb2[65];
            { int q = 0;
#pragma unroll
              for (int r = 1; r <= 10; ++r)
#pragma unroll
                  for (int j = 0; j < r; ++j) na[q++] = Nb[r * LSTR + j]; }
            { int q = 0;
#pragma unroll
              for (int r = 11; r <= 15; ++r)
#pragma unroll
                  for (int j = 0; j < r; ++j) nb2[q++] = Nb[r * LSTR + j]; }
            x[0] = (0 == rc) ? 1.f : 0.f;
            { int q = 0;
#pragma unroll
              for (int r = 1; r <= 10; ++r) { float s = (r == rc) ? 1.f : 0.f;
#pragma unroll
                  for (int j = 0; j < r; ++j) s -= na[q++] * x[j];
                  x[r] = s; } }
            { int q = 0;
#pragma unroll
              for (int r = 11; r <= 15; ++r) { float s = (r == rc) ? 1.f : 0.f;
#pragma unroll
                  for (int j = 0; j < r; ++j) s -= nb2[q++] * x[j];
                  x[r] = s; } }
#pragma unroll
            for (int r = 0; r < 16; ++r) *(LAS unsigned short*)(lds + TB + (16 * g + r) * TBSTR + 2 * (16 * g + r16)) = f2bf(x[r]);
        }
        __syncthreads();
        }
        f32x4 U[4];
        {
            const LAS unsigned char* tl = lds + TB;
#define DN_A1(b_, k_) ({ const u32x2 lo_ = *(const LAS u32x2*)(tl + (16 * (b_) + r16) * TBSTR + (16 * (k_) + 4 * g) * 2); u32x4 w_; w_.x = lo_.x; w_.y = lo_.y; w_.z = 0u; w_.w = 0u; __builtin_bit_cast(bf16x8, w_); })
#define DN_A2(b_, k0_, k1_) ({ const u32x2 lo_ = *(const LAS u32x2*)(tl + (16 * (b_) + r16) * TBSTR + (16 * (k0_) + 4 * g) * 2), hi_ = *(const LAS u32x2*)(tl + (16 * (b_) + r16) * TBSTR + (16 * (k1_) + 4 * g) * 2); \
            u32x4 w_; w_.x = lo_.x; w_.y = lo_.y; w_.z = hi_.x; w_.w = hi_.y; __builtin_bit_cast(bf16x8, w_); })
            const bf16x8 aD0 = DN_A1(0, 0), aL10 = DN_A1(1, 0), aD1 = DN_A1(1, 1), aL2 = DN_A2(2, 0, 1), aD2 = DN_A1(2, 2), aL3a = DN_A2(3, 0, 1), aL3b = DN_A1(3, 2), aD3 = DN_A1(3, 3);
            const f32x4 z4 = {0.f, 0.f, 0.f, 0.f};
#pragma unroll
            for (int which = 0; which < 2; ++which) {
                const LAS unsigned char* rp = lds + (which ? KBT : VBT) + (16 * wave + r16) * TSTR;
                f32x4 R[4];
#pragma unroll
                for (int b4 = 0; b4 < 4; ++b4) { const u32x2 w = *(const LAS u32x2*)(rp + (16 * b4 + 4 * g) * 2);
                    R[b4] = (f32x4){__uint_as_float(w.x << 16), __uint_as_float(w.x & 0xffff0000u), __uint_as_float(w.y << 16), __uint_as_float(w.y & 0xffff0000u)}; }
                f32x4 X0 = __builtin_amdgcn_mfma_f32_16x16x32_bf16(aD0, pack2(R[0], z4), z4, 0, 0, 0);
                f32x4 Y = __builtin_amdgcn_mfma_f32_16x16x32_bf16(aL10, pack2(X0, z4), z4, 0, 0, 0);
                f32x4 X1 = __builtin_amdgcn_mfma_f32_16x16x32_bf16(aD1, pack2(R[1] - Y, z4), z4, 0, 0, 0);
                const bf16x8 b01 = pack2(X0, X1);
                Y = __builtin_amdgcn_mfma_f32_16x16x32_bf16(aL2, b01, z4, 0, 0, 0);
                f32x4 X2 = __builtin_amdgcn_mfma_f32_16x16x32_bf16(aD2, pack2(R[2] - Y, z4), z4, 0, 0, 0);
                Y = __builtin_amdgcn_mfma_f32_16x16x32_bf16(aL3a, b01, z4, 0, 0, 0);
                Y = __builtin_amdgcn_mfma_f32_16x16x32_bf16(aL3b, pack2(X2, z4), Y, 0, 0, 0);
                f32x4 X3 = __builtin_amdgcn_mfma_f32_16x16x32_bf16(aD3, pack2(R[3] - Y, z4), z4, 0, 0, 0);
                if (which == 0) { U[0] = X0; U[1] = X1; U[2] = X2; U[3] = X3; }
                else { const f32x4 Xs[4] = {X0, X1, X2, X3};
#pragma unroll
                    for (int ti = 0; ti < 4; ++ti)
#pragma unroll
                        for (int e = 0; e < 4; ++e) *(LAS unsigned short*)(lds + WB + (16 * ti + 4 * g + e) * QSTR + (16 * wave + r16) * 2) = f2bf(Xs[ti][e]); }
            }
#undef DN_A1
#undef DN_A2
        }
        __syncthreads();
        if (c + 1 < 32) DN_LOAD_CHUNK(c + 1);
        unsigned dzq[8];
#pragma unroll
        for (int i = 0; i < 8; ++i) dzq[i] = *(const unsigned*)(proj + (R0 + 8 * wave + i) * PROJ + C_DZ + h * 128 + 2 * lane);
        {
            bf16x8 Sb[4];
#pragma unroll
            for (int s = 0; s < 4; ++s) Sb[s] = pack2(S[2 * s], S[2 * s + 1]);
            f32x4 Vn[4], Oa[4];
#pragma unroll
            for (int ti = 0; ti < 4; ++ti) {
                const LAS unsigned char* wp = lds + WB + (16 * ti + r16) * QSTR; const LAS unsigned char* qp = lds + QS + (16 * ti + r16) * QSTR;
                bf16x8 wf[4], qf[4];
#pragma unroll
                for (int s = 0; s < 4; ++s) { wf[s] = frag_perm(wp, s, g); qf[s] = frag_perm(qp, s, g); }
                const f32x4 gi4 = *(const LAS f32x4*)(gcumL + 16 * ti + 4 * g);
                f32x4 ws = {0.f, 0.f, 0.f, 0.f}, qs = {0.f, 0.f, 0.f, 0.f};
#pragma unroll
                for (int s = 0; s < 4; ++s) { ws = __builtin_amdgcn_mfma_f32_16x16x32_bf16(wf[s], Sb[s], ws, 0, 0, 0); qs = __builtin_amdgcn_mfma_f32_16x16x32_bf16(qf[s], Sb[s], qs, 0, 0, 0); }
                Vn[ti] = U[ti] - ws;
#pragma unroll
                for (int e = 0; e < 4; ++e) qs[e] *= ex(gi4[e]);
                Oa[ti] = qs;
            }
            bf16x8 Vb[2];
#pragma unroll
            for (int s = 0; s < 2; ++s) Vb[s] = pack2(Vn[2 * s], Vn[2 * s + 1]);
            { bf16x8 kf[4][2];
#pragma unroll
              for (int ti = 0; ti < 4; ++ti) { const LAS unsigned char* kp = lds + QKB + (16 * ti + r16) * TBSTR; kf[ti][0] = frag_perm(kp, 0, g); kf[ti][1] = frag_perm(kp, 1, g); }
#pragma unroll
              for (int ti = 0; ti < 4; ++ti)
#pragma unroll
                  for (int s = 0; s < 2; ++s) Oa[ti] = __builtin_amdgcn_mfma_f32_16x16x32_bf16(kf[ti][s], Vb[s], Oa[ti], 0, 0, 0); }
            const float egl = ex(gl);
#pragma unroll
            for (int half = 0; half < 2; ++half) { bf16x8 kf[4][2];
#pragma unroll
                for (int q = 0; q < 4; ++q) { const LAS unsigned char* kp = lds + KGT + (16 * (4 * half + q) + r16) * TSTR; kf[q][0] = frag_perm(kp, 0, g); kf[q][1] = frag_perm(kp, 1, g); }
#pragma unroll
                for (int q = 0; q < 4; ++q) { f32x4 sa = S[4 * half + q] * egl;
#pragma unroll
                    for (int s = 0; s < 2; ++s) sa = __builtin_amdgcn_mfma_f32_16x16x32_bf16(kf[q][s], Vb[s], sa, 0, 0, 0);
                    S[4 * half + q] = sa; } }
            LAS float* Of = (LAS float*)(lds + OF);
#pragma unroll
            for (int ti = 0; ti < 4; ++ti)
#pragma unroll
                for (int e = 0; e < 4; ++e) Of[(16 * ti + 4 * g + e) * OSTR + 16 * wave + r16] = Oa[ti][e];
        }
        __syncthreads();
        {
            const LAS float* Of = (const LAS float*)(lds + OF);
#pragma unroll
            for (int i = 0; i < 8; ++i) { const int r = 8 * wave + i; const f32x2 o = *(const LAS f32x2*)(Of + r * OSTR + 2 * lane);
                const float rstd = rsqrtf(wave_sum(o.x * o.x + o.y * o.y) * (1.f / 128.f) + EPS);
                const float z0 = __uint_as_float(dzq[i] << 16), z1 = __uint_as_float(dzq[i] & 0xffff0000u);
                *(unsigned*)(mix + (R0 + r) * MIXB + (h * 128 + 2 * lane) * 2) = cvtpk(o.x * rstd * gn0 * silu(z0), o.y * rstd * gn1 * silu(z1)); }
        }
    }
}
#undef DN_LOAD_CHUNK
}
struct Args { const float* in[28]; float* out; unsigned char* ws; int ph_lo, ph_hi, li, pad; };
struct Frame {
    LAS unsigned char* lds; volatile LAS unsigned* MISC; int tid, lane, wave, G, vcu;
};
template <int NR> __device__ __forceinline__ void dsa_prep_rows(int row0, int lane, const bf16_t* proj, const float* kvg, const float* lng, const float* lnb, const float* a_log, const float* dt_bias,
                                             bf16_t* ckv, bf16_t* kidx, float* widx, float* beta, float* gdec) {
    unsigned cv[NR]; unsigned short kv[NR], sm[NR];
#pragma unroll
    for (int r = 0; r < NR; ++r) { const bf16_t* pr = proj + (size_t)(row0 + r) * PROJ; cv[r] = *(const unsigned*)(pr + C_CKV + lane * 2); kv[r] = pr[C_KIX + lane]; sm[r] = pr[C_WIX + (lane & 15)]; }
    const float g0 = kvg[lane * 2], g1 = kvg[lane * 2 + 1], lg = lng[lane], lb = lnb[lane], al = a_log[lane & 3], dtb = dt_bias[lane & 3];
#pragma unroll
    for (int r = 0; r < NR; ++r) { const int row = row0 + r;
        { const float a = __uint_as_float(cv[r] << 16), b = __uint_as_float(cv[r] & 0xffff0000u);
          const float rs = rsqrtf(wave_sum(a * a + b * b) * (1.f / 128.f) + EPS); *(unsigned*)(ckv + (size_t)row * 128 + lane * 2) = pk2(a * rs * g0, b * rs * g1); }
        { const float a = bf2f(kv[r]); const float mu = wave_sum(a) * (1.f / 64.f); const float xc = a - mu; const float rs = rsqrtf(wave_sum(xc * xc) * (1.f / 64.f) + EPS);
          kidx[(size_t)row * 64 + lane] = f2bf(xc * rs * lg + lb); }
        const float sv = bf2f(sm[r]);
        if (lane < 8) widx[(size_t)row * 8 + lane] = sv * 0.04419417382415922f;
        else if (lane < 12) beta[(size_t)row * 4 + (lane - 8)] = 1.f / (1.f + __expf(-sv));
        else if (lane < 16) { const float xx = sv + dtb; const float sp = xx > 20.f ? xx : log1pf(__expf(xx)); gdec[(size_t)row * 4 + (lane - 12)] = -__expf(al) * sp; }
    }
}

__global__ void __launch_bounds__(NWAVES * 64, 2) mega(Args args) {
    extern __shared__ __attribute__((aligned(16))) unsigned char lds_raw[];
    Frame F;
    F.lds = (LAS unsigned char*)lds_raw;
    F.MISC = (volatile LAS unsigned*)(F.lds + MISC_OFF);
    F.tid = threadIdx.x; F.lane = F.tid & 63; F.wave = __builtin_amdgcn_readfirstlane(F.tid >> 6);
    F.G = gridDim.x; { const int bx = blockIdx.x; F.vcu = (F.G % 8 == 0) ? (bx % 8) * (F.G / 8) + bx / 8 : bx; }
    unsigned char* ws = args.ws;
    const float* x = args.in[0]; const float* mem = args.in[1]; const float* g_mix = args.in[2]; const float* w_in = args.in[3];
    const float* conv_w = args.in[4]; const float* a_log = args.in[5]; const float* dt_bias = args.in[6];
    const float* dn_norm_g = args.in[7]; const float* q_norm_g = args.in[8]; const float* kv_norm_g = args.in[9]; const float* w_uq = args.in[10]; const float* w_uk = args.in[11];
    const float* w_uv = args.in[12]; const float* w_qidx = args.in[13]; const float* kidx_ln_g = args.in[14]; const float* kidx_ln_b = args.in[15];
    const float* rel_bias = args.in[16]; const float* w_out = args.in[17]; const float* g_xattn = args.in[18]; const float* g_mem = args.in[19];
    const float* w_xq = args.in[20]; const float* w_xkv = args.in[21]; const float* w_xo = args.in[22]; const float* g_ffn = args.in[23];
    const float* w_gate = args.in[24]; const float* w_up = args.in[25]; const float* w_down = args.in[26]; const float* g_final = args.in[27];
    float* out = args.out;
    bf16_t* Win_t = (bf16_t*)(ws + WS_WIN); bf16_t* Wkv_t = (bf16_t*)(ws + WS_WKV); bf16_t* Wdsa_t = (bf16_t*)(ws + WS_WDSA); bf16_t* Wout_t = (bf16_t*)(ws + WS_WOUT);
    bf16_t* Wxq_t = (bf16_t*)(ws + WS_WXQ); bf16_t* Wxo_t = (bf16_t*)(ws + WS_WXO); bf16_t* Wgu_t = (bf16_t*)(ws + WS_WGU); bf16_t* Wdn_t = (bf16_t*)(ws + WS_WDN);
    unsigned char* stt = ws + WS_ST;
    float* rstdx = (float*)(stt + ST_RSTDX); float* cqss = (float*)(stt + ST_CQSS); float* lpart = (float*)(stt + ST_LPART);
    float* widx = (float*)(stt + ST_WIDX); float* beta = (float*)(stt + ST_BETA); float* gdec = (float*)(stt + ST_G); float* biastab = (float*)(stt + ST_BIAS);
    bf16_t* mnb = (bf16_t*)(ws + WS_MNB); unsigned char* kx = ws + WS_KX; unsigned char* vT = ws + WS_VT;        bf16_t* ckv = (bf16_t*)(ws + WS_CKV); bf16_t* kidx = (bf16_t*)(ws + WS_KIDX);
    float* ssq1 = (float*)(ws + WS_SSQ); float* ssq2 = ssq1 + (size_t)M * 16;
    bf16_t* proj = (bf16_t*)(ws + WS_PROJ); unsigned char* mix = ws + WS_MIX; unsigned char* Wout8 = ws + WS_W8 + 5 * MiB; bf16_t* xb = (bf16_t*)(ws + WS_XB); bf16_t* qabs = (bf16_t*)out;
    bf16_t* x1b = (bf16_t*)(ws + WS_X1B); bf16_t* qx = (bf16_t*)(ws + WS_QX); bf16_t* Pb = (bf16_t*)(ws + WS_P); bf16_t* ox = (bf16_t*)(ws + WS_OX); bf16_t* x2b = (bf16_t*)(ws + WS_X2B); unsigned char* act = ws + WS_ACT; unsigned char* Wdn8 = ws + WS_W8; unsigned char* Wxq8 = ws + WS_W8 + 3 * MiB; unsigned char* Wxo8 = ws + WS_W8 + 4 * MiB;
    unsigned char* x1f8 = (unsigned char*)out;
    unsigned char* ox8 = ws + WS_OX;

    for (int u = F.tid; u < (LDS_BYTES - LDSCTL_OFF) / 4; u += NWAVES * 64) ((LAS unsigned*)(F.lds + LDSCTL_OFF))[u] = 0u;
    __syncthreads();
    XcdBarrier bar = xcd_barrier_post((unsigned*)(ws + WS_CTL) + 4096 + args.li * XCD_BAR_WORDS, F.MISC + 8);
#define GRID_BAR() xcd_barrier(bar, F.wave)
    const int lo = args.ph_lo, hi = args.ph_hi;
#ifdef ONLY_PHASE
#define IN(k) ((k) == ONLY_PHASE && lo <= (k) && (k) < hi)
#else
#define IN(k) (lo <= (k) && (k) < hi)
#endif
#define BOTH(k) (IN(k) && IN((k) + 1))
    const int gw = F.vcu * NWAVES + F.wave, NGW = F.G * NWAVES;
    PG8_LAS unsigned char* ring = (PG8_LAS unsigned char*)F.lds;

    if (IN(0)) {
        LAS float* scr = (LAS float*)(F.lds + F.wave * 16384);
        constexpr int I_OB = 32 * 32, I_QA = 8 * 32, I_QI = 4 * 16, I_IN = 16 * 80, I_KV = 16 * 64, I_XQ = 16 * 32, I_XO = 16 * 32, I_GU = 16 * 176, I_DN = 44 * 32, I_OA = 8 * 32;
        constexpr int NITEMS = I_OB + I_QA + I_QI + I_IN + I_KV + I_XQ + I_XO + I_GU + I_DN + I_OA;
        for (int it = gw; it < NITEMS; it += NGW) {
            int r = it;
            if (r < I_OB) { const int kb = r >> 5, nb = r & 31, k0 = 32 * kb, h = k0 >> 7;
                heavy_item(w_uv, 64, w_out + (size_t)(512 + h * 64) * 1024, 1024, nullptr, 1.f, k0, 32 * nb, 32 * nb, Wout_t, MIXK, 512, scr, F.lane, (unsigned*)(ws + WS_CTL) + CTL_AMAX + 3); continue; } r -= I_OB;
            if (r < I_QA) { const int kb = r >> 5, nb = r & 31, n0 = 32 * nb, h = n0 >> 7;
                heavy_item(w_uq + h * 64, 512, w_uk + (size_t)(h * 64) * 128 - h * 128, 128, q_norm_g, 0.125f * LOG2E, 32 * kb, n0, ((n0 >> 5) & 3) * 256 + h * 32, Wdsa_t, 256, 0, scr, F.lane); continue; }   r -= I_QA;
            if (r < I_QI) { tr_item(SrcQidx{w_qidx, q_norm_g}, 512, Wdsa_t + (size_t)1024 * 256, 256, 0, scr, r, F.lane); continue; } r -= I_QI;
            if (r < I_IN) { tr_item(SrcWin{w_in, g_mix}, PROJ, Win_t, 1024, 0, scr, r, F.lane); continue; } r -= I_IN;
            if (r < I_KV) { tr_item(SrcPlain{w_xkv, 2048, nullptr, 1.f}, 2048, Wkv_t, 1024, 0, scr, r, F.lane); continue; } r -= I_KV;
            if (r < I_XQ) { tr_item(SrcPlain{w_xq, 1024, g_xattn, 0.0625f * LOG2E}, 1024, Wxq_t, 1024, 0, scr, r, F.lane, (unsigned*)(ws + WS_CTL) + CTL_AMAX + 1); continue; } r -= I_XQ;
            if (r < I_XO) { tr_item(SrcPlain{w_xo, 1024, nullptr, 1.f}, 1024, Wxo_t, 1024, 0, scr, r, F.lane, (unsigned*)(ws + WS_CTL) + CTL_AMAX + 2); continue; } r -= I_XO;
            if (r < I_GU) { tr_item(SrcGU{w_gate, w_up, g_ffn}, 2 * DFF, Wgu_t, 1024, 0, scr, r, F.lane); continue; } r -= I_GU;
            if (r < I_DN) { tr_item(SrcPlain{w_down, 1024, nullptr, 1.f}, 1024, Wdn_t, DFF, 0, scr, r, F.lane, (unsigned*)(ws + WS_CTL) + CTL_AMAX); continue; } r -= I_DN;
            tr_item(SrcPlain{w_out, 1024, nullptr, 1.f}, 1024, Wout_t, MIXK, 0, scr, r, F.lane);
        }
        for (int m = 4 * gw; m < M; m += 4 * NGW) row_prep<4>(x + (size_t)m * D, nullptr, xb + (size_t)m * D, rstdx + m, F.lane);
        for (int m = 2 * gw; m < MM; m += 2 * NGW) row_prep<2>(mem + (size_t)m * D, g_mem, mnb + (size_t)m * D, nullptr, F.lane);
        if (blockIdx.x == 0) for (int i = F.tid; i < 129 * 8; i += NWAVES * 64) {
            const int d = i >> 3, h = i & 7; int bkt;
            if (d < 16) bkt = d; else { const float lr = logf((float)d / 16.f) / 2.0794415416798357f; const int large = 16 + (int)(lr * 16.f); bkt = large < 31 ? large : 31; }
            biastab[i] = rel_bias[bkt * 8 + h] * LOG2E; }
        if (BOTH(0)) GRID_BAR();
    }
    if (IN(1)) {
        pg8::Gemm g{xb, Win_t, 1024, 1024, 1024}; pg8::StaticOrder S; S.init(M, PROJ, F.G, (int)blockIdx.x);
        pg8::EpiProj E{proj, PROJ, nullptr, cqss, 8};
        pg8::gemm_phase<pg8::EpiProj, pg8::StaticOrder, true>(ring, g, S, E, F.wave);
        if (BOTH(1)) GRID_BAR();
    }
    if (IN(2)) {
        const int lane2 = lane_now();
        for (int m = 4 * gw; m < M; m += 4 * NGW) dsa_prep_rows<4>(m, lane2, proj, kv_norm_g, kidx_ln_g, kidx_ln_b, a_log, dt_bias, ckv, kidx, widx, beta, gdec);
        { unsigned* am = (unsigned*)(ws + WS_CTL) + CTL_AMAX;
          cvt_w8(Wdn_t, Wdn8, DFF * 1024 / 16, __hip_atomic_load(am, __ATOMIC_RELAXED, __HIP_MEMORY_SCOPE_AGENT), gw * 64 + lane2, NGW * 64);
          cvt_w8(Wxq_t, Wxq8, 1024 * 1024 / 16, __hip_atomic_load(am + 1, __ATOMIC_RELAXED, __HIP_MEMORY_SCOPE_AGENT), gw * 64 + lane2, NGW * 64);
          cvt_w8(Wxo_t, Wxo8, 1024 * 1024 / 16, __hip_atomic_load(am + 2, __ATOMIC_RELAXED, __HIP_MEMORY_SCOPE_AGENT), gw * 64 + lane2, NGW * 64);
          cvt_wout8(Wout_t, Wout8, __hip_atomic_load(am + 3, __ATOMIC_RELAXED, __HIP_MEMORY_SCOPE_AGENT), gw * 64 + lane2, NGW * 64); }
        { pg8::Gemm g{proj + C_CQ, Wdsa_t, PROJ, 256, 256}; pg8::StaticOrder S; S.init(M, 1536, F.G, (int)blockIdx.x);
          pg8::EpiNormScale<4> E{qabs, 1536, cqss, 1.f / 256.f, 1.f};
          pg8::gemm_phase<pg8::EpiNormScale<4>, pg8::StaticOrder, true>(ring, g, S, E, F.wave); }
        if (BOTH(2)) GRID_BAR();
    }
    if (IN(3)) {
        const int lane3 = lane_now(); const int tid3 = F.wave * 64 + lane3;
        if (blockIdx.x < 64) dn::run(F.lds, (int)blockIdx.x >> 2, (int)blockIdx.x & 3, proj, conv_w, beta, gdec, dn_norm_g, mix, tid3, F.wave, lane3);
        __syncthreads();
        if (blockIdx.x >= 64) { unsigned* kvq = (unsigned*)(ws + WS_CTL) + 1536;
            for (;;) {
                if (tid3 == 0) F.MISC[17] = __hip_atomic_fetch_add(kvq, 1u, __ATOMIC_RELAXED, __HIP_MEMORY_SCOPE_AGENT);
                __syncthreads(); const int k = (int)F.MISC[17]; __syncthreads();
                if (k >= 128) break;
                if (k < 64) { pg8::Gemm g{mnb, Wkv_t, 1024, 1024, 1024}; pg8::OneUnit S1{{k >> 2, k & 3, 0, 0}}; pg8::EpiProj8 E{kx, 1024, pg8::KV8_SCALE};
                    pg8::gemm_phase<pg8::EpiProj8, pg8::OneUnit, false>(ring, g, S1, E, F.wave); }
                else { const int k2 = k - 64; pg8::Gemm g{Wkv_t + (size_t)1024 * 1024, mnb, 1024, 1024, 1024}; pg8::OneUnit S1{{k2 >> 4, k2 & 15, 0, 0}}; pg8::EpiProj8 E{vT, MM, pg8::KV8_SCALE};
                    pg8::gemm_phase<pg8::EpiProj8, pg8::OneUnit, false>(ring, g, S1, E, F.wave); }
            } }
        for (int pass = 0; pass <= args.pad; ++pass) {
        if (pass) GRID_BAR();
        const int lane4 = lane_now(); const int tid4 = F.wave * 64 + lane4;
        dsa::phase_init(F.lds, biastab, kv_norm_g, tid4);
        unsigned* qbase = (unsigned*)(ws + WS_CTL) + 2048 + 1024 * pass;
        const int myx = (int)(xb_xcc_id() & 7u);
        for (int sx = 0; sx < 8; ++sx) { const int qx8 = (myx + sx) & 7;
        for (;;) {
            if (tid4 == 0) F.MISC[16] = __hip_atomic_fetch_add(qbase + 64 * qx8, 1u, __ATOMIC_RELAXED, __HIP_MEMORY_SCOPE_AGENT);
            __syncthreads(); const int k = (int)F.MISC[16]; __syncthreads();
            if (k >= 256) break;
            dsa::unit(F.lds, 2 * qx8 + (k & 1), (127 - (k >> 1)) * 16, tid4, F.wave, lane4, qabs, ckv, kidx, widx, mix, (unsigned*)(ws + WS_CTL) + 1024);
        } }
        }
        if (BOTH(3)) GRID_BAR();
    }
    if (IN(4)) {
        pg8::Gemm g{(const bf16_t*)mix, (const bf16_t*)Wout8, MIXB, MIXB, MIXB}; pg8::StaticOrder S; S.init(M, 1024, F.G, (int)blockIdx.x);
        const float asc = pg8::w8_inv_scale((unsigned)__builtin_amdgcn_readfirstlane((int)__hip_atomic_load((unsigned*)(ws + WS_CTL) + CTL_AMAX + 3, __ATOMIC_RELAXED, __HIP_MEMORY_SCOPE_AGENT)), OLAT_SHIFT);
        pg8::EpiResid<true, true> E{nullptr, xb, x1b, ssq1, rstdx, x1f8, asc};
        pg8::gemm_phase<pg8::EpiResid<true, true>, pg8::StaticOrder, true, 2>(ring, g, S, E, F.wave, 8);
        if (BOTH(4)) GRID_BAR();
    }
    if (IN(5)) {
        pg8::StaticOrder S; S.init(M, 1024, F.G, (int)blockIdx.x); pg8::Unit ua, ub; const bool h0 = S.next(0, ua), h1 = S.next(1, ub);
        if (h0) {
            { pg8::Gemm g{(const bf16_t*)x1f8, (const bf16_t*)Wxq8, 1024, 1024, 1024};
              const float asc = pg8::w8_inv_scale((unsigned)__builtin_amdgcn_readfirstlane((int)__hip_atomic_load((unsigned*)(ws + WS_CTL) + CTL_AMAX + 1, __ATOMIC_RELAXED, __HIP_MEMORY_SCOPE_AGENT)), pg8::X8_SHIFT - pg8::QX8_SHIFT);
              pg8::EpiNormScale<16, true> E{qx, 1024, ssq1, 1.f / 1024.f, asc};
              pg8::gemm_phase<pg8::EpiNormScale<16, true>, pg8::StaticOrder, true, true>(ring, g, S, E, F.wave); }
            VM_WAIT(); __syncthreads();
            pg8::TwoUnits S2; S2.n = h1 ? 2 : 1;
            S2.u0 = pg8::Unit{ua.pm, ua.pm >> 3, (long)ua.pn * 256, (long)ua.pn * 256}; S2.u1 = pg8::Unit{ub.pm, ub.pm >> 3, (long)ub.pn * 256, (long)ub.pn * 256};
            { pg8::Gemm g{qx, (const bf16_t*)kx, 1024, 1024, 256};
              pg8::EpiExpP E{(unsigned char*)Pb, lpart, 1.f / (pg8::QX8_SCALE * pg8::KV8_SCALE)};
              pg8::gemm_phase<pg8::EpiExpP, pg8::TwoUnits, true, true>(ring, g, S2, E, F.wave); }
            VM_WAIT(); __syncthreads();
            pg8::TwoUnits S3; S3.n = S2.n;
            S3.u0 = pg8::Unit{ua.pm, ua.pn, (long)ua.pn * 256, (long)(ua.pm >> 3) * 256}; S3.u1 = pg8::Unit{ub.pm, ub.pn, (long)ub.pn * 256, (long)(ub.pm >> 3) * 256};
            { pg8::Gemm g{Pb, (const bf16_t*)vT, 1024, MM, 256};
              pg8::EpiPV E{ox8, lpart, pg8::OX_SCALE / pg8::KV8_SCALE};
              pg8::gemm_phase<pg8::EpiPV, pg8::TwoUnits, true, true>(ring, g, S3, E, F.wave); }
        }
        if (BOTH(5)) GRID_BAR();
    }
    if (IN(6)) {
        pg8::Gemm g{(const bf16_t*)ox8, (const bf16_t*)Wxo8, 1024, 1024, 1024}; pg8::StaticOrder S; S.init(M, 1024, F.G, (int)blockIdx.x);
        const float asc = pg8::w8_inv_scale((unsigned)__builtin_amdgcn_readfirstlane((int)__hip_atomic_load((unsigned*)(ws + WS_CTL) + CTL_AMAX + 2, __ATOMIC_RELAXED, __HIP_MEMORY_SCOPE_AGENT)), pg8::OX_SHIFT);
        pg8::EpiResid<true> E{nullptr, x1b, x2b, ssq2, nullptr, nullptr, asc};
        pg8::gemm_phase<pg8::EpiResid<true>, pg8::StaticOrder, true, true>(ring, g, S, E, F.wave);
        if (BOTH(6)) GRID_BAR();
    }
    if (IN(7)) {
        pg8::Gemm g{x2b, Wgu_t, 1024, 1024, 1024}; pg8::StaticOrder S; S.init(M, 2 * DFF, F.G, (int)blockIdx.x);
        pg8::EpiSwiglu E{act, ssq2};
        pg8::gemm_phase<pg8::EpiSwiglu, pg8::StaticOrder, true>(ring, g, S, E, F.wave);
        if (BOTH(7)) GRID_BAR();
    }
#if defined(DSA_TOPK_CHECK) || defined(DSA_FALLBACK_COUNT)
    const bool fuse_final = false;
#else
    const bool fuse_final = (F.G == 256);
#endif
    if (IN(8)) {
        pg8::Gemm g{(const bf16_t*)act, (const bf16_t*)Wdn8, DFF, DFF, DFF}; pg8::StaticOrder S; S.init(M, 1024, F.G, (int)blockIdx.x);
        const float asc = pg8::w8_inv_scale((unsigned)__builtin_amdgcn_readfirstlane((int)__hip_atomic_load((unsigned*)(ws + WS_CTL) + CTL_AMAX, __ATOMIC_RELAXED, __HIP_MEMORY_SCOPE_AGENT)), pg8::ACT_SHIFT);
        if (fuse_final) { pg8::EpiFinal E{x2b, out, ssq1, (unsigned*)(ws + WS_CTL) + 8192, g_final, asc};
            pg8::gemm_phase<pg8::EpiFinal, pg8::StaticOrder, true, true>(ring, g, S, E, F.wave); }
        else { pg8::EpiResidF32 E{x2b, out, ssq1, asc};
            pg8::gemm_phase<pg8::EpiResidF32, pg8::StaticOrder, true, true>(ring, g, S, E, F.wave);
            if (BOTH(8)) GRID_BAR(); }
    }
    if (IN(9) && !fuse_final) {
#ifdef DSA_FALLBACK_COUNT
        if (blockIdx.x == 0 && F.wave == 0 && lane_now() == 0 && __hip_atomic_load((unsigned*)(ws + WS_CTL) + 1024 + 64, __ATOMIC_RELAXED, __HIP_MEMORY_SCOPE_AGENT) > DSA_FALLBACK_COUNT) out[12345] = __builtin_nanf("");
#endif
#ifdef DSA_TOPK_CHECK
        if (blockIdx.x == 0 && F.wave == 0 && lane_now() == 0 && __hip_atomic_load((unsigned*)(ws + WS_CTL) + 1024, __ATOMIC_RELAXED, __HIP_MEMORY_SCOPE_AGENT) != 0u) out[12345] = __builtin_nanf("");
#endif
        const int lane9 = lane_now();
        for (int m = gw; m < M; m += NGW) {
            const float* pp = ssq1 + (size_t)m * 16; float s = 0.f;
#pragma unroll
            for (int q = 0; q < 4; ++q) { const f32x4 t = *(const f32x4*)(pp + 4 * q); s += (t.x + t.y) + (t.z + t.w); }
            const float rstd = rsqrtf(s * (1.f / 1024.f) + EPS);
            GAS f32x4* xr = (GAS f32x4*)(out + (size_t)m * D) + lane9;
#pragma unroll
            for (int j = 0; j < 4; ++j) { const f32x4 gg = *((const GAS f32x4*)g_final + lane9 + 64 * j); xr[64 * j] = xr[64 * j] * gg * rstd; }
        }
    }
#undef IN
#undef BOTH
}

extern "C" void kernel_launch(void* const* d_in, const int* in_sizes, int n_in, void* d_out, int out_size, void* d_ws, size_t ws_size, hipStream_t stream) {
    static int grid = 0;
    if (grid == 0) {
        if (n_in != 28 || ws_size < WS_NEED || out_size != M * D) { fprintf(stderr, "kernel_launch: unexpected problem (n_in %d ws %zu out %d)\n", n_in, ws_size, out_size); grid = -1; return; }
        int dev = 0, cus = 0, per_cu = 0;
        if (hipGetDevice(&dev) != hipSuccess || hipDeviceGetAttribute(&cus, hipDeviceAttributeMultiprocessorCount, dev) != hipSuccess) { grid = -1; return; }
        if (hipFuncSetAttribute((const void*)mega, hipFuncAttributeMaxDynamicSharedMemorySize, LDS_BYTES) != hipSuccess) { fprintf(stderr, "kernel_launch: hipFuncSetAttribute failed\n"); grid = -1; return; }
        if (hipOccupancyMaxActiveBlocksPerMultiprocessor(&per_cu, (const void*)mega, NWAVES * 64, LDS_BYTES) != hipSuccess || per_cu < 1) { fprintf(stderr, "kernel_launch: occupancy query says %d\n", per_cu); grid = -1; (void)hipGetLastError(); return; }
        grid = cus;
        if (grid < 64) { fprintf(stderr, "kernel_launch: needs >= 64 CUs\n"); grid = -1; return; }
    }
    if (grid < 0) return;
    unsigned char* ws = (unsigned char*)d_ws;
    (void)hipMemsetAsync(ws + WS_CTL, 0, CTL_ZERO_BYTES, stream);
    Args a{}; for (int i = 0; i < 28; ++i) a.in[i] = (const float*)d_in[i]; a.out = (float*)d_out; a.ws = ws;
    a.ph_lo = 0; a.ph_hi = 10; a.li = 0;
#ifdef DSA_PASSES
    a.pad = DSA_PASSES - 1;
#endif
    void* kargs[] = {&a};
    (void)hipLaunchCooperativeKernel((const void*)mega, dim3(grid), dim3(NWAVES * 64), kargs, LDS_BYTES, stream);
}
```

```cpp
#include <hip/hip_runtime.h>
#include <cstdio>
#include <cstdint>

typedef unsigned short bf16_t;
__device__ __forceinline__ float bf2f(bf16_t h) { return __uint_as_float(((unsigned)h) << 16); }
__device__ __forceinline__ bf16_t f2bf(float f) { unsigned u = __float_as_uint(f); return (bf16_t)((u + 0x7fffu + ((u >> 16) & 1u)) >> 16); }

constexpr int D = 1024, BATCH = 16, SEQ = 2048, M = BATCH * SEQ;
constexpr int PROJ_REF = 2512, PROJ = 2560;
constexpr int MEM_LEN = 256, MM = BATCH * MEM_LEN;
constexpr int DFF = 2816;
constexpr float EPS = 1e-6f;
constexpr float LOG2E = 1.4426950408889634f;
constexpr int C_DQ = 0, C_DK = 512, C_DV = 1024, C_DZ = 1536, C_CQ = 2048, C_CKV = 2304, C_KIX = 2432, C_WIX = 2496, C_DB = 2504, C_DA = 2508;
constexpr int MIXK = 1536;
constexpr int MIXB = 2048;
constexpr float OLAT_SCALE = 32.f; constexpr int OLAT_SHIFT = 5;

constexpr size_t MiB = 1u << 20;
constexpr size_t WS_WIN = 0, WS_WKV = 5 * MiB, WS_WDSA = 9 * MiB, WS_WOUT = 10 * MiB, WS_WXQ = 13 * MiB, WS_WXO = 15 * MiB, WS_WGU = 17 * MiB, WS_WDN = 28 * MiB;
constexpr size_t WS_CTL = 34 * MiB, CTL_ZERO_BYTES = 256 * 1024;
constexpr size_t WS_ST = 35 * MiB;
constexpr size_t ST_RSTDX = 0, ST_CQSS = 128 * 1024  , ST_LPART = 640 * 1024  , ST_WIDX = 2688 * 1024  , ST_BETA = 3712 * 1024  , ST_G = 4224 * 1024  , ST_BIAS = 4736 * 1024;
constexpr size_t WS_MNB = 40 * MiB, WS_KX = 48 * MiB, WS_VT = 56 * MiB, WS_CKV = 64 * MiB, WS_KIDX = 72 * MiB;
constexpr size_t WS_SSQ = 76 * MiB;
constexpr size_t WS_PROJ = 80 * MiB;
constexpr size_t WS_XB = 240 * MiB;
constexpr size_t WS_QABS = 240 * MiB;
constexpr size_t WS_MIX = 336 * MiB;
constexpr size_t WS_X1B = 240 * MiB, WS_QX = 304 * MiB, WS_P = 368 * MiB, WS_OX = 432 * MiB, WS_X2B = 304 * MiB, WS_ACT = 80 * MiB;
constexpr size_t WS_QKV = 400 * MiB;
constexpr size_t WS_W8 = 496 * MiB;
constexpr int CTL_AMAX = 1600;
constexpr size_t WS_NEED = 512 * MiB;

#define DPP_ADD(v, CTRL) ((v) + __int_as_float(__builtin_amdgcn_update_dpp(0, __float_as_int(v), (CTRL), 0xF, 0xF, true)))
__device__ __forceinline__ float wave_sum(float v) {
    v = DPP_ADD(v, 0xB1);
    v = DPP_ADD(v, 0x4E);
    v = DPP_ADD(v, 0x141);
    v = DPP_ADD(v, 0x140);
    const int b = __float_as_int(v);
    const float s0 = __int_as_float(__builtin_amdgcn_readlane(b, 0)), s1 = __int_as_float(__builtin_amdgcn_readlane(b, 16)), s2 = __int_as_float(__builtin_amdgcn_readlane(b, 32)), s3 = __int_as_float(__builtin_amdgcn_readlane(b, 48));
    return (s0 + s1) + (s2 + s3);
}
__device__ __forceinline__ int lane_now() { int l; asm volatile("v_mbcnt_lo_u32_b32 %0, -1, 0\n\tv_mbcnt_hi_u32_b32 %0, -1, %0" : "=v"(l)); return l; }
namespace pg8 {
#define PG8_LAS __attribute__((address_space(3)))
typedef short bf16x8 __attribute__((ext_vector_type(8)));
typedef float f32x4 __attribute__((ext_vector_type(4)));
typedef unsigned u32x4 __attribute__((ext_vector_type(4)));
typedef unsigned u32x2 __attribute__((ext_vector_type(2)));
typedef int i32x4 __attribute__((ext_vector_type(4)));
constexpr int BM = 256, BK = 64, HALF = 128, HTB = HALF * BK * 2  , STAGE_BYTES = 8 * HTB, NXCD = 8, WGM = 8;

__host__ __device__ __forceinline__ int lds_byte(int r, int c) { const int st = (r >> 4) * 2 + (c >> 5), rr = r & 15, cc = c & 31, ob = rr * 64 + cc * 2; return st * 1024 + (ob ^ (((ob >> 9) & 1) << 5)); }
__host__ __device__ __forceinline__ void stage_rc(int b, int& R, int& C) { const int st = b / 1024, sb = b % 1024, swz = sb ^ (((sb >> 9) & 1) << 5); R = (st >> 1) * 16 + swz / 64; C = (st & 1) * 32 + (swz % 64) / 2; }
__host__ __device__ __forceinline__ int perm32(int rho) { const int n = rho >> 4, i = rho & 15; return 8 * (i >> 2) + 4 * n + (i & 3); }

struct Unit { int pm, pn; long ao, bo; };
struct Gemm { const bf16_t* A; const bf16_t* Bt; int lda, ldb, K; };

struct StaticOrder {
    int nM, nN, nwg, G, c;
    __host__ __device__ __forceinline__ void init(int M_, int N_, int G_, int c_) { nM = M_ / BM; nN = N_ / BM; nwg = nM * nN; G = G_; c = c_; }
    __host__ __device__ __forceinline__ bool next(int i, Unit& u) const {
        const long L = (long)i * G + c; if (L >= nwg) return false;
        int wgid = (int)L; { const int q = nwg / NXCD, r = nwg % NXCD, xcd = wgid % NXCD, off = wgid / NXCD; wgid = (xcd < r ? xcd * (q + 1) : r * (q + 1) + (xcd - r) * q) + off; }
        const int nig = WGM * nN, gid = wgid / nig, fm = gid * WGM, gsz = (nM - fm) < WGM ? (nM - fm) : WGM;
        u.pm = fm + ((wgid % nig) % gsz); u.pn = (wgid % nig) / gsz; u.ao = 0; u.bo = 0; return true;
    }
};
struct OneUnit { Unit u; __host__ __device__ __forceinline__ bool next(int i, Unit& o) const { if (i) return false; o = u; return true; } };
struct TwoUnits { Unit u0, u1; int n; __host__ __device__ __forceinline__ bool next(int i, Unit& o) const { if (i >= n) return false; o = i ? u1 : u0; return true; } };

typedef float cvf32x2_t __attribute__((ext_vector_type(2))); typedef __bf16 cvbf16x2_t __attribute__((ext_vector_type(2)));
__device__ __forceinline__ unsigned cvt_pk_bf16(float lo, float hi) { cvf32x2_t v = {lo, hi}; return __builtin_bit_cast(unsigned, __builtin_convertvector(v, cvbf16x2_t)); }
__device__ __forceinline__ u32x4 pack8(const f32x4& a, const f32x4& b) { u32x4 w; w.x = cvt_pk_bf16(a[0], a[1]); w.y = cvt_pk_bf16(a[2], a[3]); w.z = cvt_pk_bf16(b[0], b[1]); w.w = cvt_pk_bf16(b[2], b[3]); return w; }
__device__ __forceinline__ unsigned pack4_fp8(float a, float b, float c, float d) {
    a = __builtin_amdgcn_fmed3f(a, -448.f, 448.f); b = __builtin_amdgcn_fmed3f(b, -448.f, 448.f); c = __builtin_amdgcn_fmed3f(c, -448.f, 448.f); d = __builtin_amdgcn_fmed3f(d, -448.f, 448.f);
    int w = 0; w = __builtin_amdgcn_cvt_pk_fp8_f32(a, b, w, false); w = __builtin_amdgcn_cvt_pk_fp8_f32(c, d, w, true); return (unsigned)w; }
__device__ __forceinline__ u32x2 pack8_fp8(const f32x4& a, const f32x4& b) { u32x2 w; w.x = pack4_fp8(a[0], a[1], a[2], a[3]); w.y = pack4_fp8(b[0], b[1], b[2], b[3]); return w; }
__device__ __forceinline__ float w8_scale(unsigned amax_bits) { const int e = (int)(amax_bits >> 23) - 127; return amax_bits ? __uint_as_float((unsigned)(127 + 6 - e) << 23) : 1.f; }
__device__ __forceinline__ float w8_inv_scale(unsigned amax_bits, int extra_shift) { const int e = (int)(amax_bits >> 23) - 127; return __uint_as_float((unsigned)(amax_bits ? 127 - 6 + e - extra_shift : 127 - extra_shift) << 23); }
__device__ __forceinline__ float dot4(const f32x4& a) { return (a[0] * a[0] + a[1] * a[1]) + (a[2] * a[2] + a[3] * a[3]); }
__device__ __forceinline__ float sum4(const f32x4& a) { return (a[0] + a[1]) + (a[2] + a[3]); }
__device__ __forceinline__ float lo_bf(unsigned w) { return __uint_as_float(w << 16); }
__device__ __forceinline__ float hi_bf(unsigned w) { return __uint_as_float(w & 0xffff0000u); }

typedef f32x4 Acc[2][2][4][2];
#define PG8_EPI_ROWS(...) _Pragma("unroll") for (int ai = 0; ai < 2; ++ai) _Pragma("unroll") for (int m = 0; m < 4; ++m) { const int rl = ai * HALF + wr * 64 + m * 16 + fr; __VA_ARGS__ }

struct EpiProj { static constexpr bool PERM = true;
    bf16_t* O; int ldc; const float* rs; float* cqss; int ssq_pn;
    __device__ __forceinline__ void operator()(const Acc& acc, const Unit& u, int wr, int wc, int fr, int fq) const {
        const int col0 = u.pn * BM + wc * 32 + 8 * fq; const bool doss = (u.pn == ssq_pn);
        PG8_EPI_ROWS( const int row = u.pm * BM + rl; const float r = rs ? rs[row] : 1.f; float ss = 0.f; bf16_t* rowp = O + (size_t)row * ldc + col0;
            _Pragma("unroll") for (int bj = 0; bj < 2; ++bj) { const f32x4 v0 = acc[ai][bj][m][0] * r, v1 = acc[ai][bj][m][1] * r; *(u32x4*)(rowp + bj * HALF) = pack8(v0, v1); ss += dot4(v0) + dot4(v1); }
            if (doss) { ss += __shfl_xor(ss, 16); ss += __shfl_xor(ss, 32); if (fq == 0) cqss[(size_t)row * 4 + wc] = ss; } )
    }
};
constexpr float KV8_SCALE = 8.f; constexpr int KV8_SHIFT = 3;
struct EpiProj8 { static constexpr bool PERM = true;
    unsigned char* O; int ldc; float scale;
    __device__ __forceinline__ void operator()(const Acc& acc, const Unit& u, int wr, int wc, int fr, int fq) const {
        const int col0 = u.pn * BM + wc * 32 + 8 * fq;
        PG8_EPI_ROWS( const int row = u.pm * BM + rl; unsigned char* rowp = O + (size_t)row * ldc + col0;
            _Pragma("unroll") for (int bj = 0; bj < 2; ++bj) *(u32x2*)(rowp + bj * HALF) = pack8_fp8(acc[ai][bj][m][0] * scale, acc[ai][bj][m][1] * scale); )
    }
};
constexpr float QX8_SCALE = 64.f; constexpr int QX8_SHIFT = 6;
template <int NP, bool F8OUT = false> struct EpiNormScale { static constexpr bool PERM = true;
    bf16_t* O; int ldc; const float* part; float inv_dim; float ascale;
    __device__ __forceinline__ void operator()(const Acc& acc, const Unit& u, int wr, int wc, int fr, int fq) const {
        const int col0 = u.pn * BM + wc * 32 + 8 * fq;
        PG8_EPI_ROWS( const int row = u.pm * BM + rl; float s = 0.f;
            _Pragma("unroll") for (int q = 0; q < NP / 4; ++q) s += sum4(*(const f32x4*)(part + (size_t)row * NP + 4 * q));
            const float r = rsqrtf(s * inv_dim + EPS) * ascale;
            if constexpr (F8OUT) { unsigned char* rowp = (unsigned char*)O + (size_t)row * ldc + col0;
                _Pragma("unroll") for (int bj = 0; bj < 2; ++bj) *(u32x2*)(rowp + bj * HALF) = pack8_fp8(acc[ai][bj][m][0] * r, acc[ai][bj][m][1] * r); }
            else { bf16_t* rowp = O + (size_t)row * ldc + col0;
                _Pragma("unroll") for (int bj = 0; bj < 2; ++bj) *(u32x4*)(rowp + bj * HALF) = pack8(acc[ai][bj][m][0] * r, acc[ai][bj][m][1] * r); } )
    }
};
constexpr float X8_SCALE = 8.f; constexpr int X8_SHIFT = 3;
template <bool SRC16, bool X8 = false> struct EpiResid { static constexpr bool PERM = true;
    const float* src; const bf16_t* src16; bf16_t* xb; float* ssq; const float* rinv; unsigned char* x8; float ascale; int pad_;
    __device__ __forceinline__ void operator()(const Acc& acc, const Unit& u, int wr, int wc, int fr, int fq) const {
        const int col0 = u.pn * BM + wc * 32 + 8 * fq;
        PG8_EPI_ROWS( const size_t row = (size_t)u.pm * BM + rl; float ss = 0.f; const size_t off = row * 1024 + col0; const float rsc = (SRC16 && rinv) ? 1.f / rinv[row] : 1.f;
            _Pragma("unroll") for (int bj = 0; bj < 2; ++bj) { f32x4 s0, s1;
                if (SRC16) { const u32x4 w = *(const u32x4*)(src16 + off + bj * HALF); s0 = (f32x4){lo_bf(w.x), hi_bf(w.x), lo_bf(w.y), hi_bf(w.y)} * rsc; s1 = (f32x4){lo_bf(w.z), hi_bf(w.z), lo_bf(w.w), hi_bf(w.w)} * rsc; }
                else { s0 = *(const f32x4*)(src + off + bj * HALF); s1 = *(const f32x4*)(src + off + bj * HALF + 4); }
                const f32x4 v0 = s0 + acc[ai][bj][m][0] * ascale, v1 = s1 + acc[ai][bj][m][1] * ascale;
                *(u32x4*)(xb + off + bj * HALF) = pack8(v0, v1); ss += dot4(v0) + dot4(v1);
                if constexpr (X8) *(u32x2*)(x8 + off + bj * HALF) = pack8_fp8(v0 * X8_SCALE, v1 * X8_SCALE); }
            ss += __shfl_xor(ss, 16); ss += __shfl_xor(ss, 32); if (fq == 0) ssq[row * 16 + u.pn * 4 + wc] = ss; )
    }
};
struct EpiResidF32 { static constexpr bool PERM = true;
    const bf16_t* src16; float* dst; float* ssq; float ascale; int pad_;
    __device__ __forceinline__ void operator()(const Acc& acc, const Unit& u, int wr, int wc, int fr, int fq) const {
        const int col0 = u.pn * BM + wc * 32 + 8 * fq;
        PG8_EPI_ROWS( const size_t row = (size_t)u.pm * BM + rl; float ss = 0.f; const size_t off = row * 1024 + col0;
            _Pragma("unroll") for (int bj = 0; bj < 2; ++bj) { const u32x4 w = *(const u32x4*)(src16 + off + bj * HALF);
                const f32x4 v0 = (f32x4){lo_bf(w.x), hi_bf(w.x), lo_bf(w.y), hi_bf(w.y)} + acc[ai][bj][m][0] * ascale, v1 = (f32x4){lo_bf(w.z), hi_bf(w.z), lo_bf(w.w), hi_bf(w.w)} + acc[ai][bj][m][1] * ascale;
                *(f32x4*)(dst + off + bj * HALF) = v0; *(f32x4*)(dst + off + bj * HALF + 4) = v1; ss += dot4(v0) + dot4(v1); }
            ss += __shfl_xor(ss, 16); ss += __shfl_xor(ss, 32); if (fq == 0) ssq[row * 16 + u.pn * 4 + wc] = ss; )
    }
};
struct EpiFinal { static constexpr bool PERM = true;
    const bf16_t* src16; float* dst; float* part; unsigned* cnt; const float* gain; float ascale; int pad_;
    __device__ __forceinline__ void operator()(Acc& acc, const Unit& u, int wr, int wc, int fr, int fq) const {
        const int col0 = u.pn * BM + wc * 32 + 8 * fq; float asl = ascale; asm volatile("" : "+s"(asl));
        PG8_EPI_ROWS( const size_t row = (size_t)u.pm * BM + rl; float ss = 0.f; const size_t off = row * 1024 + col0;
            _Pragma("unroll") for (int bj = 0; bj < 2; ++bj) { const u32x4 w = *(const u32x4*)(src16 + off + bj * HALF); const f32x4 s0 = {lo_bf(w.x), hi_bf(w.x), lo_bf(w.y), hi_bf(w.y)}, s1 = {lo_bf(w.z), hi_bf(w.z), lo_bf(w.w), hi_bf(w.w)};
                acc[ai][bj][m][0] = acc[ai][bj][m][0] * asl + s0; acc[ai][bj][m][1] = acc[ai][bj][m][1] * asl + s1; ss += dot4(acc[ai][bj][m][0]) + dot4(acc[ai][bj][m][1]); }
            ss += __shfl_xor(ss, 16); ss += __shfl_xor(ss, 32);
            if (fq == 0) __hip_atomic_store(part + row * 16 + u.pn * 4 + wc, ss, __ATOMIC_RELAXED, __HIP_MEMORY_SCOPE_AGENT); )
        asm volatile("s_waitcnt vmcnt(0)" ::: "memory");
        unsigned* c = cnt + 64 * u.pm;
        if ((fr | fq) == 0) __hip_atomic_fetch_add(c, 1u, __ATOMIC_RELAXED, __HIP_MEMORY_SCOPE_AGENT);
        for (unsigned spins = 0; spins < (1u << 22); ++spins) { if ((unsigned)__builtin_amdgcn_readfirstlane(__hip_atomic_load(c, __ATOMIC_RELAXED, __HIP_MEMORY_SCOPE_AGENT)) >= 32u) break; __builtin_amdgcn_s_sleep(4); }
        __builtin_amdgcn_fence(__ATOMIC_ACQUIRE, "agent");
        f32x4 gv[2][2];
        _Pragma("unroll") for (int bj = 0; bj < 2; ++bj) { gv[bj][0] = *(const f32x4*)(gain + col0 + bj * HALF); gv[bj][1] = *(const f32x4*)(gain + col0 + bj * HALF + 4); }
        PG8_EPI_ROWS( const size_t row = (size_t)u.pm * BM + rl; float s = 0.f;
            _Pragma("unroll") for (int q = 0; q < 4; ++q) s += sum4(*(const f32x4*)(part + row * 16 + 4 * q));
            const float r = rsqrtf(s * (1.f / 1024.f) + EPS); const size_t off = row * 1024 + col0;
            _Pragma("unroll") for (int bj = 0; bj < 2; ++bj) { *(f32x4*)(dst + off + bj * HALF) = acc[ai][bj][m][0] * gv[bj][0] * r; *(f32x4*)(dst + off + bj * HALF + 4) = acc[ai][bj][m][1] * gv[bj][1] * r; } )
    }
};
struct EpiExpP { static constexpr bool PERM = true;
    unsigned char* Pb; float* lpart; float ascale; int pad_;
    __device__ __forceinline__ void operator()(const Acc& acc, const Unit& u, int wr, int wc, int fr, int fq) const {
        const int h = (int)(u.ao >> 8), rowbase = u.pm * BM, col0 = wc * 32 + 8 * fq; unsigned char* O = Pb + (size_t)rowbase * 1024 + h * 256;
        PG8_EPI_ROWS( float ss = 0.f; unsigned char* rowp = O + (size_t)rl * 1024 + col0;
            _Pragma("unroll") for (int bj = 0; bj < 2; ++bj) { f32x4 v0 = acc[ai][bj][m][0] * ascale, v1 = acc[ai][bj][m][1] * ascale;
                _Pragma("unroll") for (int e = 0; e < 4; ++e) { v0[e] = __builtin_amdgcn_exp2f(v0[e]); v1[e] = __builtin_amdgcn_exp2f(v1[e]); }
                const u32x2 w = pack8_fp8(v0, v1); *(u32x2*)(rowp + bj * HALF) = w;
                ss += (__builtin_amdgcn_cvt_f32_fp8((int)w.x, 0) + __builtin_amdgcn_cvt_f32_fp8((int)w.x, 1)) + (__builtin_amdgcn_cvt_f32_fp8((int)w.x, 2) + __builtin_amdgcn_cvt_f32_fp8((int)w.x, 3))
                    + (__builtin_amdgcn_cvt_f32_fp8((int)w.y, 0) + __builtin_amdgcn_cvt_f32_fp8((int)w.y, 1)) + (__builtin_amdgcn_cvt_f32_fp8((int)w.y, 2) + __builtin_amdgcn_cvt_f32_fp8((int)w.y, 3)); }
            ss += __shfl_xor(ss, 16); ss += __shfl_xor(ss, 32); if (fq == 0) lpart[(size_t)(rowbase + rl) * 16 + h * 4 + wc] = ss; )
    }
};
constexpr float OX_SCALE = 32.f; constexpr int OX_SHIFT = 5;
struct EpiPV { static constexpr bool PERM = true;
    unsigned char* Ob; const float* lpart; float ascale; int pad_;
    __device__ __forceinline__ void operator()(const Acc& acc, const Unit& u, int wr, int wc, int fr, int fq) const {
        const int h = u.pn, rowbase = u.pm * BM, col0 = wc * 32 + 8 * fq; unsigned char* O = Ob + (size_t)rowbase * 1024 + h * 256;
        PG8_EPI_ROWS( const float r = ascale / sum4(*(const f32x4*)(lpart + (size_t)(rowbase + rl) * 16 + h * 4)); unsigned char* rowp = O + (size_t)rl * 1024 + col0;
            _Pragma("unroll") for (int bj = 0; bj < 2; ++bj) *(u32x2*)(rowp + bj * HALF) = pack8_fp8(acc[ai][bj][m][0] * r, acc[ai][bj][m][1] * r); )
    }
};
constexpr float ACT_SCALE = 16.f; constexpr int ACT_SHIFT = 4;
struct EpiSwiglu { static constexpr bool PERM = true;
    unsigned char* act; const float* part;
    __device__ __forceinline__ void operator()(const Acc& acc, const Unit& u, int wr, int wc, int fr, int fq) const {
        const int col0 = u.pn * BM + wc * 32 + 8 * fq;
        PG8_EPI_ROWS( const size_t row = (size_t)u.pm * BM + rl; float s = 0.f;
            _Pragma("unroll") for (int q = 0; q < 4; ++q) s += sum4(*(const f32x4*)(part + row * 16 + 4 * q));
            const float r = rsqrtf(s * (1.f / 1024.f) + EPS); unsigned char* rowp = act + row * DFF + (col0 >> 1);
            _Pragma("unroll") for (int bj = 0; bj < 2; ++bj) { const f32x4 a = acc[ai][bj][m][0] * r, b = acc[ai][bj][m][1] * r;
                const float o0 = a[0] * __builtin_amdgcn_rcpf(1.f + __builtin_amdgcn_exp2f(-LOG2E * a[0])) * a[1], o1 = a[2] * __builtin_amdgcn_rcpf(1.f + __builtin_amdgcn_exp2f(-LOG2E * a[2])) * a[3];
                const float o2 = b[0] * __builtin_amdgcn_rcpf(1.f + __builtin_amdgcn_exp2f(-LOG2E * b[0])) * b[1], o3 = b[2] * __builtin_amdgcn_rcpf(1.f + __builtin_amdgcn_exp2f(-LOG2E * b[2])) * b[3];
                *(unsigned*)(rowp + bj * (HALF / 2)) = pack4_fp8(o0 * ACT_SCALE, o1 * ACT_SCALE, o2 * ACT_SCALE, o3 * ACT_SCALE); } )
    }
};

template <class Epi, class Sched, bool ALIGN_EPI, int MODE = 0>
__device__ __forceinline__ void gemm_phase(PG8_LAS unsigned char* lds, const Gemm g, const Sched& S, const Epi& E, int wave_id, int tsplit = 0) {
    constexpr bool F8 = (MODE != 0);
    const int tid = wave_id * 64 + lane_now();
    const int wid = __builtin_amdgcn_readfirstlane(tid >> 6), lane = tid & 63, wr = wid >> 2, wc = wid & 3, fr = lane & 15, fq = lane >> 4;
    int Kop = g.K; asm volatile("" : "+s"(Kop));
    constexpr int ES = F8 ? 1 : 2;
    const int nt = Kop * ES / (BK * 2);
    unsigned voffA[2], voffB[2];
#pragma unroll
    for (int i = 0; i < 2; ++i) { int R, C; stage_rc(tid * 16 + i * 8192, R, C); const int Rb = Epi::PERM ? ((R & ~31) + perm32(R & 31)) : R;
        voffA[i] = (unsigned)(R * g.lda * ES + C * 2); voffB[i] = (unsigned)(Rb * g.ldb * ES + C * 2); }
    const size_t kstep = (size_t)(BK * 2);
    const size_t hstepA = (size_t)HALF * g.lda * ES, hstepB = (size_t)HALF * g.ldb * ES;
    const size_t tstepA = 2 * hstepA, tstepB = 2 * hstepB;
    const unsigned ldsw = (unsigned)wid * 1024u;
    const int aoff = lds_byte(wr * 64 + fr, fq * 8), boff = lds_byte(wc * 32 + fr, fq * 8);
#define PG8_SA(b, h) (((b) * 2 + (h)) * HTB)
#define PG8_SB(b, h) ((4 + (b) * 2 + (h)) * HTB)
#define PG8_STAGE(bufoff, gbase, voff, rs) do { _Pragma("unroll") for (int _i = 0; _i < 2; ++_i) { \
        if constexpr (F8) __builtin_amdgcn_raw_ptr_buffer_load_lds(rs, (PG8_LAS void*)(lds + (bufoff) + ldsw + _i * 8192), 16, (int)(voff)[_i], (int)(unsigned)(size_t)(gbase), 0, 0); \
        else __builtin_amdgcn_global_load_lds((const unsigned*)((const char*)(gbase) + (voff)[_i]), (PG8_LAS unsigned*)(lds + (bufoff) + ldsw + _i * 8192), 16, 0, 0); } } while (0)
#define PG8_LDA(dst, b, h) do { _Pragma("unroll") for (int m = 0; m < 4; ++m) _Pragma("unroll") for (int k = 0; k < 2; ++k) dst[m][k] = *(const PG8_LAS bf16x8*)(lds + PG8_SA(b, h) + aoff + m * 2048 + k * 1024); } while (0)
#define PG8_LDB(dst, b, h) do { _Pragma("unroll") for (int n = 0; n < 2; ++n) _Pragma("unroll") for (int k = 0; k < 2; ++k) dst[n][k] = *(const PG8_LAS bf16x8*)(lds + PG8_SB(b, h) + boff + n * 2048 + k * 1024); } while (0)
#define PG8_CAT8(x, y) __builtin_shufflevector(__builtin_bit_cast(i32x4, x), __builtin_bit_cast(i32x4, y), 0, 1, 2, 3, 4, 5, 6, 7)
#define PG8_MMA(ai, bj, At, Bt) do { __builtin_amdgcn_s_setprio(1); _Pragma("unroll") for (int m = 0; m < 4; ++m) _Pragma("unroll") for (int n = 0; n < 2; ++n) { \
        if constexpr (f8now) acc[ai][bj][m][n] = __builtin_amdgcn_mfma_scale_f32_16x16x128_f8f6f4(PG8_CAT8(Bt[n][0], Bt[n][1]), PG8_CAT8(At[m][0], At[m][1]), acc[ai][bj][m][n], 0, 0, 0, 0, 0, 0); \
        else { _Pragma("unroll") for (int k = 0; k < 2; ++k) acc[ai][bj][m][n] = __builtin_amdgcn_mfma_f32_16x16x32_bf16(Bt[n][k], At[m][k], acc[ai][bj][m][n], 0, 0, 0); } } \
        __builtin_amdgcn_s_setprio(0); } while (0)
#define PG8_WAIT_V(n) asm volatile("s_waitcnt vmcnt(" #n ")" ::: "memory")
#define PG8_WAIT_L(n) asm volatile("s_waitcnt lgkmcnt(" #n ")" ::: "memory")
#define PG8_BAR __builtin_amdgcn_s_barrier()
#define PG8_SCHED __builtin_amdgcn_sched_barrier(0)
    Unit cur, nxt; int ui = 0;
    if (!S.next(0, cur)) return;
    Acc acc;
#pragma unroll
    for (int a = 0; a < 2; ++a)
#pragma unroll
        for (int b = 0; b < 2; ++b)
#pragma unroll
            for (int m = 0; m < 4; ++m)
#pragma unroll
                for (int n = 0; n < 2; ++n) acc[a][b][m][n] = (f32x4){0.f, 0.f, 0.f, 0.f};
    bf16x8 At[4][2], B0[2][2], B1[2][2];
    const __amdgpu_buffer_rsrc_t rsA = __builtin_amdgcn_make_buffer_rsrc((void*)g.A, 0, -1, 0x00020000), rsB = __builtin_amdgcn_make_buffer_rsrc((void*)g.Bt, 0, -1, 0x00020000);
    const char* const baseA = F8 ? (const char*)(size_t)0 : (const char*)g.A; const char* const baseB = F8 ? (const char*)(size_t)0 : (const char*)g.Bt;
    const char* cA = baseA + (size_t)cur.pm * tstepA + cur.ao; const char* cB = baseB + (size_t)cur.pn * tstepB + cur.bo;
    PG8_STAGE(PG8_SB(0, 0), cB, voffB, rsB); PG8_STAGE(PG8_SB(0, 1), cB + hstepB, voffB, rsB); PG8_STAGE(PG8_SA(0, 0), cA, voffA, rsA); PG8_STAGE(PG8_SA(0, 1), cA + hstepA, voffA, rsA);
    if (wr == 1) PG8_BAR;
    PG8_WAIT_V(2); PG8_BAR;
    PG8_STAGE(PG8_SB(1, 0), cB + kstep, voffB, rsB); PG8_STAGE(PG8_SA(1, 0), cA + kstep, voffA, rsA); PG8_STAGE(PG8_SB(1, 1), cB + hstepB + kstep, voffB, rsB);
    PG8_WAIT_V(6); PG8_BAR;
    for (;;) {
        const bool has_next = S.next(ui + 1, nxt);
        const char* nA = has_next ? baseA + (size_t)nxt.pm * tstepA + nxt.ao : cA; const char* nB = has_next ? baseB + (size_t)nxt.pn * tstepB + nxt.bo : cB;
#define PG8_KLOOP(T0, T1, F8NOW) for (int t = (T0); t < (T1); t += 2) { \
            const bool last = (t == nt - 2); constexpr bool f8now = (F8NOW); \
            const char* a1 = cA + (size_t)(t + 1) * kstep; \
            const char* a2 = last ? nA : cA + (size_t)(t + 2) * kstep; const char* b2 = last ? nB : cB + (size_t)(t + 2) * kstep; \
            const char* a3 = a2 + kstep; const char* b3 = b2 + kstep; \
              \
            PG8_LDB(B0, 0, 0); PG8_LDB(B1, 0, 1); PG8_SCHED; PG8_LDA(At, 0, 0); PG8_STAGE(PG8_SA(1, 1), a1 + hstepA, voffA, rsA); \
            PG8_WAIT_V(8); PG8_WAIT_L(0); PG8_BAR; PG8_MMA(0, 0, At, B0); PG8_MMA(0, 1, At, B1); PG8_BAR; PG8_SCHED; \
              \
            PG8_LDA(At, 0, 1); PG8_STAGE(PG8_SB(0, 0), b2, voffB, rsB); PG8_STAGE(PG8_SB(0, 1), b2 + hstepB, voffB, rsB); PG8_STAGE(PG8_SA(0, 0), a2, voffA, rsA); \
            PG8_WAIT_V(8); PG8_WAIT_L(0); PG8_BAR; PG8_MMA(1, 0, At, B0); PG8_MMA(1, 1, At, B1); PG8_BAR; PG8_SCHED; \
              \
            PG8_LDB(B0, 1, 0); PG8_LDB(B1, 1, 1); PG8_SCHED; PG8_LDA(At, 1, 0); PG8_STAGE(PG8_SA(0, 1), a2 + hstepA, voffA, rsA); \
            PG8_WAIT_V(8); PG8_WAIT_L(0); PG8_BAR; PG8_MMA(0, 0, At, B0); PG8_MMA(0, 1, At, B1); PG8_BAR; PG8_SCHED; \
              \
            PG8_LDA(At, 1, 1); PG8_STAGE(PG8_SB(1, 0), b3, voffB, rsB); PG8_STAGE(PG8_SB(1, 1), b3 + hstepB, voffB, rsB); PG8_STAGE(PG8_SA(1, 0), a3, voffA, rsA); \
            PG8_WAIT_V(8); PG8_WAIT_L(0); PG8_BAR; PG8_MMA(1, 0, At, B0); PG8_MMA(1, 1, At, B1); PG8_BAR; PG8_SCHED; \
        }
        if constexpr (MODE == 2) { PG8_KLOOP(0, tsplit, false) PG8_KLOOP(tsplit, nt, true) }
        else { PG8_KLOOP(0, nt, (MODE == 1)) }
        if constexpr (ALIGN_EPI) { if (wr == 0) PG8_BAR; }
        { int fr_e = fr, fq_e = fq;
          if constexpr (F8) { const int l_e = lane_now(); fr_e = l_e & 15; fq_e = l_e >> 4; }
          E(acc, cur, wr, wc, fr_e, fq_e); }
        if (!has_next) break;
#pragma unroll
        for (int a = 0; a < 2; ++a)
#pragma unroll
            for (int b = 0; b < 2; ++b)
#pragma unroll
                for (int m = 0; m < 4; ++m)
#pragma unroll
                    for (int n = 0; n < 2; ++n) acc[a][b][m][n] = (f32x4){0.f, 0.f, 0.f, 0.f};
        cur = nxt; cA = nA; cB = nB; ++ui;
        if constexpr (ALIGN_EPI) { if (wr == 1) PG8_BAR; }
    }
    PG8_WAIT_V(0);
    if constexpr (!ALIGN_EPI) { if (wr == 0) PG8_BAR; }
    PG8_BAR;
#undef PG8_SA
#undef PG8_SB
#undef PG8_STAGE
#undef PG8_LDA
#undef PG8_LDB
#undef PG8_MMA
#undef PG8_KLOOP
#undef PG8_CAT8
#undef PG8_WAIT_V
#undef PG8_WAIT_L
#undef PG8_BAR
#undef PG8_SCHED
}
}
constexpr int NWAVES = 8;
constexpr int RING_BYTES = 131072;
constexpr int LDSCTL_OFF = RING_BYTES, MISC_OFF = LDSCTL_OFF + 320;
constexpr int LDS_BYTES = 147456;
#define GAS __attribute__((address_space(1)))
#define LAS __attribute__((address_space(3)))
typedef unsigned v4u __attribute__((ext_vector_type(4)));
typedef float f32x4 __attribute__((ext_vector_type(4)));
typedef GAS unsigned gu32;
#define RLX_AGENT __ATOMIC_RELAXED, __HIP_MEMORY_SCOPE_AGENT
#define LDS_WAIT() asm volatile("s_waitcnt lgkmcnt(0)" ::: "memory")
#define VM_WAIT() asm volatile("s_waitcnt vmcnt(0)" ::: "memory")
__device__ __forceinline__ unsigned pk2(float lo, float hi) { return (unsigned)f2bf(lo) | ((unsigned)f2bf(hi) << 16); }

#define XB_TMO      128
#define XB_XCNT(j)  (256  + 64 * (j))
#define XB_XSUB(j)  (1280 + 64 * (j))
#define XB_XGEN(j)  (2304 + 64 * (j))
#define XB_TOP      3328
#define XB_TOPGEN   3392
#define XCD_BAR_WORDS 3456
#define XB_SPIN_CAP (1u << 18)
__device__ __forceinline__ unsigned xb_ld(unsigned* p)              { return __hip_atomic_load(p, __ATOMIC_RELAXED, __HIP_MEMORY_SCOPE_AGENT); }
__device__ __forceinline__ unsigned xb_add(unsigned* p, unsigned v) { return __hip_atomic_fetch_add(p, v, __ATOMIC_RELAXED, __HIP_MEMORY_SCOPE_AGENT); }
__device__ __forceinline__ unsigned xb_xcc_id() { return (unsigned)__builtin_amdgcn_s_getreg((3 << 11) | 20) & 0xFu; }
#define XB_SPIN(cond, bar) do { unsigned _sp = 0; while (cond) { __builtin_amdgcn_s_sleep(1); \
    if ((++_sp & 255u) == 0u) { if (xb_ld(&(bar)[XB_TMO])) break; if (_sp > XB_SPIN_CAP) { atomicAdd(&(bar)[XB_TMO], 1u); break; } } } } while (0)
struct XcdBarrier { unsigned* bar; unsigned x; volatile LAS unsigned* st; };
__device__ __forceinline__ XcdBarrier xcd_barrier_post(unsigned* bar, volatile LAS unsigned* st) {
    XcdBarrier b; b.bar = bar; b.x = xb_xcc_id(); b.st = st;
    if (threadIdx.x == 0) (void)xb_add(&bar[XB_XCNT(b.x)], 1u);
    return b;
}
__device__ __forceinline__ void xcd_barrier_complete(unsigned* bar, unsigned x, unsigned& nloc, unsigned& nx) {
    const unsigned G = gridDim.x * gridDim.y * gridDim.z;
    unsigned sum, cnt, mine, sp = 0u;
    for (;;) {
        sum = 0u; cnt = 0u; mine = 0u;
#pragma unroll
        for (unsigned j = 0; j < 16; ++j) { const unsigned c = xb_ld(&bar[XB_XCNT(j)]); sum += c; cnt += (c > 0u) ? 1u : 0u; mine = (j == x) ? c : mine; }
        if (sum == G) break;
        __builtin_amdgcn_s_sleep(1);
        if ((++sp & 255u) == 0u) { if (xb_ld(&bar[XB_TMO])) break; if (sp > XB_SPIN_CAP) { atomicAdd(&bar[XB_TMO], 1u); break; } }
    }
    nloc = mine > 0u ? mine : 1u; nx = cnt > 0u ? cnt : 1u;
}
__device__ __forceinline__ void xcd_barrier(const XcdBarrier& b, int wave) {
    asm volatile("s_waitcnt vmcnt(0)" ::: "memory");
    __syncthreads();
    if (wave == 0 && lane_now() == 0) {
        unsigned* bar = b.bar;
        __builtin_amdgcn_s_waitcnt(0);
        unsigned nloc = b.st[0], nx = b.st[1];
        if (nloc == 0u) { xcd_barrier_complete(bar, b.x, nloc, nx); b.st[0] = nloc; b.st[1] = nx; }
        const unsigned old = xb_add(&bar[XB_XSUB(b.x)], 1u);
        const unsigned gen = old / nloc;
        if (old + 1u == (gen + 1u) * nloc) {
            __builtin_amdgcn_fence(__ATOMIC_RELEASE, "agent");
            asm volatile("s_waitcnt vmcnt(0)" ::: "memory");
            const unsigned og = xb_add(&bar[XB_TOP], 1u);
            const unsigned tg = og / nx;
            if (og + 1u == (tg + 1u) * nx) xb_add(&bar[XB_TOPGEN], 1u);
            else XB_SPIN(xb_ld(&bar[XB_TOPGEN]) == tg, bar);
            __builtin_amdgcn_fence(__ATOMIC_ACQUIRE, "agent");
            xb_add(&bar[XB_XGEN(b.x)], 1u);
            asm volatile("s_waitcnt vmcnt(0)" ::: "memory");
        } else {
            XB_SPIN(xb_ld(&bar[XB_XGEN(b.x)]) == gen, bar);
            __builtin_amdgcn_fence(__ATOMIC_ACQUIRE, "agent");
            asm volatile("s_waitcnt vmcnt(0)" ::: "memory");
        }
    }
    __syncthreads();
}

struct SrcWin { const float* w; const float* g;
    __device__ __forceinline__ float at(int k, int n) const {
        int src;
        if (n < 2048) src = n; else if (n < C_CKV) src = 2056 + (n - C_CQ); else if (n < C_KIX) src = 2312 + (n - C_CKV); else if (n < C_WIX) src = 2440 + (n - C_KIX);
        else if (n < C_DB) src = 2504 + (n - C_WIX); else if (n < C_DA) src = 2048 + (n - C_DB); else if (n < 2512) src = 2052 + (n - C_DA); else src = -1;
        return src >= 0 ? w[(size_t)k * PROJ_REF + src] * g[k] : 0.f; } };
struct SrcPlain { const float* w; int ld; const float* g; float cs;
    __device__ __forceinline__ float at(int k, int n) const { return w[(size_t)k * ld + n] * (g ? g[k] : 1.f) * cs; } };
struct SrcQidx { const float* w; const float* g;
    __device__ __forceinline__ float at(int k, int n) const { const int s = n >> 7, head = (n >> 4) & 7, r = n & 15; return w[(size_t)k * 512 + head * 64 + 16 * s + r] * g[k]; } };
struct SrcGU { const float* wg; const float* wu; const float* g;
    __device__ __forceinline__ float at(int k, int n) const { const size_t i = (size_t)k * DFF + (n >> 1); const float a = wg[i], b = wu[i]; return ((n & 1) ? b : a) * g[k]; } };
template <class Src> __device__ __forceinline__ void tr_item(const Src& S, int Nsz, bf16_t* WT, int ldo, int koff, LAS float* scr, int item, int lane, unsigned* amax = nullptr) {
    const int nblk = Nsz / 32, kb = item / nblk, nb = item % nblk, k0 = 64 * kb, n0 = 32 * nb;
    float t[32];
#pragma unroll
    for (int i = 0; i < 32; ++i) t[i] = S.at(k0 + 2 * i + (lane >> 5), n0 + (lane & 31));
    if (amax) { float mx = 0.f;
#pragma unroll
        for (int i = 0; i < 32; ++i) mx = fmaxf(mx, fabsf(t[i]));
#pragma unroll
        for (int o = 1; o < 64; o <<= 1) mx = fmaxf(mx, __shfl_xor(mx, o));
        if (lane == 0) (void)__hip_atomic_fetch_max(amax, __float_as_uint(mx), __ATOMIC_RELAXED, __HIP_MEMORY_SCOPE_AGENT); }
#pragma unroll
    for (int i = 0; i < 32; ++i) scr[(2 * i + (lane >> 5)) * 33 + (lane & 31)] = t[i];
    LDS_WAIT(); asm volatile("" ::: "memory");
    const int c = lane & 7;
#pragma unroll
    for (int j = 0; j < 4; ++j) { const int n = (lane >> 3) + 8 * j; const LAS float* s = scr + (8 * c) * 33 + n;
        v4u o; o.x = pk2(s[0 * 33], s[1 * 33]); o.y = pk2(s[2 * 33], s[3 * 33]); o.z = pk2(s[4 * 33], s[5 * 33]); o.w = pk2(s[6 * 33], s[7 * 33]);
        *(GAS v4u*)(WT + (size_t)(n0 + n) * ldo + koff + k0 + 8 * c) = o; }
    LDS_WAIT(); asm volatile("" ::: "memory");
}
__device__ __forceinline__ void heavy_item(const float* Ap, int lda, const float* Bp, int ldb, const float* cs, float cmul, int k0, int n0, int n0out, bf16_t* WT, int ldo, int koff, LAS float* scr, int lane, unsigned* amax = nullptr) {
    LAS float* At = scr; LAS float* tt = scr + 2048;
#pragma unroll
    for (int i = 0; i < 8; ++i) { const int e = (i * 64 + lane) * 4, r = e >> 6, d = e & 63; *(LAS f32x4*)(At + e) = *(const GAS f32x4*)(Ap + (size_t)(k0 + r) * lda + d); }
    float bc[64];
#pragma unroll
    for (int d = 0; d < 64; ++d) bc[d] = Bp[(size_t)d * ldb + n0 + (lane & 31)];
    LDS_WAIT(); asm volatile("" ::: "memory");
    float hmx = 0.f;
#pragma unroll 2
    for (int i = 0; i < 16; ++i) { const int kk = 2 * i + (lane >> 5); const LAS f32x4* ar = (const LAS f32x4*)(At + kk * 64); float s0 = 0.f, s1 = 0.f;
#pragma unroll
        for (int q = 0; q < 16; q += 2) { const f32x4 a = ar[q], b2 = ar[q + 1]; s0 += a.x * bc[4 * q] + a.y * bc[4 * q + 1] + a.z * bc[4 * q + 2] + a.w * bc[4 * q + 3]; s1 += b2.x * bc[4 * q + 4] + b2.y * bc[4 * q + 5] + b2.z * bc[4 * q + 6] + b2.w * bc[4 * q + 7]; }
        const float tv = (s0 + s1) * (cs ? cs[k0 + kk] : 1.f) * cmul; tt[kk * 33 + (lane & 31)] = tv; hmx = fmaxf(hmx, fabsf(tv)); }
    if (amax) {
#pragma unroll
        for (int o = 1; o < 64; o <<= 1) hmx = fmaxf(hmx, __shfl_xor(hmx, o));
        if (lane == 0) (void)__hip_atomic_fetch_max(amax, __float_as_uint(hmx), __ATOMIC_RELAXED, __HIP_MEMORY_SCOPE_AGENT); }
    LDS_WAIT(); asm volatile("" ::: "memory");
    const int c = lane & 3;
#pragma unroll
    for (int j = 0; j < 2; ++j) { const int n = (lane >> 2) + 16 * j; const LAS float* s = tt + (8 * c) * 33 + n;
        v4u o; o.x = pk2(s[0 * 33], s[1 * 33]); o.y = pk2(s[2 * 33], s[3 * 33]); o.z = pk2(s[4 * 33], s[5 * 33]); o.w = pk2(s[6 * 33], s[7 * 33]);
        *(GAS v4u*)(WT + (size_t)(n0out + n) * ldo + koff + k0 + 8 * c) = o; }
    LDS_WAIT(); asm volatile("" ::: "memory");
}
template <int NR> __device__ __forceinline__ void row_prep(const float* xrow, const float* gain, bf16_t* orow, float* rstd_out, int lane) {
    f32x4 v[NR][4]; float s[NR];
#pragma unroll
    for (int r = 0; r < NR; ++r)
#pragma unroll
        for (int j = 0; j < 4; ++j) v[r][j] = *((const GAS f32x4*)(xrow + (size_t)r * 1024) + lane + 64 * j);
#pragma unroll
    for (int r = 0; r < NR; ++r) { float a = 0.f;
#pragma unroll
        for (int j = 0; j < 4; ++j) a += (v[r][j].x * v[r][j].x + v[r][j].y * v[r][j].y) + (v[r][j].z * v[r][j].z + v[r][j].w * v[r][j].w);
        s[r] = a; }
#pragma unroll
    for (int r = 0; r < NR; ++r) { const float rstd = rsqrtf(wave_sum(s[r]) * (1.f / 1024.f) + EPS);
        if (rstd_out && lane == 0) rstd_out[r] = rstd;
        GAS unsigned long long* o8 = (GAS unsigned long long*)(orow + (size_t)r * 1024) + lane;
#pragma unroll
        for (int j = 0; j < 4; ++j) { f32x4 a = v[r][j];
            if (gain) { const f32x4 gg = *((const GAS f32x4*)gain + lane + 64 * j); a = a * gg * rstd; } else a = a * rstd;
            o8[64 * j] = (unsigned long long)pk2(a.x, a.y) | ((unsigned long long)pk2(a.z, a.w) << 32); } }
}
__device__ __forceinline__ void cvt_w8(const bf16_t* src, unsigned char* dst, int n16, unsigned amax_bits, int gtid, int nthr) {
    const float sc = pg8::w8_scale(amax_bits);
    for (int i = gtid; i < n16; i += nthr) { const v4u a = *((const GAS v4u*)src + 2 * i), b = *((const GAS v4u*)src + 2 * i + 1); v4u o;
        o.x = pg8::pack4_fp8(pg8::lo_bf(a.x) * sc, pg8::hi_bf(a.x) * sc, pg8::lo_bf(a.y) * sc, pg8::hi_bf(a.y) * sc); o.y = pg8::pack4_fp8(pg8::lo_bf(a.z) * sc, pg8::hi_bf(a.z) * sc, pg8::lo_bf(a.w) * sc, pg8::hi_bf(a.w) * sc);
        o.z = pg8::pack4_fp8(pg8::lo_bf(b.x) * sc, pg8::hi_bf(b.x) * sc, pg8::lo_bf(b.y) * sc, pg8::hi_bf(b.y) * sc); o.w = pg8::pack4_fp8(pg8::lo_bf(b.z) * sc, pg8::hi_bf(b.z) * sc, pg8::lo_bf(b.w) * sc, pg8::hi_bf(b.w) * sc);
        *((GAS v4u*)dst + i) = o; }
}
__device__ __forceinline__ void cvt_wout8(const bf16_t* src, unsigned char* dst, unsigned amax_bits, int gtid, int nthr) {
    const float sW = pg8::w8_scale(amax_bits), S = sW * OLAT_SCALE;
    for (int i = gtid; i < 1024 * 96; i += nthr) { const int n = i / 96, c = i - n * 96;
        const v4u a = *((const GAS v4u*)(src + (size_t)n * MIXK + 16 * c)), b = *((const GAS v4u*)(src + (size_t)n * MIXK + 16 * c) + 1);
        if (c < 32) { v4u o, o2;
            o.x = pg8::cvt_pk_bf16(pg8::lo_bf(a.x) * S, pg8::hi_bf(a.x) * S); o.y = pg8::cvt_pk_bf16(pg8::lo_bf(a.y) * S, pg8::hi_bf(a.y) * S); o.z = pg8::cvt_pk_bf16(pg8::lo_bf(a.z) * S, pg8::hi_bf(a.z) * S); o.w = pg8::cvt_pk_bf16(pg8::lo_bf(a.w) * S, pg8::hi_bf(a.w) * S);
            o2.x = pg8::cvt_pk_bf16(pg8::lo_bf(b.x) * S, pg8::hi_bf(b.x) * S); o2.y = pg8::cvt_pk_bf16(pg8::lo_bf(b.y) * S, pg8::hi_bf(b.y) * S); o2.z = pg8::cvt_pk_bf16(pg8::lo_bf(b.z) * S, pg8::hi_bf(b.z) * S); o2.w = pg8::cvt_pk_bf16(pg8::lo_bf(b.w) * S, pg8::hi_bf(b.w) * S);
            GAS v4u* d = (GAS v4u*)(dst + (size_t)n * MIXB + 32 * c); d[0] = o; d[1] = o2; }
        else { v4u o;
            o.x = pg8::pack4_fp8(pg8::lo_bf(a.x) * sW, pg8::hi_bf(a.x) * sW, pg8::lo_bf(a.y) * sW, pg8::hi_bf(a.y) * sW); o.y = pg8::pack4_fp8(pg8::lo_bf(a.z) * sW, pg8::hi_bf(a.z) * sW, pg8::lo_bf(a.w) * sW, pg8::hi_bf(a.w) * sW);
            o.z = pg8::pack4_fp8(pg8::lo_bf(b.x) * sW, pg8::hi_bf(b.x) * sW, pg8::lo_bf(b.y) * sW, pg8::hi_bf(b.y) * sW); o.w = pg8::pack4_fp8(pg8::lo_bf(b.z) * sW, pg8::hi_bf(b.z) * sW, pg8::lo_bf(b.w) * sW, pg8::hi_bf(b.w) * sW);
            *(GAS v4u*)(dst + (size_t)n * MIXB + 1024 + 16 * (c - 32)) = o; } }
}
namespace dsa {
typedef short bf16x8 __attribute__((ext_vector_type(8)));
typedef short s16x4 __attribute__((ext_vector_type(4)));
typedef float f32x16 __attribute__((ext_vector_type(16)));
typedef float f32x4 __attribute__((ext_vector_type(4)));
typedef unsigned u32x4 __attribute__((ext_vector_type(4)));
typedef unsigned short u16x4 __attribute__((ext_vector_type(4)));
constexpr int HIST_OFF = 145152;
constexpr int SC_OFF = 0, LIST_OFF = 132096, BIAS_OFF = 140288, W_OFF = 144416, NSEL_OFF = 144928, BMAX_OFF = 144992, CMAX_OFF = 145024;
__device__ __forceinline__ int xsw(int rr) { return rr < 8 ? 2 * rr : 2 * ((rr + 4) & 7) + 1; }
typedef float cvf32x2_t __attribute__((ext_vector_type(2))); typedef __bf16 cvbf16x2_t __attribute__((ext_vector_type(2)));
__device__ __forceinline__ unsigned cvtpk(float lo, float hi) { cvf32x2_t v = {lo, hi}; return __builtin_bit_cast(unsigned, __builtin_convertvector(v, cvbf16x2_t)); }
__device__ __forceinline__ int mbcnt64(unsigned long long m) { return (int)__builtin_amdgcn_mbcnt_hi((unsigned)(m >> 32), __builtin_amdgcn_mbcnt_lo((unsigned)m, 0u)); }

__device__ __forceinline__ void phase_init(LAS unsigned char* lds, const float* biastab, const float* kvg, int tid) {
    LAS float* bt = (LAS float*)(lds + BIAS_OFF);
    for (int i = tid; i < 129 * 8; i += 512) bt[i] = biastab[i];
    if (tid < 64) { float m = fmaxf(fabsf(kvg[tid]), fabsf(kvg[tid + 64]));
#pragma unroll
        for (int o = 1; o < 64; o <<= 1) m = fmaxf(m, __shfl_xor(m, o));
        if (tid == 0) *(LAS float*)(lds + CMAX_OFF) = m * 11.313708499f * 1.01f; }
    __syncthreads();
    if (tid < 8) { float m = -1e30f; for (int d = 0; d < 129; ++d) m = fmaxf(m, bt[d * 8 + tid]); ((LAS float*)(lds + BMAX_OFF))[tid] = m; }
    __syncthreads();
}

__device__ __forceinline__ void scores(LAS unsigned char* lds, int b, int q0, const bf16_t* qabs, const bf16_t* kidx, int wave, int lane) {
    const int hi = lane >> 5, c32 = lane & 31;
    const int a_ = c32 >> 3, hp = (c32 >> 2) & 1, r3 = c32 & 3;
    const int head = 4 * (a_ & 1) + r3, qt = 2 * hp + (a_ >> 1);
    bf16x8 A[4][4];
#pragma unroll
    for (int rt = 0; rt < 4; ++rt)
#pragma unroll
        for (int s = 0; s < 4; ++s) A[rt][s] = *(const bf16x8*)(qabs + (size_t)(b * 2048 + q0 + 4 * rt + qt) * 1536 + 1024 + s * 128 + head * 16 + 8 * hi);
    const int nkt = (q0 + 16 + 31) >> 5;
    LAS float* SC = (LAS float*)(lds + SC_OFF); const LAS float* Wl = (const LAS float*)(lds + W_OFF);
    bf16x8 Bn[4];
    { const bf16_t* kr = kidx + (size_t)(b * 2048 + (wave < nkt ? wave : 0) * 32 + c32) * 64 + 8 * hi;
#pragma unroll
      for (int s = 0; s < 4; ++s) Bn[s] = *(const bf16x8*)(kr + 16 * s); }
    __syncthreads();
    for (int kt = wave; kt < nkt; kt += 8) {
        bf16x8 B[4];
#pragma unroll
        for (int s = 0; s < 4; ++s) B[s] = Bn[s];
        if (kt + 8 < nkt) { const bf16_t* kr = kidx + (size_t)(b * 2048 + (kt + 8) * 32 + c32) * 64 + 8 * hi;
#pragma unroll
            for (int s = 0; s < 4; ++s) Bn[s] = *(const bf16x8*)(kr + 16 * s); }
        const int key = kt * 32 + c32;
        f32x16 acc[4];
#pragma unroll
        for (int rt = 0; rt < 4; ++rt) acc[rt] = (f32x16){0.f, 0.f, 0.f, 0.f, 0.f, 0.f, 0.f, 0.f, 0.f, 0.f, 0.f, 0.f, 0.f, 0.f, 0.f, 0.f};
#pragma unroll
        for (int s = 0; s < 4; ++s)
#pragma unroll
            for (int rt = 0; rt < 4; ++rt) acc[rt] = __builtin_amdgcn_mfma_f32_32x32x16_bf16(A[rt][s], B[s], acc[rt], 0, 0, 0);
        f32x4 wv[4][4];
#pragma unroll
        for (int rt = 0; rt < 4; ++rt) { const LAS f32x4* wp = (const LAS f32x4*)(Wl + (4 * rt + 2 * hi) * 8);
#pragma unroll
            for (int q = 0; q < 4; ++q) wv[rt][q] = wp[q]; }
#pragma unroll
        for (int rt = 0; rt < 4; ++rt) {
            const f32x4 w0 = wv[rt][0], w1 = wv[rt][1], w2 = wv[rt][2], w3 = wv[rt][3]; const f32x16 a = acc[rt];
            float s0 = w0.x * fmaxf(a[0], 0.f); s0 += w0.y * fmaxf(a[1], 0.f); s0 += w0.z * fmaxf(a[2], 0.f); s0 += w0.w * fmaxf(a[3], 0.f);
            s0 += w1.x * fmaxf(a[4], 0.f); s0 += w1.y * fmaxf(a[5], 0.f); s0 += w1.z * fmaxf(a[6], 0.f); s0 += w1.w * fmaxf(a[7], 0.f);
            float s1 = w2.x * fmaxf(a[8], 0.f); s1 += w2.y * fmaxf(a[9], 0.f); s1 += w2.z * fmaxf(a[10], 0.f); s1 += w2.w * fmaxf(a[11], 0.f);
            s1 += w3.x * fmaxf(a[12], 0.f); s1 += w3.y * fmaxf(a[13], 0.f); s1 += w3.z * fmaxf(a[14], 0.f); s1 += w3.w * fmaxf(a[15], 0.f);
            const int ql = 4 * rt + 2 * hi, t0 = q0 + ql;
            SC[ql * 2048 + key] = key <= t0 ? s0 : -INFINITY; SC[(ql + 1) * 2048 + key] = key <= t0 + 1 ? s1 : -INFINITY;
        }
    }
}
__device__ __forceinline__ void topk(LAS unsigned char* lds, int q0, int qq, int lane) {
    const int t = q0 + qq, n = t + 1;
    LAS unsigned short* list = (LAS unsigned short*)(lds + LIST_OFF) + qq * 256; LAS int* nsel = (LAS int*)(lds + NSEL_OFF);
    if (n <= 256) { for (int i = lane; i < 256; i += 64) list[i] = (unsigned short)(i < n ? i : t); if (lane == 0) nsel[qq] = n; return; }
    const int nk = ((q0 + 16 + 31) >> 5) * 32;
    const LAS float* SC = (const LAS float*)(lds + SC_OFF) + qq * 2048;
    unsigned u[32];
#pragma unroll
    for (int j = 0; j < 32; ++j) { const int key = lane + 64 * j; unsigned v = 0u; if (key < nk) { const unsigned bts = __float_as_uint(SC[key]); v = (bts & 0x80000000u) ? ~bts : (bts | 0x80000000u); } u[j] = v; }
    unsigned tau = 0u;
    for (int bit = 31; bit >= 0; --bit) {
        const unsigned cand = tau | (1u << bit); int cnt = 0;
#pragma unroll
        for (int j = 0; j < 32; ++j) cnt += __popcll(__ballot(u[j] >= cand));
        if (cnt >= 256) tau = cand;
        if (cnt == 256) break;
    }
    int cgt = 0;
#pragma unroll
    for (int j = 0; j < 32; ++j) cgt += __popcll(__ballot(u[j] > tau));
    const int r = 256 - cgt; int base = 0, eqb = 0;
#pragma unroll
    for (int j = 0; j < 32; ++j) {
        const bool gt = u[j] > tau, eq = u[j] == tau; const unsigned long long em = __ballot(eq);
        const bool sel = gt || (eq && (eqb + mbcnt64(em)) < r); const unsigned long long sm = __ballot(sel);
        if (sel) list[base + mbcnt64(sm)] = (unsigned short)(lane + 64 * j);
        base += __popcll(sm); eqb += __popcll(em);
    }
    if (lane == 0) nsel[qq] = 256;
}
__device__ __forceinline__ int wave_scan_incl(int x) {
    x += __builtin_amdgcn_update_dpp(0, x, 0x111, 0xF, 0xF, true);
    x += __builtin_amdgcn_update_dpp(0, x, 0x112, 0xF, 0xF, true);
    x += __builtin_amdgcn_update_dpp(0, x, 0x114, 0xF, 0xF, true);
    x += __builtin_amdgcn_update_dpp(0, x, 0x118, 0xF, 0xF, true);
    x += __builtin_amdgcn_update_dpp(0, x, 0x142, 0xA, 0xF, false);
    x += __builtin_amdgcn_update_dpp(0, x, 0x143, 0xC, 0xF, false);
    return x;
}
#define DPP_F32(v, CTRL) __int_as_float(__builtin_amdgcn_update_dpp(0, __float_as_int(v), (CTRL), 0xF, 0xF, true))
__device__ __forceinline__ float wave_max(float v) {
    v = fmaxf(v, DPP_F32(v, 0xB1)); v = fmaxf(v, DPP_F32(v, 0x4E)); v = fmaxf(v, DPP_F32(v, 0x141)); v = fmaxf(v, DPP_F32(v, 0x140));
    const int b = __float_as_int(v);
    return fmaxf(fmaxf(__int_as_float(__builtin_amdgcn_readlane(b, 0)), __int_as_float(__builtin_amdgcn_readlane(b, 16))), fmaxf(__int_as_float(__builtin_amdgcn_readlane(b, 32)), __int_as_float(__builtin_amdgcn_readlane(b, 48))));
}
__device__ __forceinline__ float wave_min(float v) {
    v = fminf(v, DPP_F32(v, 0xB1)); v = fminf(v, DPP_F32(v, 0x4E)); v = fminf(v, DPP_F32(v, 0x141)); v = fminf(v, DPP_F32(v, 0x140));
    const int b = __float_as_int(v);
    return fminf(fminf(__int_as_float(__builtin_amdgcn_readlane(b, 0)), __int_as_float(__builtin_amdgcn_readlane(b, 16))), fminf(__int_as_float(__builtin_amdgcn_readlane(b, 32)), __int_as_float(__builtin_amdgcn_readlane(b, 48))));
}
__device__ __forceinline__ void topk3(LAS unsigned char* lds, int q0, int qq, int wave, int lane, unsigned* dbg_flag_g = nullptr) {
    const int t = q0 + qq, n = t + 1;
    LAS unsigned short* list = (LAS unsigned short*)(lds + LIST_OFF) + qq * 256; LAS int* nsel = (LAS int*)(lds + NSEL_OFF);
    if (n <= 256) { for (int i = lane; i < 256; i += 64) list[i] = (unsigned short)(i < n ? i : t); if (lane == 0) nsel[qq] = n; return; }
    const int nk = ((q0 + 16 + 31) >> 5) * 32;
    LAS float* SC = (LAS float*)(lds + SC_OFF) + qq * 2048;
    LAS unsigned char* H = (LAS unsigned char*)SC;
    float v[32]; float hi = -INFINITY;
#pragma unroll
    for (int j = 0; j < 8; ++j) { f32x4 x = {-INFINITY, -INFINITY, -INFINITY, -INFINITY}; if (256 * j + 4 * lane < nk) x = *(const LAS f32x4*)(SC + 256 * j + 4 * lane);
#pragma unroll
        for (int e = 0; e < 4; ++e) { v[4 * j + e] = x[e]; hi = fmaxf(hi, x[e]); } }
    const float lo = wave_min(fminf(fminf(v[0], v[1]), fminf(v[2], v[3])));
    hi = wave_max(hi);
    const float sc = 8191.f / (hi - lo), off = __builtin_fmaf(-lo, sc, 0.25f);
    bool ok = (hi - lo) > 1e-30f && __builtin_fmaf(hi, sc, off) < 8191.9f && __builtin_fmaf(hi, sc, off) > 8190.f;
    unsigned B4 = 0u; int need2 = 0, ncand = 0;
    if (ok) {
        asm volatile("" ::: "memory");
        const u32x4 z4 = {0u, 0u, 0u, 0u};
#pragma unroll
        for (int j = 0; j < 8; ++j) *(LAS u32x4*)(H + 1024 * j + 16 * lane) = z4;
        asm volatile("" ::: "memory");
#pragma unroll
        for (int j = 0; j < 8; ++j) if (256 * j < nk) {
#pragma unroll
            for (int e = 0; e < 4; ++e) { const unsigned b = (unsigned)__builtin_fmaf(v[4 * j + e], sc, off); (void)__hip_atomic_fetch_add((LAS unsigned*)(H + (b & 0x1FFCu)), 1u, __ATOMIC_RELAXED, __HIP_MEMORY_SCOPE_WORKGROUP); } }
        asm volatile("" ::: "memory");
        const unsigned x4 = 4u * (unsigned)(lane & 31), hb = 128u * (unsigned)lane; int c[32];
#pragma unroll
        for (int k = 0; k < 32; ++k) c[k] = *(const LAS int*)(H + hb + (x4 ^ (4u * k)));
        __builtin_amdgcn_sched_barrier(0);
        int s = 0;
#pragma unroll
        for (int k = 0; k < 32; ++k) s += c[k];
        const int incl = wave_scan_incl(s), tot = __builtin_amdgcn_readlane(incl, 63), suf = tot - incl + s;
        const unsigned long long m = __ballot(suf >= 256); const int L = 63 - __builtin_clzll(m);
        const int aboveL = (L < 63) ? __builtin_amdgcn_readlane(suf, (L + 1) & 63) : 0; const int need1 = 256 - aboveL;
        const int cj = lane < 32 ? *(const LAS int*)(H + 128 * L + 4 * lane) : 0;
        const int incl2 = wave_scan_incl(cj), tot2 = __builtin_amdgcn_readlane(incl2, 63), suf2 = tot2 - incl2 + cj;
        const unsigned long long m2 = __ballot(lane < 32 && suf2 >= need1); const int J = 63 - __builtin_clzll(m2);
        const int above2 = (J < 31) ? __builtin_amdgcn_readlane(suf2, (J + 1) & 63) : 0; need2 = need1 - above2; ncand = __builtin_amdgcn_readlane(cj, J);
        B4 = (unsigned)(32 * L + J) * 4u;
        ok = (m != 0ull) && (m2 != 0ull) && (B4 > 0u) && (ncand <= 64);
    }
#ifdef DSA_FALLBACK_COUNT
    if (!ok && lane == 0) atomicAdd(dbg_flag_g + 64, 1u);
#endif
    if (!ok) {
        asm volatile("" ::: "memory");
#pragma unroll
        for (int j = 0; j < 8; ++j) if (256 * j + 4 * lane < nk) *(LAS f32x4*)(SC + 256 * j + 4 * lane) = (f32x4){v[4 * j], v[4 * j + 1], v[4 * j + 2], v[4 * j + 3]};
        asm volatile("" ::: "memory");
        topk(lds, q0, qq, lane); return; }
    LAS float* cv = (LAS float*)list; LAS unsigned short* ck = list + 128;
    int base = 0;
#pragma unroll
    for (int j = 0; j < 8; ++j) if (256 * j < nk) {
        bool isc[4];
#pragma unroll
        for (int e = 0; e < 4; ++e) { const unsigned b = (unsigned)__builtin_fmaf(v[4 * j + e], sc, off); isc[e] = (b & 0x1FFCu) == B4; }
        if (__ballot(isc[0] || isc[1] || isc[2] || isc[3])) {
#pragma unroll
            for (int e = 0; e < 4; ++e) { const unsigned long long cm = __ballot(isc[e]);
                if (isc[e]) { const int pos = base + mbcnt64(cm); cv[pos] = v[4 * j + e]; ck[pos] = (unsigned short)(256 * j + 4 * lane + e); } base += __popcll(cm); } } }
    const float myv = lane < ncand ? cv[lane] : -INFINITY; const int myk = lane < ncand ? (int)ck[lane] : 0x7fffffff; int rank = 0;
    for (int k = 0; k < ncand; ++k) { const float vk = __int_as_float(__builtin_amdgcn_readlane(__float_as_int(myv), k)); const int kk = __builtin_amdgcn_readlane(myk, k); rank += (vk > myv || (vk == myv && kk < myk)) ? 1 : 0; }
    const unsigned long long lm = __ballot(lane < ncand && rank == need2 - 1); const int ll = (int)__builtin_ctzll(lm);
    const float tauv = __int_as_float(__builtin_amdgcn_readlane(__float_as_int(myv), ll)); const int tauk = __builtin_amdgcn_readlane(myk, ll);
    int ngt = 0;
    LAS unsigned short* const dp = (LAS unsigned short*)(lds + HIST_OFF) + wave * 64 + lane;
#pragma unroll
    for (int j = 0; j < 8; ++j) if (256 * j < nk) {
        bool sel[4]; int c = 0;
#pragma unroll
        for (int e = 0; e < 4; ++e) { sel[e] = v[4 * j + e] > tauv; c += sel[e] ? 1 : 0; }
        const int incl3 = wave_scan_incl(c);
        LAS unsigned short* lp = list + ngt + (incl3 - c);
#pragma unroll
        for (int e = 0; e < 4; ++e) { LAS unsigned short* p = sel[e] ? lp : dp; *p = (unsigned short)(256 * j + 4 * lane + e); lp += sel[e] ? 1 : 0; }
        ngt += __builtin_amdgcn_readlane(incl3, 63); }
    const bool csel = lane < ncand && myv == tauv && myk <= tauk; const unsigned long long sm = __ballot(csel);
    if (csel) list[ngt + mbcnt64(sm)] = (unsigned short)myk;
    if (lane == 0) nsel[qq] = 256;
#ifdef DSA_S2_RESTORE
    asm volatile("" ::: "memory");
#pragma unroll
    for (int j = 0; j < 8; ++j) if (256 * j + 4 * lane < nk) *(LAS f32x4*)(SC + 256 * j + 4 * lane) = (f32x4){v[4 * j], v[4 * j + 1], v[4 * j + 2], v[4 * j + 3]};
    asm volatile("" ::: "memory");
#endif
}
__device__ __forceinline__ void attend2(LAS unsigned char* lds, int b, int q0, int wave, int lane, const bf16_t* qabs, const bf16_t* ckv, unsigned char* mix) {
    const int r16 = lane & 15, g = lane >> 4;
    LAS unsigned char* buf0 = lds + wave * 16384; LAS unsigned char* buf1 = buf0 + 8192;
    const LAS unsigned short* listw = (const LAS unsigned short*)(lds + LIST_OFF) + (2 * wave) * 256;
    const LAS float* biasT = (const LAS float*)(lds + BIAS_OFF);
    const int n0 = ((const LAS int*)(lds + NSEL_OFF))[2 * wave], n1 = ((const LAS int*)(lds + NSEL_OFF))[2 * wave + 1];
    const int ns0 = (n0 + 31) >> 5, total = ns0 + ((n1 + 31) >> 5);
    const float cmax = *(const LAS float*)(lds + CMAX_OFF), bmax = ((const LAS float*)(lds + BMAX_OFF))[r16 & 7];
    const int xr = xsw(r16);
    const int q4 = r16 >> 2, p4 = r16 & 3; const int rra = 4 * g + q4, rrb = 16 + 4 * g + q4; const int xa = xsw(rra & 15), xb = xsw(rrb & 15);
    int t = 0, n = 0; size_t row = 0; const LAS unsigned short* list = listw; bf16x8 QB[4]; float Mh = 0.f, lsum = 0.f; f32x4 O[8];
    u32x4 X[8], Y[8];
#define DSA_LOAD(ST, kk) do { if ((kk) < total) { const int sel_ = (kk) >= ns0 ? 1 : 0; const LAS unsigned short* lp_ = listw + sel_ * 256 + ((kk) - (sel_ ? ns0 : 0)) * 32; \
        _Pragma("unroll") for (int i_ = 0; i_ < 8; ++i_) { const int rr_ = 4 * i_ + g; const int idx_ = lp_[rr_]; ST[i_] = *(const u32x4*)(ckv + ((size_t)b * 2048 + idx_) * 128 + (r16 ^ xsw(rr_ & 15)) * 8); } } } while (0)
#define DSA_WRITE(ST, bufp) do { _Pragma("unroll") for (int i_ = 0; i_ < 8; ++i_) *(LAS u32x4*)((bufp) + (4 * i_ + g) * 256 + r16 * 16) = ST[i_]; } while (0)
#define DSA_INIT(qq_) do { t = q0 + (qq_); row = (size_t)b * 2048 + t; n = ((qq_) & 1) ? n1 : n0; list = listw + ((qq_) & 1) * 256; float qn2_ = 0.f; \
        _Pragma("unroll") for (int s_ = 0; s_ < 4; ++s_) { bf16x8 v_ = {0, 0, 0, 0, 0, 0, 0, 0}; if (r16 < 8) v_ = *(const bf16x8*)(qabs + row * 1536 + s_ * 256 + r16 * 32 + 8 * g); QB[s_] = v_; \
            _Pragma("unroll") for (int e_ = 0; e_ < 8; ++e_) { const float f_ = bf2f((bf16_t)v_[e_]); qn2_ += f_ * f_; } } \
        qn2_ += __shfl_xor(qn2_, 16); qn2_ += __shfl_xor(qn2_, 32); Mh = sqrtf(qn2_) * cmax + bmax; lsum = 0.f; \
        _Pragma("unroll") for (int dt_ = 0; dt_ < 8; ++dt_) O[dt_] = (f32x4){0.f, 0.f, 0.f, 0.f}; } while (0)
#define DSA_FINAL() do { float l_ = lsum; l_ += __shfl_xor(l_, 16); l_ += __shfl_xor(l_, 32); const float linv_ = OLAT_SCALE / l_; \
        _Pragma("unroll") for (int e_ = 0; e_ < 4; ++e_) { const int hrow_ = (4 * g + e_) & 7; const float inv_ = __shfl(linv_, hrow_); \
            if (g < 2) { _Pragma("unroll") for (int dt_ = 0; dt_ < 8; ++dt_) { const float ov_ = __builtin_amdgcn_fmed3f(O[dt_][e_] * inv_, -448.f, 448.f); \
                mix[row * MIXB + 1024 + hrow_ * 128 + 16 * dt_ + r16] = (unsigned char)__builtin_amdgcn_cvt_pk_fp8_f32(ov_, ov_, 0, false); } } } } while (0)
#define DSA_COMPUTE(kk, buf) do { if ((kk) == ns0) { DSA_FINAL(); DSA_INIT(2 * wave + 1); } const int step = (kk) >= ns0 ? (kk) - ns0 : (kk); \
          \
        bf16x8 af_[2][4]; \
        _Pragma("unroll") for (int G = 0; G < 2; ++G) _Pragma("unroll") for (int s = 0; s < 4; ++s) af_[G][s] = *(const LAS bf16x8*)((buf) + (16 * G + r16) * 256 + (((4 * s + g) ^ xr) * 16)); \
        const int pb0_ = step * 32 + 4 * g; const u16x4 ida_ = *(const LAS u16x4*)(list + pb0_), idb_ = *(const LAS u16x4*)(list + pb0_ + 16); \
        s16x4 tlo_[8], thi_[8]; \
        _Pragma("unroll") for (int dt = 0; dt < 8; ++dt) { const int ch = 2 * dt + (p4 >> 1); \
            tlo_[dt] = __builtin_bit_cast(s16x4, __builtin_amdgcn_ds_read_tr16_b64_v4i16((LAS s16x4*)((buf) + rra * 256 + ((ch ^ xa) * 16) + 8 * (p4 & 1)))); \
            thi_[dt] = __builtin_bit_cast(s16x4, __builtin_amdgcn_ds_read_tr16_b64_v4i16((LAS s16x4*)((buf) + rrb * 256 + ((ch ^ xb) * 16) + 8 * (p4 & 1)))); } \
        float bz_[2][4]; \
        _Pragma("unroll") for (int e = 0; e < 4; ++e) { int d0_ = t - (int)ida_[e]; d0_ = d0_ < 128 ? d0_ : 128; d0_ = d0_ < 0 ? 0 : d0_; int d1_ = t - (int)idb_[e]; d1_ = d1_ < 128 ? d1_ : 128; d1_ = d1_ < 0 ? 0 : d1_; \
            bz_[0][e] = biasT[d0_ * 8 + (r16 & 7)]; bz_[1][e] = biasT[d1_ * 8 + (r16 & 7)]; } \
        f32x4 S_[2]; \
        _Pragma("unroll") for (int G = 0; G < 2; ++G) { f32x4 acc = {0.f, 0.f, 0.f, 0.f}; \
            _Pragma("unroll") for (int s = 0; s < 4; ++s) acc = __builtin_amdgcn_mfma_f32_16x16x32_bf16(af_[G][s], QB[s], acc, 0, 0, 0); \
            S_[G] = acc; } \
        float P_[2][4]; \
        _Pragma("unroll") for (int G = 0; G < 2; ++G) _Pragma("unroll") for (int e = 0; e < 4; ++e) { const float lg = S_[G][e] + bz_[G][e] - Mh; \
                const float pv = (pb0_ + 16 * G + e < n) ? __builtin_amdgcn_exp2f(lg) : 0.f; lsum += pv; P_[G][e] = pv; } \
        u32x4 pw; pw.x = cvtpk(P_[0][0], P_[0][1]); pw.y = cvtpk(P_[0][2], P_[0][3]); pw.z = cvtpk(P_[1][0], P_[1][1]); pw.w = cvtpk(P_[1][2], P_[1][3]); \
        const bf16x8 PA = __builtin_bit_cast(bf16x8, pw); \
        _Pragma("unroll") for (int dt = 0; dt < 8; ++dt) { const bf16x8 vb = {tlo_[dt][0], tlo_[dt][1], tlo_[dt][2], tlo_[dt][3], thi_[dt][0], thi_[dt][1], thi_[dt][2], thi_[dt][3]}; \
            O[dt] = __builtin_amdgcn_mfma_f32_16x16x32_bf16(PA, vb, O[dt], 0, 0, 0); } } while (0)
    DSA_LOAD(X, 0); DSA_LOAD(Y, 1);
    __syncthreads();
    DSA_INIT(2 * wave);
    DSA_WRITE(X, buf0); DSA_LOAD(X, 2);
    if (1 < total) { DSA_WRITE(Y, buf1); DSA_LOAD(Y, 3); }
    for (int k = 0; k < total; k += 2) {
        DSA_COMPUTE(k, buf0);
        if (k + 2 < total) { DSA_WRITE(X, buf0); DSA_LOAD(X, k + 4); }
        if (k + 1 < total) { DSA_COMPUTE(k + 1, buf1); if (k + 3 < total) { DSA_WRITE(Y, buf1); DSA_LOAD(Y, k + 5); } }
    }
    DSA_FINAL();
#undef DSA_LOAD
#undef DSA_WRITE
#undef DSA_INIT
#undef DSA_FINAL
#undef DSA_COMPUTE
}
__device__ __forceinline__ void unit(LAS unsigned char* lds, int b, int q0, int tid, int wave, int lane, const bf16_t* qabs, const bf16_t* ckv, const bf16_t* kidx, const float* widx, unsigned char* mix, unsigned* dbg_flag) {
    asm volatile("" : "+v"(tid));
    lane = tid & 63;
    if (tid < 128) ((LAS float*)(lds + W_OFF))[tid] = widx[(size_t)(b * 2048 + q0) * 8 + tid];
#ifndef DSA_REP_S1
#define DSA_REP_S1 1
#define DSA_REP_S2 1
#define DSA_REP_S3 1
#endif
    if (q0 + 16 > 256) { for (int rp = 0; rp < DSA_REP_S1; ++rp) { scores(lds, b, q0, qabs, kidx, wave, lane); __syncthreads(); } }
    else __syncthreads();
    asm volatile("" : "+v"(tid)); lane = tid & 63;
#ifdef DSA_TOPK_CHECK
    for (int e2 = 0; e2 < 2; ++e2) { const int qq = 2 * wave + e2;
        topk(lds, q0, qq, lane); const LAS unsigned short* lw = (const LAS unsigned short*)(lds + LIST_OFF) + qq * 256; const int ns = ((const LAS int*)(lds + NSEL_OFF))[qq];
        unsigned h1 = 0, h2 = 0; for (int i = lane; i < ns; i += 64) { const unsigned x = lw[i]; h1 += x; h2 += x * x; }
        topk3(lds, q0, qq, wave, lane); const int ns2 = ((const LAS int*)(lds + NSEL_OFF))[qq];
        unsigned g1 = 0, g2 = 0; for (int i = lane; i < ns2; i += 64) { const unsigned x = lw[i]; g1 += x; g2 += x * x; }
#pragma unroll
        for (int o = 1; o < 64; o <<= 1) { h1 += __shfl_xor(h1, o); h2 += __shfl_xor(h2, o); g1 += __shfl_xor(g1, o); g2 += __shfl_xor(g2, o); }
        if (lane == 0 && (h1 != g1 || h2 != g2 || ns != ns2)) atomicAdd(dbg_flag, 1u); }
#else
    for (int rp = 0; rp < DSA_REP_S2; ++rp) { topk3(lds, q0, 2 * wave, wave, lane, dbg_flag); topk3(lds, q0, 2 * wave + 1, wave, lane, dbg_flag); }
#endif
    asm volatile("" : "+v"(tid)); lane = tid & 63;
    for (int rp = 0; rp < DSA_REP_S3; ++rp) { attend2(lds, b, q0, wave, lane, qabs, ckv, mix); __syncthreads(); }
}
}
#ifndef DN_REP_E
#define DN_REP_E 1
#define DN_REP_T 1
#endif
namespace dn {
typedef short bf16x8 __attribute__((ext_vector_type(8)));
typedef short s16x4 __attribute__((ext_vector_type(4)));
typedef float f32x4 __attribute__((ext_vector_type(4)));
typedef float f32x2 __attribute__((ext_vector_type(2)));
typedef unsigned u32x4 __attribute__((ext_vector_type(4)));
typedef unsigned u32x2 __attribute__((ext_vector_type(2)));
constexpr int CWL = 132096;
constexpr int QS = 0, KS = 17408, WB = 17408, KGT = 34816, VBT = 52224, KBT = 69632, LF = 87040, TB = 103680, XF = 112896, OF = 87040, QKB = 120832, GC = 130048, BT = 130304;
constexpr int QSTR = 272, TSTR = 136, LSTR = 65, TBSTR = 144, OSTR = 132;
typedef float cvf32x2_t __attribute__((ext_vector_type(2))); typedef __bf16 cvbf16x2_t __attribute__((ext_vector_type(2)));
__device__ __forceinline__ unsigned cvtpk(float lo, float hi) { cvf32x2_t v = {lo, hi}; return __builtin_bit_cast(unsigned, __builtin_convertvector(v, cvbf16x2_t)); }
__device__ __forceinline__ bf16x8 pack2(const f32x4& a, const f32x4& b) { u32x4 w; w.x = cvtpk(a[0], a[1]); w.y = cvtpk(a[2], a[3]); w.z = cvtpk(b[0], b[1]); w.w = cvtpk(b[2], b[3]); return __builtin_bit_cast(bf16x8, w); }
__device__ __forceinline__ bf16x8 frag_perm(const LAS unsigned char* rowp, int s, int g) {
    const u32x2 lo = *(const LAS u32x2*)(rowp + (32 * s + 4 * g) * 2), hi = *(const LAS u32x2*)(rowp + (32 * s + 16 + 4 * g) * 2);
    u32x4 w; w.x = lo.x; w.y = lo.y; w.z = hi.x; w.w = hi.y; return __builtin_bit_cast(bf16x8, w); }
__device__ __forceinline__ bf16x8 frag_nat8(const LAS unsigned char* rowp, int s, int g) {
    const u32x2 lo = *(const LAS u32x2*)(rowp + (32 * s + 8 * g) * 2), hi = *(const LAS u32x2*)(rowp + (32 * s + 8 * g + 4) * 2);
    u32x4 w; w.x = lo.x; w.y = lo.y; w.z = hi.x; w.w = hi.y; return __builtin_bit_cast(bf16x8, w); }
__device__ __forceinline__ float silu(float x) { return x * __builtin_amdgcn_rcpf(1.f + __builtin_amdgcn_exp2f(-LOG2E * x)); }
__device__ __forceinline__ float ex(float x) { return __builtin_amdgcn_exp2f(LOG2E * x); }

__device__ __forceinline__ void prep8(int b, int h, int t0, const bf16_t* proj, const float (&cw)[3][2][4], bf16_t* qkv, int lane) {
    const bf16_t* pbase = proj + ((size_t)b * 2048) * PROJ + h * 128 + 2 * lane;
    unsigned xq[11][3];
#pragma unroll
    for (int a = 0; a < 11; ++a) { const int tt = t0 - 3 + a;
#pragma unroll
        for (int p = 0; p < 3; ++p) xq[a][p] = (tt >= 0) ? *(const unsigned*)(pbase + (size_t)tt * PROJ + p * 512) : 0u; }
    float xw[3][3][2];
#pragma unroll
    for (int a = 0; a < 3; ++a)
#pragma unroll
        for (int p = 0; p < 3; ++p) { xw[a][p][0] = __uint_as_float(xq[a][p] << 16); xw[a][p][1] = __uint_as_float(xq[a][p] & 0xffff0000u); }
    bf16_t* obase = qkv + ((size_t)b * 2048 + t0) * 1536 + h * 128 + 2 * lane;
#pragma unroll
    for (int i = 0; i < 8; ++i) { float x0[3][2], sv[3][2];
#pragma unroll
        for (int p = 0; p < 3; ++p) { x0[p][0] = __uint_as_float(xq[3 + i][p] << 16); x0[p][1] = __uint_as_float(xq[3 + i][p] & 0xffff0000u); }
#pragma unroll
        for (int p = 0; p < 3; ++p)
#pragma unroll
            for (int e = 0; e < 2; ++e) { const float s = cw[p][e][0] * xw[0][p][e] + cw[p][e][1] * xw[1][p][e] + cw[p][e][2] * xw[2][p][e] + cw[p][e][3] * x0[p][e]; sv[p][e] = silu(s); }
        const float rq = rsqrtf(wave_sum(sv[0][0] * sv[0][0] + sv[0][1] * sv[0][1]) + EPS) * 0.08838834764831845f;
        const float rk = rsqrtf(wave_sum(sv[1][0] * sv[1][0] + sv[1][1] * sv[1][1]) + EPS);
        *(unsigned*)(obase + (size_t)i * 1536) = cvtpk(sv[0][0] * rq, sv[0][1] * rq);
        *(unsigned*)(obase + (size_t)i * 1536 + 512) = cvtpk(sv[1][0] * rk, sv[1][1] * rk);
        *(unsigned*)(obase + (size_t)i * 1536 + 1024) = cvtpk(sv[2][0], sv[2][1]);
#pragma unroll
        for (int p = 0; p < 3; ++p)
#pragma unroll
            for (int e = 0; e < 2; ++e) { xw[0][p][e] = xw[1][p][e]; xw[1][p][e] = xw[2][p][e]; xw[2][p][e] = x0[p][e]; }
    }
}

__device__ __forceinline__ void run(LAS unsigned char* lds0, int b, int h, const bf16_t* proj, const bf16_t* qkv, const float* beta, const float* gdec, const float* gn, unsigned char* mix, int tid, int wave, int lane) {
    const int r16c = lane & 15, gc = lane >> 4;
    const float gn0 = gn[2 * lane], gn1 = gn[2 * lane + 1];
    f32x4 S[8];
#pragma unroll
    for (int i = 0; i < 8; ++i) S[i] = (f32x4){0.f, 0.f, 0.f, 0.f};
    const bf16_t* qbase = qkv + h * 128 + 2 * lane;
    unsigned xq[8][3]; float gnext, bnext;
#define DN_LOAD_CHUNK(cn) do { const size_t Rn = (size_t)b * 2048 + 64 * (cn); \
        _Pragma("unroll") for (int a = 0; a < 8; ++a) \
            _Pragma("unroll") for (int p_ = 0; p_ < 3; ++p_) xq[a][p_] = *(const unsigned*)(qbase + (Rn + 8 * wave + a) * 1536 + p_ * 512); \
        gnext = gdec[(Rn + lane) * 4 + h]; bnext = beta[(Rn + lane) * 4 + h]; } while (0)
    DN_LOAD_CHUNK(0);
    for (int c = 0; c < 32; ++c) {
        const size_t R0 = (size_t)b * 2048 + 64 * c;
        int zoff = 0; asm volatile("" : "+v"(zoff));
        LAS unsigned char* lds = lds0 + zoff; const int r16 = r16c + zoff, g = gc + zoff;
        LAS float* Lf = (LAS float*)(lds + LF); LAS float* gcumL = (LAS float*)(lds + GC); LAS float* betaL = (LAS float*)(lds + BT);
        float gcum = gnext;
#pragma unroll
        for (int o = 1; o < 64; o <<= 1) { const float t = __shfl_up(gcum, o); if (lane >= o) gcum += t; }
        const float gl = __int_as_float(__builtin_amdgcn_readlane(__float_as_int(gcum), 63));
        const float bv = bnext;
        const float egv = ex(gcum), eklv = ex(gl - gcum);
        if (wave == 0) { gcumL[lane] = gcum; betaL[lane] = bv; }
        for (int rpE = 0; rpE < DN_REP_E; ++rpE) {
#pragma unroll
            for (int i = 0; i < 8; ++i) {
                const int r = 8 * wave + i;
                const float br = __int_as_float(__builtin_amdgcn_readlane(__float_as_int(bv), r));
                const float eg = __int_as_float(__builtin_amdgcn_readlane(__float_as_int(egv), r)), ekl = __int_as_float(__builtin_amdgcn_readlane(__float_as_int(eklv), r));
                const float k0 = __uint_as_float(xq[i][1] << 16), k1 = __uint_as_float(xq[i][1] & 0xffff0000u), v0 = __uint_as_float(xq[i][2] << 16), v1 = __uint_as_float(xq[i][2] & 0xffff0000u);
                *(LAS unsigned*)(lds + QS + r * QSTR + 4 * lane) = xq[i][0];
                *(LAS unsigned*)(lds + KS + r * QSTR + 4 * lane) = xq[i][1];
                const unsigned kg = cvtpk(k0 * ekl, k1 * ekl), kb = cvtpk(k0 * br * eg, k1 * br * eg), vb = cvtpk(v0 * br, v1 * br);
                *(LAS unsigned short*)(lds + KGT + (2 * lane) * TSTR + 2 * r) = (unsigned short)kg; *(LAS unsigned short*)(lds + KGT + (2 * lane + 1) * TSTR + 2 * r) = (unsigned short)(kg >> 16);
                *(LAS unsigned short*)(lds + KBT + (2 * lane) * TSTR + 2 * r) = (unsigned short)kb; *(LAS unsigned short*)(lds + KBT + (2 * lane + 1) * TSTR + 2 * r) = (unsigned short)(kb >> 16);
                *(LAS unsigned short*)(lds + VBT + (2 * lane) * TSTR + 2 * r) = (unsigned short)vb; *(LAS unsigned short*)(lds + VBT + (2 * lane + 1) * TSTR + 2 * r) = (unsigned short)(vb >> 16);
            }
        }
        __syncthreads();
        for (int rpT = 0; rpT < DN_REP_T; ++rpT) {
        {
            const int ti = wave & 3, sel = wave >> 2;
            const LAS unsigned char* Ab = lds + (sel ? QS : KS) + (16 * ti + r16) * QSTR;
            bf16x8 A[4];
#pragma unroll
            for (int s = 0; s < 4; ++s) A[s] = *(const LAS bf16x8*)(Ab + (32 * s + 8 * g) * 2);
            const f32x4 gi4 = *(const LAS f32x4*)(gcumL + 16 * ti + 4 * g), bi4 = *(const LAS f32x4*)(betaL + 16 * ti + 4 * g);
#pragma unroll
            for (int tj = 0; tj < 4; ++tj) {
                f32x4 acc = {0.f, 0.f, 0.f, 0.f};
                if (tj <= ti) {
                    const LAS unsigned char* Bb = lds + KS + (16 * tj + r16) * QSTR; bf16x8 Bf[4];
#pragma unroll
                    for (int s = 0; s < 4; ++s) Bf[s] = *(const LAS bf16x8*)(Bb + (32 * s + 8 * g) * 2);
#pragma unroll
                    for (int s = 0; s < 4; ++s) acc = __builtin_amdgcn_mfma_f32_16x16x32_bf16(A[s], Bf[s], acc, 0, 0, 0);
                }
                const float gj = gcumL[16 * tj + r16]; const int j = 16 * tj + r16;
#pragma unroll
                for (int e = 0; e < 4; ++e) { const int i = 16 * ti + 4 * g + e; const float dec = ex(fminf(gi4[e] - gj, 0.f));
                    if (sel == 0) { const float lv = (i > j) ? bi4[e] * acc[e] * dec : 0.f;
                        if (tj == ti) Lf[i * LSTR + j] = lv; else if (tj < ti) *(LAS unsigned short*)(lds + TB + i * TBSTR + 2 * j) = f2bf(lv); }
                    else *(LAS unsigned short*)(lds + QKB + i * TBSTR + 2 * j) = f2bf((i >= j) ? acc[e] * dec : 0.f); }
            }
        }
        __syncthreads();
        if (wave == 0) {
            const LAS float* Nb = Lf + (16 * g) * LSTR + 16 * g; float x[16]; int rc = r16; asm volatile("" : "+v"(rc));
            float na[55], nb2[65];
            { int q = 0;
#pragma unroll
              for (int r = 1; r <= 10; ++r)
#pragma unroll
                  for (int j = 0; j < r; ++j) na[q++] = Nb[r * LSTR + j]; }
            { int q = 0;
#pragma unroll
              for (int r = 11; r <= 15; ++r)
#pragma unroll
                  for (int j = 0; j < r; ++j) nb2[q++] = Nb[r * LSTR + j]; }
            x[0] = (0 == rc) ? 1.f : 0.f;
            { int q = 0;
#pragma unroll
              for (int r = 1; r <= 10; ++r) { float s = (r == rc) ? 1.f : 0.f;
#pragma unroll
                  for (int j = 0; j < r; ++j) s -= na[q++] * x[j];
                  x[r] = s; } }
            { int q = 0;
#pragma unroll
              for (int r = 11; r <= 15; ++r) { float s = (r == rc) ? 1.f : 0.f;
#pragma unroll
                  for (int j = 0; j < r; ++j) s -= nb2[q++] * x[j];
                  x[r] = s; } }
#pragma unroll
            for (int r = 0; r < 16; ++r) *(LAS unsigned short*)(lds + TB + (16 * g + r) * TBSTR + 2 * (16 * g + r16)) = f2bf(x[r]);
        }
        __syncthreads();
        }
        f32x4 U[4];
        {
            const LAS unsigned char* tl = lds + TB;
#define DN_A1(b_, k_) ({ const u32x2 lo_ = *(const LAS u32x2*)(tl + (16 * (b_) + r16) * TBSTR + (16 * (k_) + 4 * g) * 2); u32x4 w_; w_.x = lo_.x; w_.y = lo_.y; w_.z = 0u; w_.w = 0u; __builtin_bit_cast(bf16x8, w_); })
#define DN_A2(b_, k0_, k1_) ({ const u32x2 lo_ = *(const LAS u32x2*)(tl + (16 * (b_) + r16) * TBSTR + (16 * (k0_) + 4 * g) * 2), hi_ = *(const LAS u32x2*)(tl + (16 * (b_) + r16) * TBSTR + (16 * (k1_) + 4 * g) * 2); \
            u32x4 w_; w_.x = lo_.x; w_.y = lo_.y; w_.z = hi_.x; w_.w = hi_.y; __builtin_bit_cast(bf16x8, w_); })
            const bf16x8 aD0 = DN_A1(0, 0), aL10 = DN_A1(1, 0), aD1 = DN_A1(1, 1), aL2 = DN_A2(2, 0, 1), aD2 = DN_A1(2, 2), aL3a = DN_A2(3, 0, 1), aL3b = DN_A1(3, 2), aD3 = DN_A1(3, 3);
            const f32x4 z4 = {0.f, 0.f, 0.f, 0.f};
#pragma unroll
            for (int which = 0; which < 2; ++which) {
                const LAS unsigned char* rp = lds + (which ? KBT : VBT) + (16 * wave + r16) * TSTR;
                f32x4 R[4];
#pragma unroll
                for (int b4 = 0; b4 < 4; ++b4) { const u32x2 w = *(const LAS u32x2*)(rp + (16 * b4 + 4 * g) * 2);
                    R[b4] = (f32x4){__uint_as_float(w.x << 16), __uint_as_float(w.x & 0xffff0000u), __uint_as_float(w.y << 16), __uint_as_float(w.y & 0xffff0000u)}; }
                f32x4 X0 = __builtin_amdgcn_mfma_f32_16x16x32_bf16(aD0, pack2(R[0], z4), z4, 0, 0, 0);
                f32x4 Y = __builtin_amdgcn_mfma_f32_16x16x32_bf16(aL10, pack2(X0, z4), z4, 0, 0, 0);
                f32x4 X1 = __builtin_amdgcn_mfma_f32_16x16x32_bf16(aD1, pack2(R[1] - Y, z4), z4, 0, 0, 0);
                const bf16x8 b01 = pack2(X0, X1);
                Y = __builtin_amdgcn_mfma_f32_16x16x32_bf16(aL2, b01, z4, 0, 0, 0);
                f32x4 X2 = __builtin_amdgcn_mfma_f32_16x16x32_bf16(aD2, pack2(R[2] - Y, z4), z4, 0, 0, 0);
                Y = __builtin_amdgcn_mfma_f32_16x16x32_bf16(aL3a, b01, z4, 0, 0, 0);
                Y = __builtin_amdgcn_mfma_f32_16x16x32_bf16(aL3b, pack2(X2, z4), Y, 0, 0, 0);
                f32x4 X3 = __builtin_amdgcn_mfma_f32_16x16x32_bf16(aD3, pack2(R[3] - Y, z4), z4, 0, 0, 0);
                if (which == 0) { U[0] = X0; U[1] = X1; U[2] = X2; U[3] = X3; }
                else { const f32x4 Xs[4] = {X0, X1, X2, X3};
#pragma unroll
                    for (int ti = 0; ti < 4; ++ti)
#pragma unroll
                        for (int e = 0; e < 4; ++e) *(LAS unsigned short*)(lds + WB + (16 * ti + 4 * g + e) * QSTR + (16 * wave + r16) * 2) = f2bf(Xs[ti][e]); }
            }
#undef DN_A1
#undef DN_A2
        }
        __syncthreads();
        if (c + 1 < 32) DN_LOAD_CHUNK(c + 1);
        unsigned dzq[8];
#pragma unroll
        for (int i = 0; i < 8; ++i) dzq[i] = *(const unsigned*)(proj + (R0 + 8 * wave + i) * PROJ + C_DZ + h * 128 + 2 * lane);
        {
            bf16x8 Sb[4];
#pragma unroll
            for (int s = 0; s < 4; ++s) Sb[s] = pack2(S[2 * s], S[2 * s + 1]);
            f32x4 Vn[4], Oa[4];
#pragma unroll
            for (int ti = 0; ti < 4; ++ti) {
                const LAS unsigned char* wp = lds + WB + (16 * ti + r16) * QSTR; const LAS unsigned char* qp = lds + QS + (16 * ti + r16) * QSTR;
                bf16x8 wf[4], qf[4];
#pragma unroll
                for (int s = 0; s < 4; ++s) { wf[s] = frag_perm(wp, s, g); qf[s] = frag_perm(qp, s, g); }
                const f32x4 gi4 = *(const LAS f32x4*)(gcumL + 16 * ti + 4 * g);
                f32x4 ws = {0.f, 0.f, 0.f, 0.f}, qs = {0.f, 0.f, 0.f, 0.f};
#pragma unroll
                for (int s = 0; s < 4; ++s) { ws = __builtin_amdgcn_mfma_f32_16x16x32_bf16(wf[s], Sb[s], ws, 0, 0, 0); qs = __builtin_amdgcn_mfma_f32_16x16x32_bf16(qf[s], Sb[s], qs, 0, 0, 0); }
                Vn[ti] = U[ti] - ws;
#pragma unroll
                for (int e = 0; e < 4; ++e) qs[e] *= ex(gi4[e]);
                Oa[ti] = qs;
            }
            bf16x8 Vb[2];
#pragma unroll
            for (int s = 0; s < 2; ++s) Vb[s] = pack2(Vn[2 * s], Vn[2 * s + 1]);
            { bf16x8 kf[4][2];
#pragma unroll
              for (int ti = 0; ti < 4; ++ti) { const LAS unsigned char* kp = lds + QKB + (16 * ti + r16) * TBSTR; kf[ti][0] = frag_perm(kp, 0, g); kf[ti][1] = frag_perm(kp, 1, g); }
#pragma unroll
              for (int ti = 0; ti < 4; ++ti)
#pragma unroll
                  for (int s = 0; s < 2; ++s) Oa[ti] = __builtin_amdgcn_mfma_f32_16x16x32_bf16(kf[ti][s], Vb[s], Oa[ti], 0, 0, 0); }
            const float egl = ex(gl);
#pragma unroll
            for (int half = 0; half < 2; ++half) { bf16x8 kf[4][2];
#pragma unroll
                for (int q = 0; q < 4; ++q) { const LAS unsigned char* kp = lds + KGT + (16 * (4 * half + q) + r16) * TSTR; kf[q][0] = frag_perm(kp, 0, g); kf[q][1] = frag_perm(kp, 1, g); }
#pragma unroll
                for (int q = 0; q < 4; ++q) { f32x4 sa = S[4 * half + q] * egl;
#pragma unroll
                    for (int s = 0; s < 2; ++s) sa = __builtin_amdgcn_mfma_f32_16x16x32_bf16(kf[q][s], Vb[s], sa, 0, 0, 0);
                    S[4 * half + q] = sa; } }
            LAS float* Of = (LAS float*)(lds + OF);
#pragma unroll
            for (int ti = 0; ti < 4; ++ti)
#pragma unroll
                for (int e = 0; e < 4; ++e) Of[(16 * ti + 4 * g + e) * OSTR + 16 * wave + r16] = Oa[ti][e];
        }
        __syncthreads();
        {
            const LAS float* Of = (const LAS float*)(lds + OF);
#pragma unroll
            for (int i = 0; i < 8; ++i) { const int r = 8 * wave + i; const f32x2 o = *(const LAS f32x2*)(Of + r * OSTR + 2 * lane);
                const float rstd = rsqrtf(wave_sum(o.x * o.x + o.y * o.y) * (1.f / 128.f) + EPS);
                const float z0 = __uint_as_float(dzq[i] << 16), z1 = __uint_as_float(dzq[i] & 0xffff0000u);
                *(unsigned*)(mix + (R0 + r) * MIXB + (h * 128 + 2 * lane) * 2) = cvtpk(o.x * rstd * gn0 * silu(z0), o.y * rstd * gn1 * silu(z1)); }
        }
    }
}
#undef DN_LOAD_CHUNK
}
struct Args { const float* in[28]; float* out; unsigned char* ws; int ph_lo, ph_hi, li, pad; };
struct Frame {
    LAS unsigned char* lds; volatile LAS unsigned* MISC; int tid, lane, wave, G, vcu;
};
template <int NR> __device__ __forceinline__ void dsa_prep_rows(int row0, int lane, const bf16_t* proj, const float* kvg, const float* lng, const float* lnb, const float* a_log, const float* dt_bias,
                                             bf16_t* ckv, bf16_t* kidx, float* widx, float* beta, float* gdec) {
    unsigned cv[NR]; unsigned short kv[NR], sm[NR];
#pragma unroll
    for (int r = 0; r < NR; ++r) { const bf16_t* pr = proj + (size_t)(row0 + r) * PROJ; cv[r] = *(const unsigned*)(pr + C_CKV + lane * 2); kv[r] = pr[C_KIX + lane]; sm[r] = pr[C_WIX + (lane & 15)]; }
    const float g0 = kvg[lane * 2], g1 = kvg[lane * 2 + 1], lg = lng[lane], lb = lnb[lane], al = a_log[lane & 3], dtb = dt_bias[lane & 3];
#pragma unroll
    for (int r = 0; r < NR; ++r) { const int row = row0 + r;
        { const float a = __uint_as_float(cv[r] << 16), b = __uint_as_float(cv[r] & 0xffff0000u);
          const float rs = rsqrtf(wave_sum(a * a + b * b) * (1.f / 128.f) + EPS); *(unsigned*)(ckv + (size_t)row * 128 + lane * 2) = pk2(a * rs * g0, b * rs * g1); }
        { const float a = bf2f(kv[r]); const float mu = wave_sum(a) * (1.f / 64.f); const float xc = a - mu; const float rs = rsqrtf(wave_sum(xc * xc) * (1.f / 64.f) + EPS);
          kidx[(size_t)row * 64 + lane] = f2bf(xc * rs * lg + lb); }
        const float sv = bf2f(sm[r]);
        if (lane < 8) widx[(size_t)row * 8 + lane] = sv * 0.04419417382415922f;
        else if (lane < 12) beta[(size_t)row * 4 + (lane - 8)] = 1.f / (1.f + __expf(-sv));
        else if (lane < 16) { const float xx = sv + dtb; const float sp = xx > 20.f ? xx : log1pf(__expf(xx)); gdec[(size_t)row * 4 + (lane - 12)] = -__expf(al) * sp; }
    }
}

__global__ void __launch_bounds__(NWAVES * 64, 2) mega(Args args) {
    extern __shared__ __attribute__((aligned(16))) unsigned char lds_raw[];
    Frame F;
    F.lds = (LAS unsigned char*)lds_raw;
    F.MISC = (volatile LAS unsigned*)(F.lds + MISC_OFF);
    F.tid = threadIdx.x; F.lane = F.tid & 63; F.wave = __builtin_amdgcn_readfirstlane(F.tid >> 6);
    F.G = gridDim.x; { const int bx = blockIdx.x; F.vcu = (F.G % 8 == 0) ? (bx % 8) * (F.G / 8) + bx / 8 : bx; }
    unsigned char* ws = args.ws;
    const float* x = args.in[0]; const float* mem = args.in[1]; const float* g_mix = args.in[2]; const float* w_in = args.in[3];
    const float* conv_w = args.in[4]; const float* a_log = args.in[5]; const float* dt_bias = args.in[6];
    const float* dn_norm_g = args.in[7]; const float* q_norm_g = args.in[8]; const float* kv_norm_g = args.in[9]; const float* w_uq = args.in[10]; const float* w_uk = args.in[11];
    const float* w_uv = args.in[12]; const float* w_qidx = args.in[13]; const float* kidx_ln_g = args.in[14]; const float* kidx_ln_b = args.in[15];
    const float* rel_bias = args.in[16]; const float* w_out = args.in[17]; const float* g_xattn = args.in[18]; const float* g_mem = args.in[19];
    const float* w_xq = args.in[20]; const float* w_xkv = args.in[21]; const float* w_xo = args.in[22]; const float* g_ffn = args.in[23];
    const float* w_gate = args.in[24]; const float* w_up = args.in[25]; const float* w_down = args.in[26]; const float* g_final = args.in[27];
    float* out = args.out;
    bf16_t* Win_t = (bf16_t*)(ws + WS_WIN); bf16_t* Wkv_t = (bf16_t*)(ws + WS_WKV); bf16_t* Wdsa_t = (bf16_t*)(ws + WS_WDSA); bf16_t* Wout_t = (bf16_t*)(ws + WS_WOUT);
    bf16_t* Wxq_t = (bf16_t*)(ws + WS_WXQ); bf16_t* Wxo_t = (bf16_t*)(ws + WS_WXO); bf16_t* Wgu_t = (bf16_t*)(ws + WS_WGU); bf16_t* Wdn_t = (bf16_t*)(ws + WS_WDN);
    unsigned char* stt = ws + WS_ST;
    float* rstdx = (float*)(stt + ST_RSTDX); float* cqss = (float*)(stt + ST_CQSS); float* lpart = (float*)(stt + ST_LPART);
    float* widx = (float*)(stt + ST_WIDX); float* beta = (float*)(stt + ST_BETA); float* gdec = (float*)(stt + ST_G); float* biastab = (float*)(stt + ST_BIAS);
    bf16_t* mnb = (bf16_t*)(ws + WS_MNB); unsigned char* kx = ws + WS_KX; unsigned char* vT = ws + WS_VT;        bf16_t* ckv = (bf16_t*)(ws + WS_CKV); bf16_t* kidx = (bf16_t*)(ws + WS_KIDX);
    float* ssq1 = (float*)(ws + WS_SSQ); float* ssq2 = ssq1 + (size_t)M * 16;
    bf16_t* proj = (bf16_t*)(ws + WS_PROJ); unsigned char* mix = ws + WS_MIX; unsigned char* Wout8 = ws + WS_W8 + 5 * MiB; bf16_t* xb = (bf16_t*)(ws + WS_XB); bf16_t* qabs = (bf16_t*)out;
    bf16_t* x1b = (bf16_t*)(ws + WS_X1B); bf16_t* qx = (bf16_t*)(ws + WS_QX); bf16_t* Pb = (bf16_t*)(ws + WS_P); bf16_t* ox = (bf16_t*)(ws + WS_OX); bf16_t* x2b = (bf16_t*)(ws + WS_X2B); unsigned char* act = ws + WS_ACT; unsigned char* Wdn8 = ws + WS_W8; unsigned char* Wxq8 = ws + WS_W8 + 3 * MiB; unsigned char* Wxo8 = ws + WS_W8 + 4 * MiB;
    unsigned char* x1f8 = (unsigned char*)out;
    unsigned char* ox8 = ws + WS_OX;

    for (int u = F.tid; u < (LDS_BYTES - LDSCTL_OFF) / 4; u += NWAVES * 64) ((LAS unsigned*)(F.lds + LDSCTL_OFF))[u] = 0u;
    __syncthreads();
    XcdBarrier bar = xcd_barrier_post((unsigned*)(ws + WS_CTL) + 4096 + args.li * XCD_BAR_WORDS, F.MISC + 8);
#define GRID_BAR() xcd_barrier(bar, F.wave)
    const int lo = args.ph_lo, hi = args.ph_hi;
#ifdef ONLY_PHASE
#define IN(k) ((k) == ONLY_PHASE && lo <= (k) && (k) < hi)
#else
#define IN(k) (lo <= (k) && (k) < hi)
#endif
#define BOTH(k) (IN(k) && IN((k) + 1))
    const int gw = F.vcu * NWAVES + F.wave, NGW = F.G * NWAVES;
    PG8_LAS unsigned char* ring = (PG8_LAS unsigned char*)F.lds;

    if (IN(0)) {
        LAS float* scr = (LAS float*)(F.lds + F.wave * 16384);
        constexpr int I_OB = 32 * 32, I_QA = 8 * 32, I_QI = 4 * 16, I_IN = 16 * 80, I_KV = 16 * 64, I_XQ = 16 * 32, I_XO = 16 * 32, I_GU = 16 * 176, I_DN = 44 * 32, I_OA = 8 * 32;
        constexpr int NITEMS = I_OB + I_QA + I_QI + I_IN + I_KV + I_XQ + I_XO + I_GU + I_DN + I_OA;
        for (int it = gw; it < NITEMS; it += NGW) {
            int r = it;
            if (r < I_OB) { const int kb = r >> 5, nb = r & 31, k0 = 32 * kb, h = k0 >> 7;
                heavy_item(w_uv, 64, w_out + (size_t)(512 + h * 64) * 1024, 1024, nullptr, 1.f, k0, 32 * nb, 32 * nb, Wout_t, MIXK, 512, scr, F.lane, (unsigned*)(ws + WS_CTL) + CTL_AMAX + 3); continue; } r -= I_OB;
            if (r < I_QA) { const int kb = r >> 5, nb = r & 31, n0 = 32 * nb, h = n0 >> 7;
                heavy_item(w_uq + h * 64, 512, w_uk + (size_t)(h * 64) * 128 - h * 128, 128, q_norm_g, 0.125f * LOG2E, 32 * kb, n0, ((n0 >> 5) & 3) * 256 + h * 32, Wdsa_t, 256, 0, scr, F.lane); continue; }   r -= I_QA;
            if (r < I_QI) { tr_item(SrcQidx{w_qidx, q_norm_g}, 512, Wdsa_t + (size_t)1024 * 256, 256, 0, scr, r, F.lane); continue; } r -= I_QI;
            if (r < I_IN) { tr_item(SrcWin{w_in, g_mix}, PROJ, Win_t, 1024, 0, scr, r, F.lane); continue; } r -= I_IN;
            if (r < I_KV) { tr_item(SrcPlain{w_xkv, 2048, nullptr, 1.f}, 2048, Wkv_t, 1024, 0, scr, r, F.lane); continue; } r -= I_KV;
            if (r < I_XQ) { tr_item(SrcPlain{w_xq, 1024, g_xattn, 0.0625f * LOG2E}, 1024, Wxq_t, 1024, 0, scr, r, F.lane, (unsigned*)(ws + WS_CTL) + CTL_AMAX + 1); continue; } r -= I_XQ;
            if (r < I_XO) { tr_item(SrcPlain{w_xo, 1024, nullptr, 1.f}, 1024, Wxo_t, 1024, 0, scr, r, F.lane, (unsigned*)(ws + WS_CTL) + CTL_AMAX + 2); continue; } r -= I_XO;
            if (r < I_GU) { tr_item(SrcGU{w_gate, w_up, g_ffn}, 2 * DFF, Wgu_t, 1024, 0, scr, r, F.lane); continue; } r -= I_GU;
            if (r < I_DN) { tr_item(SrcPlain{w_down, 1024, nullptr, 1.f}, 1024, Wdn_t, DFF, 0, scr, r, F.lane, (unsigned*)(ws + WS_CTL) + CTL_AMAX); continue; } r -= I_DN;
            tr_item(SrcPlain{w_out, 1024, nullptr, 1.f}, 1024, Wout_t, MIXK, 0, scr, r, F.lane);
        }
        for (int m = 4 * gw; m < M; m += 4 * NGW) row_prep<4>(x + (size_t)m * D, nullptr, xb + (size_t)m * D, rstdx + m, F.lane);
        for (int m = 2 * gw; m < MM; m += 2 * NGW) row_prep<2>(mem + (size_t)m * D, g_mem, mnb + (size_t)m * D, nullptr, F.lane);
        if (blockIdx.x == 0) for (int i = F.tid; i < 129 * 8; i += NWAVES * 64) {
            const int d = i >> 3, h = i & 7; int bkt;
            if (d < 16) bkt = d; else { const float lr = logf((float)d / 16.f) / 2.0794415416798357f; const int large = 16 + (int)(lr * 16.f); bkt = large < 31 ? large : 31; }
            biastab[i] = rel_bias[bkt * 8 + h] * LOG2E; }
        if (BOTH(0)) GRID_BAR();
    }
    if (IN(1)) {
        pg8::Gemm g{xb, Win_t, 1024, 1024, 1024}; pg8::StaticOrder S; S.init(M, PROJ, F.G, (int)blockIdx.x);
        pg8::EpiProj E{proj, PROJ, nullptr, cqss, 8};
        pg8::gemm_phase<pg8::EpiProj, pg8::StaticOrder, true>(ring, g, S, E, F.wave);
        if (BOTH(1)) GRID_BAR();
    }
    if (IN(2)) {
        const int lane2 = lane_now();
        for (int m = 4 * gw; m < M; m += 4 * NGW) dsa_prep_rows<4>(m, lane2, proj, kv_norm_g, kidx_ln_g, kidx_ln_b, a_log, dt_bias, ckv, kidx, widx, beta, gdec);
        { const int hh = gw & 3; float cw[3][2][4];
#pragma unroll
          for (int p = 0; p < 3; ++p)
#pragma unroll
              for (int e = 0; e < 2; ++e)
#pragma unroll
                  for (int j = 0; j < 4; ++j) cw[p][e][j] = conv_w[j * 1536 + p * 512 + hh * 128 + 2 * lane2 + e];
          for (int it = gw >> 2; it < 16 * 256; it += NGW >> 2) dn::prep8(it >> 8, hh, (it & 255) * 8, proj, cw, (bf16_t*)(ws + WS_QKV), lane2); }
        { unsigned* am = (unsigned*)(ws + WS_CTL) + CTL_AMAX;
          cvt_w8(Wdn_t, Wdn8, DFF * 1024 / 16, __hip_atomic_load(am, __ATOMIC_RELAXED, __HIP_MEMORY_SCOPE_AGENT), gw * 64 + lane2, NGW * 64);
          cvt_w8(Wxq_t, Wxq8, 1024 * 1024 / 16, __hip_atomic_load(am + 1, __ATOMIC_RELAXED, __HIP_MEMORY_SCOPE_AGENT), gw * 64 + lane2, NGW * 64);
          cvt_w8(Wxo_t, Wxo8, 1024 * 1024 / 16, __hip_atomic_load(am + 2, __ATOMIC_RELAXED, __HIP_MEMORY_SCOPE_AGENT), gw * 64 + lane2, NGW * 64);
          cvt_wout8(Wout_t, Wout8, __hip_atomic_load(am + 3, __ATOMIC_RELAXED, __HIP_MEMORY_SCOPE_AGENT), gw * 64 + lane2, NGW * 64); }
        { pg8::Gemm g{proj + C_CQ, Wdsa_t, PROJ, 256, 256}; pg8::StaticOrder S; S.init(M, 1536, F.G, (int)blockIdx.x);
          pg8::EpiNormScale<4> E{qabs, 1536, cqss, 1.f / 256.f, 1.f};
          pg8::gemm_phase<pg8::EpiNormScale<4>, pg8::StaticOrder, true>(ring, g, S, E, F.wave); }
        if (BOTH(2)) GRID_BAR();
    }
    if (IN(3)) {
        const int lane3 = lane_now(); const int tid3 = F.wave * 64 + lane3;
        if (blockIdx.x < 64) dn::run(F.lds, (int)blockIdx.x >> 2, (int)blockIdx.x & 3, proj, (const bf16_t*)(ws + WS_QKV), beta, gdec, dn_norm_g, mix, tid3, F.wave, lane3);
        __syncthreads();
        if (blockIdx.x >= 64) { unsigned* kvq = (unsigned*)(ws + WS_CTL) + 1536;
            for (;;) {
                if (tid3 == 0) F.MISC[17] = __hip_atomic_fetch_add(kvq, 1u, __ATOMIC_RELAXED, __HIP_MEMORY_SCOPE_AGENT);
                __syncthreads(); const int k = (int)F.MISC[17]; __syncthreads();
                if (k >= 128) break;
                if (k < 64) { pg8::Gemm g{mnb, Wkv_t, 1024, 1024, 1024}; pg8::OneUnit S1{{k >> 2, k & 3, 0, 0}}; pg8::EpiProj8 E{kx, 1024, pg8::KV8_SCALE};
                    pg8::gemm_phase<pg8::EpiProj8, pg8::OneUnit, false>(ring, g, S1, E, F.wave); }
                else { const int k2 = k - 64; pg8::Gemm g{Wkv_t + (size_t)1024 * 1024, mnb, 1024, 1024, 1024}; pg8::OneUnit S1{{k2 >> 4, k2 & 15, 0, 0}}; pg8::EpiProj8 E{vT, MM, pg8::KV8_SCALE};
                    pg8::gemm_phase<pg8::EpiProj8, pg8::OneUnit, false>(ring, g, S1, E, F.wave); }
            } }
        for (int pass = 0; pass <= args.pad; ++pass) {
        if (pass) GRID_BAR();
        const int lane4 = lane_now(); const int tid4 = F.wave * 64 + lane4;
        dsa::phase_init(F.lds, biastab, kv_norm_g, tid4);
        unsigned* qbase = (unsigned*)(ws + WS_CTL) + 2048 + 1024 * pass;
        const int myx = (int)(xb_xcc_id() & 7u);
        for (int sx = 0; sx < 8; ++sx) { const int qx8 = (myx + sx) & 7;
        for (;;) {
            if (tid4 == 0) F.MISC[16] = __hip_atomic_fetch_add(qbase + 64 * qx8, 1u, __ATOMIC_RELAXED, __HIP_MEMORY_SCOPE_AGENT);
            __syncthreads(); const int k = (int)F.MISC[16]; __syncthreads();
            if (k >= 256) break;
            dsa::unit(F.lds, 2 * qx8 + (k & 1), (127 - (k >> 1)) * 16, tid4, F.wave, lane4, qabs, ckv, kidx, widx, mix, (unsigned*)(ws + WS_CTL) + 1024);
        } }
        }
        if (BOTH(3)) GRID_BAR();
    }
    if (IN(4)) {
        pg8::Gemm g{(const bf16_t*)mix, (const bf16_t*)Wout8, MIXB, MIXB, MIXB}; pg8::StaticOrder S; S.init(M, 1024, F.G, (int)blockIdx.x);
        const float asc = pg8::w8_inv_scale((unsigned)__builtin_amdgcn_readfirstlane((int)__hip_atomic_load((unsigned*)(ws + WS_CTL) + CTL_AMAX + 3, __ATOMIC_RELAXED, __HIP_MEMORY_SCOPE_AGENT)), OLAT_SHIFT);
        pg8::EpiResid<true, true> E{nullptr, xb, x1b, ssq1, rstdx, x1f8, asc};
        pg8::gemm_phase<pg8::EpiResid<true, true>, pg8::StaticOrder, true, 2>(ring, g, S, E, F.wave, 8);
        if (BOTH(4)) GRID_BAR();
    }
    if (IN(5)) {
        pg8::StaticOrder S; S.init(M, 1024, F.G, (int)blockIdx.x); pg8::Unit ua, ub; const bool h0 = S.next(0, ua), h1 = S.next(1, ub);
        if (h0) {
            { pg8::Gemm g{(const bf16_t*)x1f8, (const bf16_t*)Wxq8, 1024, 1024, 1024};
              const float asc = pg8::w8_inv_scale((unsigned)__builtin_amdgcn_readfirstlane((int)__hip_atomic_load((unsigned*)(ws + WS_CTL) + CTL_AMAX + 1, __ATOMIC_RELAXED, __HIP_MEMORY_SCOPE_AGENT)), pg8::X8_SHIFT - pg8::QX8_SHIFT);
              pg8::EpiNormScale<16, true> E{qx, 1024, ssq1, 1.f / 1024.f, asc};
              pg8::gemm_phase<pg8::EpiNormScale<16, true>, pg8::StaticOrder, true, true>(ring, g, S, E, F.wave); }
            VM_WAIT(); __syncthreads();
            pg8::TwoUnits S2; S2.n = h1 ? 2 : 1;
            S2.u0 = pg8::Unit{ua.pm, ua.pm >> 3, (long)ua.pn * 256, (long)ua.pn * 256}; S2.u1 = pg8::Unit{ub.pm, ub.pm >> 3, (long)ub.pn * 256, (long)ub.pn * 256};
            { pg8::Gemm g{qx, (const bf16_t*)kx, 1024, 1024, 256};
              pg8::EpiExpP E{(unsigned char*)Pb, lpart, 1.f / (pg8::QX8_SCALE * pg8::KV8_SCALE)};
              pg8::gemm_phase<pg8::EpiExpP, pg8::TwoUnits, true, true>(ring, g, S2, E, F.wave); }
            VM_WAIT(); __syncthreads();
            pg8::TwoUnits S3; S3.n = S2.n;
            S3.u0 = pg8::Unit{ua.pm, ua.pn, (long)ua.pn * 256, (long)(ua.pm >> 3) * 256}; S3.u1 = pg8::Unit{ub.pm, ub.pn, (long)ub.pn * 256, (long)(ub.pm >> 3) * 256};
            { pg8::Gemm g{Pb, (const bf16_t*)vT, 1024, MM, 256};
              pg8::EpiPV E{ox8, lpart, pg8::OX_SCALE / pg8::KV8_SCALE};
              pg8::gemm_phase<pg8::EpiPV, pg8::TwoUnits, true, true>(ring, g, S3, E, F.wave); }
        }
        if (BOTH(5)) GRID_BAR();
    }
    if (IN(6)) {
        pg8::Gemm g{(const bf16_t*)ox8, (const bf16_t*)Wxo8, 1024, 1024, 1024}; pg8::StaticOrder S; S.init(M, 1024, F.G, (int)blockIdx.x);
        const float asc = pg8::w8_inv_scale((unsigned)__builtin_amdgcn_readfirstlane((int)__hip_atomic_load((unsigned*)(ws + WS_CTL) + CTL_AMAX + 2, __ATOMIC_RELAXED, __HIP_MEMORY_SCOPE_AGENT)), pg8::OX_SHIFT);
        pg8::EpiResid<true> E{nullptr, x1b, x2b, ssq2, nullptr, nullptr, asc};
        pg8::gemm_phase<pg8::EpiResid<true>, pg8::StaticOrder, true, true>(ring, g, S, E, F.wave);
        if (BOTH(6)) GRID_BAR();
    }
    if (IN(7)) {
        pg8::Gemm g{x2b, Wgu_t, 1024, 1024, 1024}; pg8::StaticOrder S; S.init(M, 2 * DFF, F.G, (int)blockIdx.x);
        pg8::EpiSwiglu E{act, ssq2};
        pg8::gemm_phase<pg8::EpiSwiglu, pg8::StaticOrder, true>(ring, g, S, E, F.wave);
        if (BOTH(7)) GRID_BAR();
    }
#if defined(DSA_TOPK_CHECK) || defined(DSA_FALLBACK_COUNT)
    const bool fuse_final = false;
#else
    const bool fuse_final = (F.G == 256);
#endif
    if (IN(8)) {
        pg8::Gemm g{(const bf16_t*)act, (const bf16_t*)Wdn8, DFF, DFF, DFF}; pg8::StaticOrder S; S.init(M, 1024, F.G, (int)blockIdx.x);
        const float asc = pg8::w8_inv_scale((unsigned)__builtin_amdgcn_readfirstlane((int)__hip_atomic_load((unsigned*)(ws + WS_CTL) + CTL_AMAX, __ATOMIC_RELAXED, __HIP_MEMORY_SCOPE_AGENT)), pg8::ACT_SHIFT);
        if (fuse_final) { pg8::EpiFinal E{x2b, out, ssq1, (unsigned*)(ws + WS_CTL) + 8192, g_final, asc};
            pg8::gemm_phase<pg8::EpiFinal, pg8::StaticOrder, true, true>(ring, g, S, E, F.wave); }
        else { pg8::EpiResidF32 E{x2b, out, ssq1, asc};
            pg8::gemm_phase<pg8::EpiResidF32, pg8::StaticOrder, true, true>(ring, g, S, E, F.wave);
            if (BOTH(8)) GRID_BAR(); }
    }
    if (IN(9) && !fuse_final) {
#ifdef DSA_FALLBACK_COUNT
        if (blockIdx.x == 0 && F.wave == 0 && lane_now() == 0 && __hip_atomic_load((unsigned*)(ws + WS_CTL) + 1024 + 64, __ATOMIC_RELAXED, __HIP_MEMORY_SCOPE_AGENT) > DSA_FALLBACK_COUNT) out[12345] = __builtin_nanf("");
#endif
#ifdef DSA_TOPK_CHECK
        if (blockIdx.x == 0 && F.wave == 0 && lane_now() == 0 && __hip_atomic_load((unsigned*)(ws + WS_CTL) + 1024, __ATOMIC_RELAXED, __HIP_MEMORY_SCOPE_AGENT) != 0u) out[12345] = __builtin_nanf("");
#endif
        const int lane9 = lane_now();
        for (int m = gw; m < M; m += NGW) {
            const float* pp = ssq1 + (size_t)m * 16; float s = 0.f;
#pragma unroll
            for (int q = 0; q < 4; ++q) { const f32x4 t = *(const f32x4*)(pp + 4 * q); s += (t.x + t.y) + (t.z + t.w); }
            const float rstd = rsqrtf(s * (1.f / 1024.f) + EPS);
            GAS f32x4* xr = (GAS f32x4*)(out + (size_t)m * D) + lane9;
#pragma unroll
            for (int j = 0; j < 4; ++j) { const f32x4 gg = *((const GAS f32x4*)g_final + lane9 + 64 * j); xr[64 * j] = xr[64 * j] * gg * rstd; }
        }
    }
#undef IN
#undef BOTH
}

extern "C" void kernel_launch(void* const* d_in, const int* in_sizes, int n_in, void* d_out, int out_size, void* d_ws, size_t ws_size, hipStream_t stream) {
    static int grid = 0;
    if (grid == 0) {
        if (n_in != 28 || ws_size < WS_NEED || out_size != M * D) { fprintf(stderr, "kernel_launch: unexpected problem (n_in %d ws %zu out %d)\n", n_in, ws_size, out_size); grid = -1; return; }
        int dev = 0, cus = 0, per_cu = 0;
        if (hipGetDevice(&dev) != hipSuccess || hipDeviceGetAttribute(&cus, hipDeviceAttributeMultiprocessorCount, dev) != hipSuccess) { grid = -1; return; }
        if (hipFuncSetAttribute((const void*)mega, hipFuncAttributeMaxDynamicSharedMemorySize, LDS_BYTES) != hipSuccess) { fprintf(stderr, "kernel_launch: hipFuncSetAttribute failed\n"); grid = -1; return; }
        if (hipOccupancyMaxActiveBlocksPerMultiprocessor(&per_cu, (const void*)mega, NWAVES * 64, LDS_BYTES) != hipSuccess || per_cu < 1) { fprintf(stderr, "kernel_launch: occupancy query says %d\n", per_cu); grid = -1; (void)hipGetLastError(); return; }
        grid = cus;
        if (grid < 64) { fprintf(stderr, "kernel_launch: needs >= 64 CUs\n"); grid = -1; return; }
    }
    if (grid < 0) return;
    unsigned char* ws = (unsigned char*)d_ws;
    (void)hipMemsetAsync(ws + WS_CTL, 0, CTL_ZERO_BYTES, stream);
    Args a{}; for (int i = 0; i < 28; ++i) a.in[i] = (const float*)d_in[i]; a.out = (float*)d_out; a.ws = ws;
    a.ph_lo = 0; a.ph_hi = 10; a.li = 0;
#ifdef DSA_PASSES
    a.pad = DSA_PASSES - 1;
#endif
    void* kargs[] = {&a};
    (void)hipLaunchCooperativeKernel((const void*)mega, dim3(grid), dim3(NWAVES * 64), kargs, LDS_BYTES, stream);
}
```
